# Optimizing an MI355X kernel written in HIP

```python
import math
import jax
import jax.numpy as jnp
from jax import lax
import numpy as np


D_MODEL = 1024
BATCH = 8
SEQ = 2048
DEPTH = 4

N_MIXERS = 3
N_MEM = 256
MIX_WIDTH = (3 * D_MODEL) // 4
XATTN_HEADS = 4
XATTN_WIDTH = D_MODEL - MIX_WIDTH
XATTN_HEAD_DIM = XATTN_WIDTH // XATTN_HEADS
CAT_WIDTH = MIX_WIDTH + XATTN_WIDTH

S5_GROUP = 16
S5_GROUPS = MIX_WIDTH // S5_GROUP
S5_STATE = 64
S5_DT_MIN = 1e-3
S5_DT_MAX = 1e-1
S5_IN = MIX_WIDTH

ML_HEADS = 4
ML_QK = MIX_WIDTH // 2
ML_DQK = ML_QK // ML_HEADS
ML_DV = MIX_WIDTH // ML_HEADS
ML_CONV = 4
ML_CHUNK = 64
ML_IN = 2 * ML_QK + 2 * MIX_WIDTH + 2 * ML_HEADS

RET_HEADS = 4
RET_QK = MIX_WIDTH // 2
RET_DQK = RET_QK // RET_HEADS
RET_DV = MIX_WIDTH // RET_HEADS
RET_CHUNK = 128
RET_IN = 2 * RET_QK + 2 * MIX_WIDTH
ROPE_BASE = 10000.0

N_EXPERTS = 32
TOP_K = 4
D_EXPERT = D_MODEL
SWIGLU_LIMIT = 7.0
SWIGLU_ALPHA = 1.702
MOE_BLOCK = 256

DEEPNORM_ALPHA = (2.0 * DEPTH) ** 0.25
DEEPNORM_BETA = (8.0 * DEPTH) ** -0.25
LN_EPS = 1e-5

kernel_name = 'hybrid_s5_mlstm_retention_moe_deepnorm'


def layer_norm(h, g, b):
    hf = h.astype(jnp.float32)
    mu = jnp.mean(hf, axis=-1, keepdims=True)
    var = jnp.mean(jnp.square(hf - mu), axis=-1, keepdims=True)
    return ((hf - mu) * lax.rsqrt(var + LN_EPS) * g + b).astype(h.dtype)


def head_norm(h, g):
    hf = h.astype(jnp.float32)
    mu = jnp.mean(hf, axis=-1, keepdims=True)
    var = jnp.mean(jnp.square(hf - mu), axis=-1, keepdims=True)
    return ((hf - mu) * lax.rsqrt(var + LN_EPS)).astype(h.dtype) * g.reshape(h.shape[-2], h.shape[-1])


def to_chunks(t, chunk):
    b, l, nh, d = t.shape
    return t.reshape(b, l // chunk, chunk, nh, d).transpose(0, 3, 1, 2, 4)


def from_chunks(t):
    b, nh, nc, cl, d = t.shape
    return t.transpose(0, 2, 3, 1, 4).reshape(b, nc * cl, nh, d)


def rope_tables(positions, dim):
    inv = ROPE_BASE ** (-jnp.arange(0, dim, 2, dtype=jnp.float32) / dim)
    ang = positions.astype(jnp.float32)[..., None] * inv
    return jnp.cos(ang)[:, :, None, :], jnp.sin(ang)[:, :, None, :]


def apply_rope(t, cos, sin):
    t1, t2 = jnp.split(t, 2, axis=-1)
    return jnp.concatenate([t1 * cos - t2 * sin, t2 * cos + t1 * sin], axis=-1)


def causal_dwconv(t, w):
    return lax.conv_general_dilated(t, w.astype(t.dtype)[:, None, :], window_strides=(1,),
                                    padding=[(w.shape[0] - 1, 0)],
                                    dimension_numbers=('NWC', 'WIO', 'NWC'),
                                    feature_group_count=t.shape[-1])


def _complex_linear_combine(e1, e2):
    a1r, a1i, b1r, b1i = e1
    a2r, a2i, b2r, b2i = e2
    return (a2r * a1r - a2i * a1i, a2r * a1i + a2i * a1r,
            a2r * b1r - a2i * b1i + b2r, a2r * b1i + a2i * b1r + b2i)


def s5_mixer(u, a_re, a_im, log_dt, b_re, b_im, c_re, c_im, d_skip, w_glu, b_glu):
    bsz, seqlen, _ = u.shape
    ug = u.reshape(bsz, seqlen, S5_GROUPS, S5_GROUP).astype(jnp.float32)
    lam_re = jnp.minimum(a_re.astype(jnp.float32), -1e-4)
    lam_im = a_im.astype(jnp.float32)
    dt = jnp.exp(log_dt.astype(jnp.float32))[:, None]
    mag = jnp.exp(dt * lam_re)
    ab_re = mag * jnp.cos(dt * lam_im)
    ab_im = mag * jnp.sin(dt * lam_im)
    den = lam_re * lam_re + lam_im * lam_im
    num_re = ab_re - 1.0
    coef_re = (num_re * lam_re + ab_im * lam_im) / den
    coef_im = (ab_im * lam_re - num_re * lam_im) / den
    bre = b_re.astype(jnp.float32)
    bim = b_im.astype(jnp.float32)
    bb_re = coef_re[..., None] * bre - coef_im[..., None] * bim
    bb_im = coef_re[..., None] * bim + coef_im[..., None] * bre
    bu_re = jnp.einsum('gph,blgh->lbgp', bb_re, ug)
    bu_im = jnp.einsum('gph,blgh->lbgp', bb_im, ug)
    a_seq_re = jnp.broadcast_to(ab_re[None, None], (seqlen, 1, S5_GROUPS, S5_STATE))
    a_seq_im = jnp.broadcast_to(ab_im[None, None], (seqlen, 1, S5_GROUPS, S5_STATE))
    _, _, x_re, x_im = lax.associative_scan(_complex_linear_combine,
                                            (a_seq_re, a_seq_im, bu_re, bu_im), axis=0)
    y = (jnp.einsum('ghp,lbgp->blgh', c_re.astype(jnp.float32), x_re)
         - jnp.einsum('ghp,lbgp->blgh', c_im.astype(jnp.float32), x_im))
    y = y.reshape(bsz, seqlen, MIX_WIDTH) + d_skip * u
    y = jax.nn.gelu(y)
    return y * jax.nn.sigmoid(y @ w_glu + b_glu)


def mlstm_mixer(p, conv_q, conv_k, b_i, b_f, norm_g):
    bsz, seqlen, _ = p.shape
    q_pre, k_pre, v, o, ig_pre, fg_pre = jnp.split(
        p, [ML_QK, 2 * ML_QK, 2 * ML_QK + MIX_WIDTH, 2 * ML_QK + 2 * MIX_WIDTH,
            2 * ML_QK + 2 * MIX_WIDTH + ML_HEADS], axis=-1)
    q = jax.nn.silu(causal_dwconv(q_pre, conv_q))
    k = jax.nn.silu(causal_dwconv(k_pre, conv_k))
    qc = to_chunks(q.reshape(bsz, seqlen, ML_HEADS, ML_DQK), ML_CHUNK) * (ML_DQK ** -0.5)
    kc = to_chunks(k.reshape(bsz, seqlen, ML_HEADS, ML_DQK), ML_CHUNK)
    vc = to_chunks(v.reshape(bsz, seqlen, ML_HEADS, ML_DV), ML_CHUNK)
    ig = (ig_pre + b_i).astype(jnp.float32)
    lf = jax.nn.log_sigmoid((fg_pre + b_f).astype(jnp.float32))
    igc = to_chunks(ig[..., None], ML_CHUNK)[..., 0]
    lfc = to_chunks(lf[..., None], ML_CHUNK)[..., 0]
    bcum = jnp.cumsum(lfc, axis=-1)
    btot = bcum[..., -1]
    w = btot[..., None] - bcum + igc
    m_loc = jnp.max(w, axis=-1)
    e = jnp.exp(w - m_loc[..., None])
    kv = jnp.einsum('bhcs,bhcsk,bhcsv->bhckv', e, kc, vc).astype(jnp.float32)
    nk = jnp.einsum('bhcs,bhcsk->bhck', e, kc).astype(jnp.float32)

    def step(carry, inp):
        c_st, n_st, m_st = carry
        kv_c, nk_c, mloc_c, btot_c = inp
        m_new = jnp.maximum(btot_c + m_st, mloc_c)
        sa = jnp.exp(btot_c + m_st - m_new)
        sb = jnp.exp(mloc_c - m_new)
        c_new = sa[..., None, None] * c_st + sb[..., None, None] * kv_c
        n_new = sa[..., None] * n_st + sb[..., None] * nk_c
        return (c_new, n_new, m_new), (c_st, n_st, m_st)

    init = (jnp.zeros((bsz, ML_HEADS, ML_DQK, ML_DV), jnp.float32),
            jnp.zeros((bsz, ML_HEADS, ML_DQK), jnp.float32),
            jnp.zeros((bsz, ML_HEADS), jnp.float32))
    _, (c_prev, n_prev, m_prev) = lax.scan(
        step, init, (jnp.moveaxis(kv, 2, 0), jnp.moveaxis(nk, 2, 0),
                     jnp.moveaxis(m_loc, 2, 0), jnp.moveaxis(btot, 2, 0)))
    c_prev = jnp.moveaxis(c_prev, 0, 2)
    n_prev = jnp.moveaxis(n_prev, 0, 2)
    m_prev = jnp.moveaxis(m_prev, 0, 2)
    idx = jnp.arange(ML_CHUNK)
    causal = idx[:, None] >= idx[None, :]
    dmat = jnp.where(causal, bcum[..., :, None] - bcum[..., None, :] + igc[..., None, :], -jnp.inf)
    g = bcum + m_prev[..., None]
    m_row = jnp.maximum(g, jnp.max(dmat, axis=-1))
    inter = jnp.exp(g - m_row)
    s_qk = jnp.einsum('bhcjd,bhcsd->bhcjs', qc, kc).astype(jnp.float32) * jnp.exp(dmat - m_row[..., None])
    num = (inter[..., None] * jnp.einsum('bhcjd,bhcdv->bhcjv', qc, c_prev)
           + jnp.einsum('bhcjs,bhcsv->bhcjv', s_qk, vc))
    den = inter * jnp.einsum('bhcjd,bhcd->bhcj', qc, n_prev) + jnp.sum(s_qk, axis=-1)
    h = num / jnp.maximum(jnp.abs(den), jnp.exp(-m_row))[..., None]
    h = head_norm(from_chunks(h), norm_g).reshape(bsz, seqlen, MIX_WIDTH)
    return jax.nn.sigmoid(o) * h


def retention_mixer(p, cos, sin, norm_g):
    bsz, seqlen, _ = p.shape
    q, k, v, gate = jnp.split(p, [RET_QK, 2 * RET_QK, 2 * RET_QK + MIX_WIDTH], axis=-1)
    q = apply_rope(q.reshape(bsz, seqlen, RET_HEADS, RET_DQK), cos, sin)
    k = apply_rope(k.reshape(bsz, seqlen, RET_HEADS, RET_DQK), cos, sin) * (RET_DQK ** -0.5)
    qc = to_chunks(q, RET_CHUNK)
    kc = to_chunks(k, RET_CHUNK)
    vc = to_chunks(v.reshape(bsz, seqlen, RET_HEADS, RET_DV), RET_CHUNK)
    log_gamma = jnp.log(1.0 - jnp.power(2.0, -5.0 - jnp.arange(RET_HEADS, dtype=jnp.float32)))
    idx = jnp.arange(RET_CHUNK, dtype=jnp.float32)
    rel = idx[:, None] - idx[None, :]
    decay_intra = jnp.where(rel >= 0, jnp.exp(jnp.maximum(rel, 0.0) * log_gamma[:, None, None]), 0.0)
    s = jnp.einsum('bhcjd,bhcsd->bhcjs', qc, kc) * decay_intra[:, None]
    intra = jnp.einsum('bhcjs,bhcsv->bhcjv', s, vc)
    zeta = jnp.exp((RET_CHUNK - 1 - idx) * log_gamma[:, None])
    r = jnp.einsum('bhcsk,hs,bhcsv->bhckv', kc, zeta, vc).astype(jnp.float32)
    chunk_decay = jnp.exp(RET_CHUNK * log_gamma)[None, :, None, None]

    def step(state, r_c):
        return chunk_decay * state + r_c, state

    _, s_prev = lax.scan(step, jnp.zeros((bsz, RET_HEADS, RET_DQK, RET_DV), jnp.float32),
                         jnp.moveaxis(r, 2, 0))
    s_prev = jnp.moveaxis(s_prev, 0, 2)
    xi = jnp.exp((idx + 1.0) * log_gamma[:, None])
    cross = jnp.einsum('bhcjk,bhckv->bhcjv', qc, s_prev) * xi[:, None, :, None]
    y = head_norm(from_chunks(intra + cross), norm_g).reshape(bsz, seqlen, MIX_WIDTH)
    return jax.nn.silu(gate) * y


def memory_cross_attention(xq, mem_k, mem_v):
    bsz, seqlen, _ = xq.shape
    q = xq.reshape(bsz, seqlen, XATTN_HEADS, XATTN_HEAD_DIM) * (XATTN_HEAD_DIM ** -0.5)
    scores = jnp.einsum('blhd,bmhd->bhlm', q, mem_k).astype(jnp.float32)
    probs = jax.nn.softmax(scores, axis=-1).astype(mem_v.dtype)
    return jnp.einsum('bhlm,bmhd->blhd', probs, mem_v).reshape(bsz, seqlen, XATTN_WIDTH)


def moe_ffn(h, router_w, router_b, w_gu, b_gu, w_down, b_down):
    bsz, seqlen, d = h.shape
    t = bsz * seqlen
    xt = h.reshape(t, d)
    logits = (xt @ router_w + router_b).astype(jnp.float32)
    top_val, top_idx = lax.top_k(logits, TOP_K)
    gates = jax.nn.softmax(top_val, axis=-1)
    n_assign = t * TOP_K
    e_flat = top_idx.reshape(n_assign).astype(jnp.int32)
    g_flat = gates.reshape(n_assign)
    tok_flat = jnp.arange(n_assign, dtype=jnp.int32) // TOP_K
    counts = jax.ops.segment_sum(jnp.ones((n_assign,), jnp.int32), e_flat, num_segments=N_EXPERTS)
    padded = ((counts + MOE_BLOCK - 1) // MOE_BLOCK) * MOE_BLOCK
    pad_end = jnp.cumsum(padded)
    pad_start = pad_end - padded
    raw_start = jnp.cumsum(counts) - counts
    order = jnp.argsort(e_flat)
    se = e_flat[order]
    dest = pad_start[se] + (jnp.arange(n_assign, dtype=jnp.int32) - raw_start[se])
    n_rows = (-(-n_assign // MOE_BLOCK) + N_EXPERTS) * MOE_BLOCK
    n_blocks = n_rows // MOE_BLOCK
    row_tok = jnp.zeros((n_rows,), jnp.int32).at[dest].set(tok_flat[order])
    row_gate = jnp.zeros((n_rows,), jnp.float32).at[dest].set(g_flat[order])
    block_start = jnp.arange(n_blocks, dtype=jnp.int32) * MOE_BLOCK
    block_exp = jnp.minimum(jnp.sum((block_start[:, None] >= pad_end[None, :]).astype(jnp.int32), axis=1),
                            N_EXPERTS - 1)
    xr = xt[row_tok].reshape(n_blocks, MOE_BLOCK, d)

    def expert_block(args):
        xb, e = args
        gu = xb @ w_gu[e] + b_gu[e]
        x_glu = jnp.minimum(gu[..., :D_EXPERT], SWIGLU_LIMIT)
        x_lin = jnp.clip(gu[..., D_EXPERT:], -SWIGLU_LIMIT, SWIGLU_LIMIT)
        act = x_glu * jax.nn.sigmoid(SWIGLU_ALPHA * x_glu) * (x_lin + 1.0)
        return act @ w_down[e] + b_down[e]

    yr = lax.map(expert_block, (xr, block_exp)).reshape(n_rows, d)
    out = jnp.zeros((t, d), yr.dtype).at[row_tok].add(row_gate[:, None].astype(yr.dtype) * yr)
    return out.reshape(bsz, seqlen, d)


def _normal(k, shape, scale):
    return jax.random.normal(k, shape, jnp.float32) * scale


def _s5_params(key, prefix):
    k = jax.random.split(key, 11)
    n = jnp.arange(S5_STATE, dtype=jnp.float32)[None, :]
    gp = (S5_GROUPS, S5_STATE)
    return {
        prefix + 'w_in': _normal(k[0], (D_MODEL, S5_IN + XATTN_WIDTH), D_MODEL ** -0.5),
        prefix + 's5_a_re': -0.5 + _normal(k[1], gp, 0.01),
        prefix + 's5_a_im': math.pi * n + _normal(k[2], gp, 0.01),
        prefix + 's5_log_dt': jax.random.uniform(k[3], (S5_GROUPS,), jnp.float32,
                                                 minval=math.log(S5_DT_MIN), maxval=math.log(S5_DT_MAX)),
        prefix + 's5_b_re': _normal(k[4], (S5_GROUPS, S5_STATE, S5_GROUP), (2 * S5_GROUP) ** -0.5),
        prefix + 's5_b_im': _normal(k[5], (S5_GROUPS, S5_STATE, S5_GROUP), (2 * S5_GROUP) ** -0.5),
        prefix + 's5_c_re': _normal(k[6], (S5_GROUPS, S5_GROUP, S5_STATE), S5_STATE ** -0.5),
        prefix + 's5_c_im': _normal(k[7], (S5_GROUPS, S5_GROUP, S5_STATE), S5_STATE ** -0.5),
        prefix + 's5_d': 1.0 + _normal(k[8], (MIX_WIDTH,), 0.1),
        prefix + 's5_w_glu': _normal(k[9], (MIX_WIDTH, MIX_WIDTH), MIX_WIDTH ** -0.5),
        prefix + 's5_b_glu': _normal(k[10], (MIX_WIDTH,), 0.01),
    }


def setup_inputs(seed: int = 0) -> dict:
    key = jax.random.key(seed)
    k = jax.random.split(key, 32)
    inputs = {
        'x': _normal(k[0], (BATCH, SEQ, D_MODEL), 1.0),
        'mem': _normal(k[1], (BATCH, N_MEM, D_MODEL), 1.0),
        'positions': (jnp.arange(SEQ, dtype=jnp.int32)[None, :]
                      + jax.random.randint(k[2], (BATCH, 1), 0, 4096, dtype=jnp.int32)),
        'mem_w_k': _normal(k[3], (D_MODEL, XATTN_WIDTH), D_MODEL ** -0.5),
        'mem_w_v': _normal(k[4], (D_MODEL, XATTN_WIDTH), D_MODEL ** -0.5),
    }
    inputs.update(_s5_params(k[5], 'l0_'))
    inputs.update({
        'l1_w_in': _normal(k[6], (D_MODEL, ML_IN + XATTN_WIDTH), D_MODEL ** -0.5),
        'l1_ml_conv_q': _normal(k[7], (ML_CONV, ML_QK), ML_CONV ** -0.5),
        'l1_ml_conv_k': _normal(k[8], (ML_CONV, ML_QK), ML_CONV ** -0.5),
        'l1_ml_b_i': _normal(k[9], (ML_HEADS,), 0.1),
        'l1_ml_b_f': jnp.linspace(3.0, 6.0, ML_HEADS, dtype=jnp.float32) + _normal(k[10], (ML_HEADS,), 0.1),
        'l1_ml_norm_g': 1.0 + _normal(k[11], (MIX_WIDTH,), 0.1),
        'l2_w_in': _normal(k[12], (D_MODEL, RET_IN + XATTN_WIDTH), D_MODEL ** -0.5),
        'l2_ret_norm_g': 1.0 + _normal(k[13], (MIX_WIDTH,), 0.1),
    })
    inputs.update(_s5_params(k[14], 'l3_'))
    inputs.update({
        'w_out': _normal(k[15], (DEPTH, CAT_WIDTH, D_MODEL), CAT_WIDTH ** -0.5 * DEEPNORM_BETA),
        'ln1_g': 1.0 + _normal(k[16], (DEPTH, D_MODEL), 0.1),
        'ln1_b': _normal(k[17], (DEPTH, D_MODEL), 0.01),
        'ln2_g': 1.0 + _normal(k[18], (DEPTH, D_MODEL), 0.1),
        'ln2_b': _normal(k[19], (DEPTH, D_MODEL), 0.01),
        'router_w': _normal(k[20], (DEPTH, D_MODEL, N_EXPERTS), D_MODEL ** -0.5),
        'router_b': _normal(k[21], (DEPTH, N_EXPERTS), 0.01),
        'exp_w_gu': _normal(k[22], (DEPTH, N_EXPERTS, D_MODEL, 2 * D_EXPERT), D_MODEL ** -0.5),
        'exp_b_gu': _normal(k[23], (DEPTH, N_EXPERTS, 2 * D_EXPERT), 0.01),
        'exp_w_down': _normal(k[24], (DEPTH, N_EXPERTS, D_EXPERT, D_MODEL), D_EXPERT ** -0.5 * DEEPNORM_BETA),
        'exp_b_down': _normal(k[25], (DEPTH, N_EXPERTS, D_MODEL), 0.01),
    })
    return inputs


def reference(x, mem, positions, mem_w_k, mem_w_v,
              l0_w_in, l0_s5_a_re, l0_s5_a_im, l0_s5_log_dt, l0_s5_b_re, l0_s5_b_im,
              l0_s5_c_re, l0_s5_c_im, l0_s5_d, l0_s5_w_glu, l0_s5_b_glu,
              l1_w_in, l1_ml_conv_q, l1_ml_conv_k, l1_ml_b_i, l1_ml_b_f, l1_ml_norm_g,
              l2_w_in, l2_ret_norm_g,
              l3_w_in, l3_s5_a_re, l3_s5_a_im, l3_s5_log_dt, l3_s5_b_re, l3_s5_b_im,
              l3_s5_c_re, l3_s5_c_im, l3_s5_d, l3_s5_w_glu, l3_s5_b_glu,
              w_out, ln1_g, ln1_b, ln2_g, ln2_b, router_w, router_b,
              exp_w_gu, exp_b_gu, exp_w_down, exp_b_down):
    bsz, seqlen, _ = x.shape
    cos, sin = rope_tables(positions, RET_DQK)
    mem_k = (mem @ mem_w_k).reshape(bsz, N_MEM, XATTN_HEADS, XATTN_HEAD_DIM)
    mem_v = (mem @ mem_w_v).reshape(bsz, N_MEM, XATTN_HEADS, XATTN_HEAD_DIM)
    w_ins = (l0_w_in, l1_w_in, l2_w_in, l3_w_in)
    mixer_params = (
        (l0_s5_a_re, l0_s5_a_im, l0_s5_log_dt, l0_s5_b_re, l0_s5_b_im,
         l0_s5_c_re, l0_s5_c_im, l0_s5_d, l0_s5_w_glu, l0_s5_b_glu),
        (l1_ml_conv_q, l1_ml_conv_k, l1_ml_b_i, l1_ml_b_f, l1_ml_norm_g),
        (l2_ret_norm_g,),
        (l3_s5_a_re, l3_s5_a_im, l3_s5_log_dt, l3_s5_b_re, l3_s5_b_im,
         l3_s5_c_re, l3_s5_c_im, l3_s5_d, l3_s5_w_glu, l3_s5_b_glu),
    )
    h = x
    for i in range(DEPTH):
        kind = i % N_MIXERS
        proj = h @ w_ins[i]
        p_mix = proj[..., :-XATTN_WIDTH]
        xq = proj[..., -XATTN_WIDTH:]
        if kind == 0:
            y_mix = s5_mixer(p_mix, *mixer_params[i])
        elif kind == 1:
            y_mix = mlstm_mixer(p_mix, *mixer_params[i])
        else:
            y_mix = retention_mixer(p_mix, cos, sin, *mixer_params[i])
        y_mem = memory_cross_attention(xq, mem_k, mem_v)
        y = jnp.concatenate([y_mix.astype(y_mem.dtype), y_mem], axis=-1) @ w_out[i]
        h = layer_norm(DEEPNORM_ALPHA * h + y, ln1_g[i], ln1_b[i])
        y = moe_ffn(h, router_w[i], router_b[i], exp_w_gu[i], exp_b_gu[i], exp_w_down[i], exp_b_down[i])
        h = layer_norm(DEEPNORM_ALPHA * h + y, ln2_g[i], ln2_b[i])
    return h
```

```cpp
#include <hip/hip_runtime.h>
#include <cstdio>
#include <cstdint>

#ifndef MK_ONE_LAUNCH
#define MK_ONE_LAUNCH 1
#endif

#ifndef FAST_DENSE
#define FAST_DENSE 1
#endif
#ifndef FAST_MOE
#define FAST_MOE 1
#endif
#ifndef REP_MASK
#define REP_MASK 0
#endif
#define REPS(k) for (int rep_ = 0; rep_ < 1 + ((REP_MASK >> (k)) & 1); ++rep_)
#ifndef FAST_S5
#define FAST_S5 1
#endif
#ifndef MOE_SPARSE
#define MOE_SPARSE 0
#endif
#ifndef YR_FP8
#define YR_FP8 0
#endif
#ifndef RES_BF16
#define RES_BF16 1
#endif
#ifndef MOE_FP8
#define MOE_FP8 1
#endif
#ifndef MOE_GATHER
#define MOE_GATHER 1
#endif
#ifndef BG_CONV
#define BG_CONV 1
#endif
#ifndef FAST_LN1
#define FAST_LN1 1
#endif
#ifndef FAST_XATTN
#define FAST_XATTN 1
#endif
#ifndef FAST_LINATT
#define FAST_LINATT 1
#endif
#define LAS __attribute__((address_space(3)))
typedef unsigned short bf16;

#ifndef MOE_SPARSE
#define MOE_SPARSE 0
#endif
#if MOE_SPARSE
#define MOE_SPARSE_ROWS (32 * 16384)
#else
#define MOE_SPARSE_ROWS (16384 * 4 + 32 * 256)
#endif
constexpr int NB = 8, SEQ = 2048, T = NB * SEQ, D = 1024, MIXW = 768, XW = 256, NMEM = 256, DEPTH = 4;
constexpr int NEXP = 32, TOPK = 4, DEXP = 1024, MOEBLK = 256;
constexpr int NROWS_MAX = MOE_SPARSE_ROWS;
constexpr int LDP = 2816;
constexpr float LN_EPS = 1e-5f;
constexpr float DN_ALPHA = 1.6817928305074290f;
constexpr int NWAVES = 8, NTHR = 512;

constexpr size_t MiB = (size_t)1 << 20;
constexpr size_t WS_CTL = 0, CTL_BYTES = 1 * MiB;
constexpr size_t WS_HF = 1 * MiB;
constexpr size_t WS_Y2 = WS_HF + (size_t)T * D * 4;
constexpr size_t WS_HB = WS_Y2 + (size_t)T * D * 4;
constexpr size_t WS_PROJ = WS_HB + (size_t)T * D * 2;
constexpr size_t WS_YG = WS_PROJ + (size_t)T * LDP * 2;
constexpr size_t WS_CAT = WS_YG + (size_t)T * MIXW * 2;
constexpr size_t WS_TOPE = WS_CAT + (size_t)T * D * 2;
constexpr size_t WS_TOPG = WS_TOPE + (size_t)T * 4 * 4;
constexpr size_t WS_DEST = WS_TOPG + (size_t)T * 4 * 4;
constexpr size_t WS_XR = WS_DEST + (size_t)T * 4 * 4;
constexpr size_t WS_ACT = WS_XR + (size_t)(T * TOPK + NEXP * MOEBLK) * D * 2;
constexpr size_t WS_YR = WS_ACT + (size_t)NROWS_MAX * DEXP * 2;
constexpr size_t WS_MEMK = WS_YR + (size_t)NROWS_MAX * D * 2;
constexpr size_t WS_MEMV = WS_MEMK + 1 * MiB;
constexpr size_t WS_MEMVT = WS_MEMV + 1 * MiB;
constexpr size_t WS_ROPE = WS_MEMVT + 1 * MiB;
constexpr size_t WS_WIN = WS_ROPE + (size_t)T * 48 * 2 * 4;
constexpr size_t WS_WGLU = WS_WIN + 4 * 6 * MiB;
constexpr size_t WS_WOUT = WS_WGLU + 2 * 2 * MiB;
constexpr size_t WS_WMEM = WS_WOUT + 4 * 2 * MiB;
constexpr size_t WS_MEMB = WS_WMEM + 1 * MiB;
constexpr size_t WS_WGU = WS_MEMB + 4 * MiB;
constexpr size_t WS_WDN = WS_WGU + (size_t)DEPTH * NEXP * 2 * DEXP * D * 2;
constexpr size_t WS_RWT = WS_WDN + (size_t)DEPTH * NEXP * D * DEXP * 2;
constexpr size_t WS_RTOK = WS_RWT + (size_t)DEPTH * 2 * NEXP * D * 2;
constexpr size_t WS_END = WS_RTOK + (size_t)NROWS_MAX * 4;
constexpr int CW_BAR = 4096;
constexpr int CW_CNT = 16384;
constexpr int CW_CUR = 16384 + 1024;
constexpr int CW_CQ = 16384 + 2048;

constexpr int LDS_BYTES = 163840;
constexpr int LDS_RMAP = 147456;
constexpr int LDS_MISC = 131072 + 8192;

__device__ __forceinline__ float bf2f(bf16 v) { return __uint_as_float(((unsigned)v) << 16); }
__device__ __forceinline__ bf16 f2bf(float f) { unsigned u = __float_as_uint(f); return (bf16)((u + 0x7fffu + ((u >> 16) & 1u)) >> 16); }
__device__ __forceinline__ unsigned pk2(float lo, float hi) { return (unsigned)f2bf(lo) | ((unsigned)f2bf(hi) << 16); }
__device__ __forceinline__ int sh_idx_i(int v, int src, int) { return __builtin_amdgcn_ds_bpermute(src << 2, v); }
__device__ __forceinline__ float sh_idx(float v, int src, int lane) { return __int_as_float(sh_idx_i(__float_as_int(v), src, lane)); }
__device__ __forceinline__ unsigned sh_idx(unsigned v, int src, int lane) { return (unsigned)sh_idx_i((int)v, src, lane); }
__device__ __forceinline__ float sh_xor(float v, int m, int lane) { return __int_as_float(__builtin_amdgcn_ds_bpermute((lane ^ m) << 2, __float_as_int(v))); }
__device__ __forceinline__ int sh_xor(int v, int m, int lane) { return __builtin_amdgcn_ds_bpermute((lane ^ m) << 2, v); }
__device__ __forceinline__ float sh_up(float v, int d, int lane) { const int s = lane - d; return __int_as_float(__builtin_amdgcn_ds_bpermute((s < 0 ? lane : s) << 2, __float_as_int(v))); }
__device__ __forceinline__ float wave_sum(float v, int lane) {
#pragma unroll
    for (int o = 1; o < 64; o <<= 1) v += sh_xor(v, o, lane);
    return v;
}
__device__ __forceinline__ float sigmoidf(float x) { return __builtin_amdgcn_rcpf(1.0f + __expf(-x)); }
__device__ __forceinline__ void unpack8(uint4 v, float* f) {
    f[0] = __uint_as_float(v.x << 16); f[1] = __uint_as_float(v.x & 0xffff0000u);
    f[2] = __uint_as_float(v.y << 16); f[3] = __uint_as_float(v.y & 0xffff0000u);
    f[4] = __uint_as_float(v.z << 16); f[5] = __uint_as_float(v.z & 0xffff0000u);
    f[6] = __uint_as_float(v.w << 16); f[7] = __uint_as_float(v.w & 0xffff0000u);
}
__device__ __forceinline__ void sincos_rad(float ang, float& s, float& c) {
    float r = ang * 0.15915494309189535f; r -= rintf(r);
    s = __builtin_amdgcn_sinf(r); c = __builtin_amdgcn_cosf(r);
}
__device__ __forceinline__ float gelu_tanh(float x) {
    const float u = 0.7978845608028654f * (x + 0.044715f * x * x * x);
    const float e = __expf(2.0f * u);
    const float th = 1.0f - 2.0f / (e + 1.0f);
    return 0.5f * x * (1.0f + th);
}

__device__ __forceinline__ int lane_id_opaque() { int l; asm volatile("v_mbcnt_lo_u32_b32 %0, -1, 0\n\tv_mbcnt_hi_u32_b32 %0, -1, %0" : "=v"(l)); return l; }
__device__ __forceinline__ bool wg_leader(int wave) { return wave == 0 && lane_id_opaque() == 0; }

#define XB_TMO      128
#define XB_XCNT(j)  (256  + 64 * (j))
#define XB_XSUB(j)  (1280 + 64 * (j))
#define XB_XGEN(j)  (2304 + 64 * (j))
#define XB_TOP      3328
#define XB_TOPGEN   3392
#define XCD_BAR_WORDS 3456
#define XB_SPIN_CAP (1u << 24)
__device__ __forceinline__ unsigned xb_ld(unsigned* p)              { return __hip_atomic_load(p, __ATOMIC_RELAXED, __HIP_MEMORY_SCOPE_AGENT); }
__device__ __forceinline__ unsigned xb_add(unsigned* p, unsigned v) { return __hip_atomic_fetch_add(p, v, __ATOMIC_RELAXED, __HIP_MEMORY_SCOPE_AGENT); }
__device__ __forceinline__ unsigned xb_xcc_id() { return (unsigned)__builtin_amdgcn_s_getreg((3 << 11) | 20) & 0xFu; }
#define XB_SPIN(cond, bar) do { unsigned _sp = 0; while (cond) { __builtin_amdgcn_s_sleep(1); \
    if ((++_sp & 255u) == 0u) { if (xb_ld(&(bar)[XB_TMO])) break; if (_sp > XB_SPIN_CAP) { atomicAdd(&(bar)[XB_TMO], 1u); break; } } } } while (0)
struct XcdBarrier { unsigned* bar; unsigned x; volatile LAS unsigned* st; };
__device__ __forceinline__ XcdBarrier xcd_barrier_post(unsigned* bar, volatile LAS unsigned* st, int wave) {
    XcdBarrier b; b.bar = bar; b.x = xb_xcc_id(); b.st = st;
    if (wg_leader(wave)) (void)xb_add(&bar[XB_XCNT(b.x)], 1u);
    return b;
}
__device__ __forceinline__ void xcd_barrier_complete(unsigned* bar, unsigned x, unsigned& nloc, unsigned& nx) {
    const unsigned G = gridDim.x * gridDim.y * gridDim.z;
    unsigned sum, cnt, mine, sp = 0u;
    for (;;) {
        sum = 0u; cnt = 0u; mine = 0u;
#pragma unroll
        for (unsigned j = 0; j < 16; ++j) { const unsigned c = xb_ld(&bar[XB_XCNT(j)]); sum += c; cnt += (c > 0u) ? 1u : 0u; mine = (j == x) ? c : mine; }
        if (sum == G) break;
        __builtin_amdgcn_s_sleep(1);
        if ((++sp & 255u) == 0u) { if (xb_ld(&bar[XB_TMO])) break; if (sp > XB_SPIN_CAP) { atomicAdd(&bar[XB_TMO], 1u); break; } }
    }
    nloc = mine > 0u ? mine : 1u; nx = cnt > 0u ? cnt : 1u;
}
__device__ __forceinline__ void xcd_barrier(const XcdBarrier& b, int wave) {
    asm volatile("s_waitcnt vmcnt(0)" ::: "memory");
    __syncthreads();
    if (wg_leader(wave)) {
        unsigned* bar = b.bar; asm volatile("" : "+s"(bar));
        __builtin_amdgcn_s_waitcnt(0);
        unsigned nloc = b.st[0], nx = b.st[1];
        if (nloc == 0u) { xcd_barrier_complete(bar, b.x, nloc, nx); b.st[0] = nloc; b.st[1] = nx; }
        const unsigned old = xb_add(&bar[XB_XSUB(b.x)], 1u);
        const unsigned gen = old / nloc;
        if (old + 1u == (gen + 1u) * nloc) {
            __builtin_amdgcn_fence(__ATOMIC_RELEASE, "agent");
            asm volatile("s_waitcnt vmcnt(0)" ::: "memory");
            const unsigned og = xb_add(&bar[XB_TOP], 1u);
            const unsigned tg = og / nx;
            if (og + 1u == (tg + 1u) * nx) xb_add(&bar[XB_TOPGEN], 1u);
            else XB_SPIN(xb_ld(&bar[XB_TOPGEN]) == tg, bar);
            __builtin_amdgcn_fence(__ATOMIC_ACQUIRE, "agent");
            xb_add(&bar[XB_XGEN(b.x)], 1u);
            asm volatile("s_waitcnt vmcnt(0)" ::: "memory");
        } else {
            XB_SPIN(xb_ld(&bar[XB_XGEN(b.x)]) == gen, bar);
            __builtin_amdgcn_fence(__ATOMIC_ACQUIRE, "agent");
            asm volatile("s_waitcnt vmcnt(0)" ::: "memory");
        }
    }
    __syncthreads();
}


namespace pg8 {
#define PG8_LAS __attribute__((address_space(3)))
typedef unsigned short bf16_t;
typedef short bf16x8 __attribute__((ext_vector_type(8)));
typedef float f32x4 __attribute__((ext_vector_type(4)));
typedef unsigned u32x4 __attribute__((ext_vector_type(4)));
typedef unsigned u32x2 __attribute__((ext_vector_type(2)));
typedef int i32x4 __attribute__((ext_vector_type(4)));
typedef int i32x8 __attribute__((ext_vector_type(8)));
constexpr int BM = 256, BK = 64, HALF = 128, HTB = HALF * BK * 2, STAGE_BYTES = 8 * HTB, NXCD = 8, WGM = 8;
__host__ __device__ __forceinline__ int lds_byte(int r, int c) { const int st = (r >> 4) * 2 + (c >> 5), rr = r & 15, cc = c & 31, ob = rr * 64 + cc * 2; return st * 1024 + (ob ^ (((ob >> 9) & 1) << 5)); }
__host__ __device__ __forceinline__ void stage_rc(int b, int& R, int& C) { const int st = b / 1024, sb = b % 1024, swz = sb ^ (((sb >> 9) & 1) << 5); R = (st >> 1) * 16 + swz / 64; C = (st & 1) * 32 + (swz % 64) / 2; }
__host__ __device__ __forceinline__ int perm32(int rho) { const int n = rho >> 4, i = rho & 15; return 8 * (i >> 2) + 4 * n + (i & 3); }
struct Unit { int pm, pn, pb, e; };
struct Gemm { const bf16_t* A; const bf16_t* Bt; int K; const PG8_LAS int* rowmap; };
struct StaticOrder {
    int nM, nN, nwg, G, c;
    __device__ __forceinline__ void init(int M, int N, int G_, int c_) { nM = M / BM; nN = N / BM; nwg = nM * nN; G = G_; c = c_; }
    __device__ __forceinline__ bool next(int i, Unit& u) const {
        const long L = (long)i * G + c; if (L >= nwg) return false;
        int wgid = (int)L; { const int q = nwg / NXCD, r = nwg % NXCD, xcd = wgid % NXCD, off = wgid / NXCD; wgid = (xcd < r ? xcd * (q + 1) : r * (q + 1) + (xcd - r) * q) + off; }
        const int nig = WGM * nN, gid = wgid / nig, fm = gid * WGM, gsz = (nM - fm) < WGM ? (nM - fm) : WGM;
        u.pm = fm + ((wgid % nig) % gsz); u.pn = (wgid % nig) / gsz; u.pb = u.pn; u.e = 0; return true;
    }
    __device__ __forceinline__ void a_ready(const Unit&) const {}
    __device__ __forceinline__ void done(const Unit&) const {}
};
struct MoeOrder {
    const PG8_LAS int* pend; int nb, ntn, G, vc;
    __device__ __forceinline__ bool next(int i, Unit& u) const {
        const int U = nb * ntn, per = G >> 3, chunk = (U + 7) >> 3, x = vc / per, r = vc - x * per;
        const int off = i * per + r; if (off >= chunk) return false;
        const long L = (long)x * chunk + off; if (L >= (long)U) return false;
        const int rb = (int)(L / ntn), pn = (int)(L % ntn); const int start = rb * 256; int e = 0, prev = 0;
#pragma unroll
        for (int j = 0; j < 32; ++j) { const int pj = pend[j]; if (start >= pj) { e += 1; prev = pj; } }
        e = e < 31 ? e : 31; e = __builtin_amdgcn_readfirstlane(e); prev = __builtin_amdgcn_readfirstlane(prev);
#if MOE_SPARSE
        u.pm = e * (16384 / 256) + (rb - prev / 256);
#else
        u.pm = rb;
#endif
        u.pn = pn; u.pb = e * ntn + pn; u.e = e; return true;
    }
    __device__ __forceinline__ void a_ready(const Unit&) const {}
    __device__ __forceinline__ void done(const Unit&) const {}
};
__device__ __forceinline__ unsigned cvt_pk_bf16(float lo, float hi) { unsigned r; asm volatile("v_cvt_pk_bf16_f32 %0, %1, %2" : "=v"(r) : "v"(lo), "v"(hi)); return r; }
__device__ __forceinline__ float fsig(float x) { return __builtin_amdgcn_rcpf(1.0f + __expf(-x)); }
template <bool OUT8> struct EpiBf16T {
    static constexpr bool PERM = true, AFTER_DRAIN = false;
    void* O; int ldc; const float* bias; int bias_estride; float scale;
    __device__ __forceinline__ void operator()(const f32x4 (&acc)[2][2][4][2], const Unit& u, int wr, int wc, int fr, int fq) const {
        const int row0 = u.pm * BM + wr * 64 + fr, col0 = u.pn * BM + wc * 32 + 8 * fq;
        f32x4 bv[2][2];
#pragma unroll
        for (int bj = 0; bj < 2; ++bj)
#pragma unroll
            for (int n = 0; n < 2; ++n) bv[bj][n] = bias ? *(const f32x4*)(bias + (size_t)u.e * bias_estride + col0 + bj * HALF + 4 * n) : (f32x4){0.f, 0.f, 0.f, 0.f};
#pragma unroll
        for (int ai = 0; ai < 2; ++ai)
#pragma unroll
            for (int m = 0; m < 4; ++m) { const size_t ro = (size_t)(row0 + ai * HALF + m * 16) * ldc + col0;
#pragma unroll
                for (int bj = 0; bj < 2; ++bj) { const f32x4 v0 = acc[ai][bj][m][0] * scale + bv[bj][0], v1 = acc[ai][bj][m][1] * scale + bv[bj][1];
                    if constexpr (OUT8) { int w0 = __builtin_amdgcn_cvt_pk_fp8_f32(v0[0], v0[1], 0, false); w0 = __builtin_amdgcn_cvt_pk_fp8_f32(v0[2], v0[3], w0, true); int w1 = __builtin_amdgcn_cvt_pk_fp8_f32(v1[0], v1[1], 0, false); w1 = __builtin_amdgcn_cvt_pk_fp8_f32(v1[2], v1[3], w1, true);
                        u32x2 w; w.x = (unsigned)w0; w.y = (unsigned)w1; *(u32x2*)((unsigned char*)O + ro + bj * HALF) = w; }
                    else { u32x4 w; w.x = cvt_pk_bf16(v0[0], v0[1]); w.y = cvt_pk_bf16(v0[2], v0[3]); w.z = cvt_pk_bf16(v1[0], v1[1]); w.w = cvt_pk_bf16(v1[2], v1[3]);
                        *(u32x4*)((bf16_t*)O + ro + bj * HALF) = w; } } }
    }
};
typedef EpiBf16T<false> EpiBf16;
struct EpiGlu {
    static constexpr bool PERM = true, AFTER_DRAIN = false;
    bf16_t* O; int ldc; const bf16_t* Y; int ldy; const float* bias;
    __device__ __forceinline__ void operator()(const f32x4 (&acc)[2][2][4][2], const Unit& u, int wr, int wc, int fr, int fq) const {
        const int row0 = u.pm * BM + wr * 64 + fr, col0 = u.pn * BM + wc * 32 + 8 * fq;
        f32x4 bv[2][2];
#pragma unroll
        for (int bj = 0; bj < 2; ++bj)
#pragma unroll
            for (int n = 0; n < 2; ++n) bv[bj][n] = *(const f32x4*)(bias + col0 + bj * HALF + 4 * n);
#pragma unroll
        for (int ai = 0; ai < 2; ++ai)
#pragma unroll
            for (int m = 0; m < 4; ++m) { const size_t r = (size_t)(row0 + ai * HALF + m * 16);
#pragma unroll
                for (int bj = 0; bj < 2; ++bj) { const int c = col0 + bj * HALF; const u32x4 yv = *(const u32x4*)(Y + r * ldy + c);
                    const f32x4 z0 = acc[ai][bj][m][0] + bv[bj][0], z1 = acc[ai][bj][m][1] + bv[bj][1];
                    float y[8]; y[0] = __uint_as_float(yv.x << 16); y[1] = __uint_as_float(yv.x & 0xffff0000u); y[2] = __uint_as_float(yv.y << 16); y[3] = __uint_as_float(yv.y & 0xffff0000u);
                    y[4] = __uint_as_float(yv.z << 16); y[5] = __uint_as_float(yv.z & 0xffff0000u); y[6] = __uint_as_float(yv.w << 16); y[7] = __uint_as_float(yv.w & 0xffff0000u);
                    u32x4 w; w.x = cvt_pk_bf16(y[0] * fsig(z0[0]), y[1] * fsig(z0[1])); w.y = cvt_pk_bf16(y[2] * fsig(z0[2]), y[3] * fsig(z0[3]));
                    w.z = cvt_pk_bf16(y[4] * fsig(z1[0]), y[5] * fsig(z1[1])); w.w = cvt_pk_bf16(y[6] * fsig(z1[2]), y[7] * fsig(z1[3]));
                    *(u32x4*)(O + r * ldc + c) = w; } }
    }
};
struct EpiResF32 {
    static constexpr bool PERM = false, AFTER_DRAIN = false;
    float* C; const float* R; int ldc; float alpha;
    __device__ __forceinline__ void operator()(const f32x4 (&acc)[2][2][4][2], const Unit& u, int wr, int wc, int fr, int fq) const {
        const int row0 = u.pm * BM + wr * 64 + fr, col0 = u.pn * BM + wc * 32 + 4 * fq;
#pragma unroll
        for (int ai = 0; ai < 2; ++ai)
#pragma unroll
            for (int m = 0; m < 4; ++m) { const size_t off = (size_t)(row0 + ai * HALF + m * 16) * ldc + col0;
#pragma unroll
                for (int bj = 0; bj < 2; ++bj)
#pragma unroll
                    for (int n = 0; n < 2; ++n) { const f32x4 rv = *(const f32x4*)(R + off + bj * HALF + n * 16); *(f32x4*)(C + off + bj * HALF + n * 16) = rv * alpha + acc[ai][bj][m][n]; } }
    }
};
struct EpiResBf16 {
    static constexpr bool PERM = true, AFTER_DRAIN = false;
    bf16_t* O; const bf16_t* R; int ldc; float alpha;
    __device__ __forceinline__ void operator()(const f32x4 (&acc)[2][2][4][2], const Unit& u, int wr, int wc, int fr, int fq) const {
        const int row0 = u.pm * BM + wr * 64 + fr, col0 = u.pn * BM + wc * 32 + 8 * fq;
#pragma unroll
        for (int ai = 0; ai < 2; ++ai)
#pragma unroll
            for (int m = 0; m < 4; ++m) { const size_t off = (size_t)(row0 + ai * HALF + m * 16) * ldc + col0;
#pragma unroll
                for (int bj = 0; bj < 2; ++bj) { const u32x4 rv = *(const u32x4*)(R + off + bj * HALF); const f32x4 a0 = acc[ai][bj][m][0], a1 = acc[ai][bj][m][1];
                    u32x4 w; w.x = cvt_pk_bf16(__uint_as_float(rv.x << 16) * alpha + a0[0], __uint_as_float(rv.x & 0xffff0000u) * alpha + a0[1]); w.y = cvt_pk_bf16(__uint_as_float(rv.y << 16) * alpha + a0[2], __uint_as_float(rv.y & 0xffff0000u) * alpha + a0[3]);
                    w.z = cvt_pk_bf16(__uint_as_float(rv.z << 16) * alpha + a1[0], __uint_as_float(rv.z & 0xffff0000u) * alpha + a1[1]); w.w = cvt_pk_bf16(__uint_as_float(rv.w << 16) * alpha + a1[2], __uint_as_float(rv.w & 0xffff0000u) * alpha + a1[3]);
                    *(u32x4*)(O + off + bj * HALF) = w; } }
    }
};
template <bool OUT8> struct EpiSwiglu {
    static constexpr bool PERM = true, AFTER_DRAIN = false;
    void* O; const float* bgu; float scale;
    __device__ __forceinline__ void operator()(const f32x4 (&acc)[2][2][4][2], const Unit& u, int wr, int wc, int fr, int fq) const {
        const int row0 = u.pm * BM + wr * 64 + fr, cidx = u.pn * HALF + wc * 32 + 8 * fq;
        const float* bg = bgu + (size_t)u.e * 2048 + cidx;
        f32x4 bG[2], bL[2];
#pragma unroll
        for (int n = 0; n < 2; ++n) { bG[n] = *(const f32x4*)(bg + 4 * n); bL[n] = *(const f32x4*)(bg + 1024 + 4 * n); }
#pragma unroll
        for (int ai = 0; ai < 2; ++ai)
#pragma unroll
            for (int m = 0; m < 4; ++m) { const size_t ro = (size_t)(row0 + ai * HALF + m * 16) * 1024 + cidx; float o[8];
#pragma unroll
                for (int n = 0; n < 2; ++n) { const f32x4 g = acc[ai][0][m][n] * scale + bG[n], l = acc[ai][1][m][n] * scale + bL[n];
#pragma unroll
                    for (int j = 0; j < 4; ++j) { const float xg = fminf(g[j], 7.0f), xl = fminf(fmaxf(l[j], -7.0f), 7.0f); o[4 * n + j] = xg * fsig(1.702f * xg) * (xl + 1.0f); } }
                if constexpr (OUT8) { int w0 = __builtin_amdgcn_cvt_pk_fp8_f32(o[0], o[1], 0, false); w0 = __builtin_amdgcn_cvt_pk_fp8_f32(o[2], o[3], w0, true); int w1 = __builtin_amdgcn_cvt_pk_fp8_f32(o[4], o[5], 0, false); w1 = __builtin_amdgcn_cvt_pk_fp8_f32(o[6], o[7], w1, true);
                    u32x2 w; w.x = (unsigned)w0; w.y = (unsigned)w1; *(u32x2*)((unsigned char*)O + ro) = w; }
                else { u32x4 w; w.x = cvt_pk_bf16(o[0], o[1]); w.y = cvt_pk_bf16(o[2], o[3]); w.z = cvt_pk_bf16(o[4], o[5]); w.w = cvt_pk_bf16(o[6], o[7]);
                    *(u32x4*)((bf16_t*)O + ro) = w; } }
    }
};
struct EpiMem {
    static constexpr bool PERM = false, AFTER_DRAIN = false;
    bf16_t* mk; bf16_t* mv; bf16_t* mvt;
    __device__ __forceinline__ void operator()(const f32x4 (&acc)[2][2][4][2], const Unit& u, int wr, int wc, int fr, int fq) const {
        const int row0 = u.pm * BM + wr * 64 + fr, col0 = u.pn * BM + wc * 32 + 4 * fq;
#pragma unroll
        for (int ai = 0; ai < 2; ++ai)
#pragma unroll
            for (int m = 0; m < 4; ++m) { const int r = row0 + ai * HALF + m * 16, b = r >> 8, key = r & 255;
#pragma unroll
                for (int bj = 0; bj < 2; ++bj)
#pragma unroll
                    for (int n = 0; n < 2; ++n) { const int c = col0 + bj * HALF + n * 16, cc = c & 255, head = cc >> 6, d = cc & 63; const f32x4 v = acc[ai][bj][m][n];
                        u32x2 w; w.x = cvt_pk_bf16(v[0], v[1]); w.y = cvt_pk_bf16(v[2], v[3]);
                        const size_t o = ((size_t)(b * 4 + head) * 256 + key) * 64 + d;
                        if (c < 256) *(u32x2*)(mk + o) = w;
                        else { *(u32x2*)(mv + o) = w; bf16_t* t = mvt + ((size_t)(b * 4 + head) * 64 + d) * 256 + key;
                            t[0] = (bf16_t)(w.x & 0xffffu); t[256] = (bf16_t)(w.x >> 16); t[512] = (bf16_t)(w.y & 0xffffu); t[768] = (bf16_t)(w.y >> 16); } } }
    }
};
template <class Epi, class Sched, bool ALIGN_EPI = true, bool SP2 = true, bool GATHER = false, bool FP8 = false>
__device__ __forceinline__ void gemm_phase(PG8_LAS unsigned char* lds, const Gemm g, const Sched& S, const Epi& E, const int wave_) {
    const int tid_ = wave_ * 64 + lane_id_opaque();
    const int tid = tid_, wid = wave_, lane = tid & 63, wr = wid >> 2, wc = wid & 3, fr = lane & 15, fq = lane >> 4;
    const int K = g.K, rowb = FP8 ? K : 2 * K  , nt = rowb / (BK * 2);
    unsigned voffA[2], voffB[2];
#pragma unroll
    for (int i = 0; i < 2; ++i) { int R, C; stage_rc(tid * 16 + i * 8192, R, C); const int Rb = Epi::PERM ? ((R & ~31) + perm32(R & 31)) : R;
        voffA[i] = (unsigned)(R * rowb + C * 2); voffB[i] = (unsigned)(Rb * rowb + C * 2); }
    const size_t kstep = (size_t)(BK * 2);
    const size_t hstep = (size_t)HALF * rowb;
    const size_t tstep = 2 * hstep;
    const unsigned ldsw = (unsigned)wid * 1024u;
    int aoffv[2], boffv[2];
#pragma unroll
    for (int k = 0; k < 2; ++k) { const int p = FP8 ? 2 * fq + k : 4 * k + fq; aoffv[k] = lds_byte(wr * 64 + fr, (p & 3) * 8) + (p >> 2) * 1024; boffv[k] = lds_byte(wc * 32 + fr, (p & 3) * 8) + (p >> 2) * 1024; }
#define PG8_SA(b, h) (((b) * 2 + (h)) * HTB)
#define PG8_SB(b, h) ((4 + (b) * 2 + (h)) * HTB)
#define PG8_STAGE(bufoff, gbase, voff) do { _Pragma("unroll") for (int _i = 0; _i < 2; ++_i) \
        __builtin_amdgcn_global_load_lds((const unsigned*)((const char*)(gbase) + (voff)[_i]), (PG8_LAS unsigned*)(lds + (bufoff) + ldsw + _i * 8192), 16, 0, 0); } while (0)
#define PG8_VSEL_0(h, i) vgC[h][i]
#define PG8_VSEL_1(h, i) (last ? vgX[h][i] : vgC[h][i])
#define PG8_STAGE_A(bufoff, gbase, h, set) do { if constexpr (GATHER) { _Pragma("unroll") for (int _i = 0; _i < 2; ++_i) \
        __builtin_amdgcn_global_load_lds((const unsigned*)((const char*)(gbase) + PG8_VSEL_##set(h, _i)), (PG8_LAS unsigned*)(lds + (bufoff) + ldsw + _i * 8192), 16, 0, 0); } \
    else { PG8_STAGE(bufoff, (gbase) + (h) * hstep, voffA); } } while (0)
#define PG8_LDA(dst, b, h) do { if constexpr (FP8) { _Pragma("unroll") for (int m = 0; m < 4; ++m) { const i32x4 lo_ = *(const PG8_LAS i32x4*)(lds + PG8_SA(b, h) + aoffv[0] + m * 2048), hi_ = *(const PG8_LAS i32x4*)(lds + PG8_SA(b, h) + aoffv[1] + m * 2048); dst##8[m] = __builtin_shufflevector(lo_, hi_, 0, 1, 2, 3, 4, 5, 6, 7); } } \
    else { _Pragma("unroll") for (int m = 0; m < 4; ++m) _Pragma("unroll") for (int k = 0; k < 2; ++k) dst[m][k] = *(const PG8_LAS bf16x8*)(lds + PG8_SA(b, h) + aoffv[k] + m * 2048); } } while (0)
#define PG8_LDB(dst, b, h) do { if constexpr (FP8) { _Pragma("unroll") for (int n = 0; n < 2; ++n) { const i32x4 lo_ = *(const PG8_LAS i32x4*)(lds + PG8_SB(b, h) + boffv[0] + n * 2048), hi_ = *(const PG8_LAS i32x4*)(lds + PG8_SB(b, h) + boffv[1] + n * 2048); dst##8[n] = __builtin_shufflevector(lo_, hi_, 0, 1, 2, 3, 4, 5, 6, 7); } } \
    else { _Pragma("unroll") for (int n = 0; n < 2; ++n) _Pragma("unroll") for (int k = 0; k < 2; ++k) dst[n][k] = *(const PG8_LAS bf16x8*)(lds + PG8_SB(b, h) + boffv[k] + n * 2048); } } while (0)
#define PG8_MMA(ai, bj, At, Bt) do { __builtin_amdgcn_s_setprio(1); _Pragma("unroll") for (int m = 0; m < 4; ++m) _Pragma("unroll") for (int n = 0; n < 2; ++n) { \
        if constexpr (FP8) { acc[ai][bj][m][n] = __builtin_amdgcn_mfma_scale_f32_16x16x128_f8f6f4(Bt##8[n], At##8[m], acc[ai][bj][m][n], 0, 0, 0, 0x7f7f7f7f, 0, 0x7f7f7f7f); } \
        else { _Pragma("unroll") for (int k = 0; k < 2; ++k) acc[ai][bj][m][n] = __builtin_amdgcn_mfma_f32_16x16x32_bf16(Bt[n][k], At[m][k], acc[ai][bj][m][n], 0, 0, 0); } } \
        if constexpr (FP8) { _Pragma("unroll") for (int m = 0; m < 4; ++m) asm volatile("" : "+v"(acc[ai][bj][m][0]), "+v"(acc[ai][bj][m][1])); }     \
        __builtin_amdgcn_s_setprio(0); } while (0)
#define PG8_WAIT_V(n) asm volatile("s_waitcnt vmcnt(" #n ")" ::: "memory")
#define PG8_WAIT_L(n) asm volatile("s_waitcnt lgkmcnt(" #n ")" ::: "memory")
#define PG8_BAR __builtin_amdgcn_s_barrier()
#define PG8_SCHED __builtin_amdgcn_sched_barrier(0)
    Unit cur, nxt; int ui = 0;
    if (!S.next(0, cur)) return;
    f32x4 acc[2][2][4][2];
#pragma unroll
    for (int a = 0; a < 2; ++a)
#pragma unroll
        for (int b = 0; b < 2; ++b)
#pragma unroll
            for (int m = 0; m < 4; ++m)
#pragma unroll
                for (int n = 0; n < 2; ++n) acc[a][b][m][n] = (f32x4){0.f, 0.f, 0.f, 0.f};
    bf16x8 At[4][2], B0[2][2], B1[2][2];
    i32x8 At8[4], B08[2], B18[2];
    unsigned vgC[2][2], vgX[2][2];
#define PG8_GOFF(dst, pm_) do { const int t_ = wave_ * 64 + lane_id_opaque();   _Pragma("unroll") for (int _i = 0; _i < 2; ++_i) { int gR_, gC_; stage_rc(t_ * 16 + _i * 8192, gR_, gC_); _Pragma("unroll") for (int _h = 0; _h < 2; ++_h) \
        dst[_h][_i] = (unsigned)(g.rowmap[(pm_) * BM + _h * HALF + gR_] * rowb + gC_ * 2); } } while (0)
    if constexpr (GATHER) { PG8_GOFF(vgC, 0); }
    const char* cA = GATHER ? (const char*)g.A : (const char*)g.A + (size_t)cur.pm * tstep; const char* cB = (const char*)g.Bt + (size_t)cur.pb * tstep;
    S.a_ready(cur);
    if constexpr (SP2) {
        PG8_STAGE(PG8_SB(0, 0), cB, voffB); PG8_STAGE(PG8_SB(0, 1), cB + hstep, voffB); PG8_STAGE_A(PG8_SA(0, 0), cA, 0, 0); PG8_STAGE_A(PG8_SA(0, 1), cA, 1, 0);
        if (wr == 1) PG8_BAR;
        PG8_WAIT_V(2); PG8_BAR;
        PG8_STAGE(PG8_SB(1, 0), cB + kstep, voffB); PG8_STAGE_A(PG8_SA(1, 0), cA + kstep, 0, 0); PG8_STAGE(PG8_SB(1, 1), cB + hstep + kstep, voffB);
        PG8_WAIT_V(6); PG8_BAR;
    } else {
        PG8_STAGE(PG8_SB(0, 0), cB, voffB); PG8_STAGE_A(PG8_SA(0, 0), cA, 0, 0); PG8_STAGE(PG8_SB(0, 1), cB + hstep, voffB); PG8_STAGE_A(PG8_SA(0, 1), cA, 1, 0);
        if (wr == 1) PG8_BAR;
        PG8_WAIT_V(4); PG8_BAR;
        PG8_STAGE(PG8_SB(1, 0), cB + kstep, voffB); PG8_STAGE_A(PG8_SA(1, 0), cA + kstep, 0, 0); PG8_STAGE(PG8_SB(1, 1), cB + hstep + kstep, voffB);
        PG8_WAIT_V(6); PG8_BAR;
    }
    for (;;) {
        const bool has_next = S.next(ui + 1, nxt);
        if constexpr (GATHER) { if (has_next) PG8_GOFF(vgX, ui + 1); else { _Pragma("unroll") for (int _h = 0; _h < 2; ++_h) _Pragma("unroll") for (int _i = 0; _i < 2; ++_i) vgX[_h][_i] = vgC[_h][_i]; } }
        const char* nA = GATHER ? (const char*)g.A : (has_next ? (const char*)g.A + (size_t)nxt.pm * tstep : cA); const char* nB = has_next ? (const char*)g.Bt + (size_t)nxt.pb * tstep : cB;
        for (int t = 0; t < nt; t += 2) {
            const bool last = (t == nt - 2);
            const char* a1 = cA + (size_t)(t + 1) * kstep;
            const char* a2 = last ? nA : cA + (size_t)(t + 2) * kstep; const char* b2 = last ? nB : cB + (size_t)(t + 2) * kstep;
            const char* a3 = a2 + kstep; const char* b3 = b2 + kstep;
            if (last && has_next) S.a_ready(nxt);
            if constexpr (SP2) {
            PG8_LDB(B0, 0, 0); PG8_LDB(B1, 0, 1); PG8_SCHED; PG8_LDA(At, 0, 0); PG8_STAGE_A(PG8_SA(1, 1), a1, 1, 0);
            PG8_WAIT_V(8); PG8_WAIT_L(0); PG8_BAR; PG8_MMA(0, 0, At, B0); PG8_MMA(0, 1, At, B1); PG8_BAR; PG8_SCHED;
            PG8_LDA(At, 0, 1); PG8_STAGE(PG8_SB(0, 0), b2, voffB); PG8_STAGE(PG8_SB(0, 1), b2 + hstep, voffB); PG8_STAGE_A(PG8_SA(0, 0), a2, 0, 1);
            PG8_WAIT_V(8); PG8_WAIT_L(0); PG8_BAR; PG8_MMA(1, 0, At, B0); PG8_MMA(1, 1, At, B1); PG8_BAR; PG8_SCHED;
            PG8_LDB(B0, 1, 0); PG8_LDB(B1, 1, 1); PG8_SCHED; PG8_LDA(At, 1, 0); PG8_STAGE_A(PG8_SA(0, 1), a2, 1, 1);
            PG8_WAIT_V(8); PG8_WAIT_L(0); PG8_BAR; PG8_MMA(0, 0, At, B0); PG8_MMA(0, 1, At, B1); PG8_BAR; PG8_SCHED;
            PG8_LDA(At, 1, 1); PG8_STAGE(PG8_SB(1, 0), b3, voffB); PG8_STAGE(PG8_SB(1, 1), b3 + hstep, voffB); PG8_STAGE_A(PG8_SA(1, 0), a3, 0, 1);
            PG8_WAIT_V(8); PG8_WAIT_L(0); PG8_BAR; PG8_MMA(1, 0, At, B0); PG8_MMA(1, 1, At, B1); PG8_BAR; PG8_SCHED;
            } else {
            PG8_LDB(B0, 0, 0); PG8_SCHED; PG8_LDA(At, 0, 0); PG8_STAGE_A(PG8_SA(1, 1), a1, 1, 0);
            PG8_WAIT_L(8); PG8_BAR; PG8_WAIT_L(0); PG8_MMA(0, 0, At, B0); PG8_BAR; PG8_SCHED;
            PG8_LDB(B1, 0, 1); PG8_STAGE(PG8_SB(0, 0), b2, voffB);
            PG8_BAR; PG8_WAIT_L(0); PG8_MMA(0, 1, At, B1); PG8_BAR;
            PG8_LDA(At, 0, 1); PG8_STAGE_A(PG8_SA(0, 0), a2, 0, 1);
            PG8_BAR; PG8_WAIT_L(0); PG8_MMA(1, 0, At, B0); PG8_BAR; PG8_SCHED;
            PG8_STAGE(PG8_SB(0, 1), b2 + hstep, voffB);
            PG8_WAIT_V(6); PG8_BAR; PG8_MMA(1, 1, At, B1); PG8_BAR;
            PG8_LDB(B0, 1, 0); PG8_SCHED; PG8_LDA(At, 1, 0); PG8_STAGE_A(PG8_SA(0, 1), a2, 1, 1);
            PG8_WAIT_L(8); PG8_BAR; PG8_WAIT_L(0); PG8_MMA(0, 0, At, B0); PG8_BAR; PG8_SCHED;
            PG8_LDB(B1, 1, 1); PG8_STAGE(PG8_SB(1, 0), b3, voffB);
            PG8_BAR; PG8_WAIT_L(0); PG8_MMA(0, 1, At, B1); PG8_BAR;
            PG8_LDA(At, 1, 1); PG8_STAGE_A(PG8_SA(1, 0), a3, 0, 1);
            PG8_BAR; PG8_WAIT_L(0); PG8_MMA(1, 0, At, B0); PG8_BAR; PG8_SCHED;
            PG8_STAGE(PG8_SB(1, 1), b3 + hstep, voffB);
            PG8_WAIT_V(6); PG8_BAR; PG8_MMA(1, 1, At, B1); PG8_BAR;
            }
        }
        if constexpr (ALIGN_EPI) { if (wr == 0) PG8_BAR; }
        if constexpr (!Epi::AFTER_DRAIN) { const int l2_ = lane_id_opaque(); E(acc, cur, wr, wc, l2_ & 15, l2_ >> 4); S.done(cur); }
        if (!has_next) break;
#pragma unroll
        for (int a = 0; a < 2; ++a)
#pragma unroll
            for (int b = 0; b < 2; ++b)
#pragma unroll
                for (int m = 0; m < 4; ++m)
#pragma unroll
                    for (int n = 0; n < 2; ++n) acc[a][b][m][n] = (f32x4){0.f, 0.f, 0.f, 0.f};
        cur = nxt; cA = nA; cB = nB; ++ui;
        if constexpr (GATHER) { _Pragma("unroll") for (int _h = 0; _h < 2; ++_h) _Pragma("unroll") for (int _i = 0; _i < 2; ++_i) vgC[_h][_i] = vgX[_h][_i]; }
        if constexpr (ALIGN_EPI) { if (wr == 1) PG8_BAR; }
    }
    PG8_WAIT_V(0);
    if constexpr (!ALIGN_EPI) { if (wr == 0) PG8_BAR; }
    PG8_BAR;
    if constexpr (Epi::AFTER_DRAIN) { E.fused(acc, cur, wr, wc, fr, fq, lds, wid, lane); S.done(cur); }
#undef PG8_GOFF
#undef PG8_SA
#undef PG8_SB
#undef PG8_STAGE
#undef PG8_STAGE_A
#undef PG8_VSEL_0
#undef PG8_VSEL_1
#undef PG8_LDA
#undef PG8_LDB
#undef PG8_MMA
#undef PG8_WAIT_V
#undef PG8_WAIT_L
#undef PG8_BAR
#undef PG8_SCHED
}
}

template <class TC, class LA, class LB, class EP>
__device__ __forceinline__ void oracle_gemm(LAS float* lds, int M, int N, int K, TC tilectx, LA loadA, LB loadB, EP epi) {
    LAS float* As = lds; LAS float* Bs = lds + 16 * 132;
    int tid = threadIdx.x; asm volatile("" : "+v"(tid)); const int ty = tid >> 4, tx = tid & 15;
    const int ntm = M / 128, ntn = (N + 127) / 128;
    for (int tile = blockIdx.x; tile < ntm * ntn; tile += gridDim.x) {
        const int tm = tile / ntn, tn = tile % ntn;
        const int ctx = tilectx(tm);
        float acc[4][8];
#pragma unroll
        for (int i = 0; i < 4; ++i)
#pragma unroll
            for (int j = 0; j < 8; ++j) acc[i][j] = 0.f;
        for (int k0 = 0; k0 < K; k0 += 16) {
#pragma unroll
            for (int i = 0; i < 4; ++i) { const int idx = tid + 512 * i; const int r = idx >> 4, kk = idx & 15; As[kk * 132 + r] = loadA(tm * 128 + r, k0 + kk); }
#pragma unroll
            for (int i = 0; i < 4; ++i) { const int idx = tid + 512 * i; const int kk = idx >> 7, n = idx & 127; Bs[kk * 132 + n] = loadB(k0 + kk, tn * 128 + n, ctx); }
            __syncthreads();
#pragma unroll 2
            for (int kk = 0; kk < 16; ++kk) {
                float a[4], b[8];
#pragma unroll
                for (int i = 0; i < 4; ++i) a[i] = As[kk * 132 + ty * 4 + i];
#pragma unroll
                for (int j = 0; j < 8; ++j) b[j] = Bs[kk * 132 + tx * 8 + j];
#pragma unroll
                for (int i = 0; i < 4; ++i)
#pragma unroll
                    for (int j = 0; j < 8; ++j) acc[i][j] += a[i] * b[j];
            }
            __syncthreads();
        }
        epi(tm * 128 + ty * 4, tn * 128 + tx * 8, acc, ctx);
    }
}


template <class MAP>
__device__ __forceinline__ void tr_item(const float* W, int ldw, int K, bf16* WT, int nblk, int item, LAS float* scr, int lane, MAP map) {
    const int kb = item / nblk, nb = item % nblk, k0 = kb * 64, n0 = nb * 64;
    const int s = map(n0 + lane);
    const float* wp = W + (size_t)k0 * ldw + (s >= 0 ? s : 0);
#pragma unroll 8
    for (int i = 0; i < 64; ++i) scr[i * 65 + lane] = (s >= 0) ? wp[(size_t)i * ldw] : 0.f;
    asm volatile("s_waitcnt lgkmcnt(0)" ::: "memory");
    const int c = lane & 7;
#pragma unroll
    for (int j = 0; j < 8; ++j) { const int n = (lane >> 3) + 8 * j; const LAS float* sp = scr + (8 * c) * 65 + n;
        uint4 o; o.x = pg8::cvt_pk_bf16(sp[0], sp[65]); o.y = pg8::cvt_pk_bf16(sp[130], sp[195]); o.z = pg8::cvt_pk_bf16(sp[260], sp[325]); o.w = pg8::cvt_pk_bf16(sp[390], sp[455]);
        *(uint4*)(WT + (size_t)(n0 + n) * K + k0 + 8 * c) = o; }
    asm volatile("s_waitcnt lgkmcnt(0)" ::: "memory");
}

template <class MAP>
__device__ __forceinline__ void tr_item8(const float* W, int ldw, int K, unsigned char* WT8, int nblk, int item, LAS float* scr, int lane, float scale, MAP map) {
    const int kb = item / nblk, nb = item % nblk, k0 = kb * 64, n0 = nb * 64;
    const int s = map(n0 + lane);
    const float* wp = W + (size_t)k0 * ldw + (s >= 0 ? s : 0);
#pragma unroll 8
    for (int i = 0; i < 64; ++i) scr[i * 65 + lane] = (s >= 0) ? wp[(size_t)i * ldw] * scale : 0.f;
    asm volatile("s_waitcnt lgkmcnt(0)" ::: "memory");
    const int c = lane & 7;
#pragma unroll
    for (int j = 0; j < 8; ++j) { const int n = (lane >> 3) + 8 * j; const LAS float* sp = scr + (8 * c) * 65 + n;
        int w0 = __builtin_amdgcn_cvt_pk_fp8_f32(sp[0], sp[65], 0, false); w0 = __builtin_amdgcn_cvt_pk_fp8_f32(sp[130], sp[195], w0, true);
        int w1 = __builtin_amdgcn_cvt_pk_fp8_f32(sp[260], sp[325], 0, false); w1 = __builtin_amdgcn_cvt_pk_fp8_f32(sp[390], sp[455], w1, true);
        uint2 o; o.x = (unsigned)w0; o.y = (unsigned)w1; *(uint2*)(WT8 + (size_t)(n0 + n) * K + k0 + 8 * c) = o; }
    asm volatile("s_waitcnt lgkmcnt(0)" ::: "memory");
}

struct Args { const void* in[46]; float* out; unsigned char* ws; int ph_lo, ph_hi; };

enum { PH_PRO = 0, PH_MEM = 1, PH_L0 = 2, PH_PER_LAYER = 9, PH_TOTAL = 2 + 9 * DEPTH };
enum { LP_INPROJ = 0, LP_MIXA = 1, LP_MIXB = 2, LP_OUTPROJ = 3, LP_LN1 = 4, LP_DISP = 5, LP_GU = 6, LP_DOWN = 7, LP_COMB = 8 };

__device__ __forceinline__ int expert_of_block(const LAS int* pend, int rb) {
    const int start = rb * MOEBLK; int e = 0;
#pragma unroll
    for (int i = 0; i < NEXP; ++i) e += (start >= pend[i]) ? 1 : 0;
    return e < NEXP - 1 ? e : NEXP - 1;
}

typedef const void* const __attribute__((address_space(4)))* KARG;
__global__ void __launch_bounds__(NTHR, 2) mk_fwd(Args args) {
    extern __shared__ __attribute__((aligned(16))) unsigned char lds_raw[];
    LAS unsigned char* lds = (LAS unsigned char*)lds_raw;
    LAS float* ldsf = (LAS float*)lds;
    volatile LAS unsigned* MISC = (volatile LAS unsigned*)(lds + LDS_MISC);
    const int tid0 = threadIdx.x, wave0 = __builtin_amdgcn_readfirstlane(tid0 >> 6);
    const int G = gridDim.x, bid = blockIdx.x;
#define LDS_BARRIER() do { asm volatile("s_waitcnt lgkmcnt(0)" ::: "memory"); __builtin_amdgcn_s_barrier(); asm volatile("" ::: "memory"); } while (0)
#define ARGP(i) ((const void*)kp_[i])
#define PHASE_IDS() int wave = wave0; asm volatile("" : "+s"(wave)); KARG kp_ = (KARG)__builtin_amdgcn_kernarg_segment_ptr(); asm volatile("" : "+s"(kp_)); unsigned char* ws = ws0; asm volatile("" : "+s"(ws)); unsigned* const ctl = (unsigned*)(ws + WS_CTL); (void)ctl; const int tid = wave * 64 + lane_id_opaque(); const int lane = tid & 63; (void)lane
    unsigned char* const ws0 = args.ws;
    unsigned* const ctl0 = (unsigned*)(ws0 + WS_CTL);
#define hf ((float*)(ws + WS_HF))
#define y2 ((float*)(ws + WS_Y2))
#define hb ((bf16*)(ws + WS_HB))
#define proj ((bf16*)(ws + WS_PROJ))
#define yg ((bf16*)(ws + WS_YG))
#define cat ((bf16*)(ws + WS_CAT))
#define top_e ((int*)(ws + WS_TOPE))
#define top_g ((float*)(ws + WS_TOPG))
#define dest ((int*)(ws + WS_DEST))
#define xr ((bf16*)(ws + WS_XR))
#define act ((bf16*)(ws + WS_ACT))
#define yr ((bf16*)(ws + WS_YR))
#define memK ((bf16*)(ws + WS_MEMK))
#define memV ((bf16*)(ws + WS_MEMV))
#define memVT ((bf16*)(ws + WS_MEMVT))
#define rope ((float*)(ws + WS_ROPE))
#define win_t ((bf16*)(ws + WS_WIN))
#define wglu_t ((bf16*)(ws + WS_WGLU))
#define wout_t ((bf16*)(ws + WS_WOUT))
#define wmem_t ((bf16*)(ws + WS_WMEM))
#define memb ((bf16*)(ws + WS_MEMB))
#define wgu_t ((bf16*)(ws + WS_WGU))
#define wdn_t ((bf16*)(ws + WS_WDN))
#define rwt ((bf16*)(ws + WS_RWT))
#define row_tok ((int*)(ws + WS_RTOK))
#define wgu8 (ws + WS_WGU)
#define wdn8 (ws + WS_WDN)
#define act8 (ws + WS_ACT)
#define hb8 (ws + WS_XR)
    constexpr float GU_WS = 32.0f, DN_WS = 64.0f;
    const int vcu = (G % 8 == 0) ? (bid % 8) * (G / 8) + bid / 8 : bid;

    if (tid0 < 64) MISC[tid0] = 0u;
    __syncthreads();
    const int lo = args.ph_lo, hi = args.ph_hi;
    XcdBarrier bar; bar.bar = ctl0 + CW_BAR; bar.x = 0; bar.st = MISC;
    if (hi - lo > 1) bar = xcd_barrier_post(ctl0 + CW_BAR, MISC, wave0);
#define IN(k) (lo <= (k) && (k) < hi)
#define SEAM(k) do { if (IN(k) && IN((k) + 1)) xcd_barrier(bar, wave0); } while (0)

    if (IN(PH_PRO)) {
            PHASE_IDS();
            REPS(0) { if (rep_) __syncthreads();
        {
            LAS float* scr = ldsf + wave * (64 * 65);
            const int gw = vcu * NWAVES + wave, NGW = G * NWAVES;
            constexpr int PRO_LAYERS = BG_CONV ? 1 : DEPTH;
            constexpr int N_GU = FAST_MOE ? PRO_LAYERS * NEXP * 512 : 0, N_DN = FAST_MOE ? PRO_LAYERS * NEXP * 256 : 0;
            constexpr int N_IN0 = FAST_DENSE ? 256 : 0, N_IN1 = FAST_DENSE ? 704 : 0, N_IN2 = FAST_DENSE ? 640 : 0, N_IN3 = N_IN0, N_GLU = FAST_DENSE ? 144 : 0, N_OUT = FAST_DENSE ? 256 : 0, N_MEM = FAST_DENSE ? 64 : 0;
            constexpr int NITEMS = N_GU + N_DN + N_IN0 + N_IN1 + N_IN2 + N_IN3 + 2 * N_GLU + 4 * N_OUT + 2 * N_MEM;
            for (int it = gw; it < NITEMS; it += NGW) {
                int r = it;
                if (r < N_GU) { const int le = r >> 9;
#if MOE_FP8
                    tr_item8((const float*)ARGP(42) + (size_t)le * D * 2 * DEXP, 2 * DEXP, D, wgu8 + (size_t)le * 2 * DEXP * D, 32, r & 511, scr, lane, GU_WS, [](int d) { const int tile = d >> 8, q = d & 255; return q < 128 ? tile * 128 + q : DEXP + tile * 128 + (q - 128); });
#else
                    tr_item((const float*)ARGP(42) + (size_t)le * D * 2 * DEXP, 2 * DEXP, D, wgu_t + (size_t)le * 2 * DEXP * D, 32, r & 511, scr, lane, [](int d) { const int tile = d >> 8, q = d & 255; return q < 128 ? tile * 128 + q : DEXP + tile * 128 + (q - 128); });
#endif
                    continue; } r -= N_GU;
                if (r < N_DN) { const int le = r >> 8;
#if MOE_FP8
                    tr_item8((const float*)ARGP(44) + (size_t)le * DEXP * D, D, DEXP, wdn8 + (size_t)le * D * DEXP, 16, r & 255, scr, lane, DN_WS, [](int d) { return d; });
#else
                    tr_item((const float*)ARGP(44) + (size_t)le * DEXP * D, D, DEXP, wdn_t + (size_t)le * D * DEXP, 16, r & 255, scr, lane, [](int d) { return d; });
#endif
                    continue; } r -= N_DN;
                if (r < N_IN0) { tr_item((const float*)ARGP(5), 1024, D, win_t, 16, r, scr, lane, [](int d) { return d; }); continue; } r -= N_IN0;
                if (r < N_IN1) { tr_item((const float*)ARGP(16), 2568, D, win_t + (size_t)1 * 3 * MiB, 44, r, scr, lane, [](int d) { return d < 2568 ? d : -1; }); continue; } r -= N_IN1;
                if (r < N_IN2) { tr_item((const float*)ARGP(22), 2560, D, win_t + (size_t)2 * 3 * MiB, 40, r, scr, lane, [](int d) { return d; }); continue; } r -= N_IN2;
                if (r < N_IN3) { tr_item((const float*)ARGP(24), 1024, D, win_t + (size_t)3 * 3 * MiB, 16, r, scr, lane, [](int d) { return d; }); continue; } r -= N_IN3;
                if (r < N_GLU) { tr_item((const float*)ARGP(14), MIXW, MIXW, wglu_t, 12, r, scr, lane, [](int d) { return d; }); continue; } r -= N_GLU;
                if (r < N_GLU) { tr_item((const float*)ARGP(33), MIXW, MIXW, wglu_t + (size_t)1 * MiB, 12, r, scr, lane, [](int d) { return d; }); continue; } r -= N_GLU;
                if (r < 4 * N_OUT) { const int l = r >> 8; tr_item((const float*)ARGP(35) + (size_t)l * D * D, D, D, wout_t + (size_t)l * D * D, 16, r & 255, scr, lane, [](int d) { return d; }); continue; } r -= 4 * N_OUT;
                if (r < N_MEM) { tr_item((const float*)ARGP(3), 256, D, wmem_t, 4, r, scr, lane, [](int d) { return d; }); continue; } r -= N_MEM;
                tr_item((const float*)ARGP(4), 256, D, wmem_t + (size_t)256 * D, 4, r, scr, lane, [](int d) { return d; });
            }
            const float* mem = (const float*)ARGP(1);
            for (size_t i = ((size_t)bid * NTHR + tid) * 4; i < (size_t)NB * NMEM * D; i += (size_t)G * NTHR * 4) {
                const float4 v = *(const float4*)(mem + i); uint2 o; o.x = pg8::cvt_pk_bf16(v.x, v.y); o.y = pg8::cvt_pk_bf16(v.z, v.w); *(uint2*)(memb + i) = o; }
        }
        {
            const float* rwf = (const float*)ARGP(40);
            for (int i = bid * NTHR + tid; i < DEPTH * NEXP * D; i += G * NTHR) { const int l = i / (NEXP * D), rem = i % (NEXP * D), e = rem / D, k = rem % D;
                const float v = rwf[((size_t)l * D + k) * NEXP + e]; const bf16 hi_ = f2bf(v); const bf16 lo_ = f2bf(v - bf2f(hi_));
                rwt[((size_t)(l * 2 + 0) * NEXP + e) * D + k] = hi_; rwt[((size_t)(l * 2 + 1) * NEXP + e) * D + k] = lo_; }
        }
        const float* x = (const float*)ARGP(0);
        for (size_t i = ((size_t)bid * NTHR + tid) * 4; i < (size_t)T * D; i += (size_t)G * NTHR * 4) {
            const float4 v = *(const float4*)(x + i);
#if !RES_BF16
            *(float4*)(hf + i) = v;
#endif
            uint2 o; o.x = pk2(v.x, v.y); o.y = pk2(v.z, v.w); *(uint2*)(hb + i) = o;
        }
        const int* pos = (const int*)ARGP(2);
        for (int idx = bid * NTHR + tid; idx < T * 48; idx += G * NTHR) {
            const int t = idx / 48, i = idx % 48;
            const double inv = exp(-((double)(2 * i) / 96.0) * 9.210340371976184);
            double r = (double)pos[t] * inv * 0.15915494309189535; r -= rint(r);
            const float rf = (float)r;
            typedef _Float16 h2_t __attribute__((ext_vector_type(2))); h2_t cs_; cs_.x = (_Float16)__builtin_amdgcn_cosf(rf); cs_.y = (_Float16)__builtin_amdgcn_sinf(rf);
            ((unsigned*)rope)[idx] = __builtin_bit_cast(unsigned, cs_);
        }
    } }
    SEAM(PH_PRO);

    if (IN(PH_MEM)) {
            PHASE_IDS();
            REPS(1) { if (rep_) __syncthreads();
#if FAST_DENSE
        { pg8::Gemm g{memb, wmem_t, D, nullptr}; pg8::StaticOrder S; S.init(NB * NMEM, 512, G, bid); pg8::EpiMem E{memK, memV, memVT}; pg8::gemm_phase(lds, g, S, E, wave); }
#else
        const float* mem = (const float*)ARGP(1); const float* wk = (const float*)ARGP(3); const float* wv = (const float*)ARGP(4);
        oracle_gemm(ldsf, NB * NMEM, 512, D,
            [&](int) { return 0; },
            [&](int m, int k) { return mem[(size_t)m * D + k]; },
            [&](int k, int n, int) { return n < 256 ? wk[(size_t)k * 256 + n] : wv[(size_t)k * 256 + n - 256]; },
            [&](int m0, int n0, float (&acc)[4][8], int) {
#pragma unroll
                for (int i = 0; i < 4; ++i)
#pragma unroll
                    for (int j = 0; j < 8; ++j) { const int m = m0 + i, n = n0 + j; const int b = m >> 8, key = m & 255; const int nn = n & 255, head = nn >> 6, d = nn & 63; const bf16 v = f2bf(acc[i][j]);
                        if (n < 256) memK[((size_t)(b * 4 + head) * 256 + key) * 64 + d] = v;
                        else { memV[((size_t)(b * 4 + head) * 256 + key) * 64 + d] = v; memVT[((size_t)(b * 4 + head) * 64 + d) * 256 + key] = v; } }
            });
#endif
    } }

    for (int L = 0; L < DEPTH; ++L) {
        const int P = PH_L0 + PH_PER_LAYER * L;
        const int kind = L % 3;
        const int Nin = (kind == 0) ? 1024 : (kind == 1 ? 2568 : 2560);
        const int xq_off = (kind == 0) ? 768 : (kind == 1 ? 2312 : 2304);

        if (IN(P + LP_INPROJ)) {
            PHASE_IDS();
            REPS(2) { if (rep_) __syncthreads();
#if FAST_DENSE
            { const int Npad = (kind == 0) ? 1024 : (kind == 1 ? 2816 : 2560);
              pg8::Gemm g{hb, win_t + (size_t)L * 3 * MiB, D, nullptr}; pg8::StaticOrder S; S.init(T, Npad, G, bid); pg8::EpiBf16 E{proj, LDP, nullptr, 0, 1.0f}; pg8::gemm_phase(lds, g, S, E, wave); }
#else
            const float* w_in = (const float*)(L == 0 ? ARGP(5) : L == 1 ? ARGP(16) : L == 2 ? ARGP(22) : ARGP(24));
            oracle_gemm(ldsf, T, Nin, D,
                [&](int) { return 0; },
                [&](int m, int k) { return bf2f(hb[(size_t)m * D + k]); },
                [&](int k, int n, int) { return n < Nin ? w_in[(size_t)k * Nin + n] : 0.f; },
                [&](int m0, int n0, float (&acc)[4][8], int) {
#pragma unroll
                    for (int i = 0; i < 4; ++i)
#pragma unroll
                        for (int j = 0; j < 8; ++j) if (n0 + j < Nin) proj[(size_t)(m0 + i) * LDP + n0 + j] = f2bf(acc[i][j]);
                });
#endif
        } }
        SEAM(P + LP_INPROJ);

        if (IN(P + LP_MIXA)) {
            PHASE_IDS();
            REPS(kind == 0 ? 11 : 12) { if (rep_) __syncthreads();
            if (kind == 0) {
                const int o = (L == 0) ? 6 : 25;
                const float* a_re = (const float*)args.in[o + 0]; const float* a_im = (const float*)args.in[o + 1]; const float* log_dt = (const float*)args.in[o + 2];
                const float* b_re = (const float*)args.in[o + 3]; const float* b_im = (const float*)args.in[o + 4]; const float* c_re = (const float*)args.in[o + 5];
                const float* c_im = (const float*)args.in[o + 6]; const float* d_skip = (const float*)args.in[o + 7];
#if FAST_S5
                typedef pg8::bf16x8 bx8; typedef pg8::f32x4 fx4;
                LAS float* BU = (LAS float*)(lds + wave * 32768);
                LAS bf16* XS = (LAS bf16*)(lds + wave * 32768 + 16896);
                for (int unit = wave * G + vcu; wave < 4 && unit < NB * 48; unit += G * 4) {
                    const int b = unit / 48, g = unit % 48, p = lane, tok = lane & 15, sg = lane >> 4;
                    const float lre = fminf(a_re[g * 64 + p], -1e-4f), lim = a_im[g * 64 + p];
                    const float dt = __expf(log_dt[g]);
                    const float mag = __expf(dt * lre); float sn, cs; sincos_rad(dt * lim, sn, cs);
                    const float abr = mag * cs, abi = mag * sn;
                    const float den = lre * lre + lim * lim, nr = abr - 1.0f;
                    const float cr = (nr * lre + abi * lim) / den, ci = (abi * lre - nr * lim) / den;
                    bx8 Bf[8], Cf[4];
#pragma unroll
                    for (int tI = 0; tI < 4; ++tI) {
                        const int sp = 16 * tI + tok; const float crs = sh_idx(cr, sp, lane), cis = sh_idx(ci, sp, lane);
                        unsigned wr_[4] = {0u, 0u, 0u, 0u}, wi_[4] = {0u, 0u, 0u, 0u};
                        if (sg < 2) { const float4* pr_ = (const float4*)(b_re + (size_t)(g * 64 + sp) * 16 + 8 * sg); const float4* pi_ = (const float4*)(b_im + (size_t)(g * 64 + sp) * 16 + 8 * sg);
                            const float4 r0 = pr_[0], r1 = pr_[1], i0 = pi_[0], i1 = pi_[1];
                            const float br[8] = {r0.x, r0.y, r0.z, r0.w, r1.x, r1.y, r1.z, r1.w}, bi[8] = {i0.x, i0.y, i0.z, i0.w, i1.x, i1.y, i1.z, i1.w};
#pragma unroll
                            for (int q = 0; q < 4; ++q) { wr_[q] = pk2(crs * br[2 * q] - cis * bi[2 * q], crs * br[2 * q + 1] - cis * bi[2 * q + 1]); wi_[q] = pk2(crs * bi[2 * q] + cis * br[2 * q], crs * bi[2 * q + 1] + cis * br[2 * q + 1]); } }
                        uint4 a4; a4.x = wr_[0]; a4.y = wr_[1]; a4.z = wr_[2]; a4.w = wr_[3]; Bf[tI] = __builtin_bit_cast(bx8, a4);
                        uint4 b4; b4.x = wi_[0]; b4.y = wi_[1]; b4.z = wi_[2]; b4.w = wi_[3]; Bf[4 + tI] = __builtin_bit_cast(bx8, b4);
                    }
#pragma unroll
                    for (int j = 0; j < 4; ++j) {
                        const float4 c4 = *(const float4*)(c_re + (size_t)(g * 16 + tok) * 64 + 16 * j + 4 * sg), d4 = *(const float4*)(c_im + (size_t)(g * 16 + tok) * 64 + 16 * j + 4 * sg);
                        uint4 a4; a4.x = pk2(c4.x, -d4.x); a4.y = pk2(c4.y, -d4.y); a4.z = pk2(c4.z, -d4.z); a4.w = pk2(c4.w, -d4.w); Cf[j] = __builtin_bit_cast(bx8, a4);
                    }
                    const float4 dsk4 = *(const float4*)(d_skip + g * 16 + 4 * sg);
                    float sxr = 0.f, sxi = 0.f;
                    const bf16* ubase = proj + (size_t)b * SEQ * LDP + g * 16;
                    uint4 unx[4]; uint2 uex[4];
#pragma unroll
                    for (int q = 0; q < 4; ++q) { unx[q] = make_uint4(0u, 0u, 0u, 0u); if (sg < 2) unx[q] = *(const uint4*)(ubase + (size_t)(16 * q + tok) * LDP + 8 * sg); uex[q] = *(const uint2*)(ubase + (size_t)(16 * q + tok) * LDP + 4 * sg); }
                    fx4 dnx[8];
                    { const bx8 uf0 = __builtin_bit_cast(bx8, unx[0]);
#pragma unroll
                      for (int tI = 0; tI < 8; ++tI) { const fx4 d = __builtin_amdgcn_mfma_f32_16x16x32_bf16(Bf[tI], uf0, (fx4){0.f, 0.f, 0.f, 0.f}, 0, 0, 0); *(LAS fx4*)(BU + tok * 132 + 16 * tI + 4 * sg) = d; } }
                    uint2 ue_prev = make_uint2(0u, 0u);
                    for (int t64 = 0; t64 < SEQ; t64 += 64) {
                        uint4 ucu[4]; uint2 uec[4];
#pragma unroll
                        for (int q = 0; q < 4; ++q) { ucu[q] = unx[q]; uec[q] = uex[q]; }
                        if (t64 + 64 < SEQ) {
#pragma unroll
                            for (int q = 0; q < 4; ++q) { if (sg < 2) unx[q] = *(const uint4*)(ubase + (size_t)(t64 + 64 + 16 * q + tok) * LDP + 8 * sg); uex[q] = *(const uint2*)(ubase + (size_t)(t64 + 64 + 16 * q + tok) * LDP + 4 * sg); } }
#pragma unroll
                        for (int q = 0; q < 4; ++q) {
                            const int t0 = t64 + 16 * q, cb = q & 1, nb = cb ^ 1;
                            LAS float* BUc = BU + cb * (16 * 132); LAS float* BUn = BU + nb * (16 * 132);
                            LAS bf16* XSc = XS + cb * (16 * 136); LAS bf16* XSp = XS + nb * (16 * 136);
                            float bre[16], bim[16];
#pragma unroll
                            for (int t = 0; t < 16; ++t) { bre[t] = BUc[t * 132 + p]; bim[t] = BUc[t * 132 + 64 + p]; }
                            const bool has_next = (t0 + 16 < SEQ);
                            { const bx8 ufn = __builtin_bit_cast(bx8, (q < 3) ? ucu[(q + 1) & 3] : unx[0]);
#pragma unroll
                              for (int tI = 0; tI < 8; ++tI) dnx[tI] = __builtin_amdgcn_mfma_f32_16x16x32_bf16(Bf[tI], ufn, (fx4){0.f, 0.f, 0.f, 0.f}, 0, 0, 0); }
                            fx4 y = (fx4){0.f, 0.f, 0.f, 0.f};
                            if (t0 > 0) {
#pragma unroll
                                for (int j = 0; j < 4; ++j) { const bx8 xf = *(const LAS bx8*)(XSp + tok * 136 + 32 * j + 8 * sg); y = __builtin_amdgcn_mfma_f32_16x16x32_bf16(Cf[j], xf, y, 0, 0, 0); } }
#pragma unroll
                            for (int t = 0; t < 16; ++t) { const float nxr = abr * sxr - abi * sxi + bre[t], nxi = abr * sxi + abi * sxr + bim[t]; sxr = nxr; sxi = nxi;
                                *(LAS unsigned*)(XSc + t * 136 + 2 * p) = pg8::cvt_pk_bf16(sxr, sxi); }
                            if (has_next) {
#pragma unroll
                                for (int tI = 0; tI < 8; ++tI) *(LAS fx4*)(BUn + tok * 132 + 16 * tI + 4 * sg) = dnx[tI]; }
                            if (t0 > 0) {
                                const float u0 = __uint_as_float(ue_prev.x << 16), u1 = __uint_as_float(ue_prev.x & 0xffff0000u), u2 = __uint_as_float(ue_prev.y << 16), u3 = __uint_as_float(ue_prev.y & 0xffff0000u);
                                uint2 o; o.x = pg8::cvt_pk_bf16(gelu_tanh(y[0] + dsk4.x * u0), gelu_tanh(y[1] + dsk4.y * u1)); o.y = pg8::cvt_pk_bf16(gelu_tanh(y[2] + dsk4.z * u2), gelu_tanh(y[3] + dsk4.w * u3));
                                *(uint2*)(yg + (size_t)(b * SEQ + t0 - 16 + tok) * MIXW + g * 16 + 4 * sg) = o; }
                            ue_prev = uec[q];
                        }
                    }
                    {
                        LAS bf16* XSp = XS + 1 * (16 * 136);
                        fx4 y = (fx4){0.f, 0.f, 0.f, 0.f};
#pragma unroll
                        for (int j = 0; j < 4; ++j) { const bx8 xf = *(const LAS bx8*)(XSp + tok * 136 + 32 * j + 8 * sg); y = __builtin_amdgcn_mfma_f32_16x16x32_bf16(Cf[j], xf, y, 0, 0, 0); }
                        const float u0 = __uint_as_float(ue_prev.x << 16), u1 = __uint_as_float(ue_prev.x & 0xffff0000u), u2 = __uint_as_float(ue_prev.y << 16), u3 = __uint_as_float(ue_prev.y & 0xffff0000u);
                        uint2 o; o.x = pg8::cvt_pk_bf16(gelu_tanh(y[0] + dsk4.x * u0), gelu_tanh(y[1] + dsk4.y * u1)); o.y = pg8::cvt_pk_bf16(gelu_tanh(y[2] + dsk4.z * u2), gelu_tanh(y[3] + dsk4.w * u3));
                        *(uint2*)(yg + (size_t)(b * SEQ + SEQ - 16 + tok) * MIXW + g * 16 + 4 * sg) = o;
                    }
                }
#else
                for (int unit = bid * NWAVES + wave; unit < NB * 48; unit += G * NWAVES) {
                    const int b = unit / 48, g = unit % 48, p = lane;
                    const float lre = fminf(a_re[g * 64 + p], -1e-4f), lim = a_im[g * 64 + p];
                    const float dt = __expf(log_dt[g]);
                    const float mag = __expf(dt * lre); float sn, cs; sincos_rad(dt * lim, sn, cs);
                    const float abr = mag * cs, abi = mag * sn;
                    const float den = lre * lre + lim * lim, nr = abr - 1.0f;
                    const float cr = (nr * lre + abi * lim) / den, ci = (abi * lre - nr * lim) / den;
                    float Br[16], Bi[16], Cr[16], Ci[16];
#pragma unroll
                    for (int h = 0; h < 16; ++h) { const float br = b_re[(size_t)(g * 64 + p) * 16 + h], bi = b_im[(size_t)(g * 64 + p) * 16 + h];
                        Br[h] = cr * br - ci * bi; Bi[h] = cr * bi + ci * br; Cr[h] = c_re[(size_t)(g * 16 + h) * 64 + p]; Ci[h] = c_im[(size_t)(g * 16 + h) * 64 + p]; }
                    const float dsk = d_skip[g * 16 + (lane & 15)];
                    float sxr = 0.f, sxi = 0.f;
                    for (int t = 0; t < SEQ; ++t) {
                        const bf16* up = proj + (size_t)(b * SEQ + t) * LDP + g * 16;
                        float u[16]; unpack8(*(const uint4*)up, u); unpack8(*(const uint4*)(up + 8), u + 8);
                        float bur = 0.f, bui = 0.f;
#pragma unroll
                        for (int h = 0; h < 16; ++h) { bur += Br[h] * u[h]; bui += Bi[h] * u[h]; }
                        const float nxr = abr * sxr - abi * sxi + bur, nxi = abr * sxi + abi * sxr + bui; sxr = nxr; sxi = nxi;
                        float myy = 0.f;
#pragma unroll
                        for (int h = 0; h < 16; ++h) { float v = Cr[h] * sxr - Ci[h] * sxi; v = wave_sum(v, lane); myy = (lane == h) ? v : myy; }
                        if (lane < 16) { const float uu = bf2f(up[lane]); const float y = gelu_tanh(myy + dsk * uu); yg[(size_t)(b * SEQ + t) * MIXW + g * 16 + lane] = f2bf(y); }
                    }
                }
#endif
            } else {
#if FAST_LINATT
                {
                    typedef pg8::bf16x8 bx8; typedef pg8::f32x4 fx4; typedef pg8::u32x4 ux4; typedef pg8::u32x2 ux2;
                    LAS bf16* Qs = (LAS bf16*)lds;
                    LAS bf16* Ks = (LAS bf16*)(lds + 13312);
                    LAS bf16* KTe = (LAS bf16*)(lds + 26624);
                    LAS bf16* VT = (LAS bf16*)(lds + 40448);
                    LAS bf16* Ps = (LAS bf16*)(lds + 68096);
                    LAS bf16* CT = (LAS bf16*)(lds + 77312);
                    LAS float* fa = (LAS float*)(lds + 117248);
                    LAS float* aArr = fa, *MArr = fa + 64, *interArr = fa + 128, *clampArr = fa + 192, *eArr = fa + 256, *denArr = fa + 320, *nArr = fa + 384  , *stat = fa + 480  , *scal = fa + 736;
                    const float* conv_q = (const float*)ARGP(17); const float* conv_k = (const float*)ARGP(18);
                    const float* b_i = (const float*)ARGP(19); const float* b_f = (const float*)ARGP(20);
                    const float* norm_g = (const float*)(kind == 1 ? ARGP(21) : ARGP(23));
                    const int tok = lane & 15, sg = lane >> 4;
                    for (int unit = bid; unit < NB * 4; unit += G) {
                        const int b = unit >> 2, h = unit & 3;
                        const float lgam = __logf(1.0f - exp2f(-5.0f - (float)h));
                        fx4 Cst[3][3];
#pragma unroll
                        for (int x = 0; x < 3; ++x)
#pragma unroll
                            for (int y = 0; y < 3; ++y) Cst[x][y] = (fx4){0.f, 0.f, 0.f, 0.f};
                        float nreg = 0.f, m_prev = 0.f;
                        __syncthreads();
                        for (int i = tid; i < 192 * 104 / 2; i += NTHR) ((LAS unsigned*)CT)[i] = 0u;
                        if (tid < 96) nArr[tid] = 0.f;
                        const int ctU = 3 * (wave & 3), itU = 3 * (wave >> 2);
                        const int jt = wave & 3, half = wave >> 2;
                        typedef _Float16 h2_t __attribute__((ext_vector_type(2)));
                        ux4 rv[3], rg[8]; float rig = 0.f, rfg = 0.f;
#pragma unroll
                        for (int q = 0; q < 8; ++q) rg[q] = (ux4){0u, 0u, 0u, 0u};
#define LINATT_LOAD_RAW(cc) do { const size_t r0_ = (size_t)b * SEQ + (size_t)(cc) * 64; \
                            _Pragma("unroll") for (int kq = 0; kq < 3; ++kq) { const int idx = tidv + NTHR * kq, cg = idx >> 6, s = idx & 63; rv[kq] = *(const ux4*)(proj + (r0_ + s) * LDP + 768 + h * 192 + 8 * cg); } \
                            if (kind == 1) { _Pragma("unroll") for (int kq = 0; kq < 3; ++kq) { const int idx = tidv + NTHR * kq, which = idx / 768, rem = idx % 768, cg = rem >> 6, s = rem & 63; \
                                    rg[kq] = *(const ux4*)(proj + (r0_ + s) * LDP + which * 384 + h * 96 + 8 * cg); } \
                                if (wave == 0) { const bf16* pr = proj + (r0_ + lanev) * LDP; rig = bf2f(pr[2304 + h]); rfg = bf2f(pr[2308 + h]); } } \
                            else { _Pragma("unroll") for (int kq = 0; kq < 2; ++kq) { const int idx = tidv + NTHR * kq; if (idx < 768) { const int which = idx / 384, rem = idx % 384, cg = rem >> 6, s = rem & 63; \
                                    const bf16* xp = proj + (r0_ + s) * LDP + which * 384 + h * 96 + 8 * cg; rg[kq] = *(const ux4*)xp; rg[2 + kq] = *(const ux4*)(xp + 48); \
                                    const ux4* rp = (const ux4*)((const unsigned*)rope + (r0_ + s) * 48 + 8 * cg); rg[4 + 2 * kq] = rp[0]; rg[5 + 2 * kq] = rp[1]; } } } } while (0)
                        { int tidv = tid; asm volatile("" : "+v"(tidv)); const int lanev = tidv & 63; LINATT_LOAD_RAW(0); }
                        for (int c = 0; c < SEQ / 64; ++c) {
                            const size_t row0 = (size_t)b * SEQ + c * 64;
                            int tidv = tid; asm volatile("" : "+v"(tidv));
                            const int lanev = tidv & 63, tokv = lanev & 15, sgv = lanev >> 4;
                            if (wave == 0) {
                                float lf, ig;
                                if (kind == 1) { ig = rig + b_i[h]; const float fg = rfg + b_f[h]; lf = fminf(fg, 0.f) - __logf(1.0f + __expf(-fabsf(fg))); }
                                else { ig = 0.f; lf = lgam; }
                                float bc = lf;
#pragma unroll
                                for (int o = 1; o < 64; o <<= 1) { const float t = sh_up(bc, o, lanev); if (lanev >= o) bc += t; }
                                const float a = ig - bc; float M;
                                if (kind == 1) { float A = a;
#pragma unroll
                                    for (int o = 1; o < 64; o <<= 1) { const float t = sh_up(A, o, lanev); if (lanev >= o) A = fmaxf(A, t); }
                                    M = fmaxf(m_prev, A); }
                                else M = -bc;
                                const float M63 = sh_idx(M, 63, lane), btot = sh_idx(bc, 63, lane);
                                aArr[lanev] = a; MArr[lanev] = M; interArr[lanev] = __expf(m_prev - M); clampArr[lanev] = __expf(-(bc + M)); eArr[lanev] = __expf(a - M63);
                                if (lanev == 0) scal[0] = __expf(m_prev - M63);
                                if (kind == 1) m_prev = btot + M63;
                            }
                            LDS_BARRIER();
#pragma unroll
                            for (int kq = 0; kq < 3; ++kq) {
                                const int idx = tidv + NTHR * kq, cg = idx >> 6, s = idx & 63; const ux4 v = rv[kq];
                                LAS bf16* d = VT + (8 * cg) * 72 + s;
                                d[0] = (bf16)(v.x & 0xffffu); d[72] = (bf16)(v.x >> 16); d[144] = (bf16)(v.y & 0xffffu); d[216] = (bf16)(v.y >> 16);
                                d[288] = (bf16)(v.z & 0xffffu); d[360] = (bf16)(v.z >> 16); d[432] = (bf16)(v.w & 0xffffu); d[504] = (bf16)(v.w >> 16);
                            }
                            if (kind == 1) {
#pragma unroll
                                for (int kq = 0; kq < 3; ++kq) {
                                    const int idx = tidv + NTHR * kq, which = idx / 768, rem = idx % 768, cg = rem >> 6, s = rem & 63;
                                    const int ch = h * 96 + 8 * cg;
                                    const float* cw = (which ? conv_k : conv_q) + ch;
                                    float r[8];
                                    { float x[8]; uint4 xu; xu.x = rg[kq].x; xu.y = rg[kq].y; xu.z = rg[kq].z; xu.w = rg[kq].w; unpack8(xu, x);
                                      const float4 w0 = *(const float4*)(cw + 3 * 384), w1 = *(const float4*)(cw + 3 * 384 + 4);
                                      r[0] = w0.x * x[0]; r[1] = w0.y * x[1]; r[2] = w0.z * x[2]; r[3] = w0.w * x[3]; r[4] = w1.x * x[4]; r[5] = w1.y * x[5]; r[6] = w1.z * x[6]; r[7] = w1.w * x[7]; }
#pragma unroll
                                    for (int dl = 1; dl <= 3; ++dl) {
                                        const int sl = (lanev - dl) & 63; uint4 xu;
                                        { const unsigned c0 = sh_idx(rg[kq].x, sl, lanev), p0 = sh_idx(rg[3 + kq].x, sl, lanev); xu.x = (lanev >= dl) ? c0 : p0; }
                                        { const unsigned c0 = sh_idx(rg[kq].y, sl, lanev), p0 = sh_idx(rg[3 + kq].y, sl, lanev); xu.y = (lanev >= dl) ? c0 : p0; }
                                        { const unsigned c0 = sh_idx(rg[kq].z, sl, lanev), p0 = sh_idx(rg[3 + kq].z, sl, lanev); xu.z = (lanev >= dl) ? c0 : p0; }
                                        { const unsigned c0 = sh_idx(rg[kq].w, sl, lanev), p0 = sh_idx(rg[3 + kq].w, sl, lanev); xu.w = (lanev >= dl) ? c0 : p0; }
                                        float x[8]; unpack8(xu, x);
                                        const float4 w0 = *(const float4*)(cw + (3 - dl) * 384), w1 = *(const float4*)(cw + (3 - dl) * 384 + 4);
                                        r[0] += w0.x * x[0]; r[1] += w0.y * x[1]; r[2] += w0.z * x[2]; r[3] += w0.w * x[3]; r[4] += w1.x * x[4]; r[5] += w1.y * x[5]; r[6] += w1.z * x[6]; r[7] += w1.w * x[7];
                                    }
                                    rg[3 + kq] = rg[kq];
                                    const float sc = which ? 1.0f : 0.10206207261596575f;
#pragma unroll
                                    for (int i = 0; i < 8; ++i) r[i] = r[i] * sigmoidf(r[i]) * sc;
                                    ux4 pk; pk.x = pg8::cvt_pk_bf16(r[0], r[1]); pk.y = pg8::cvt_pk_bf16(r[2], r[3]); pk.z = pg8::cvt_pk_bf16(r[4], r[5]); pk.w = pg8::cvt_pk_bf16(r[6], r[7]);
                                    if (which == 0) *(LAS ux4*)(Qs + s * 104 + 8 * cg) = pk;
                                    else { *(LAS ux4*)(Ks + s * 104 + 8 * cg) = pk; const float es = eArr[s]; LAS bf16* d = KTe + (8 * cg) * 72 + s;
#pragma unroll
                                        for (int i = 0; i < 8; ++i) d[72 * i] = f2bf(r[i] * es); }
                                }
                            } else {
#pragma unroll
                                for (int kq = 0; kq < 2; ++kq) {
                                    const int idx = tidv + NTHR * kq;
                                    if (idx < 768) {
                                        const int which = idx / 384, rem = idx % 384, cg = rem >> 6, s = rem & 63;
                                        float x1[8], x2[8]; { uint4 xu; xu.x = rg[kq].x; xu.y = rg[kq].y; xu.z = rg[kq].z; xu.w = rg[kq].w; unpack8(xu, x1); xu.x = rg[2 + kq].x; xu.y = rg[2 + kq].y; xu.z = rg[2 + kq].z; xu.w = rg[2 + kq].w; unpack8(xu, x2); }
                                        const unsigned rpw[8] = {rg[4 + 2 * kq].x, rg[4 + 2 * kq].y, rg[4 + 2 * kq].z, rg[4 + 2 * kq].w, rg[5 + 2 * kq].x, rg[5 + 2 * kq].y, rg[5 + 2 * kq].z, rg[5 + 2 * kq].w};
                                        float o1[8], o2[8]; const float sc = which ? 0.10206207261596575f : 1.0f;
#pragma unroll
                                        for (int q8 = 0; q8 < 8; ++q8) { const h2_t cs_ = __builtin_bit_cast(h2_t, rpw[q8]); const float c0 = (float)cs_.x, s0 = (float)cs_.y;
                                            o1[q8] = (x1[q8] * c0 - x2[q8] * s0) * sc; o2[q8] = (x2[q8] * c0 + x1[q8] * s0) * sc; }
                                        ux4 p1; p1.x = pg8::cvt_pk_bf16(o1[0], o1[1]); p1.y = pg8::cvt_pk_bf16(o1[2], o1[3]); p1.z = pg8::cvt_pk_bf16(o1[4], o1[5]); p1.w = pg8::cvt_pk_bf16(o1[6], o1[7]);
                                        ux4 p2; p2.x = pg8::cvt_pk_bf16(o2[0], o2[1]); p2.y = pg8::cvt_pk_bf16(o2[2], o2[3]); p2.z = pg8::cvt_pk_bf16(o2[4], o2[5]); p2.w = pg8::cvt_pk_bf16(o2[6], o2[7]);
                                        LAS bf16* dst = which ? Ks : Qs;
                                        *(LAS ux4*)(dst + s * 104 + 8 * cg) = p1; *(LAS ux4*)(dst + s * 104 + 48 + 8 * cg) = p2;
                                        if (which) { const float es = eArr[s]; LAS bf16* d = KTe + (8 * cg) * 72 + s;
#pragma unroll
                                            for (int i = 0; i < 8; ++i) { d[72 * i] = f2bf(o1[i] * es); d[72 * (48 + i)] = f2bf(o2[i] * es); } }
                                    }
                                }
                            }
                            if (c + 1 < SEQ / 64) LINATT_LOAD_RAW(c + 1);
                            LDS_BARRIER(); __builtin_amdgcn_sched_barrier(0);
                            {
                                bx8 yq[3];
#pragma unroll
                                for (int kk = 0; kk < 3; ++kk) yq[kk] = *(const LAS bx8*)(Qs + (16 * jt + tokv) * 104 + 32 * kk + 8 * sgv);
                                const int j = 16 * jt + tokv; const float Mj = MArr[j];
#pragma unroll
                                for (int q2 = 0; q2 < 2; ++q2) {
                                    const int st = 2 * half + q2; fx4 d = (fx4){0.f, 0.f, 0.f, 0.f};
                                    if (st <= jt) {
#pragma unroll
                                        for (int kk = 0; kk < 3; ++kk) { const bx8 xk = *(const LAS bx8*)(Ks + (16 * st + tokv) * 104 + 32 * kk + 8 * sgv); d = __builtin_amdgcn_mfma_f32_16x16x32_bf16(xk, yq[kk], d, 0, 0, 0); }
#pragma unroll
                                        for (int r = 0; r < 4; ++r) { const int s = 16 * st + 4 * sgv + r; d[r] = (s <= j) ? d[r] * __expf(aArr[s] - Mj) : 0.f; }
                                    }
                                    ux2 pw; pw.x = pg8::cvt_pk_bf16(d[0], d[1]); pw.y = pg8::cvt_pk_bf16(d[2], d[3]);
                                    *(LAS ux2*)(Ps + j * 72 + 16 * st + 4 * sgv) = pw;
                                }
                            }
                            LDS_BARRIER();
                            __builtin_amdgcn_sched_barrier(0);
                            if (kind == 1) {
                                const int j = tidv >> 3, part = tidv & 7; float dq = 0.f, dp = 0.f;
#pragma unroll
                                for (int i = 0; i < 12; ++i) dq += bf2f(Qs[j * 104 + part * 12 + i]) * nArr[part * 12 + i];
#pragma unroll
                                for (int s = 0; s < 8; ++s) dp += bf2f(Ps[j * 72 + part * 8 + s]);
                                float dn = interArr[j] * dq + dp; dn += sh_xor(dn, 1, lane); dn += sh_xor(dn, 2, lane); dn += sh_xor(dn, 4, lane);
                                if (part == 0) denArr[j] = dn;
                            }
                            __builtin_amdgcn_sched_barrier(0);
                            fx4 acc[6];
                            const size_t orow = row0 + 16 * jt + tokv;
                            ux2 ogate[6];
#pragma unroll
                            for (int x = 0; x < 6; ++x) ogate[x] = *(const ux2*)(proj + orow * LDP + 1536 + h * 192 + 16 * (6 * half + x) + 4 * sgv);
                            {
                                bx8 yq[3];
#pragma unroll
                                for (int kk = 0; kk < 3; ++kk) yq[kk] = *(const LAS bx8*)(Qs + (16 * jt + tokv) * 104 + 32 * kk + 8 * sgv);
#pragma unroll
                                for (int x = 0; x < 6; ++x) { acc[x] = (fx4){0.f, 0.f, 0.f, 0.f}; const int ct = 6 * half + x;
#pragma unroll
                                    for (int kk = 0; kk < 3; ++kk) { const bx8 xc = *(const LAS bx8*)(CT + (16 * ct + tokv) * 104 + 32 * kk + 8 * sgv); acc[x] = __builtin_amdgcn_mfma_f32_16x16x32_bf16(xc, yq[kk], acc[x], 0, 0, 0); } }
                                __builtin_amdgcn_sched_barrier(0);
                                const float in_j = interArr[16 * jt + tokv];
#pragma unroll
                                for (int x = 0; x < 6; ++x) acc[x] = acc[x] * in_j;
                                bx8 yp[2];
#pragma unroll
                                for (int kk = 0; kk < 2; ++kk) yp[kk] = *(const LAS bx8*)(Ps + (16 * jt + tokv) * 72 + 32 * kk + 8 * sgv);
#pragma unroll
                                for (int x = 0; x < 6; ++x) { const int ct = 6 * half + x;
#pragma unroll
                                    for (int kk = 0; kk < 2; ++kk) { const bx8 xv = *(const LAS bx8*)(VT + (16 * ct + tokv) * 72 + 32 * kk + 8 * sgv); acc[x] = __builtin_amdgcn_mfma_f32_16x16x32_bf16(xv, yp[kk], acc[x], 0, 0, 0); } }
                            }
                            __builtin_amdgcn_sched_barrier(0);
                            {
                                const float sa = scal[0];
                                bx8 yv[3][2];
#pragma unroll
                                for (int x = 0; x < 3; ++x)
#pragma unroll
                                    for (int kk = 0; kk < 2; ++kk) yv[x][kk] = *(const LAS bx8*)(VT + (16 * (ctU + x) + tokv) * 72 + 32 * kk + 8 * sgv);
#pragma unroll
                                for (int x = 0; x < 3; ++x) { bx8 xk[2];
#pragma unroll
                                    for (int kk = 0; kk < 2; ++kk) xk[kk] = *(const LAS bx8*)(KTe + (16 * (itU + x) + tokv) * 72 + 32 * kk + 8 * sgv);
#pragma unroll
                                    for (int y = 0; y < 3; ++y) { Cst[x][y] = Cst[x][y] * sa;
#pragma unroll
                                        for (int kk = 0; kk < 2; ++kk) Cst[x][y] = __builtin_amdgcn_mfma_f32_16x16x32_bf16(xk[kk], yv[y][kk], Cst[x][y], 0, 0, 0); } }
                                if (kind == 1 && tidv < 96) { float sn = 0.f;
#pragma unroll 8
                                    for (int s = 0; s < 64; ++s) sn += bf2f(KTe[tidv * 72 + s]);
                                    nreg = sa * nreg + sn; }
                            }
                            __builtin_amdgcn_sched_barrier(0);
                            LDS_BARRIER();
                            {
                                const int j = 16 * jt + tokv;
                                if (kind == 1) { const float dv = 1.0f / fmaxf(fabsf(denArr[j]), clampArr[j]);
#pragma unroll
                                    for (int x = 0; x < 6; ++x) acc[x] = acc[x] * dv; }
                                float s1 = 0.f, s2 = 0.f;
#pragma unroll
                                for (int x = 0; x < 6; ++x)
#pragma unroll
                                    for (int r = 0; r < 4; ++r) { s1 += acc[x][r]; s2 += acc[x][r] * acc[x][r]; }
                                s1 += sh_xor(s1, 16, lane); s1 += sh_xor(s1, 32, lane); s2 += sh_xor(s2, 16, lane); s2 += sh_xor(s2, 32, lane);
                                if (sgv == 0) { stat[(j * 2 + half) * 2 + 0] = s1; stat[(j * 2 + half) * 2 + 1] = s2; }
                            }
                            LDS_BARRIER();
                            {
                                const int j = 16 * jt + tokv;
                                const float mean = (stat[j * 4 + 0] + stat[j * 4 + 2]) * (1.0f / 192.0f);
                                const float var = (stat[j * 4 + 1] + stat[j * 4 + 3]) * (1.0f / 192.0f) - mean * mean;
                                const float rstd = 1.0f / sqrtf(fmaxf(var, 0.f) + LN_EPS);
#pragma unroll
                                for (int x = 0; x < 6; ++x) { const int colh = 16 * (6 * half + x) + 4 * sgv; const float4 g4 = *(const float4*)(norm_g + h * 192 + colh);
                                    const float o0 = __uint_as_float(ogate[x].x << 16), o1 = __uint_as_float(ogate[x].x & 0xffff0000u), o2 = __uint_as_float(ogate[x].y << 16), o3 = __uint_as_float(ogate[x].y & 0xffff0000u);
                                    float g0, g1, g2, g3;
                                    if (kind == 1) { g0 = sigmoidf(o0); g1 = sigmoidf(o1); g2 = sigmoidf(o2); g3 = sigmoidf(o3); } else { g0 = o0 * sigmoidf(o0); g1 = o1 * sigmoidf(o1); g2 = o2 * sigmoidf(o2); g3 = o3 * sigmoidf(o3); }
                                    ux2 ov; ov.x = pg8::cvt_pk_bf16((acc[x][0] - mean) * rstd * g4.x * g0, (acc[x][1] - mean) * rstd * g4.y * g1); ov.y = pg8::cvt_pk_bf16((acc[x][2] - mean) * rstd * g4.z * g2, (acc[x][3] - mean) * rstd * g4.w * g3);
                                    *(ux2*)(cat + orow * D + h * 192 + colh) = ov; }
#pragma unroll
                                for (int x = 0; x < 3; ++x)
#pragma unroll
                                    for (int y = 0; y < 3; ++y) { ux2 cw; cw.x = pg8::cvt_pk_bf16(Cst[x][y][0], Cst[x][y][1]); cw.y = pg8::cvt_pk_bf16(Cst[x][y][2], Cst[x][y][3]);
                                        *(LAS ux2*)(CT + (16 * (ctU + y) + tokv) * 104 + 16 * (itU + x) + 4 * sgv) = cw; }
                                if (kind == 1 && tidv < 96) nArr[tidv] = nreg;
                            }
                        }
                    }
                }
#else
                LAS float* sq = ldsf; LAS float* sk = ldsf + 96; LAS float* sg = ldsf + 192; LAS float* sred = ldsf + 256;
                const float* conv_q = (const float*)ARGP(17); const float* conv_k = (const float*)ARGP(18);
                const float* b_i = (const float*)ARGP(19); const float* b_f = (const float*)ARGP(20);
                const float* norm_g = (const float*)(kind == 1 ? ARGP(21) : ARGP(23));
                for (int unit = bid; unit < NB * 4; unit += G) {
                    const int b = unit >> 2, h = unit & 3;
                    const float gamma = 1.0f - exp2f(-5.0f - (float)h);
                    float C[96];
#pragma unroll
                    for (int i = 0; i < 96; ++i) C[i] = 0.f;
                    for (int t = 0; t < SEQ; ++t) {
                        const size_t row = (size_t)b * SEQ + t; const bf16* pr = proj + row * LDP;
                        if (tid < 192) {
                            const int c = tid % 96; const bool isk = tid >= 96; const int ch = h * 96 + c; const int col = (isk ? 384 : 0) + ch;
                            float s;
                            if (kind == 1) {
                                const float* cw = isk ? conv_k : conv_q; s = 0.f;
#pragma unroll
                                for (int w = 0; w < 4; ++w) { const int tt = t - 3 + w; if (tt >= 0) s += cw[w * 384 + ch] * bf2f(proj[((size_t)b * SEQ + tt) * LDP + col]); }
                                s = s * sigmoidf(s); if (!isk) s *= 0.10206207261596575f;
                            } else {
                                const int i = c % 48; const bool first = c < 48; const int cb = (isk ? 384 : 0) + h * 96;
                                const float t1 = bf2f(pr[cb + i]), t2 = bf2f(pr[cb + 48 + i]);
                                typedef _Float16 h2_t __attribute__((ext_vector_type(2))); const h2_t cs_ = __builtin_bit_cast(h2_t, ((const unsigned*)rope)[row * 48 + i]); const float cs = (float)cs_.x, sn = (float)cs_.y;
                                s = first ? (t1 * cs - t2 * sn) : (t2 * cs + t1 * sn); if (isk) s *= 0.10206207261596575f;
                            }
                            (isk ? sk : sq)[c] = s;
                        }
                        if (tid == 192) {
                            if (kind == 1) { const float ig = bf2f(pr[2304 + h]) + b_i[h], fg = bf2f(pr[2308 + h]) + b_f[h]; sg[0] = sigmoidf(fg); sg[1] = __expf(ig); }
                            else { sg[0] = gamma; sg[1] = 1.0f; }
                        }
                        __syncthreads();
                        const float f = sg[0], ei = sg[1];
                        float num = 0.f;
                        if (tid < 193) {
                            const float v = tid < 192 ? bf2f(pr[768 + h * 192 + tid]) : 1.0f;
#pragma unroll
                            for (int i = 0; i < 96; ++i) { C[i] = f * C[i] + (ei * sk[i]) * v; num += sq[i] * C[i]; if ((i & 15) == 15) asm volatile("" ::: "memory"); }
                            if (tid == 192) sg[2] = num;
                        }
                        __syncthreads();
                        float hv = num;
                        if (kind == 1) hv = num / fmaxf(fabsf(sg[2]), 1.0f);
                        float s1 = (tid < 192) ? hv : 0.f; s1 = wave_sum(s1, lane); if (lane == 0) sred[wave] = s1;
                        __syncthreads();
                        const float mean = (sred[0] + sred[1] + sred[2]) * (1.0f / 192.0f);
                        float dv = (tid < 192) ? (hv - mean) : 0.f; float s2 = wave_sum(dv * dv, lane); if (lane == 0) sred[8 + wave] = s2;
                        __syncthreads();
                        const float var = (sred[8] + sred[9] + sred[10]) * (1.0f / 192.0f);
                        if (tid < 192) {
                            const float yn = dv * (1.0f / sqrtf(var + LN_EPS)) * norm_g[h * 192 + tid];
                            const float ov = bf2f(pr[1536 + h * 192 + tid]);
                            const float outv = (kind == 1) ? sigmoidf(ov) * yn : (ov * sigmoidf(ov)) * yn;
                            cat[row * D + h * 192 + tid] = f2bf(outv);
                        }
                    }
                }
#endif
            }
            }
#if BG_CONV && FAST_MOE
            {
                if (kind != 0) {
                __syncthreads();
                LAS float* scr = ldsf + wave * (64 * 65);
                unsigned* qh = ctl + CW_CQ + 64 * L;
                const int Lfirst = (L == 1) ? 1 : 3, nlay = (L == 1) ? 2 : 1;
                for (;;) {
                    int it = 0; if (lane == 0) it = (int)__hip_atomic_fetch_add(qh, 1u, __ATOMIC_RELAXED, __HIP_MEMORY_SCOPE_AGENT);
                    it = __builtin_amdgcn_readfirstlane(it);
                    if (it >= nlay * NEXP * (512 + 256)) break;
                    const int Lc = Lfirst + it / (NEXP * (512 + 256)); it = it % (NEXP * (512 + 256));
                    if (it < NEXP * 512) { const int le = Lc * NEXP + (it >> 9);
#if MOE_FP8
                        tr_item8((const float*)ARGP(42) + (size_t)le * D * 2 * DEXP, 2 * DEXP, D, wgu8 + (size_t)le * 2 * DEXP * D, 32, it & 511, scr, lane, GU_WS, [](int d) { const int tile = d >> 8, q = d & 255; return q < 128 ? tile * 128 + q : DEXP + tile * 128 + (q - 128); });
#else
                        tr_item((const float*)ARGP(42) + (size_t)le * D * 2 * DEXP, 2 * DEXP, D, wgu_t + (size_t)le * 2 * DEXP * D, 32, it & 511, scr, lane, [](int d) { const int tile = d >> 8, q = d & 255; return q < 128 ? tile * 128 + q : DEXP + tile * 128 + (q - 128); });
#endif
                    }
                    else { const int r = it - NEXP * 512; const int le = Lc * NEXP + (r >> 8);
#if MOE_FP8
                        tr_item8((const float*)ARGP(44) + (size_t)le * DEXP * D, D, DEXP, wdn8 + (size_t)le * D * DEXP, 16, r & 255, scr, lane, DN_WS, [](int d) { return d; });
#else
                        tr_item((const float*)ARGP(44) + (size_t)le * DEXP * D, D, DEXP, wdn_t + (size_t)le * D * DEXP, 16, r & 255, scr, lane, [](int d) { return d; });
#endif
                    }
                }
                }
            }
#endif
            REPS(13) { if (rep_) __syncthreads();
#if FAST_XATTN
            {
                typedef pg8::bf16x8 bx8; typedef pg8::f32x4 fx4;
                LAS bf16* Kt = (LAS bf16*)lds;
                LAS bf16* Vt = (LAS bf16*)(lds + 36864);
                const int tok = lane & 15, sg = lane >> 4;
                for (int unit = bid; unit < NB * 4 * 8; unit += G) {
                    const int b = unit >> 5, head = (unit >> 3) & 3, qt = unit & 7;
                    __syncthreads();
                    const bf16* kg = memK + (size_t)(b * 4 + head) * 256 * 64; const bf16* vg = memVT + (size_t)(b * 4 + head) * 64 * 256;
                    for (int c = tid; c < 2048; c += NTHR) { const int key = c >> 3, d8 = (c & 7) * 8; *(LAS pg8::u32x4*)(Kt + key * 72 + d8) = *(const pg8::u32x4*)(kg + key * 64 + d8); }
                    for (int c = tid; c < 2048; c += NTHR) { const int d = c >> 5, m = (c & 31) * 8; const pg8::u32x4 v = *(const pg8::u32x4*)(vg + d * 256 + m);
                        const int a = m >> 5, w = m & 31, tp = w >> 4, sk = (w & 15) >> 2;
                        pg8::u32x2 lo; lo.x = v.x; lo.y = v.y; pg8::u32x2 hi2; hi2.x = v.z; hi2.y = v.w;
                        *(LAS pg8::u32x2*)(Vt + d * 264 + 32 * a + 8 * sk + 4 * tp) = lo; *(LAS pg8::u32x2*)(Vt + d * 264 + 32 * a + 8 * (sk + 1) + 4 * tp) = hi2; }
                    __syncthreads();
#pragma unroll 1
                    for (int qi = 0; qi < 2; ++qi) {
                        const size_t row = (size_t)b * SEQ + qt * 256 + wave * 32 + qi * 16 + tok;
                        const bf16* qp = proj + row * LDP + xq_off + head * 64 + 8 * sg;
                        const bx8 q0 = __builtin_bit_cast(bx8, *(const uint4*)qp), q1 = __builtin_bit_cast(bx8, *(const uint4*)(qp + 32));
                        fx4 s[16];
#pragma unroll
                        for (int kt = 0; kt < 16; ++kt) { const bx8 k0 = *(const LAS bx8*)(Kt + (16 * kt + tok) * 72 + 8 * sg), k1 = *(const LAS bx8*)(Kt + (16 * kt + tok) * 72 + 32 + 8 * sg);
                            s[kt] = __builtin_amdgcn_mfma_f32_16x16x32_bf16(k0, q0, (fx4){0.f, 0.f, 0.f, 0.f}, 0, 0, 0); s[kt] = __builtin_amdgcn_mfma_f32_16x16x32_bf16(k1, q1, s[kt], 0, 0, 0); }
                        float mx = -3.0e38f;
#pragma unroll
                        for (int kt = 0; kt < 16; ++kt) mx = fmaxf(fmaxf(fmaxf(s[kt][0], s[kt][1]), fmaxf(s[kt][2], s[kt][3])), mx);
                        mx = fmaxf(mx, sh_xor(mx, 16, lane)); mx = fmaxf(mx, sh_xor(mx, 32, lane));
                        float sum = 0.f;
#pragma unroll
                        for (int kt = 0; kt < 16; ++kt)
#pragma unroll
                            for (int r = 0; r < 4; ++r) { const float pe = __expf((s[kt][r] - mx) * 0.125f); s[kt][r] = pe; sum += pe; }
                        sum += sh_xor(sum, 16, lane); sum += sh_xor(sum, 32, lane);
                        fx4 o[4];
#pragma unroll
                        for (int dt = 0; dt < 4; ++dt) o[dt] = (fx4){0.f, 0.f, 0.f, 0.f};
#pragma unroll
                        for (int a = 0; a < 8; ++a) {
                            uint4 pw; pw.x = pg8::cvt_pk_bf16(s[2 * a][0], s[2 * a][1]); pw.y = pg8::cvt_pk_bf16(s[2 * a][2], s[2 * a][3]); pw.z = pg8::cvt_pk_bf16(s[2 * a + 1][0], s[2 * a + 1][1]); pw.w = pg8::cvt_pk_bf16(s[2 * a + 1][2], s[2 * a + 1][3]);
                            const bx8 pf = __builtin_bit_cast(bx8, pw);
#pragma unroll
                            for (int dt = 0; dt < 4; ++dt) { const bx8 vf = *(const LAS bx8*)(Vt + (16 * dt + tok) * 264 + 32 * a + 8 * sg); o[dt] = __builtin_amdgcn_mfma_f32_16x16x32_bf16(vf, pf, o[dt], 0, 0, 0); }
                        }
                        const float inv = 1.0f / sum; bf16* op = cat + row * D + MIXW + head * 64 + 4 * sg;
#pragma unroll
                        for (int dt = 0; dt < 4; ++dt) { uint2 ov; ov.x = pg8::cvt_pk_bf16(o[dt][0] * inv, o[dt][1] * inv); ov.y = pg8::cvt_pk_bf16(o[dt][2] * inv, o[dt][3] * inv); *(uint2*)(op + 16 * dt) = ov; }
                    }
                }
            }
#else
            for (int wu = bid * NWAVES + wave; wu < (T / 16) * 4; wu += G * NWAVES) {
                const int head = wu & 3, row = (wu >> 2) * 16 + (lane >> 2), part = lane & 3, b = row / SEQ;
                float q[16], acc[16];
                { const bf16* qp = proj + (size_t)row * LDP + xq_off + head * 64 + part * 16;
                  unpack8(*(const uint4*)qp, q); unpack8(*(const uint4*)(qp + 8), q + 8);
#pragma unroll
                  for (int d = 0; d < 16; ++d) { q[d] *= 0.125f; acc[d] = 0.f; } }
                float mx = -3.0e38f, l = 0.f;
                const bf16* kb = memK + (size_t)(b * 4 + head) * 256 * 64 + part * 16; const bf16* vb = memV + (size_t)(b * 4 + head) * 256 * 64 + part * 16;
                for (int m = 0; m < NMEM; ++m) {
                    float kk[16]; unpack8(*(const uint4*)(kb + m * 64), kk); unpack8(*(const uint4*)(kb + m * 64 + 8), kk + 8);
                    float s = 0.f;
#pragma unroll
                    for (int j = 0; j < 16; ++j) s += q[j] * kk[j];
                    s += sh_xor(s, 1, lane); s += sh_xor(s, 2, lane);
                    const float mn = fmaxf(mx, s); const float corr = __expf(mx - mn), pv = __expf(s - mn); mx = mn; l = l * corr + pv;
                    float vv[16]; unpack8(*(const uint4*)(vb + m * 64), vv); unpack8(*(const uint4*)(vb + m * 64 + 8), vv + 8);
#pragma unroll
                    for (int j = 0; j < 16; ++j) acc[j] = acc[j] * corr + pv * vv[j];
                }
                const float il = 1.0f / l; bf16* op = cat + (size_t)row * D + MIXW + head * 64 + part * 16;
#pragma unroll
                for (int c = 0; c < 2; ++c) { uint4 o; o.x = pk2(acc[8 * c + 0] * il, acc[8 * c + 1] * il); o.y = pk2(acc[8 * c + 2] * il, acc[8 * c + 3] * il);
                    o.z = pk2(acc[8 * c + 4] * il, acc[8 * c + 5] * il); o.w = pk2(acc[8 * c + 6] * il, acc[8 * c + 7] * il); *(uint4*)(op + 8 * c) = o; }
            }
#endif
        } }
        SEAM(P + LP_MIXA);

        if (IN(P + LP_MIXB)) {
            PHASE_IDS();
            REPS(4) { if (rep_) __syncthreads();
            if (kind == 0) {
                const float* w_glu = (const float*)(L == 0 ? ARGP(14) : ARGP(33)); const float* b_glu = (const float*)(L == 0 ? ARGP(15) : ARGP(34));
#if FAST_DENSE
                { (void)w_glu; pg8::Gemm g{yg, wglu_t + (size_t)(L == 0 ? 0 : 1) * MiB, MIXW, nullptr}; pg8::StaticOrder S; S.init(T, MIXW, G, bid); pg8::EpiGlu E{cat, D, yg, MIXW, b_glu}; pg8::gemm_phase(lds, g, S, E, wave); }
#else
                oracle_gemm(ldsf, T, MIXW, MIXW,
                    [&](int) { return 0; },
                    [&](int m, int k) { return bf2f(yg[(size_t)m * MIXW + k]); },
                    [&](int k, int n, int) { return w_glu[(size_t)k * MIXW + n]; },
                    [&](int m0, int n0, float (&acc)[4][8], int) {
#pragma unroll
                        for (int i = 0; i < 4; ++i)
#pragma unroll
                            for (int j = 0; j < 8; ++j) { const int m = m0 + i, n = n0 + j; const float z = acc[i][j] + b_glu[n]; const float yv = bf2f(yg[(size_t)m * MIXW + n]);
                                cat[(size_t)m * D + n] = f2bf(yv * sigmoidf(z)); }
                    });
#endif
            }
        } }
        if (kind == 0) SEAM(P + LP_MIXB);

        if (IN(P + LP_OUTPROJ)) {
            PHASE_IDS();
            REPS(5) { if (rep_) __syncthreads();
            const float* w_out = (const float*)ARGP(35) + (size_t)L * D * D;
#if FAST_DENSE
            { (void)w_out; pg8::Gemm g{cat, wout_t + (size_t)L * D * D, D, nullptr}; pg8::StaticOrder S; S.init(T, D, G, bid);
#if RES_BF16
              pg8::EpiResBf16 E{(bf16*)y2, hb, D, DN_ALPHA}; pg8::gemm_phase(lds, g, S, E, wave); }
#else
              pg8::EpiResF32 E{y2, hf, D, DN_ALPHA}; pg8::gemm_phase(lds, g, S, E, wave); }
#endif
#else
            oracle_gemm(ldsf, T, D, D,
                [&](int) { return 0; },
                [&](int m, int k) { return bf2f(cat[(size_t)m * D + k]); },
                [&](int k, int n, int) { return w_out[(size_t)k * D + n]; },
                [&](int m0, int n0, float (&acc)[4][8], int) {
#pragma unroll
                    for (int i = 0; i < 4; ++i)
#pragma unroll
                        for (int j = 0; j < 8; ++j) { const size_t o = (size_t)(m0 + i) * D + n0 + j; y2[o] = DN_ALPHA * hf[o] + acc[i][j]; }
                });
#endif
        } }
        SEAM(P + LP_OUTPROJ);

        if (IN(P + LP_LN1)) {
            PHASE_IDS();
            REPS(8) { if (rep_) __syncthreads();
            const float* g1 = (const float*)ARGP(36) + L * D; const float* b1 = (const float*)ARGP(37) + L * D;
            const float* rw = (const float*)ARGP(40) + (size_t)L * D * NEXP; const float* rb = (const float*)ARGP(41) + L * NEXP;
#if FAST_LN1
            {
            typedef pg8::bf16x8 bx8; typedef pg8::f32x4 fx4; typedef pg8::u32x4 ux4;
            LAS bf16* RWH = (LAS bf16*)lds;
            LAS float* stg = (LAS float*)(lds + 66048 + wave * 8320);
            LAS int* hist = (LAS int*)(lds + 66048 + 8 * 8320); LAS int* lbase = hist + 32;
            const bf16* rwh_g = rwt + (size_t)(L * 2 + 0) * NEXP * D; const bf16* rwl_g = rwt + (size_t)(L * 2 + 1) * NEXP * D;
            for (int c = tid; c < 4096; c += NTHR) { const int e = c >> 7, k8 = (c & 127) * 8; *(LAS ux4*)(RWH + e * 1032 + k8) = *(const ux4*)(rwh_g + e * 1024 + k8); }
            if (tid < 32) hist[tid] = 0;
            __syncthreads();
            const int tok = lane & 15, sg = lane >> 4;
            for (int wt = bid * NWAVES + wave; wt < T / 8; wt += G * NWAVES) {
                float4 v[8][4];
#pragma unroll
                for (int rr = 0; rr < 8; ++rr)
#pragma unroll
                    for (int j = 0; j < 4; ++j) {
#if RES_BF16
                        const uint2 yv_ = *(const uint2*)((const bf16*)y2 + ((size_t)wt * 8 + rr) * D + (lane + 64 * j) * 4);
                        v[rr][j] = make_float4(__uint_as_float(yv_.x << 16), __uint_as_float(yv_.x & 0xffff0000u), __uint_as_float(yv_.y << 16), __uint_as_float(yv_.y & 0xffff0000u));
#else
                        v[rr][j] = *(const float4*)(y2 + ((size_t)wt * 8 + rr) * D + (lane + 64 * j) * 4);
#endif
                    }
#pragma unroll
                for (int rr = 0; rr < 8; ++rr) {
                    float s = 0.f;
#pragma unroll
                    for (int j = 0; j < 4; ++j) s += (v[rr][j].x + v[rr][j].y) + (v[rr][j].z + v[rr][j].w);
                    const float mean = wave_sum(s, lane) * (1.0f / D); float s2 = 0.f;
#pragma unroll
                    for (int j = 0; j < 4; ++j) { v[rr][j].x -= mean; v[rr][j].y -= mean; v[rr][j].z -= mean; v[rr][j].w -= mean; s2 += (v[rr][j].x * v[rr][j].x + v[rr][j].y * v[rr][j].y) + (v[rr][j].z * v[rr][j].z + v[rr][j].w * v[rr][j].w); }
                    const float rstd = 1.0f / sqrtf(wave_sum(s2, lane) * (1.0f / D) + LN_EPS);
                    const size_t row = (size_t)wt * 8 + rr;
#pragma unroll
                    for (int j = 0; j < 4; ++j) { const int cc = (lane + 64 * j) * 4; const float4 gg = *(const float4*)(g1 + cc), bb = *(const float4*)(b1 + cc);
                        float4 o; o.x = v[rr][j].x * rstd * gg.x + bb.x; o.y = v[rr][j].y * rstd * gg.y + bb.y; o.z = v[rr][j].z * rstd * gg.z + bb.z; o.w = v[rr][j].w * rstd * gg.w + bb.w;
                        v[rr][j] = o;
#if RES_BF16
                        { uint2 ob; ob.x = pg8::cvt_pk_bf16(o.x, o.y); ob.y = pg8::cvt_pk_bf16(o.z, o.w); *(uint2*)(hb + row * D + cc) = ob; }
#else
                        *(float4*)(hf + row * D + cc) = o;
#endif
#if MOE_FP8 && MOE_GATHER
                        { int w8 = __builtin_amdgcn_cvt_pk_fp8_f32(o.x, o.y, 0, false); w8 = __builtin_amdgcn_cvt_pk_fp8_f32(o.z, o.w, w8, true); *(int*)(hb8 + row * D + cc) = w8; }
#elif !RES_BF16
                        { uint2 ob; ob.x = pg8::cvt_pk_bf16(o.x, o.y); ob.y = pg8::cvt_pk_bf16(o.z, o.w); *(uint2*)(hb + row * D + cc) = ob; }
#endif
                    }
                }
                fx4 lacc[2]; lacc[0] = (fx4){0.f, 0.f, 0.f, 0.f}; lacc[1] = (fx4){0.f, 0.f, 0.f, 0.f};
#pragma unroll
                for (int j = 0; j < 4; ++j) {
#pragma unroll
                    for (int rr = 0; rr < 8; ++rr) *(LAS fx4*)(stg + rr * 260 + lane * 4) = (fx4){v[rr][j].x, v[rr][j].y, v[rr][j].z, v[rr][j].w};
                    asm volatile("s_waitcnt lgkmcnt(0)" ::: "memory");
#pragma unroll 2
                    for (int kk = 0; kk < 8; ++kk) {
                        fx4 f0 = (fx4){0.f, 0.f, 0.f, 0.f}, f1 = f0;
                        if (tok < 8) { f0 = *(const LAS fx4*)(stg + tok * 260 + 32 * kk + 8 * sg); f1 = *(const LAS fx4*)(stg + tok * 260 + 32 * kk + 8 * sg + 4); }
                        ux4 hw, lw;
                        hw.x = pg8::cvt_pk_bf16(f0[0], f0[1]); hw.y = pg8::cvt_pk_bf16(f0[2], f0[3]); hw.z = pg8::cvt_pk_bf16(f1[0], f1[1]); hw.w = pg8::cvt_pk_bf16(f1[2], f1[3]);
                        lw.x = pg8::cvt_pk_bf16(f0[0] - __uint_as_float(hw.x << 16), f0[1] - __uint_as_float(hw.x & 0xffff0000u)); lw.y = pg8::cvt_pk_bf16(f0[2] - __uint_as_float(hw.y << 16), f0[3] - __uint_as_float(hw.y & 0xffff0000u));
                        lw.z = pg8::cvt_pk_bf16(f1[0] - __uint_as_float(hw.z << 16), f1[1] - __uint_as_float(hw.z & 0xffff0000u)); lw.w = pg8::cvt_pk_bf16(f1[2] - __uint_as_float(hw.w << 16), f1[3] - __uint_as_float(hw.w & 0xffff0000u));
                        const bx8 yh = __builtin_bit_cast(bx8, hw), yl = __builtin_bit_cast(bx8, lw);
#pragma unroll
                        for (int t = 0; t < 2; ++t) { const int kcol = 256 * j + 32 * kk + 8 * sg;
                            const bx8 xh = *(const LAS bx8*)(RWH + (16 * t + tok) * 1032 + kcol); const bx8 xl = __builtin_bit_cast(bx8, *(const ux4*)(rwl_g + (16 * t + tok) * 1024 + kcol));
                            lacc[t] = __builtin_amdgcn_mfma_f32_16x16x32_bf16(xh, yh, lacc[t], 0, 0, 0); lacc[t] = __builtin_amdgcn_mfma_f32_16x16x32_bf16(xl, yh, lacc[t], 0, 0, 0); lacc[t] = __builtin_amdgcn_mfma_f32_16x16x32_bf16(xh, yl, lacc[t], 0, 0, 0); }
                    }
                    asm volatile("s_waitcnt lgkmcnt(0)" ::: "memory");
                }
                float lv[8];
#pragma unroll
                for (int t = 0; t < 2; ++t) { const float4 rb4 = *(const float4*)(rb + 16 * t + 4 * sg); lv[4 * t + 0] = lacc[t][0] + rb4.x; lv[4 * t + 1] = lacc[t][1] + rb4.y; lv[4 * t + 2] = lacc[t][2] + rb4.z; lv[4 * t + 3] = lacc[t][3] + rb4.w; }
                float tv[4]; int ti[4];
#pragma unroll
                for (int k = 0; k < 4; ++k) {
                    float bv = -3.0e38f; int bi = 0;
#pragma unroll
                    for (int q = 0; q < 8; ++q) { const int e = 16 * (q >> 2) + 4 * sg + (q & 3); if (lv[q] > bv) { bv = lv[q]; bi = e; } }
#pragma unroll
                    for (int o = 16; o <= 32; o <<= 1) { const float ov = sh_xor(bv, o, lane); const int oi = sh_xor(bi, o, lane); if (ov > bv || (ov == bv && oi < bi)) { bv = ov; bi = oi; } }
                    tv[k] = bv; ti[k] = bi;
#pragma unroll
                    for (int q = 0; q < 8; ++q) { const int e = 16 * (q >> 2) + 4 * sg + (q & 3); if (e == bi) lv[q] = -3.0e38f; }
                }
                if (sg == 0 && tok < 8) {
                    const size_t row = (size_t)wt * 8 + tok; float ex[4], sum = 0.f;
#pragma unroll
                    for (int k = 0; k < 4; ++k) { ex[k] = __expf(tv[k] - tv[0]); sum += ex[k]; }
                    const float inv = 1.0f / sum;
                    *(int4*)(top_e + row * 4) = make_int4(ti[0], ti[1], ti[2], ti[3]); *(float4*)(top_g + row * 4) = make_float4(ex[0] * inv, ex[1] * inv, ex[2] * inv, ex[3] * inv);
#pragma unroll
                    for (int k = 0; k < 4; ++k) ti[k] |= atomicAdd((int*)&hist[ti[k]], 1) << 8;
                }
#if MOE_SPARSE
                __syncthreads();
                if (tid < 32) { const int hc = hist[tid]; lbase[tid] = hc ? (int)atomicAdd(ctl + CW_CNT + 64 * L + tid, (unsigned)hc) : 0; hist[tid] = 0; }
                __syncthreads();
                if (sg == 0 && tok < 8) { const size_t row = (size_t)wt * 8 + tok; int dd[4];
#pragma unroll
                    for (int k = 0; k < 4; ++k) { const int e = ti[k] & 255; dd[k] = e * T + lbase[e] + (ti[k] >> 8); row_tok[dd[k]] = (int)row; }
                    *(int4*)(dest + row * 4) = make_int4(dd[0], dd[1], dd[2], dd[3]); }
#endif
            }
#if !MOE_SPARSE
            __syncthreads();
            if (rep_ == 0 && tid < 32 && hist[tid] != 0) atomicAdd(ctl + CW_CNT + 64 * L + tid, (unsigned)hist[tid]);
#endif
            __syncthreads();
            }
#else
            LAS float* rows = ldsf; LAS float* lg = ldsf + 16 * 1024; LAS int* hist = (LAS int*)(ldsf + 16 * 1024 + 512);
            if (tid < 32) hist[tid] = 0;
            __syncthreads();
            for (int tile = bid; tile < T / 16; tile += G) {
#pragma unroll
                for (int rr = 0; rr < 2; ++rr) {
                    const int r = 2 * wave + rr; const size_t row = (size_t)tile * 16 + r;
                    float4 v[4]; float s = 0.f;
#pragma unroll
                    for (int j = 0; j < 4; ++j) { v[j] = *(const float4*)(y2 + row * D + (lane + 64 * j) * 4); s += (v[j].x + v[j].y) + (v[j].z + v[j].w); }
                    const float mean = wave_sum(s, lane) * (1.0f / D); float s2 = 0.f;
#pragma unroll
                    for (int j = 0; j < 4; ++j) { v[j].x -= mean; v[j].y -= mean; v[j].z -= mean; v[j].w -= mean; s2 += (v[j].x * v[j].x + v[j].y * v[j].y) + (v[j].z * v[j].z + v[j].w * v[j].w); }
                    const float rstd = 1.0f / sqrtf(wave_sum(s2, lane) * (1.0f / D) + LN_EPS);
#pragma unroll
                    for (int j = 0; j < 4; ++j) { const int c = (lane + 64 * j) * 4; const float4 gg = *(const float4*)(g1 + c), bb = *(const float4*)(b1 + c);
                        float4 o; o.x = v[j].x * rstd * gg.x + bb.x; o.y = v[j].y * rstd * gg.y + bb.y; o.z = v[j].z * rstd * gg.z + bb.z; o.w = v[j].w * rstd * gg.w + bb.w;
                        *(float4*)(hf + row * D + c) = o; uint2 ob; ob.x = pk2(o.x, o.y); ob.y = pk2(o.z, o.w); *(uint2*)(hb + row * D + c) = ob;
                        rows[r * 1024 + c + 0] = o.x; rows[r * 1024 + c + 1] = o.y; rows[r * 1024 + c + 2] = o.z; rows[r * 1024 + c + 3] = o.w; }
                }
                __syncthreads();
                { const int r = tid >> 5, e = tid & 31; float a = rb[e];
                  for (int k = 0; k < D; ++k) a += rows[r * 1024 + k] * rw[(size_t)k * NEXP + e];
                  lg[r * 32 + e] = a; }
                __syncthreads();
                if (tid < 16) {
                    const size_t row = (size_t)tile * 16 + tid; float tv[4]; int ti[4];
#pragma unroll
                    for (int k = 0; k < 4; ++k) { float best = -3.0e38f; int bi = 0;
                        for (int e = 0; e < NEXP; ++e) { const float v = lg[tid * 32 + e]; if (v > best) { best = v; bi = e; } }
                        tv[k] = best; ti[k] = bi; lg[tid * 32 + bi] = -3.0e38f; }
                    float ex[4], sum = 0.f;
#pragma unroll
                    for (int k = 0; k < 4; ++k) { ex[k] = __expf(tv[k] - tv[0]); sum += ex[k]; }
#pragma unroll
                    for (int k = 0; k < 4; ++k) { top_e[row * 4 + k] = ti[k]; top_g[row * 4 + k] = ex[k] / sum; atomicAdd((int*)&hist[ti[k]], 1); }
                }
                __syncthreads();
            }
            if (rep_ == 0 && tid < 32 && hist[tid] != 0) atomicAdd(ctl + CW_CNT + 64 * L + tid, (unsigned)hist[tid]);
            __syncthreads();
#endif
        } }
        SEAM(P + LP_LN1);

        if (!MOE_SPARSE && IN(P + LP_DISP)) {
            PHASE_IDS();
            REPS(9) { if (rep_) __syncthreads();
            LAS int* pstart = (LAS int*)ldsf; LAS int* lh = pstart + 32; LAS int* lbase = pstart + 64; LAS int* ldest = pstart + 128;
            if (tid == 0) { int a = 0; for (int e = 0; e < NEXP; ++e) { const int c = (int)__hip_atomic_load(ctl + CW_CNT + 64 * L + e, __ATOMIC_RELAXED, __HIP_MEMORY_SCOPE_AGENT); pstart[e] = a; a += ((c + MOEBLK - 1) / MOEBLK) * MOEBLK; } }
            __syncthreads();
#if MOE_GATHER
            for (int idx = bid * NTHR + tid; idx < NEXP * MOEBLK; idx += G * NTHR) { const int e = idx >> 8, r = idx & 255; const int cnt = (int)__hip_atomic_load(ctl + CW_CNT + 64 * L + e, __ATOMIC_RELAXED, __HIP_MEMORY_SCOPE_AGENT);
                const int padded = ((cnt + MOEBLK - 1) / MOEBLK) * MOEBLK; if (cnt + r < padded) row_tok[pstart[e] + cnt + r] = 0; }
#endif
            for (int tile = bid; tile < T * TOPK / NTHR; tile += G) {
                if (tid < 32) lh[tid] = 0;
                __syncthreads();
                const int pair = tile * NTHR + tid; const int e = top_e[pair];
                int dd;
                if (rep_ == 0) {
                const int rank = atomicAdd((int*)&lh[e], 1);
                __syncthreads();
                if (tid < 32) lbase[tid] = lh[tid] ? (int)atomicAdd(ctl + CW_CUR + 64 * L + tid, (unsigned)lh[tid]) : 0;
                __syncthreads();
                dd = pstart[e] + lbase[e] + rank; dest[pair] = dd; } else dd = dest[pair];
                ldest[tid] = dd;
#if MOE_GATHER
                if (rep_ == 0) row_tok[dd] = pair >> 2;
#endif
                __syncthreads();
#if !MOE_GATHER
                for (int i = 0; i < 64; ++i) { const int pp = wave * 64 + i; const int d2 = ldest[pp]; const int tt = (tile * NTHR + pp) >> 2;
                    const uint4* src = (const uint4*)(hb + (size_t)tt * D); uint4* dst = (uint4*)(xr + (size_t)d2 * D);
                    dst[lane] = src[lane]; dst[lane + 64] = src[lane + 64]; }
#endif
                __syncthreads();
            }
        } }
        if (!MOE_SPARSE) SEAM(P + LP_DISP);

        if (IN(P + LP_GU) || IN(P + LP_DOWN)) {
            PHASE_IDS();
            LAS int* pend = (LAS int*)(lds + LDS_MISC + 512);
            if (tid == 0) { int a = 0; for (int e = 0; e < NEXP; ++e) { const int c = (int)__hip_atomic_load(ctl + CW_CNT + 64 * L + e, __ATOMIC_RELAXED, __HIP_MEMORY_SCOPE_AGENT); a += ((c + MOEBLK - 1) / MOEBLK) * MOEBLK; pend[e] = a; } }
            __syncthreads();
        }
        if (IN(P + LP_GU)) {
            PHASE_IDS();
            REPS(6) { if (rep_) __syncthreads();
            const LAS int* pend = (const LAS int*)(lds + LDS_MISC + 512);
            const int nrows = pend[NEXP - 1];
            const float* wgu = (const float*)ARGP(42) + (size_t)L * NEXP * D * 2 * DEXP; const float* bgu = (const float*)ARGP(43) + (size_t)L * NEXP * 2 * DEXP;
#if FAST_MOE
            { (void)wgu; pg8::MoeOrder S{pend, nrows / 256, 8, G, vcu};
#if MOE_GATHER && MOE_FP8
              pg8::EpiSwiglu<true> E{act8, bgu, 1.0f / GU_WS};
              LAS int* rmapL = (LAS int*)(lds + LDS_RMAP);
              { pg8::Unit uu; for (int i = 0; i < 15 && S.next(i, uu); ++i) { if (tid < 256) { const int rt_ = row_tok[uu.pm * 256 + tid]; rmapL[i * 256 + tid] = rt_ < 0 ? 0 : (rt_ < T ? rt_ : T - 1); } } }
              __syncthreads();
              pg8::Gemm g{(const pg8::bf16_t*)hb8, (const pg8::bf16_t*)(wgu8 + (size_t)L * NEXP * 2 * DEXP * D), D, rmapL}; pg8::gemm_phase<pg8::EpiSwiglu<true>, pg8::MoeOrder, true, true, true, true>(lds, g, S, E, wave);
#elif MOE_GATHER
              pg8::EpiSwiglu<false> E{act, bgu, 1.0f};
              LAS int* rmapL = (LAS int*)(lds + LDS_RMAP);
              { pg8::Unit uu; for (int i = 0; i < 15 && S.next(i, uu); ++i) { if (tid < 256) { const int rt_ = row_tok[uu.pm * 256 + tid]; rmapL[i * 256 + tid] = rt_ < 0 ? 0 : (rt_ < T ? rt_ : T - 1); } } }
              __syncthreads();
              pg8::Gemm g{hb, wgu_t + (size_t)L * NEXP * 2 * DEXP * D, D, rmapL}; pg8::gemm_phase<pg8::EpiSwiglu<false>, pg8::MoeOrder, true, true, true>(lds, g, S, E, wave);
#else
              pg8::EpiSwiglu<false> E{act, bgu, 1.0f};
              pg8::Gemm g{xr, wgu_t + (size_t)L * NEXP * 2 * DEXP * D, D, nullptr}; pg8::gemm_phase(lds, g, S, E, wave);
#endif
            }
#else
            oracle_gemm(ldsf, nrows, 2 * DEXP, D,
                [&](int tm) { return expert_of_block(pend, tm >> 1); },
                [&](int m, int k) { return bf2f(xr[(size_t)m * D + k]); },
                [&](int k, int n, int e) { const int tn = n >> 7, v = n & 127; const int c = tn * 64 + (v >> 1) + ((v & 1) ? DEXP : 0); return wgu[((size_t)e * D + k) * (2 * DEXP) + c]; },
                [&](int m0, int n0, float (&acc)[4][8], int e) {
                    const int tn = n0 >> 7, v0 = n0 & 127;
#pragma unroll
                    for (int i = 0; i < 4; ++i)
#pragma unroll
                        for (int jj = 0; jj < 4; ++jj) { const int c = tn * 64 + (v0 >> 1) + jj;
                            const float xg = fminf(acc[i][2 * jj] + bgu[(size_t)e * 2 * DEXP + c], 7.0f);
                            const float xl = fminf(fmaxf(acc[i][2 * jj + 1] + bgu[(size_t)e * 2 * DEXP + DEXP + c], -7.0f), 7.0f);
                            act[(size_t)(m0 + i) * DEXP + c] = f2bf(xg * sigmoidf(1.702f * xg) * (xl + 1.0f)); }
                });
#endif
        } }
        SEAM(P + LP_GU);

        if (IN(P + LP_DOWN)) {
            PHASE_IDS();
            REPS(7) { if (rep_) __syncthreads();
            const LAS int* pend = (const LAS int*)(lds + LDS_MISC + 512);
            const int nrows = pend[NEXP - 1];
            const float* wd = (const float*)ARGP(44) + (size_t)L * NEXP * DEXP * D; const float* bd = (const float*)ARGP(45) + (size_t)L * NEXP * D;
#if FAST_MOE
            { (void)wd; pg8::MoeOrder S{pend, nrows / 256, 4, G, vcu};
#if MOE_FP8 && MOE_GATHER
              pg8::Gemm g{(const pg8::bf16_t*)act8, (const pg8::bf16_t*)(wdn8 + (size_t)L * NEXP * D * DEXP), DEXP, nullptr};
#if YR_FP8
              pg8::EpiBf16T<true> E{(unsigned char*)yr, D, bd, D, 1.0f / DN_WS};
              pg8::gemm_phase<pg8::EpiBf16T<true>, pg8::MoeOrder, true, true, false, true>(lds, g, S, E, wave);
#else
              pg8::EpiBf16 E{yr, D, bd, D, 1.0f / DN_WS};
              pg8::gemm_phase<pg8::EpiBf16, pg8::MoeOrder, true, true, false, true>(lds, g, S, E, wave);
#endif
#else
              pg8::Gemm g{act, wdn_t + (size_t)L * NEXP * D * DEXP, DEXP, nullptr}; pg8::EpiBf16 E{yr, D, bd, D, 1.0f}; pg8::gemm_phase(lds, g, S, E, wave);
#endif
            }
#else
            oracle_gemm(ldsf, nrows, D, DEXP,
                [&](int tm) { return expert_of_block(pend, tm >> 1); },
                [&](int m, int k) { return bf2f(act[(size_t)m * DEXP + k]); },
                [&](int k, int n, int e) { return wd[((size_t)e * DEXP + k) * D + n]; },
                [&](int m0, int n0, float (&acc)[4][8], int e) {
#pragma unroll
                    for (int i = 0; i < 4; ++i)
#pragma unroll
                        for (int j = 0; j < 8; ++j) yr[(size_t)(m0 + i) * D + n0 + j] = f2bf(acc[i][j] + bd[(size_t)e * D + n0 + j]);
                });
#endif
        } }
        SEAM(P + LP_DOWN);

        if (IN(P + LP_COMB)) {
            PHASE_IDS();
            REPS(10) { const bool dummy_ = (rep_ == 0) && ((REP_MASK >> 10) & 1);
            const float* g2 = (const float*)ARGP(38) + L * D; const float* b2 = (const float*)ARGP(39) + L * D;
            const int l32 = lane & 31, hw = lane >> 5;
            for (int row = 2 * (bid * NWAVES + wave) + hw; row < T; row += 2 * G * NWAVES) {
                int dd[4]; float gg[4];
                { const int4 d4 = *(const int4*)(dest + (size_t)row * 4); const float4 g4 = *(const float4*)(top_g + (size_t)row * 4); dd[0] = d4.x; dd[1] = d4.y; dd[2] = d4.z; dd[3] = d4.w; gg[0] = g4.x; gg[1] = g4.y; gg[2] = g4.z; gg[3] = g4.w; }
                float4 v[8]; float s = 0.f;
#pragma unroll
                for (int j = 0; j < 8; ++j) { const int c = (l32 + 32 * j) * 4;
#if RES_BF16
                    const uint2 hv_ = *(const uint2*)(hb + (size_t)row * D + c); const float4 hv = make_float4(__uint_as_float(hv_.x << 16), __uint_as_float(hv_.x & 0xffff0000u), __uint_as_float(hv_.y << 16), __uint_as_float(hv_.y & 0xffff0000u));
#else
                    const float4 hv = *(const float4*)(hf + (size_t)row * D + c);
#endif
                    float4 a; a.x = DN_ALPHA * hv.x; a.y = DN_ALPHA * hv.y; a.z = DN_ALPHA * hv.z; a.w = DN_ALPHA * hv.w;
                    float mo[4] = {0.f, 0.f, 0.f, 0.f};
#pragma unroll
                    for (int k = 0; k < 4; ++k) {
#if YR_FP8 && MOE_FP8 && MOE_GATHER
                        typedef float f32x2_ __attribute__((ext_vector_type(2)));
                        const int yw = *(const int*)((const unsigned char*)yr + (size_t)dd[k] * D + c); const f32x2_ y01 = __builtin_amdgcn_cvt_pk_f32_fp8(yw, false), y23 = __builtin_amdgcn_cvt_pk_f32_fp8(yw, true);
                        mo[0] += gg[k] * y01.x; mo[1] += gg[k] * y01.y; mo[2] += gg[k] * y23.x; mo[3] += gg[k] * y23.y;
#else
                        const uint2 yv = *(const uint2*)(yr + (size_t)dd[k] * D + c);
                        mo[0] += gg[k] * __uint_as_float(yv.x << 16); mo[1] += gg[k] * __uint_as_float(yv.x & 0xffff0000u);
                        mo[2] += gg[k] * __uint_as_float(yv.y << 16); mo[3] += gg[k] * __uint_as_float(yv.y & 0xffff0000u);
#endif
                    }
                    a.x += mo[0]; a.y += mo[1]; a.z += mo[2]; a.w += mo[3];
                    v[j] = a; s += (a.x + a.y) + (a.z + a.w); }
#pragma unroll
                for (int o = 1; o < 32; o <<= 1) s += sh_xor(s, o, lane);
                const float mean = s * (1.0f / D); float s2 = 0.f;
#pragma unroll
                for (int j = 0; j < 8; ++j) { v[j].x -= mean; v[j].y -= mean; v[j].z -= mean; v[j].w -= mean; s2 += (v[j].x * v[j].x + v[j].y * v[j].y) + (v[j].z * v[j].z + v[j].w * v[j].w); }
#pragma unroll
                for (int o = 1; o < 32; o <<= 1) s2 += sh_xor(s2, o, lane);
                const float rstd = 1.0f / sqrtf(s2 * (1.0f / D) + LN_EPS);
#pragma unroll
                for (int j = 0; j < 8; ++j) { const int c = (l32 + 32 * j) * 4; const float4 gv = *(const float4*)(g2 + c), bv = *(const float4*)(b2 + c);
                    float4 o; o.x = v[j].x * rstd * gv.x + bv.x; o.y = v[j].y * rstd * gv.y + bv.y; o.z = v[j].z * rstd * gv.z + bv.z; o.w = v[j].w * rstd * gv.w + bv.w;
                    if (dummy_) *(float4*)(y2 + (size_t)row * D + c) = o;
                    else if (L == DEPTH - 1) *(float4*)(((float*)ARGP(46)) + (size_t)row * D + c) = o;
                    else {
#if !RES_BF16
                        *(float4*)(hf + (size_t)row * D + c) = o;
#endif
                        uint2 ob; ob.x = pg8::cvt_pk_bf16(o.x, o.y); ob.y = pg8::cvt_pk_bf16(o.z, o.w); *(uint2*)(hb + (size_t)row * D + c) = ob; } }
            }
        } }
        SEAM(P + LP_COMB);
    }
#undef IN
#undef SEAM
}

extern "C" void kernel_launch(void* const* d_in, const int* in_sizes, int n_in, void* d_out, int out_size, void* d_ws, size_t ws_size, hipStream_t stream) {
    static int grid = 0;
    if (grid == 0) {
        if (n_in != 46 || out_size != T * D || ws_size < WS_END) { fprintf(stderr, "kernel_launch: unexpected problem (n_in %d, out %d, ws %zu < %zu)\n", n_in, out_size, ws_size, (size_t)WS_END); grid = -1; return; }
        int dev = 0, cus = 0, per_cu = 0;
        if (hipGetDevice(&dev) != hipSuccess || hipDeviceGetAttribute(&cus, hipDeviceAttributeMultiprocessorCount, dev) != hipSuccess) { grid = -1; return; }
        if (hipFuncSetAttribute((const void*)mk_fwd, hipFuncAttributeMaxDynamicSharedMemorySize, LDS_BYTES) != hipSuccess) { fprintf(stderr, "kernel_launch: hipFuncSetAttribute failed\n"); grid = -1; return; }
        if (hipOccupancyMaxActiveBlocksPerMultiprocessor(&per_cu, (const void*)mk_fwd, NTHR, LDS_BYTES) != hipSuccess || per_cu < 1) fprintf(stderr, "kernel_launch: occupancy query says %d\n", per_cu);
        (void)hipGetLastError();
        grid = cus;
    }
    if (grid < 0) return;
    (void)hipMemsetAsync((char*)d_ws + WS_CTL, 0, CTL_BYTES, stream);
    Args a{};
    for (int i = 0; i < 46; ++i) a.in[i] = d_in[i];
    a.out = (float*)d_out; a.ws = (unsigned char*)d_ws;
#if MK_ONE_LAUNCH
    a.ph_lo = 0; a.ph_hi = PH_TOTAL;
    hipLaunchKernelGGL(mk_fwd, dim3(grid), dim3(NTHR), LDS_BYTES, stream, a);
#else
    for (int p = 0; p < PH_TOTAL; ++p) {
        const int j = (p - PH_L0) % PH_PER_LAYER, L = (p - PH_L0) / PH_PER_LAYER;
        if (p >= PH_L0 && j == LP_MIXB && (L % 3) != 0) continue;
        a.ph_lo = p; a.ph_hi = p + 1;
        hipLaunchKernelGGL(mk_fwd, dim3(grid), dim3(NTHR), LDS_BYTES, stream, a);
    }
#endif
}
```

```cpp
#include <hip/hip_runtime.h>
#include <cstdio>
#include <cstdint>

#ifndef MK_ONE_LAUNCH
#define MK_ONE_LAUNCH 1
#endif

#ifndef FAST_DENSE
#define FAST_DENSE 1
#endif
#ifndef FAST_MOE
#define FAST_MOE 1
#endif
#ifndef REP_MASK
#define REP_MASK 0
#endif
#define REPS(k) for (int rep_ = 0; rep_ < 1 + ((REP_MASK >> (k)) & 1); ++rep_)
#ifndef FAST_S5
#define FAST_S5 1
#endif
#ifndef MOE_SPARSE
#define MOE_SPARSE 0
#endif
#ifndef YR_FP8
#define YR_FP8 0
#endif
#ifndef NT_STORES
#define NT_STORES 0
#endif
#ifndef WT_STORES
#define WT_STORES 0
#endif
#ifndef RES_BF16
#define RES_BF16 1
#endif
#ifndef MOE_FP8
#define MOE_FP8 1
#endif
#ifndef MOE_GATHER
#define MOE_GATHER 1
#endif
#ifndef BG_CONV
#define BG_CONV 1
#endif
#ifndef FAST_LN1
#define FAST_LN1 1
#endif
#ifndef FAST_XATTN
#define FAST_XATTN 1
#endif
#ifndef FAST_LINATT
#define FAST_LINATT 1
#endif
#define LAS __attribute__((address_space(3)))
typedef unsigned short bf16;

#ifndef MOE_SPARSE
#define MOE_SPARSE 0
#endif
#if MOE_SPARSE
#define MOE_SPARSE_ROWS (32 * 16384)
#else
#define MOE_SPARSE_ROWS (16384 * 4 + 32 * 256)
#endif
constexpr int NB = 8, SEQ = 2048, T = NB * SEQ, D = 1024, MIXW = 768, XW = 256, NMEM = 256, DEPTH = 4;
constexpr int NEXP = 32, TOPK = 4, DEXP = 1024, MOEBLK = 256;
constexpr int NROWS_MAX = MOE_SPARSE_ROWS;
constexpr int LDP = 2816;
constexpr float LN_EPS = 1e-5f;
constexpr float DN_ALPHA = 1.6817928305074290f;
constexpr int NWAVES = 8, NTHR = 512;

constexpr size_t MiB = (size_t)1 << 20;
constexpr size_t WS_CTL = 0, CTL_BYTES = 1 * MiB;
constexpr size_t WS_HF = 1 * MiB;
constexpr size_t WS_Y2 = WS_HF + (size_t)T * D * 4;
constexpr size_t WS_HB = WS_Y2 + (size_t)T * D * 4;
constexpr size_t WS_PROJ = WS_HB + (size_t)T * D * 2;
constexpr size_t WS_YG = WS_PROJ + (size_t)T * LDP * 2;
constexpr size_t WS_CAT = WS_YG + (size_t)T * MIXW * 2;
constexpr size_t WS_TOPE = WS_CAT + (size_t)T * D * 2;
constexpr size_t WS_TOPG = WS_TOPE + (size_t)T * 4 * 4;
constexpr size_t WS_DEST = WS_TOPG + (size_t)T * 4 * 4;
constexpr size_t WS_XR = WS_DEST + (size_t)T * 4 * 4;
constexpr size_t WS_ACT = WS_XR + (size_t)(T * TOPK + NEXP * MOEBLK) * D * 2;
constexpr size_t WS_YR = WS_ACT + (size_t)NROWS_MAX * DEXP * 2;
constexpr size_t WS_MEMK = WS_YR + (size_t)NROWS_MAX * D * 2;
constexpr size_t WS_MEMV = WS_MEMK + 1 * MiB;
constexpr size_t WS_MEMVT = WS_MEMV + 1 * MiB;
constexpr size_t WS_ROPE = WS_MEMVT + 1 * MiB;
constexpr size_t WS_WIN = WS_ROPE + (size_t)T * 48 * 2 * 4;
constexpr size_t WS_WGLU = WS_WIN + 4 * 6 * MiB;
constexpr size_t WS_WOUT = WS_WGLU + 2 * 2 * MiB;
constexpr size_t WS_WMEM = WS_WOUT + 4 * 2 * MiB;
constexpr size_t WS_MEMB = WS_WMEM + 1 * MiB;
constexpr size_t WS_WGU = WS_MEMB + 4 * MiB;
constexpr size_t WS_WDN = WS_WGU + (size_t)DEPTH * NEXP * 2 * DEXP * D * 2;
constexpr size_t WS_RWT = WS_WDN + (size_t)DEPTH * NEXP * D * DEXP * 2;
constexpr size_t WS_RTOK = WS_RWT + (size_t)DEPTH * 2 * NEXP * D * 2;
constexpr size_t WS_END = WS_RTOK + (size_t)NROWS_MAX * 4;
constexpr int CW_BAR = 4096;
constexpr int CW_CNT = 16384;
constexpr int CW_CUR = 16384 + 1024;
constexpr int CW_CQ = 16384 + 2048;

constexpr int LDS_BYTES = 163840;
constexpr int LDS_RMAP = 147456;
constexpr int LDS_MISC = 131072 + 8192;

__device__ __forceinline__ float bf2f(bf16 v) { return __uint_as_float(((unsigned)v) << 16); }
__device__ __forceinline__ bf16 f2bf(float f) { unsigned u = __float_as_uint(f); return (bf16)((u + 0x7fffu + ((u >> 16) & 1u)) >> 16); }
__device__ __forceinline__ unsigned pk2(float lo, float hi) { return (unsigned)f2bf(lo) | ((unsigned)f2bf(hi) << 16); }
__device__ __forceinline__ int sh_idx_i(int v, int src, int) { return __builtin_amdgcn_ds_bpermute(src << 2, v); }
__device__ __forceinline__ float sh_idx(float v, int src, int lane) { return __int_as_float(sh_idx_i(__float_as_int(v), src, lane)); }
__device__ __forceinline__ unsigned sh_idx(unsigned v, int src, int lane) { return (unsigned)sh_idx_i((int)v, src, lane); }
__device__ __forceinline__ float sh_xor(float v, int m, int lane) { return __int_as_float(__builtin_amdgcn_ds_bpermute((lane ^ m) << 2, __float_as_int(v))); }
__device__ __forceinline__ int sh_xor(int v, int m, int lane) { return __builtin_amdgcn_ds_bpermute((lane ^ m) << 2, v); }
__device__ __forceinline__ float sh_up(float v, int d, int lane) { const int s = lane - d; return __int_as_float(__builtin_amdgcn_ds_bpermute((s < 0 ? lane : s) << 2, __float_as_int(v))); }
__device__ __forceinline__ float wave_sum(float v, int lane) {
#pragma unroll
    for (int o = 1; o < 64; o <<= 1) v += sh_xor(v, o, lane);
    return v;
}
__device__ __forceinline__ float sigmoidf(float x) { return __builtin_amdgcn_rcpf(1.0f + __expf(-x)); }
__device__ __forceinline__ void unpack8(uint4 v, float* f) {
    f[0] = __uint_as_float(v.x << 16); f[1] = __uint_as_float(v.x & 0xffff0000u);
    f[2] = __uint_as_float(v.y << 16); f[3] = __uint_as_float(v.y & 0xffff0000u);
    f[4] = __uint_as_float(v.z << 16); f[5] = __uint_as_float(v.z & 0xffff0000u);
    f[6] = __uint_as_float(v.w << 16); f[7] = __uint_as_float(v.w & 0xffff0000u);
}
__device__ __forceinline__ void sincos_rad(float ang, float& s, float& c) {
    float r = ang * 0.15915494309189535f; r -= rintf(r);
    s = __builtin_amdgcn_sinf(r); c = __builtin_amdgcn_cosf(r);
}
__device__ __forceinline__ float gelu_tanh(float x) {
    const float u = 0.7978845608028654f * (x + 0.044715f * x * x * x);
    const float e = __expf(2.0f * u);
    const float th = 1.0f - 2.0f / (e + 1.0f);
    return 0.5f * x * (1.0f + th);
}

__device__ __forceinline__ int lane_id_opaque() { int l; asm volatile("v_mbcnt_lo_u32_b32 %0, -1, 0\n\tv_mbcnt_hi_u32_b32 %0, -1, %0" : "=v"(l)); return l; }
__device__ __forceinline__ bool wg_leader(int wave) { return wave == 0 && lane_id_opaque() == 0; }

#define XB_TMO      128
#define XB_XCNT(j)  (256  + 64 * (j))
#define XB_XSUB(j)  (1280 + 64 * (j))
#define XB_XGEN(j)  (2304 + 64 * (j))
#define XB_TOP      3328
#define XB_TOPGEN   3392
#define XCD_BAR_WORDS 3456
#define XB_SPIN_CAP (1u << 24)
__device__ __forceinline__ unsigned xb_ld(unsigned* p)              { return __hip_atomic_load(p, __ATOMIC_RELAXED, __HIP_MEMORY_SCOPE_AGENT); }
__device__ __forceinline__ unsigned xb_add(unsigned* p, unsigned v) { return __hip_atomic_fetch_add(p, v, __ATOMIC_RELAXED, __HIP_MEMORY_SCOPE_AGENT); }
__device__ __forceinline__ unsigned xb_xcc_id() { return (unsigned)__builtin_amdgcn_s_getreg((3 << 11) | 20) & 0xFu; }
#define XB_SPIN(cond, bar) do { unsigned _sp = 0; while (cond) { __builtin_amdgcn_s_sleep(1); \
    if ((++_sp & 255u) == 0u) { if (xb_ld(&(bar)[XB_TMO])) break; if (_sp > XB_SPIN_CAP) { atomicAdd(&(bar)[XB_TMO], 1u); break; } } } } while (0)
struct XcdBarrier { unsigned* bar; unsigned x; volatile LAS unsigned* st; };
__device__ __forceinline__ XcdBarrier xcd_barrier_post(unsigned* bar, volatile LAS unsigned* st, int wave) {
    XcdBarrier b; b.bar = bar; b.x = xb_xcc_id(); b.st = st;
    if (wg_leader(wave)) (void)xb_add(&bar[XB_XCNT(b.x)], 1u);
    return b;
}
__device__ __forceinline__ void xcd_barrier_complete(unsigned* bar, unsigned x, unsigned& nloc, unsigned& nx) {
    const unsigned G = gridDim.x * gridDim.y * gridDim.z;
    unsigned sum, cnt, mine, sp = 0u;
    for (;;) {
        sum = 0u; cnt = 0u; mine = 0u;
#pragma unroll
        for (unsigned j = 0; j < 16; ++j) { const unsigned c = xb_ld(&bar[XB_XCNT(j)]); sum += c; cnt += (c > 0u) ? 1u : 0u; mine = (j == x) ? c : mine; }
        if (sum == G) break;
        __builtin_amdgcn_s_sleep(1);
        if ((++sp & 255u) == 0u) { if (xb_ld(&bar[XB_TMO])) break; if (sp > XB_SPIN_CAP) { atomicAdd(&bar[XB_TMO], 1u); break; } }
    }
    nloc = mine > 0u ? mine : 1u; nx = cnt > 0u ? cnt : 1u;
}
__device__ __forceinline__ void xcd_barrier(const XcdBarrier& b, int wave) {
    asm volatile("s_waitcnt vmcnt(0)" ::: "memory");
    __syncthreads();
    if (wg_leader(wave)) {
        unsigned* bar = b.bar; asm volatile("" : "+s"(bar));
        __builtin_amdgcn_s_waitcnt(0);
        unsigned nloc = b.st[0], nx = b.st[1];
        if (nloc == 0u) { xcd_barrier_complete(bar, b.x, nloc, nx); b.st[0] = nloc; b.st[1] = nx; }
        const unsigned old = xb_add(&bar[XB_XSUB(b.x)], 1u);
        const unsigned gen = old / nloc;
        if (old + 1u == (gen + 1u) * nloc) {
            __builtin_amdgcn_fence(__ATOMIC_RELEASE, "agent");
            asm volatile("s_waitcnt vmcnt(0)" ::: "memory");
            const unsigned og = xb_add(&bar[XB_TOP], 1u);
            const unsigned tg = og / nx;
            if (og + 1u == (tg + 1u) * nx) xb_add(&bar[XB_TOPGEN], 1u);
            else XB_SPIN(xb_ld(&bar[XB_TOPGEN]) == tg, bar);
            __builtin_amdgcn_fence(__ATOMIC_ACQUIRE, "agent");
            xb_add(&bar[XB_XGEN(b.x)], 1u);
            asm volatile("s_waitcnt vmcnt(0)" ::: "memory");
        } else {
            XB_SPIN(xb_ld(&bar[XB_XGEN(b.x)]) == gen, bar);
            __builtin_amdgcn_fence(__ATOMIC_ACQUIRE, "agent");
            asm volatile("s_waitcnt vmcnt(0)" ::: "memory");
        }
    }
    __syncthreads();
}


namespace pg8 {
#define PG8_LAS __attribute__((address_space(3)))
typedef unsigned short bf16_t;
typedef short bf16x8 __attribute__((ext_vector_type(8)));
typedef float f32x4 __attribute__((ext_vector_type(4)));
typedef unsigned u32x4 __attribute__((ext_vector_type(4)));
typedef unsigned u32x2 __attribute__((ext_vector_type(2)));
typedef int i32x4 __attribute__((ext_vector_type(4)));
typedef int i32x8 __attribute__((ext_vector_type(8)));
constexpr int BM = 256, BK = 64, HALF = 128, HTB = HALF * BK * 2, STAGE_BYTES = 8 * HTB, NXCD = 8, WGM = 8;
__host__ __device__ __forceinline__ int lds_byte(int r, int c) { const int st = (r >> 4) * 2 + (c >> 5), rr = r & 15, cc = c & 31, ob = rr * 64 + cc * 2; return st * 1024 + (ob ^ (((ob >> 9) & 1) << 5)); }
__host__ __device__ __forceinline__ void stage_rc(int b, int& R, int& C) { const int st = b / 1024, sb = b % 1024, swz = sb ^ (((sb >> 9) & 1) << 5); R = (st >> 1) * 16 + swz / 64; C = (st & 1) * 32 + (swz % 64) / 2; }
__host__ __device__ __forceinline__ int perm32(int rho) { const int n = rho >> 4, i = rho & 15; return 8 * (i >> 2) + 4 * n + (i & 3); }
struct Unit { int pm, pn, pb, e; };
struct Gemm { const bf16_t* A; const bf16_t* Bt; int K; const PG8_LAS int* rowmap; };
struct StaticOrder {
    int nM, nN, nwg, G, c;
    __device__ __forceinline__ void init(int M, int N, int G_, int c_) { nM = M / BM; nN = N / BM; nwg = nM * nN; G = G_; c = c_; }
    __device__ __forceinline__ bool next(int i, Unit& u) const {
        const long L = (long)i * G + c; if (L >= nwg) return false;
        int wgid = (int)L; { const int q = nwg / NXCD, r = nwg % NXCD, xcd = wgid % NXCD, off = wgid / NXCD; wgid = (xcd < r ? xcd * (q + 1) : r * (q + 1) + (xcd - r) * q) + off; }
        const int nig = WGM * nN, gid = wgid / nig, fm = gid * WGM, gsz = (nM - fm) < WGM ? (nM - fm) : WGM;
        u.pm = fm + ((wgid % nig) % gsz); u.pn = (wgid % nig) / gsz; u.pb = u.pn; u.e = 0; return true;
    }
    __device__ __forceinline__ void a_ready(const Unit&) const {}
    __device__ __forceinline__ void done(const Unit&) const {}
};
struct MoeOrder {
    const PG8_LAS int* pend; int nb, ntn, G, vc;
    __device__ __forceinline__ bool next(int i, Unit& u) const {
        const int U = nb * ntn, per = G >> 3, chunk = (U + 7) >> 3, x = vc / per, r = vc - x * per;
        const int off = i * per + r; if (off >= chunk) return false;
        const long L = (long)x * chunk + off; if (L >= (long)U) return false;
        const int rb = (int)(L / ntn), pn = (int)(L % ntn); const int start = rb * 256; int e = 0, prev = 0;
#pragma unroll
        for (int j = 0; j < 32; ++j) { const int pj = pend[j]; if (start >= pj) { e += 1; prev = pj; } }
        e = e < 31 ? e : 31; e = __builtin_amdgcn_readfirstlane(e); prev = __builtin_amdgcn_readfirstlane(prev);
#if MOE_SPARSE
        u.pm = e * (16384 / 256) + (rb - prev / 256);
#else
        u.pm = rb;
#endif
        u.pn = pn; u.pb = e * ntn + pn; u.e = e; return true;
    }
    __device__ __forceinline__ void a_ready(const Unit&) const {}
    __device__ __forceinline__ void done(const Unit&) const {}
};
__device__ __forceinline__ unsigned cvt_pk_bf16(float lo, float hi) { unsigned r; asm volatile("v_cvt_pk_bf16_f32 %0, %1, %2" : "=v"(r) : "v"(lo), "v"(hi)); return r; }
__device__ __forceinline__ float fsig(float x) { return __builtin_amdgcn_rcpf(1.0f + __expf(-x)); }
#if WT_STORES
__device__ __forceinline__ void st16(void* p, u32x4 v) { asm volatile("global_store_dwordx4 %0, %1, off sc1\n\ts_nop 0" :: "v"(p), "v"(v) : "memory"); }
__device__ __forceinline__ void st8(void* p, u32x2 v) { asm volatile("global_store_dwordx2 %0, %1, off sc1\n\ts_nop 0" :: "v"(p), "v"(v) : "memory"); }
#elif NT_STORES
__device__ __forceinline__ void st16(void* p, u32x4 v) { __builtin_nontemporal_store(v, (u32x4*)p); }
__device__ __forceinline__ void st8(void* p, u32x2 v) { __builtin_nontemporal_store(v, (u32x2*)p); }
#else
__device__ __forceinline__ void st16(void* p, u32x4 v) { *(u32x4*)p = v; }
__device__ __forceinline__ void st8(void* p, u32x2 v) { *(u32x2*)p = v; }
#endif
template <bool OUT8> struct EpiBf16T {
    static constexpr bool PERM = true, AFTER_DRAIN = false;
    void* O; int ldc; const float* bias; int bias_estride; float scale;
    __device__ __forceinline__ void operator()(const f32x4 (&acc)[2][2][4][2], const Unit& u, int wr, int wc, int fr, int fq) const {
        const int row0 = u.pm * BM + wr * 64 + fr, col0 = u.pn * BM + wc * 32 + 8 * fq;
        f32x4 bv[2][2];
#pragma unroll
        for (int bj = 0; bj < 2; ++bj)
#pragma unroll
            for (int n = 0; n < 2; ++n) bv[bj][n] = bias ? *(const f32x4*)(bias + (size_t)u.e * bias_estride + col0 + bj * HALF + 4 * n) : (f32x4){0.f, 0.f, 0.f, 0.f};
#pragma unroll
        for (int ai = 0; ai < 2; ++ai)
#pragma unroll
            for (int m = 0; m < 4; ++m) { const size_t ro = (size_t)(row0 + ai * HALF + m * 16) * ldc + col0;
#pragma unroll
                for (int bj = 0; bj < 2; ++bj) { const f32x4 v0 = acc[ai][bj][m][0] * scale + bv[bj][0], v1 = acc[ai][bj][m][1] * scale + bv[bj][1];
                    if constexpr (OUT8) { int w0 = __builtin_amdgcn_cvt_pk_fp8_f32(v0[0], v0[1], 0, false); w0 = __builtin_amdgcn_cvt_pk_fp8_f32(v0[2], v0[3], w0, true); int w1 = __builtin_amdgcn_cvt_pk_fp8_f32(v1[0], v1[1], 0, false); w1 = __builtin_amdgcn_cvt_pk_fp8_f32(v1[2], v1[3], w1, true);
                        u32x2 w; w.x = (unsigned)w0; w.y = (unsigned)w1; st8((unsigned char*)O + ro + bj * HALF, w); }
                    else { u32x4 w; w.x = cvt_pk_bf16(v0[0], v0[1]); w.y = cvt_pk_bf16(v0[2], v0[3]); w.z = cvt_pk_bf16(v1[0], v1[1]); w.w = cvt_pk_bf16(v1[2], v1[3]);
                        st16((bf16_t*)O + ro + bj * HALF, w); } } }
    }
};
typedef EpiBf16T<false> EpiBf16;
struct EpiGlu {
    static constexpr bool PERM = true, AFTER_DRAIN = false;
    bf16_t* O; int ldc; const bf16_t* Y; int ldy; const float* bias;
    __device__ __forceinline__ void operator()(const f32x4 (&acc)[2][2][4][2], const Unit& u, int wr, int wc, int fr, int fq) const {
        const int row0 = u.pm * BM + wr * 64 + fr, col0 = u.pn * BM + wc * 32 + 8 * fq;
        f32x4 bv[2][2];
#pragma unroll
        for (int bj = 0; bj < 2; ++bj)
#pragma unroll
            for (int n = 0; n < 2; ++n) bv[bj][n] = *(const f32x4*)(bias + col0 + bj * HALF + 4 * n);
#pragma unroll
        for (int ai = 0; ai < 2; ++ai)
#pragma unroll
            for (int m = 0; m < 4; ++m) { const size_t r = (size_t)(row0 + ai * HALF + m * 16);
#pragma unroll
                for (int bj = 0; bj < 2; ++bj) { const int c = col0 + bj * HALF; const u32x4 yv = *(const u32x4*)(Y + r * ldy + c);
                    const f32x4 z0 = acc[ai][bj][m][0] + bv[bj][0], z1 = acc[ai][bj][m][1] + bv[bj][1];
                    float y[8]; y[0] = __uint_as_float(yv.x << 16); y[1] = __uint_as_float(yv.x & 0xffff0000u); y[2] = __uint_as_float(yv.y << 16); y[3] = __uint_as_float(yv.y & 0xffff0000u);
                    y[4] = __uint_as_float(yv.z << 16); y[5] = __uint_as_float(yv.z & 0xffff0000u); y[6] = __uint_as_float(yv.w << 16); y[7] = __uint_as_float(yv.w & 0xffff0000u);
                    u32x4 w; w.x = cvt_pk_bf16(y[0] * fsig(z0[0]), y[1] * fsig(z0[1])); w.y = cvt_pk_bf16(y[2] * fsig(z0[2]), y[3] * fsig(z0[3]));
                    w.z = cvt_pk_bf16(y[4] * fsig(z1[0]), y[5] * fsig(z1[1])); w.w = cvt_pk_bf16(y[6] * fsig(z1[2]), y[7] * fsig(z1[3]));
                    st16(O + r * ldc + c, w); } }
    }
};
struct EpiResF32 {
    static constexpr bool PERM = false, AFTER_DRAIN = false;
    float* C; const float* R; int ldc; float alpha;
    __device__ __forceinline__ void operator()(const f32x4 (&acc)[2][2][4][2], const Unit& u, int wr, int wc, int fr, int fq) const {
        const int row0 = u.pm * BM + wr * 64 + fr, col0 = u.pn * BM + wc * 32 + 4 * fq;
#pragma unroll
        for (int ai = 0; ai < 2; ++ai)
#pragma unroll
            for (int m = 0; m < 4; ++m) { const size_t off = (size_t)(row0 + ai * HALF + m * 16) * ldc + col0;
#pragma unroll
                for (int bj = 0; bj < 2; ++bj)
#pragma unroll
                    for (int n = 0; n < 2; ++n) { const f32x4 rv = *(const f32x4*)(R + off + bj * HALF + n * 16); *(f32x4*)(C + off + bj * HALF + n * 16) = rv * alpha + acc[ai][bj][m][n]; } }
    }
};
struct EpiResBf16 {
    static constexpr bool PERM = true, AFTER_DRAIN = false;
    bf16_t* O; const bf16_t* R; int ldc; float alpha;
    __device__ __forceinline__ void operator()(const f32x4 (&acc)[2][2][4][2], const Unit& u, int wr, int wc, int fr, int fq) const {
        const int row0 = u.pm * BM + wr * 64 + fr, col0 = u.pn * BM + wc * 32 + 8 * fq;
#pragma unroll
        for (int ai = 0; ai < 2; ++ai)
#pragma unroll
            for (int m = 0; m < 4; ++m) { const size_t off = (size_t)(row0 + ai * HALF + m * 16) * ldc + col0;
#pragma unroll
                for (int bj = 0; bj < 2; ++bj) { const u32x4 rv = *(const u32x4*)(R + off + bj * HALF); const f32x4 a0 = acc[ai][bj][m][0], a1 = acc[ai][bj][m][1];
                    u32x4 w; w.x = cvt_pk_bf16(__uint_as_float(rv.x << 16) * alpha + a0[0], __uint_as_float(rv.x & 0xffff0000u) * alpha + a0[1]); w.y = cvt_pk_bf16(__uint_as_float(rv.y << 16) * alpha + a0[2], __uint_as_float(rv.y & 0xffff0000u) * alpha + a0[3]);
                    w.z = cvt_pk_bf16(__uint_as_float(rv.z << 16) * alpha + a1[0], __uint_as_float(rv.z & 0xffff0000u) * alpha + a1[1]); w.w = cvt_pk_bf16(__uint_as_float(rv.w << 16) * alpha + a1[2], __uint_as_float(rv.w & 0xffff0000u) * alpha + a1[3]);
                    st16(O + off + bj * HALF, w); } }
    }
};
template <bool OUT8> struct EpiSwiglu {
    static constexpr bool PERM = true, AFTER_DRAIN = false;
    void* O; const float* bgu; float scale;
    __device__ __forceinline__ void operator()(const f32x4 (&acc)[2][2][4][2], const Unit& u, int wr, int wc, int fr, int fq) const {
        const int row0 = u.pm * BM + wr * 64 + fr, cidx = u.pn * HALF + wc * 32 + 8 * fq;
        const float* bg = bgu + (size_t)u.e * 2048 + cidx;
        f32x4 bG[2], bL[2];
#pragma unroll
        for (int n = 0; n < 2; ++n) { bG[n] = *(const f32x4*)(bg + 4 * n); bL[n] = *(const f32x4*)(bg + 1024 + 4 * n); }
#pragma unroll
        for (int ai = 0; ai < 2; ++ai)
#pragma unroll
            for (int m = 0; m < 4; ++m) { const size_t ro = (size_t)(row0 + ai * HALF + m * 16) * 1024 + cidx; float o[8];
#pragma unroll
                for (int n = 0; n < 2; ++n) { const f32x4 g = acc[ai][0][m][n] * scale + bG[n], l = acc[ai][1][m][n] * scale + bL[n];
#pragma unroll
                    for (int j = 0; j < 4; ++j) { const float xg = fminf(g[j], 7.0f), xl = fminf(fmaxf(l[j], -7.0f), 7.0f); o[4 * n + j] = xg * fsig(1.702f * xg) * (xl + 1.0f); } }
                if constexpr (OUT8) { int w0 = __builtin_amdgcn_cvt_pk_fp8_f32(o[0], o[1], 0, false); w0 = __builtin_amdgcn_cvt_pk_fp8_f32(o[2], o[3], w0, true); int w1 = __builtin_amdgcn_cvt_pk_fp8_f32(o[4], o[5], 0, false); w1 = __builtin_amdgcn_cvt_pk_fp8_f32(o[6], o[7], w1, true);
                    u32x2 w; w.x = (unsigned)w0; w.y = (unsigned)w1; st8((unsigned char*)O + ro, w); }
                else { u32x4 w; w.x = cvt_pk_bf16(o[0], o[1]); w.y = cvt_pk_bf16(o[2], o[3]); w.z = cvt_pk_bf16(o[4], o[5]); w.w = cvt_pk_bf16(o[6], o[7]);
                    st16((bf16_t*)O + ro, w); } }
    }
};
struct EpiMem {
    static constexpr bool PERM = false, AFTER_DRAIN = false;
    bf16_t* mk; bf16_t* mv; bf16_t* mvt;
    __device__ __forceinline__ void operator()(const f32x4 (&acc)[2][2][4][2], const Unit& u, int wr, int wc, int fr, int fq) const {
        const int row0 = u.pm * BM + wr * 64 + fr, col0 = u.pn * BM + wc * 32 + 4 * fq;
#pragma unroll
        for (int ai = 0; ai < 2; ++ai)
#pragma unroll
            for (int m = 0; m < 4; ++m) { const int r = row0 + ai * HALF + m * 16, b = r >> 8, key = r & 255;
#pragma unroll
                for (int bj = 0; bj < 2; ++bj)
#pragma unroll
                    for (int n = 0; n < 2; ++n) { const int c = col0 + bj * HALF + n * 16, cc = c & 255, head = cc >> 6, d = cc & 63; const f32x4 v = acc[ai][bj][m][n];
                        u32x2 w; w.x = cvt_pk_bf16(v[0], v[1]); w.y = cvt_pk_bf16(v[2], v[3]);
                        const size_t o = ((size_t)(b * 4 + head) * 256 + key) * 64 + d;
                        if (c < 256) *(u32x2*)(mk + o) = w;
                        else { *(u32x2*)(mv + o) = w; bf16_t* t = mvt + ((size_t)(b * 4 + head) * 64 + d) * 256 + key;
                            t[0] = (bf16_t)(w.x & 0xffffu); t[256] = (bf16_t)(w.x >> 16); t[512] = (bf16_t)(w.y & 0xffffu); t[768] = (bf16_t)(w.y >> 16); } } }
    }
};
template <class Epi, class Sched, bool ALIGN_EPI = true, bool SP2 = true, bool GATHER = false, bool FP8 = false>
__device__ __forceinline__ void gemm_phase(PG8_LAS unsigned char* lds, const Gemm g, const Sched& S, const Epi& E, const int wave_) {
    const int tid_ = wave_ * 64 + lane_id_opaque();
    const int tid = tid_, wid = wave_, lane = tid & 63, wr = wid >> 2, wc = wid & 3, fr = lane & 15, fq = lane >> 4;
    const int K = g.K, rowb = FP8 ? K : 2 * K  , nt = rowb / (BK * 2);
    unsigned voffA[2], voffB[2];
#pragma unroll
    for (int i = 0; i < 2; ++i) { int R, C; stage_rc(tid * 16 + i * 8192, R, C); const int Rb = Epi::PERM ? ((R & ~31) + perm32(R & 31)) : R;
        voffA[i] = (unsigned)(R * rowb + C * 2); voffB[i] = (unsigned)(Rb * rowb + C * 2); }
    const size_t kstep = (size_t)(BK * 2);
    const size_t hstep = (size_t)HALF * rowb;
    const size_t tstep = 2 * hstep;
    const unsigned ldsw = (unsigned)wid * 1024u;
    int aoffv[2], boffv[2];
#pragma unroll
    for (int k = 0; k < 2; ++k) { const int p = FP8 ? 2 * fq + k : 4 * k + fq; aoffv[k] = lds_byte(wr * 64 + fr, (p & 3) * 8) + (p >> 2) * 1024; boffv[k] = lds_byte(wc * 32 + fr, (p & 3) * 8) + (p >> 2) * 1024; }
#define PG8_SA(b, h) (((b) * 2 + (h)) * HTB)
#define PG8_SB(b, h) ((4 + (b) * 2 + (h)) * HTB)
#define PG8_STAGE(bufoff, gbase, voff) do { _Pragma("unroll") for (int _i = 0; _i < 2; ++_i) \
        __builtin_amdgcn_global_load_lds((const unsigned*)((const char*)(gbase) + (voff)[_i]), (PG8_LAS unsigned*)(lds + (bufoff) + ldsw + _i * 8192), 16, 0, 0); } while (0)
#define PG8_VSEL_0(h, i) vgC[h][i]
#define PG8_VSEL_1(h, i) (last ? vgX[h][i] : vgC[h][i])
#define PG8_STAGE_A(bufoff, gbase, h, set) do { if constexpr (GATHER) { _Pragma("unroll") for (int _i = 0; _i < 2; ++_i) \
        __builtin_amdgcn_global_load_lds((const unsigned*)((const char*)(gbase) + PG8_VSEL_##set(h, _i)), (PG8_LAS unsigned*)(lds + (bufoff) + ldsw + _i * 8192), 16, 0, 0); } \
    else { PG8_STAGE(bufoff, (gbase) + (h) * hstep, voffA); } } while (0)
#define PG8_LDA(dst, b, h) do { if constexpr (FP8) { _Pragma("unroll") for (int m = 0; m < 4; ++m) { const i32x4 lo_ = *(const PG8_LAS i32x4*)(lds + PG8_SA(b, h) + aoffv[0] + m * 2048), hi_ = *(const PG8_LAS i32x4*)(lds + PG8_SA(b, h) + aoffv[1] + m * 2048); dst##8[m] = __builtin_shufflevector(lo_, hi_, 0, 1, 2, 3, 4, 5, 6, 7); } } \
    else { _Pragma("unroll") for (int m = 0; m < 4; ++m) _Pragma("unroll") for (int k = 0; k < 2; ++k) dst[m][k] = *(const PG8_LAS bf16x8*)(lds + PG8_SA(b, h) + aoffv[k] + m * 2048); } } while (0)
#define PG8_LDB(dst, b, h) do { if constexpr (FP8) { _Pragma("unroll") for (int n = 0; n < 2; ++n) { const i32x4 lo_ = *(const PG8_LAS i32x4*)(lds + PG8_SB(b, h) + boffv[0] + n * 2048), hi_ = *(const PG8_LAS i32x4*)(lds + PG8_SB(b, h) + boffv[1] + n * 2048); dst##8[n] = __builtin_shufflevector(lo_, hi_, 0, 1, 2, 3, 4, 5, 6, 7); } } \
    else { _Pragma("unroll") for (int n = 0; n < 2; ++n) _Pragma("unroll") for (int k = 0; k < 2; ++k) dst[n][k] = *(const PG8_LAS bf16x8*)(lds + PG8_SB(b, h) + boffv[k] + n * 2048); } } while (0)
#define PG8_MMA(ai, bj, At, Bt) do { __builtin_amdgcn_s_setprio(1); _Pragma("unroll") for (int m = 0; m < 4; ++m) _Pragma("unroll") for (int n = 0; n < 2; ++n) { \
        if constexpr (FP8) { acc[ai][bj][m][n] = __builtin_amdgcn_mfma_scale_f32_16x16x128_f8f6f4(Bt##8[n], At##8[m], acc[ai][bj][m][n], 0, 0, 0, 0x7f7f7f7f, 0, 0x7f7f7f7f); } \
        else { _Pragma("unroll") for (int k = 0; k < 2; ++k) acc[ai][bj][m][n] = __builtin_amdgcn_mfma_f32_16x16x32_bf16(Bt[n][k], At[m][k], acc[ai][bj][m][n], 0, 0, 0); } } \
        if constexpr (FP8) { _Pragma("unroll") for (int m = 0; m < 4; ++m) asm volatile("" : "+v"(acc[ai][bj][m][0]), "+v"(acc[ai][bj][m][1])); }     \
        __builtin_amdgcn_s_setprio(0); } while (0)
#define PG8_WAIT_V(n) asm volatile("s_waitcnt vmcnt(" #n ")" ::: "memory")
#define PG8_WAIT_L(n) asm volatile("s_waitcnt lgkmcnt(" #n ")" ::: "memory")
#define PG8_BAR __builtin_amdgcn_s_barrier()
#define PG8_SCHED __builtin_amdgcn_sched_barrier(0)
    Unit cur, nxt; int ui = 0;
    if (!S.next(0, cur)) return;
    f32x4 acc[2][2][4][2];
#pragma unroll
    for (int a = 0; a < 2; ++a)
#pragma unroll
        for (int b = 0; b < 2; ++b)
#pragma unroll
            for (int m = 0; m < 4; ++m)
#pragma unroll
                for (int n = 0; n < 2; ++n) acc[a][b][m][n] = (f32x4){0.f, 0.f, 0.f, 0.f};
    bf16x8 At[4][2], B0[2][2], B1[2][2];
    i32x8 At8[4], B08[2], B18[2];
    unsigned vgC[2][2], vgX[2][2];
#define PG8_GOFF(dst, pm_) do { const int t_ = wave_ * 64 + lane_id_opaque();   _Pragma("unroll") for (int _i = 0; _i < 2; ++_i) { int gR_, gC_; stage_rc(t_ * 16 + _i * 8192, gR_, gC_); _Pragma("unroll") for (int _h = 0; _h < 2; ++_h) \
        dst[_h][_i] = (unsigned)(g.rowmap[(pm_) * BM + _h * HALF + gR_] * rowb + gC_ * 2); } } while (0)
    if constexpr (GATHER) { PG8_GOFF(vgC, 0); }
    const char* cA = GATHER ? (const char*)g.A : (const char*)g.A + (size_t)cur.pm * tstep; const char* cB = (const char*)g.Bt + (size_t)cur.pb * tstep;
    S.a_ready(cur);
    if constexpr (SP2) {
        PG8_STAGE(PG8_SB(0, 0), cB, voffB); PG8_STAGE(PG8_SB(0, 1), cB + hstep, voffB); PG8_STAGE_A(PG8_SA(0, 0), cA, 0, 0); PG8_STAGE_A(PG8_SA(0, 1), cA, 1, 0);
        if (wr == 1) PG8_BAR;
        PG8_WAIT_V(2); PG8_BAR;
        PG8_STAGE(PG8_SB(1, 0), cB + kstep, voffB); PG8_STAGE_A(PG8_SA(1, 0), cA + kstep, 0, 0); PG8_STAGE(PG8_SB(1, 1), cB + hstep + kstep, voffB);
        PG8_WAIT_V(6); PG8_BAR;
    } else {
        PG8_STAGE(PG8_SB(0, 0), cB, voffB); PG8_STAGE_A(PG8_SA(0, 0), cA, 0, 0); PG8_STAGE(PG8_SB(0, 1), cB + hstep, voffB); PG8_STAGE_A(PG8_SA(0, 1), cA, 1, 0);
        if (wr == 1) PG8_BAR;
        PG8_WAIT_V(4); PG8_BAR;
        PG8_STAGE(PG8_SB(1, 0), cB + kstep, voffB); PG8_STAGE_A(PG8_SA(1, 0), cA + kstep, 0, 0); PG8_STAGE(PG8_SB(1, 1), cB + hstep + kstep, voffB);
        PG8_WAIT_V(6); PG8_BAR;
    }
    for (;;) {
        const bool has_next = S.next(ui + 1, nxt);
        if constexpr (GATHER) { if (has_next) PG8_GOFF(vgX, ui + 1); else { _Pragma("unroll") for (int _h = 0; _h < 2; ++_h) _Pragma("unroll") for (int _i = 0; _i < 2; ++_i) vgX[_h][_i] = vgC[_h][_i]; } }
        const char* nA = GATHER ? (const char*)g.A : (has_next ? (const char*)g.A + (size_t)nxt.pm * tstep : cA); const char* nB = has_next ? (const char*)g.Bt + (size_t)nxt.pb * tstep : cB;
        for (int t = 0; t < nt; t += 2) {
            const bool last = (t == nt - 2);
            const char* a1 = cA + (size_t)(t + 1) * kstep;
            const char* a2 = last ? nA : cA + (size_t)(t + 2) * kstep; const char* b2 = last ? nB : cB + (size_t)(t + 2) * kstep;
            const char* a3 = a2 + kstep; const char* b3 = b2 + kstep;
            if (last && has_next) S.a_ready(nxt);
            if constexpr (SP2) {
            PG8_LDB(B0, 0, 0); PG8_LDB(B1, 0, 1); PG8_SCHED; PG8_LDA(At, 0, 0); PG8_STAGE_A(PG8_SA(1, 1), a1, 1, 0);
            PG8_WAIT_V(8); PG8_WAIT_L(0); PG8_BAR; PG8_MMA(0, 0, At, B0); PG8_MMA(0, 1, At, B1); PG8_BAR; PG8_SCHED;
            PG8_LDA(At, 0, 1); PG8_STAGE(PG8_SB(0, 0), b2, voffB); PG8_STAGE(PG8_SB(0, 1), b2 + hstep, voffB); PG8_STAGE_A(PG8_SA(0, 0), a2, 0, 1);
            PG8_WAIT_V(8); PG8_WAIT_L(0); PG8_BAR; PG8_MMA(1, 0, At, B0); PG8_MMA(1, 1, At, B1); PG8_BAR; PG8_SCHED;
            PG8_LDB(B0, 1, 0); PG8_LDB(B1, 1, 1); PG8_SCHED; PG8_LDA(At, 1, 0); PG8_STAGE_A(PG8_SA(0, 1), a2, 1, 1);
            PG8_WAIT_V(8); PG8_WAIT_L(0); PG8_BAR; PG8_MMA(0, 0, At, B0); PG8_MMA(0, 1, At, B1); PG8_BAR; PG8_SCHED;
            PG8_LDA(At, 1, 1); PG8_STAGE(PG8_SB(1, 0), b3, voffB); PG8_STAGE(PG8_SB(1, 1), b3 + hstep, voffB); PG8_STAGE_A(PG8_SA(1, 0), a3, 0, 1);
            PG8_WAIT_V(8); PG8_WAIT_L(0); PG8_BAR; PG8_MMA(1, 0, At, B0); PG8_MMA(1, 1, At, B1); PG8_BAR; PG8_SCHED;
            } else {
            PG8_LDB(B0, 0, 0); PG8_SCHED; PG8_LDA(At, 0, 0); PG8_STAGE_A(PG8_SA(1, 1), a1, 1, 0);
            PG8_WAIT_L(8); PG8_BAR; PG8_WAIT_L(0); PG8_MMA(0, 0, At, B0); PG8_BAR; PG8_SCHED;
            PG8_LDB(B1, 0, 1); PG8_STAGE(PG8_SB(0, 0), b2, voffB);
            PG8_BAR; PG8_WAIT_L(0); PG8_MMA(0, 1, At, B1); PG8_BAR;
            PG8_LDA(At, 0, 1); PG8_STAGE_A(PG8_SA(0, 0), a2, 0, 1);
            PG8_BAR; PG8_WAIT_L(0); PG8_MMA(1, 0, At, B0); PG8_BAR; PG8_SCHED;
            PG8_STAGE(PG8_SB(0, 1), b2 + hstep, voffB);
            PG8_WAIT_V(6); PG8_BAR; PG8_MMA(1, 1, At, B1); PG8_BAR;
            PG8_LDB(B0, 1, 0); PG8_SCHED; PG8_LDA(At, 1, 0); PG8_STAGE_A(PG8_SA(0, 1), a2, 1, 1);
            PG8_WAIT_L(8); PG8_BAR; PG8_WAIT_L(0); PG8_MMA(0, 0, At, B0); PG8_BAR; PG8_SCHED;
            PG8_LDB(B1, 1, 1); PG8_STAGE(PG8_SB(1, 0), b3, voffB);
            PG8_BAR; PG8_WAIT_L(0); PG8_MMA(0, 1, At, B1); PG8_BAR;
            PG8_LDA(At, 1, 1); PG8_STAGE_A(PG8_SA(1, 0), a3, 0, 1);
            PG8_BAR; PG8_WAIT_L(0); PG8_MMA(1, 0, At, B0); PG8_BAR; PG8_SCHED;
            PG8_STAGE(PG8_SB(1, 1), b3 + hstep, voffB);
            PG8_WAIT_V(6); PG8_BAR; PG8_MMA(1, 1, At, B1); PG8_BAR;
            }
        }
        if constexpr (ALIGN_EPI) { if (wr == 0) PG8_BAR; }
        if constexpr (!Epi::AFTER_DRAIN) { const int l2_ = lane_id_opaque(); E(acc, cur, wr, wc, l2_ & 15, l2_ >> 4); S.done(cur); }
        if (!has_next) break;
#pragma unroll
        for (int a = 0; a < 2; ++a)
#pragma unroll
            for (int b = 0; b < 2; ++b)
#pragma unroll
                for (int m = 0; m < 4; ++m)
#pragma unroll
                    for (int n = 0; n < 2; ++n) acc[a][b][m][n] = (f32x4){0.f, 0.f, 0.f, 0.f};
        cur = nxt; cA = nA; cB = nB; ++ui;
        if constexpr (GATHER) { _Pragma("unroll") for (int _h = 0; _h < 2; ++_h) _Pragma("unroll") for (int _i = 0; _i < 2; ++_i) vgC[_h][_i] = vgX[_h][_i]; }
        if constexpr (ALIGN_EPI) { if (wr == 1) PG8_BAR; }
    }
    PG8_WAIT_V(0);
    if constexpr (!ALIGN_EPI) { if (wr == 0) PG8_BAR; }
    PG8_BAR;
    if constexpr (Epi::AFTER_DRAIN) { E.fused(acc, cur, wr, wc, fr, fq, lds, wid, lane); S.done(cur); }
#undef PG8_GOFF
#undef PG8_SA
#undef PG8_SB
#undef PG8_STAGE
#undef PG8_STAGE_A
#undef PG8_VSEL_0
#undef PG8_VSEL_1
#undef PG8_LDA
#undef PG8_LDB
#undef PG8_MMA
#undef PG8_WAIT_V
#undef PG8_WAIT_L
#undef PG8_BAR
#undef PG8_SCHED
}
}

template <class TC, class LA, class LB, class EP>
__device__ __forceinline__ void oracle_gemm(LAS float* lds, int M, int N, int K, TC tilectx, LA loadA, LB loadB, EP epi) {
    LAS float* As = lds; LAS float* Bs = lds + 16 * 132;
    int tid = threadIdx.x; asm volatile("" : "+v"(tid)); const int ty = tid >> 4, tx = tid & 15;
    const int ntm = M / 128, ntn = (N + 127) / 128;
    for (int tile = blockIdx.x; tile < ntm * ntn; tile += gridDim.x) {
        const int tm = tile / ntn, tn = tile % ntn;
        const int ctx = tilectx(tm);
        float acc[4][8];
#pragma unroll
        for (int i = 0; i < 4; ++i)
#pragma unroll
            for (int j = 0; j < 8; ++j) acc[i][j] = 0.f;
        for (int k0 = 0; k0 < K; k0 += 16) {
#pragma unroll
            for (int i = 0; i < 4; ++i) { const int idx = tid + 512 * i; const int r = idx >> 4, kk = idx & 15; As[kk * 132 + r] = loadA(tm * 128 + r, k0 + kk); }
#pragma unroll
            for (int i = 0; i < 4; ++i) { const int idx = tid + 512 * i; const int kk = idx >> 7, n = idx & 127; Bs[kk * 132 + n] = loadB(k0 + kk, tn * 128 + n, ctx); }
            __syncthreads();
#pragma unroll 2
            for (int kk = 0; kk < 16; ++kk) {
                float a[4], b[8];
#pragma unroll
                for (int i = 0; i < 4; ++i) a[i] = As[kk * 132 + ty * 4 + i];
#pragma unroll
                for (int j = 0; j < 8; ++j) b[j] = Bs[kk * 132 + tx * 8 + j];
#pragma unroll
                for (int i = 0; i < 4; ++i)
#pragma unroll
                    for (int j = 0; j < 8; ++j) acc[i][j] += a[i] * b[j];
            }
            __syncthreads();
        }
        epi(tm * 128 + ty * 4, tn * 128 + tx * 8, acc, ctx);
    }
}


template <class MAP>
__device__ __forceinline__ void tr_item(const float* W, int ldw, int K, bf16* WT, int nblk, int item, LAS float* scr, int lane, MAP map) {
    const int kb = item / nblk, nb = item % nblk, k0 = kb * 64, n0 = nb * 64;
    const int s = map(n0 + lane);
    const float* wp = W + (size_t)k0 * ldw + (s >= 0 ? s : 0);
#pragma unroll 8
    for (int i = 0; i < 64; ++i) scr[i * 65 + lane] = (s >= 0) ? wp[(size_t)i * ldw] : 0.f;
    asm volatile("s_waitcnt lgkmcnt(0)" ::: "memory");
    const int c = lane & 7;
#pragma unroll
    for (int j = 0; j < 8; ++j) { const int n = (lane >> 3) + 8 * j; const LAS float* sp = scr + (8 * c) * 65 + n;
        uint4 o; o.x = pg8::cvt_pk_bf16(sp[0], sp[65]); o.y = pg8::cvt_pk_bf16(sp[130], sp[195]); o.z = pg8::cvt_pk_bf16(sp[260], sp[325]); o.w = pg8::cvt_pk_bf16(sp[390], sp[455]);
        *(uint4*)(WT + (size_t)(n0 + n) * K + k0 + 8 * c) = o; }
    asm volatile("s_waitcnt lgkmcnt(0)" ::: "memory");
}

template <class MAP>
__device__ __forceinline__ void tr_item8(const float* W, int ldw, int K, unsigned char* WT8, int nblk, int item, LAS float* scr, int lane, float scale, MAP map) {
    const int kb = item / nblk, nb = item % nblk, k0 = kb * 64, n0 = nb * 64;
    const int s = map(n0 + lane);
    const float* wp = W + (size_t)k0 * ldw + (s >= 0 ? s : 0);
#pragma unroll 8
    for (int i = 0; i < 64; ++i) scr[i * 65 + lane] = (s >= 0) ? wp[(size_t)i * ldw] * scale : 0.f;
    asm volatile("s_waitcnt lgkmcnt(0)" ::: "memory");
    const int c = lane & 7;
#pragma unroll
    for (int j = 0; j < 8; ++j) { const int n = (lane >> 3) + 8 * j; const LAS float* sp = scr + (8 * c) * 65 + n;
        int w0 = __builtin_amdgcn_cvt_pk_fp8_f32(sp[0], sp[65], 0, false); w0 = __builtin_amdgcn_cvt_pk_fp8_f32(sp[130], sp[195], w0, true);
        int w1 = __builtin_amdgcn_cvt_pk_fp8_f32(sp[260], sp[325], 0, false); w1 = __builtin_amdgcn_cvt_pk_fp8_f32(sp[390], sp[455], w1, true);
        uint2 o; o.x = (unsigned)w0; o.y = (unsigned)w1; *(uint2*)(WT8 + (size_t)(n0 + n) * K + k0 + 8 * c) = o; }
    asm volatile("s_waitcnt lgkmcnt(0)" ::: "memory");
}

struct Args { const void* in[46]; float* out; unsigned char* ws; int ph_lo, ph_hi; };

enum { PH_PRO = 0, PH_MEM = 1, PH_L0 = 2, PH_PER_LAYER = 9, PH_TOTAL = 2 + 9 * DEPTH };
enum { LP_INPROJ = 0, LP_MIXA = 1, LP_MIXB = 2, LP_OUTPROJ = 3, LP_LN1 = 4, LP_DISP = 5, LP_GU = 6, LP_DOWN = 7, LP_COMB = 8 };

__device__ __forceinline__ int expert_of_block(const LAS int* pend, int rb) {
    const int start = rb * MOEBLK; int e = 0;
#pragma unroll
    for (int i = 0; i < NEXP; ++i) e += (start >= pend[i]) ? 1 : 0;
    return e < NEXP - 1 ? e : NEXP - 1;
}

typedef const void* const __attribute__((address_space(4)))* KARG;
__global__ void __launch_bounds__(NTHR, 2) mk_fwd(Args args) {
    extern __shared__ __attribute__((aligned(16))) unsigned char lds_raw[];
    LAS unsigned char* lds = (LAS unsigned char*)lds_raw;
    LAS float* ldsf = (LAS float*)lds;
    volatile LAS unsigned* MISC = (volatile LAS unsigned*)(lds + LDS_MISC);
    const int tid0 = threadIdx.x, wave0 = __builtin_amdgcn_readfirstlane(tid0 >> 6);
    const int G = gridDim.x, bid = blockIdx.x;
#define LDS_BARRIER() do { asm volatile("s_waitcnt lgkmcnt(0)" ::: "memory"); __builtin_amdgcn_s_barrier(); asm volatile("" ::: "memory"); } while (0)
#define ARGP(i) ((const void*)kp_[i])
#define PHASE_IDS() int wave = wave0; asm volatile("" : "+s"(wave)); KARG kp_ = (KARG)__builtin_amdgcn_kernarg_segment_ptr(); asm volatile("" : "+s"(kp_)); unsigned char* ws = ws0; asm volatile("" : "+s"(ws)); unsigned* const ctl = (unsigned*)(ws + WS_CTL); (void)ctl; const int tid = wave * 64 + lane_id_opaque(); const int lane = tid & 63; (void)lane
    unsigned char* const ws0 = args.ws;
    unsigned* const ctl0 = (unsigned*)(ws0 + WS_CTL);
#define hf ((float*)(ws + WS_HF))
#define y2 ((float*)(ws + WS_Y2))
#define hb ((bf16*)(ws + WS_HB))
#define proj ((bf16*)(ws + WS_PROJ))
#define yg ((bf16*)(ws + WS_YG))
#define cat ((bf16*)(ws + WS_CAT))
#define top_e ((int*)(ws + WS_TOPE))
#define top_g ((float*)(ws + WS_TOPG))
#define dest ((int*)(ws + WS_DEST))
#define xr ((bf16*)(ws + WS_XR))
#define act ((bf16*)(ws + WS_ACT))
#define yr ((bf16*)(ws + WS_YR))
#define memK ((bf16*)(ws + WS_MEMK))
#define memV ((bf16*)(ws + WS_MEMV))
#define memVT ((bf16*)(ws + WS_MEMVT))
#define rope ((float*)(ws + WS_ROPE))
#define win_t ((bf16*)(ws + WS_WIN))
#define wglu_t ((bf16*)(ws + WS_WGLU))
#define wout_t ((bf16*)(ws + WS_WOUT))
#define wmem_t ((bf16*)(ws + WS_WMEM))
#define memb ((bf16*)(ws + WS_MEMB))
#define wgu_t ((bf16*)(ws + WS_WGU))
#define wdn_t ((bf16*)(ws + WS_WDN))
#define rwt ((bf16*)(ws + WS_RWT))
#define row_tok ((int*)(ws + WS_RTOK))
#define wgu8 (ws + WS_WGU)
#define wdn8 (ws + WS_WDN)
#define act8 (ws + WS_ACT)
#define hb8 (ws + WS_XR)
    constexpr float GU_WS = 32.0f, DN_WS = 64.0f;
    const int vcu = (G % 8 == 0) ? (bid % 8) * (G / 8) + bid / 8 : bid;

    if (tid0 < 64) MISC[tid0] = 0u;
    __syncthreads();
    const int lo = args.ph_lo, hi = args.ph_hi;
    XcdBarrier bar; bar.bar = ctl0 + CW_BAR; bar.x = 0; bar.st = MISC;
    if (hi - lo > 1) bar = xcd_barrier_post(ctl0 + CW_BAR, MISC, wave0);
#define IN(k) (lo <= (k) && (k) < hi)
#define SEAM(k) do { if (IN(k) && IN((k) + 1)) xcd_barrier(bar, wave0); } while (0)

    if (IN(PH_PRO)) {
            PHASE_IDS();
            REPS(0) { if (rep_) __syncthreads();
        {
            LAS float* scr = ldsf + wave * (64 * 65);
            const int gw = vcu * NWAVES + wave, NGW = G * NWAVES;
            constexpr int PRO_LAYERS = BG_CONV ? 1 : DEPTH;
            constexpr int N_GU = FAST_MOE ? PRO_LAYERS * NEXP * 512 : 0, N_DN = FAST_MOE ? PRO_LAYERS * NEXP * 256 : 0;
            constexpr int N_IN0 = FAST_DENSE ? 256 : 0, N_IN1 = FAST_DENSE ? 704 : 0, N_IN2 = FAST_DENSE ? 640 : 0, N_IN3 = N_IN0, N_GLU = FAST_DENSE ? 144 : 0, N_OUT = FAST_DENSE ? 256 : 0, N_MEM = FAST_DENSE ? 64 : 0;
            constexpr int NITEMS = N_GU + N_DN + N_IN0 + N_IN1 + N_IN2 + N_IN3 + 2 * N_GLU + 4 * N_OUT + 2 * N_MEM;
            for (int it = gw; it < NITEMS; it += NGW) {
                int r = it;
                if (r < N_GU) { const int le = r >> 9;
#if MOE_FP8
                    tr_item8((const float*)ARGP(42) + (size_t)le * D * 2 * DEXP, 2 * DEXP, D, wgu8 + (size_t)le * 2 * DEXP * D, 32, r & 511, scr, lane, GU_WS, [](int d) { const int tile = d >> 8, q = d & 255; return q < 128 ? tile * 128 + q : DEXP + tile * 128 + (q - 128); });
#else
                    tr_item((const float*)ARGP(42) + (size_t)le * D * 2 * DEXP, 2 * DEXP, D, wgu_t + (size_t)le * 2 * DEXP * D, 32, r & 511, scr, lane, [](int d) { const int tile = d >> 8, q = d & 255; return q < 128 ? tile * 128 + q : DEXP + tile * 128 + (q - 128); });
#endif
                    continue; } r -= N_GU;
                if (r < N_DN) { const int le = r >> 8;
#if MOE_FP8
                    tr_item8((const float*)ARGP(44) + (size_t)le * DEXP * D, D, DEXP, wdn8 + (size_t)le * D * DEXP, 16, r & 255, scr, lane, DN_WS, [](int d) { return d; });
#else
                    tr_item((const float*)ARGP(44) + (size_t)le * DEXP * D, D, DEXP, wdn_t + (size_t)le * D * DEXP, 16, r & 255, scr, lane, [](int d) { return d; });
#endif
                    continue; } r -= N_DN;
                if (r < N_IN0) { tr_item((const float*)ARGP(5), 1024, D, win_t, 16, r, scr, lane, [](int d) { return d; }); continue; } r -= N_IN0;
                if (r < N_IN1) { tr_item((const float*)ARGP(16), 2568, D, win_t + (size_t)1 * 3 * MiB, 44, r, scr, lane, [](int d) { return d < 2568 ? d : -1; }); continue; } r -= N_IN1;
                if (r < N_IN2) { tr_item((const float*)ARGP(22), 2560, D, win_t + (size_t)2 * 3 * MiB, 40, r, scr, lane, [](int d) { return d; }); continue; } r -= N_IN2;
                if (r < N_IN3) { tr_item((const float*)ARGP(24), 1024, D, win_t + (size_t)3 * 3 * MiB, 16, r, scr, lane, [](int d) { return d; }); continue; } r -= N_IN3;
                if (r < N_GLU) { tr_item((const float*)ARGP(14), MIXW, MIXW, wglu_t, 12, r, scr, lane, [](int d) { return d; }); continue; } r -= N_GLU;
                if (r < N_GLU) { tr_item((const float*)ARGP(33), MIXW, MIXW, wglu_t + (size_t)1 * MiB, 12, r, scr, lane, [](int d) { return d; }); continue; } r -= N_GLU;
                if (r < 4 * N_OUT) { const int l = r >> 8; tr_item((const float*)ARGP(35) + (size_t)l * D * D, D, D, wout_t + (size_t)l * D * D, 16, r & 255, scr, lane, [](int d) { return d; }); continue; } r -= 4 * N_OUT;
                if (r < N_MEM) { tr_item((const float*)ARGP(3), 256, D, wmem_t, 4, r, scr, lane, [](int d) { return d; }); continue; } r -= N_MEM;
                tr_item((const float*)ARGP(4), 256, D, wmem_t + (size_t)256 * D, 4, r, scr, lane, [](int d) { return d; });
            }
            const float* mem = (const float*)ARGP(1);
            for (size_t i = ((size_t)bid * NTHR + tid) * 4; i < (size_t)NB * NMEM * D; i += (size_t)G * NTHR * 4) {
                const float4 v = *(const float4*)(mem + i); uint2 o; o.x = pg8::cvt_pk_bf16(v.x, v.y); o.y = pg8::cvt_pk_bf16(v.z, v.w); *(uint2*)(memb + i) = o; }
        }
        {
            const float* rwf = (const float*)ARGP(40);
            for (int i = bid * NTHR + tid; i < DEPTH * NEXP * D; i += G * NTHR) { const int l = i / (NEXP * D), rem = i % (NEXP * D), e = rem / D, k = rem % D;
                const float v = rwf[((size_t)l * D + k) * NEXP + e]; const bf16 hi_ = f2bf(v); const bf16 lo_ = f2bf(v - bf2f(hi_));
                rwt[((size_t)(l * 2 + 0) * NEXP + e) * D + k] = hi_; rwt[((size_t)(l * 2 + 1) * NEXP + e) * D + k] = lo_; }
        }
        const float* x = (const float*)ARGP(0);
        for (size_t i = ((size_t)bid * NTHR + tid) * 4; i < (size_t)T * D; i += (size_t)G * NTHR * 4) {
            const float4 v = *(const float4*)(x + i);
#if !RES_BF16
            *(float4*)(hf + i) = v;
#endif
            uint2 o; o.x = pk2(v.x, v.y); o.y = pk2(v.z, v.w); *(uint2*)(hb + i) = o;
        }
        const int* pos = (const int*)ARGP(2);
        for (int idx = bid * NTHR + tid; idx < T * 48; idx += G * NTHR) {
            const int t = idx / 48, i = idx % 48;
            const double inv = exp(-((double)(2 * i) / 96.0) * 9.210340371976184);
            double r = (double)pos[t] * inv * 0.15915494309189535; r -= rint(r);
            const float rf = (float)r;
            typedef _Float16 h2_t __attribute__((ext_vector_type(2))); h2_t cs_; cs_.x = (_Float16)__builtin_amdgcn_cosf(rf); cs_.y = (_Float16)__builtin_amdgcn_sinf(rf);
            ((unsigned*)rope)[idx] = __builtin_bit_cast(unsigned, cs_);
        }
    } }
    SEAM(PH_PRO);

    if (IN(PH_MEM)) {
            PHASE_IDS();
            REPS(1) { if (rep_) __syncthreads();
#if FAST_DENSE
        { pg8::Gemm g{memb, wmem_t, D, nullptr}; pg8::StaticOrder S; S.init(NB * NMEM, 512, G, bid); pg8::EpiMem E{memK, memV, memVT}; pg8::gemm_phase(lds, g, S, E, wave); }
#else
        const float* mem = (const float*)ARGP(1); const float* wk = (const float*)ARGP(3); const float* wv = (const float*)ARGP(4);
        oracle_gemm(ldsf, NB * NMEM, 512, D,
            [&](int) { return 0; },
            [&](int m, int k) { return mem[(size_t)m * D + k]; },
            [&](int k, int n, int) { return n < 256 ? wk[(size_t)k * 256 + n] : wv[(size_t)k * 256 + n - 256]; },
            [&](int m0, int n0, float (&acc)[4][8], int) {
#pragma unroll
                for (int i = 0; i < 4; ++i)
#pragma unroll
                    for (int j = 0; j < 8; ++j) { const int m = m0 + i, n = n0 + j; const int b = m >> 8, key = m & 255; const int nn = n & 255, head = nn >> 6, d = nn & 63; const bf16 v = f2bf(acc[i][j]);
                        if (n < 256) memK[((size_t)(b * 4 + head) * 256 + key) * 64 + d] = v;
                        else { memV[((size_t)(b * 4 + head) * 256 + key) * 64 + d] = v; memVT[((size_t)(b * 4 + head) * 64 + d) * 256 + key] = v; } }
            });
#endif
    } }

    for (int L = 0; L < DEPTH; ++L) {
        const int P = PH_L0 + PH_PER_LAYER * L;
        const int kind = L % 3;
        const int Nin = (kind == 0) ? 1024 : (kind == 1 ? 2568 : 2560);
        const int xq_off = (kind == 0) ? 768 : (kind == 1 ? 2312 : 2304);

        if (IN(P + LP_INPROJ)) {
            PHASE_IDS();
            REPS(2) { if (rep_) __syncthreads();
#if FAST_DENSE
            { const int Npad = (kind == 0) ? 1024 : (kind == 1 ? 2816 : 2560);
              pg8::Gemm g{hb, win_t + (size_t)L * 3 * MiB, D, nullptr}; pg8::StaticOrder S; S.init(T, Npad, G, bid); pg8::EpiBf16 E{proj, LDP, nullptr, 0, 1.0f}; pg8::gemm_phase(lds, g, S, E, wave); }
#else
            const float* w_in = (const float*)(L == 0 ? ARGP(5) : L == 1 ? ARGP(16) : L == 2 ? ARGP(22) : ARGP(24));
            oracle_gemm(ldsf, T, Nin, D,
                [&](int) { return 0; },
                [&](int m, int k) { return bf2f(hb[(size_t)m * D + k]); },
                [&](int k, int n, int) { return n < Nin ? w_in[(size_t)k * Nin + n] : 0.f; },
                [&](int m0, int n0, float (&acc)[4][8], int) {
#pragma unroll
                    for (int i = 0; i < 4; ++i)
#pragma unroll
                        for (int j = 0; j < 8; ++j) if (n0 + j < Nin) proj[(size_t)(m0 + i) * LDP + n0 + j] = f2bf(acc[i][j]);
                });
#endif
        } }
        SEAM(P + LP_INPROJ);

        if (IN(P + LP_MIXA)) {
            PHASE_IDS();
            REPS(kind == 0 ? 11 : 12) { if (rep_) __syncthreads();
            if (kind == 0) {
                const int o = (L == 0) ? 6 : 25;
                const float* a_re = (const float*)args.in[o + 0]; const float* a_im = (const float*)args.in[o + 1]; const float* log_dt = (const float*)args.in[o + 2];
                const float* b_re = (const float*)args.in[o + 3]; const float* b_im = (const float*)args.in[o + 4]; const float* c_re = (const float*)args.in[o + 5];
                const float* c_im = (const float*)args.in[o + 6]; const float* d_skip = (const float*)args.in[o + 7];
#if FAST_S5
                typedef pg8::bf16x8 bx8; typedef pg8::f32x4 fx4;
                LAS float* BU = (LAS float*)(lds + wave * 32768);
                LAS bf16* XS = (LAS bf16*)(lds + wave * 32768 + 16896);
                for (int unit = wave * G + vcu; wave < 4 && unit < NB * 48; unit += G * 4) {
                    const int b = unit / 48, g = unit % 48, p = lane, tok = lane & 15, sg = lane >> 4;
                    const float lre = fminf(a_re[g * 64 + p], -1e-4f), lim = a_im[g * 64 + p];
                    const float dt = __expf(log_dt[g]);
                    const float mag = __expf(dt * lre); float sn, cs; sincos_rad(dt * lim, sn, cs);
                    const float abr = mag * cs, abi = mag * sn;
                    const float den = lre * lre + lim * lim, nr = abr - 1.0f;
                    const float cr = (nr * lre + abi * lim) / den, ci = (abi * lre - nr * lim) / den;
                    bx8 Bf[8], Cf[4];
#pragma unroll
                    for (int tI = 0; tI < 4; ++tI) {
                        const int sp = 16 * tI + tok; const float crs = sh_idx(cr, sp, lane), cis = sh_idx(ci, sp, lane);
                        unsigned wr_[4] = {0u, 0u, 0u, 0u}, wi_[4] = {0u, 0u, 0u, 0u};
                        if (sg < 2) { const float4* pr_ = (const float4*)(b_re + (size_t)(g * 64 + sp) * 16 + 8 * sg); const float4* pi_ = (const float4*)(b_im + (size_t)(g * 64 + sp) * 16 + 8 * sg);
                            const float4 r0 = pr_[0], r1 = pr_[1], i0 = pi_[0], i1 = pi_[1];
                            const float br[8] = {r0.x, r0.y, r0.z, r0.w, r1.x, r1.y, r1.z, r1.w}, bi[8] = {i0.x, i0.y, i0.z, i0.w, i1.x, i1.y, i1.z, i1.w};
#pragma unroll
                            for (int q = 0; q < 4; ++q) { wr_[q] = pk2(crs * br[2 * q] - cis * bi[2 * q], crs * br[2 * q + 1] - cis * bi[2 * q + 1]); wi_[q] = pk2(crs * bi[2 * q] + cis * br[2 * q], crs * bi[2 * q + 1] + cis * br[2 * q + 1]); } }
                        uint4 a4; a4.x = wr_[0]; a4.y = wr_[1]; a4.z = wr_[2]; a4.w = wr_[3]; Bf[tI] = __builtin_bit_cast(bx8, a4);
                        uint4 b4; b4.x = wi_[0]; b4.y = wi_[1]; b4.z = wi_[2]; b4.w = wi_[3]; Bf[4 + tI] = __builtin_bit_cast(bx8, b4);
                    }
#pragma unroll
                    for (int j = 0; j < 4; ++j) {
                        const float4 c4 = *(const float4*)(c_re + (size_t)(g * 16 + tok) * 64 + 16 * j + 4 * sg), d4 = *(const float4*)(c_im + (size_t)(g * 16 + tok) * 64 + 16 * j + 4 * sg);
                        uint4 a4; a4.x = pk2(c4.x, -d4.x); a4.y = pk2(c4.y, -d4.y); a4.z = pk2(c4.z, -d4.z); a4.w = pk2(c4.w, -d4.w); Cf[j] = __builtin_bit_cast(bx8, a4);
                    }
                    const float4 dsk4 = *(const float4*)(d_skip + g * 16 + 4 * sg);
                    float sxr = 0.f, sxi = 0.f;
                    const bf16* ubase = proj + (size_t)b * SEQ * LDP + g * 16;
                    uint4 unx[4]; uint2 uex[4];
#pragma unroll
                    for (int q = 0; q < 4; ++q) { unx[q] = make_uint4(0u, 0u, 0u, 0u); if (sg < 2) unx[q] = *(const uint4*)(ubase + (size_t)(16 * q + tok) * LDP + 8 * sg); uex[q] = *(const uint2*)(ubase + (size_t)(16 * q + tok) * LDP + 4 * sg); }
                    fx4 dnx[8];
                    { const bx8 uf0 = __builtin_bit_cast(bx8, unx[0]);
#pragma unroll
                      for (int tI = 0; tI < 8; ++tI) { const fx4 d = __builtin_amdgcn_mfma_f32_16x16x32_bf16(Bf[tI], uf0, (fx4){0.f, 0.f, 0.f, 0.f}, 0, 0, 0); *(LAS fx4*)(BU + tok * 132 + 16 * tI + 4 * sg) = d; } }
                    uint2 ue_prev = make_uint2(0u, 0u);
                    for (int t64 = 0; t64 < SEQ; t64 += 64) {
                        uint4 ucu[4]; uint2 uec[4];
#pragma unroll
                        for (int q = 0; q < 4; ++q) { ucu[q] = unx[q]; uec[q] = uex[q]; }
                        if (t64 + 64 < SEQ) {
#pragma unroll
                            for (int q = 0; q < 4; ++q) { if (sg < 2) unx[q] = *(const uint4*)(ubase + (size_t)(t64 + 64 + 16 * q + tok) * LDP + 8 * sg); uex[q] = *(const uint2*)(ubase + (size_t)(t64 + 64 + 16 * q + tok) * LDP + 4 * sg); } }
#pragma unroll
                        for (int q = 0; q < 4; ++q) {
                            const int t0 = t64 + 16 * q, cb = q & 1, nb = cb ^ 1;
                            LAS float* BUc = BU + cb * (16 * 132); LAS float* BUn = BU + nb * (16 * 132);
                            LAS bf16* XSc = XS + cb * (16 * 136); LAS bf16* XSp = XS + nb * (16 * 136);
                            float bre[16], bim[16];
#pragma unroll
                            for (int t = 0; t < 16; ++t) { bre[t] = BUc[t * 132 + p]; bim[t] = BUc[t * 132 + 64 + p]; }
                            const bool has_next = (t0 + 16 < SEQ);
                            { const bx8 ufn = __builtin_bit_cast(bx8, (q < 3) ? ucu[(q + 1) & 3] : unx[0]);
#pragma unroll
                              for (int tI = 0; tI < 8; ++tI) dnx[tI] = __builtin_amdgcn_mfma_f32_16x16x32_bf16(Bf[tI], ufn, (fx4){0.f, 0.f, 0.f, 0.f}, 0, 0, 0); }
                            fx4 y = (fx4){0.f, 0.f, 0.f, 0.f};
                            if (t0 > 0) {
#pragma unroll
                                for (int j = 0; j < 4; ++j) { const bx8 xf = *(const LAS bx8*)(XSp + tok * 136 + 32 * j + 8 * sg); y = __builtin_amdgcn_mfma_f32_16x16x32_bf16(Cf[j], xf, y, 0, 0, 0); } }
#pragma unroll
                            for (int t = 0; t < 16; ++t) { const float nxr = abr * sxr - abi * sxi + bre[t], nxi = abr * sxi + abi * sxr + bim[t]; sxr = nxr; sxi = nxi;
                                *(LAS unsigned*)(XSc + t * 136 + 2 * p) = pg8::cvt_pk_bf16(sxr, sxi); }
                            if (has_next) {
#pragma unroll
                                for (int tI = 0; tI < 8; ++tI) *(LAS fx4*)(BUn + tok * 132 + 16 * tI + 4 * sg) = dnx[tI]; }
                            if (t0 > 0) {
                                const float u0 = __uint_as_float(ue_prev.x << 16), u1 = __uint_as_float(ue_prev.x & 0xffff0000u), u2 = __uint_as_float(ue_prev.y << 16), u3 = __uint_as_float(ue_prev.y & 0xffff0000u);
                                uint2 o; o.x = pg8::cvt_pk_bf16(gelu_tanh(y[0] + dsk4.x * u0), gelu_tanh(y[1] + dsk4.y * u1)); o.y = pg8::cvt_pk_bf16(gelu_tanh(y[2] + dsk4.z * u2), gelu_tanh(y[3] + dsk4.w * u3));
                                *(uint2*)(yg + (size_t)(b * SEQ + t0 - 16 + tok) * MIXW + g * 16 + 4 * sg) = o; }
                            ue_prev = uec[q];
                        }
                    }
                    {
                        LAS bf16* XSp = XS + 1 * (16 * 136);
                        fx4 y = (fx4){0.f, 0.f, 0.f, 0.f};
#pragma unroll
                        for (int j = 0; j < 4; ++j) { const bx8 xf = *(const LAS bx8*)(XSp + tok * 136 + 32 * j + 8 * sg); y = __builtin_amdgcn_mfma_f32_16x16x32_bf16(Cf[j], xf, y, 0, 0, 0); }
                        const float u0 = __uint_as_float(ue_prev.x << 16), u1 = __uint_as_float(ue_prev.x & 0xffff0000u), u2 = __uint_as_float(ue_prev.y << 16), u3 = __uint_as_float(ue_prev.y & 0xffff0000u);
                        uint2 o; o.x = pg8::cvt_pk_bf16(gelu_tanh(y[0] + dsk4.x * u0), gelu_tanh(y[1] + dsk4.y * u1)); o.y = pg8::cvt_pk_bf16(gelu_tanh(y[2] + dsk4.z * u2), gelu_tanh(y[3] + dsk4.w * u3));
                        *(uint2*)(yg + (size_t)(b * SEQ + SEQ - 16 + tok) * MIXW + g * 16 + 4 * sg) = o;
                    }
                }
#else
                for (int unit = bid * NWAVES + wave; unit < NB * 48; unit += G * NWAVES) {
                    const int b = unit / 48, g = unit % 48, p = lane;
                    const float lre = fminf(a_re[g * 64 + p], -1e-4f), lim = a_im[g * 64 + p];
                    const float dt = __expf(log_dt[g]);
                    const float mag = __expf(dt * lre); float sn, cs; sincos_rad(dt * lim, sn, cs);
                    const float abr = mag * cs, abi = mag * sn;
                    const float den = lre * lre + lim * lim, nr = abr - 1.0f;
                    const float cr = (nr * lre + abi * lim) / den, ci = (abi * lre - nr * lim) / den;
                    float Br[16], Bi[16], Cr[16], Ci[16];
#pragma unroll
                    for (int h = 0; h < 16; ++h) { const float br = b_re[(size_t)(g * 64 + p) * 16 + h], bi = b_im[(size_t)(g * 64 + p) * 16 + h];
                        Br[h] = cr * br - ci * bi; Bi[h] = cr * bi + ci * br; Cr[h] = c_re[(size_t)(g * 16 + h) * 64 + p]; Ci[h] = c_im[(size_t)(g * 16 + h) * 64 + p]; }
                    const float dsk = d_skip[g * 16 + (lane & 15)];
                    float sxr = 0.f, sxi = 0.f;
                    for (int t = 0; t < SEQ; ++t) {
                        const bf16* up = proj + (size_t)(b * SEQ + t) * LDP + g * 16;
                        float u[16]; unpack8(*(const uint4*)up, u); unpack8(*(const uint4*)(up + 8), u + 8);
                        float bur = 0.f, bui = 0.f;
#pragma unroll
                        for (int h = 0; h < 16; ++h) { bur += Br[h] * u[h]; bui += Bi[h] * u[h]; }
                        const float nxr = abr * sxr - abi * sxi + bur, nxi = abr * sxi + abi * sxr + bui; sxr = nxr; sxi = nxi;
                        float myy = 0.f;
#pragma unroll
                        for (int h = 0; h < 16; ++h) { float v = Cr[h] * sxr - Ci[h] * sxi; v = wave_sum(v, lane); myy = (lane == h) ? v : myy; }
                        if (lane < 16) { const float uu = bf2f(up[lane]); const float y = gelu_tanh(myy + dsk * uu); yg[(size_t)(b * SEQ + t) * MIXW + g * 16 + lane] = f2bf(y); }
                    }
                }
#endif
            } else {
#if FAST_LINATT
                {
                    typedef pg8::bf16x8 bx8; typedef pg8::f32x4 fx4; typedef pg8::u32x4 ux4; typedef pg8::u32x2 ux2;
                    LAS bf16* Qs = (LAS bf16*)lds;
                    LAS bf16* Ks = (LAS bf16*)(lds + 13312);
                    LAS bf16* KTe = (LAS bf16*)(lds + 26624);
                    LAS bf16* VT = (LAS bf16*)(lds + 40448);
                    LAS bf16* Ps = (LAS bf16*)(lds + 68096);
                    LAS bf16* CT = (LAS bf16*)(lds + 77312);
                    LAS float* fa = (LAS float*)(lds + 117248);
                    LAS float* aArr = fa, *MArr = fa + 64, *interArr = fa + 128, *clampArr = fa + 192, *eArr = fa + 256, *denArr = fa + 320, *nArr = fa + 384  , *stat = fa + 480  , *scal = fa + 736;
                    const float* conv_q = (const float*)ARGP(17); const float* conv_k = (const float*)ARGP(18);
                    const float* b_i = (const float*)ARGP(19); const float* b_f = (const float*)ARGP(20);
                    const float* norm_g = (const float*)(kind == 1 ? ARGP(21) : ARGP(23));
                    const int tok = lane & 15, sg = lane >> 4;
                    for (int unit = bid; unit < NB * 4; unit += G) {
                        const int b = unit >> 2, h = unit & 3;
                        const float lgam = __logf(1.0f - exp2f(-5.0f - (float)h));
                        fx4 Cst[3][3];
#pragma unroll
                        for (int x = 0; x < 3; ++x)
#pragma unroll
                            for (int y = 0; y < 3; ++y) Cst[x][y] = (fx4){0.f, 0.f, 0.f, 0.f};
                        float nreg = 0.f, m_prev = 0.f;
                        __syncthreads();
                        for (int i = tid; i < 192 * 104 / 2; i += NTHR) ((LAS unsigned*)CT)[i] = 0u;
                        if (tid < 96) nArr[tid] = 0.f;
                        const int ctU = 3 * (wave & 3), itU = 3 * (wave >> 2);
                        const int jt = wave & 3, half = wave >> 2;
                        typedef _Float16 h2_t __attribute__((ext_vector_type(2)));
                        ux4 rv[3], rg[8]; float rig = 0.f, rfg = 0.f;
#pragma unroll
                        for (int q = 0; q < 8; ++q) rg[q] = (ux4){0u, 0u, 0u, 0u};
#define LINATT_LOAD_RAW(cc) do { const size_t r0_ = (size_t)b * SEQ + (size_t)(cc) * 64; \
                            _Pragma("unroll") for (int kq = 0; kq < 3; ++kq) { const int idx = tidv + NTHR * kq, cg = idx >> 6, s = idx & 63; rv[kq] = *(const ux4*)(proj + (r0_ + s) * LDP + 768 + h * 192 + 8 * cg); } \
                            if (kind == 1) { _Pragma("unroll") for (int kq = 0; kq < 3; ++kq) { const int idx = tidv + NTHR * kq, which = idx / 768, rem = idx % 768, cg = rem >> 6, s = rem & 63; \
                                    rg[kq] = *(const ux4*)(proj + (r0_ + s) * LDP + which * 384 + h * 96 + 8 * cg); } \
                                if (wave == 0) { const bf16* pr = proj + (r0_ + lanev) * LDP; rig = bf2f(pr[2304 + h]); rfg = bf2f(pr[2308 + h]); } } \
                            else { _Pragma("unroll") for (int kq = 0; kq < 2; ++kq) { const int idx = tidv + NTHR * kq; if (idx < 768) { const int which = idx / 384, rem = idx % 384, cg = rem >> 6, s = rem & 63; \
                                    const bf16* xp = proj + (r0_ + s) * LDP + which * 384 + h * 96 + 8 * cg; rg[kq] = *(const ux4*)xp; rg[2 + kq] = *(const ux4*)(xp + 48); \
                                    const ux4* rp = (const ux4*)((const unsigned*)rope + (r0_ + s) * 48 + 8 * cg); rg[4 + 2 * kq] = rp[0]; rg[5 + 2 * kq] = rp[1]; } } } } while (0)
                        { int tidv = tid; asm volatile("" : "+v"(tidv)); const int lanev = tidv & 63; LINATT_LOAD_RAW(0); }
                        for (int c = 0; c < SEQ / 64; ++c) {
                            const size_t row0 = (size_t)b * SEQ + c * 64;
                            int tidv = tid; asm volatile("" : "+v"(tidv));
                            const int lanev = tidv & 63, tokv = lanev & 15, sgv = lanev >> 4;
                            if (wave == 0) {
                                float lf, ig;
                                if (kind == 1) { ig = rig + b_i[h]; const float fg = rfg + b_f[h]; lf = fminf(fg, 0.f) - __logf(1.0f + __expf(-fabsf(fg))); }
                                else { ig = 0.f; lf = lgam; }
                                float bc = lf;
#pragma unroll
                                for (int o = 1; o < 64; o <<= 1) { const float t = sh_up(bc, o, lanev); if (lanev >= o) bc += t; }
                                const float a = ig - bc; float M;
                                if (kind == 1) { float A = a;
#pragma unroll
                                    for (int o = 1; o < 64; o <<= 1) { const float t = sh_up(A, o, lanev); if (lanev >= o) A = fmaxf(A, t); }
                                    M = fmaxf(m_prev, A); }
                                else M = -bc;
                                const float M63 = sh_idx(M, 63, lane), btot = sh_idx(bc, 63, lane);
                                aArr[lanev] = a; MArr[lanev] = M; interArr[lanev] = __expf(m_prev - M); clampArr[lanev] = __expf(-(bc + M)); eArr[lanev] = __expf(a - M63);
                                if (lanev == 0) scal[0] = __expf(m_prev - M63);
                                if (kind == 1) m_prev = btot + M63;
                            }
                            LDS_BARRIER();
#pragma unroll
                            for (int kq = 0; kq < 3; ++kq) {
                                const int idx = tidv + NTHR * kq, cg = idx >> 6, s = idx & 63; const ux4 v = rv[kq];
                                LAS bf16* d = VT + (8 * cg) * 72 + s;
                                d[0] = (bf16)(v.x & 0xffffu); d[72] = (bf16)(v.x >> 16); d[144] = (bf16)(v.y & 0xffffu); d[216] = (bf16)(v.y >> 16);
                                d[288] = (bf16)(v.z & 0xffffu); d[360] = (bf16)(v.z >> 16); d[432] = (bf16)(v.w & 0xffffu); d[504] = (bf16)(v.w >> 16);
                            }
                            if (kind == 1) {
#pragma unroll
                                for (int kq = 0; kq < 3; ++kq) {
                                    const int idx = tidv + NTHR * kq, which = idx / 768, rem = idx % 768, cg = rem >> 6, s = rem & 63;
                                    const int ch = h * 96 + 8 * cg;
                                    const float* cw = (which ? conv_k : conv_q) + ch;
                                    float r[8];
                                    { float x[8]; uint4 xu; xu.x = rg[kq].x; xu.y = rg[kq].y; xu.z = rg[kq].z; xu.w = rg[kq].w; unpack8(xu, x);
                                      const float4 w0 = *(const float4*)(cw + 3 * 384), w1 = *(const float4*)(cw + 3 * 384 + 4);
                                      r[0] = w0.x * x[0]; r[1] = w0.y * x[1]; r[2] = w0.z * x[2]; r[3] = w0.w * x[3]; r[4] = w1.x * x[4]; r[5] = w1.y * x[5]; r[6] = w1.z * x[6]; r[7] = w1.w * x[7]; }
#pragma unroll
                                    for (int dl = 1; dl <= 3; ++dl) {
                                        const int sl = (lanev - dl) & 63; uint4 xu;
                                        { const unsigned c0 = sh_idx(rg[kq].x, sl, lanev), p0 = sh_idx(rg[3 + kq].x, sl, lanev); xu.x = (lanev >= dl) ? c0 : p0; }
                                        { const unsigned c0 = sh_idx(rg[kq].y, sl, lanev), p0 = sh_idx(rg[3 + kq].y, sl, lanev); xu.y = (lanev >= dl) ? c0 : p0; }
                                        { const unsigned c0 = sh_idx(rg[kq].z, sl, lanev), p0 = sh_idx(rg[3 + kq].z, sl, lanev); xu.z = (lanev >= dl) ? c0 : p0; }
                                        { const unsigned c0 = sh_idx(rg[kq].w, sl, lanev), p0 = sh_idx(rg[3 + kq].w, sl, lanev); xu.w = (lanev >= dl) ? c0 : p0; }
                                        float x[8]; unpack8(xu, x);
                                        const float4 w0 = *(const float4*)(cw + (3 - dl) * 384), w1 = *(const float4*)(cw + (3 - dl) * 384 + 4);
                                        r[0] += w0.x * x[0]; r[1] += w0.y * x[1]; r[2] += w0.z * x[2]; r[3] += w0.w * x[3]; r[4] += w1.x * x[4]; r[5] += w1.y * x[5]; r[6] += w1.z * x[6]; r[7] += w1.w * x[7];
                                    }
                                    rg[3 + kq] = rg[kq];
                                    const float sc = which ? 1.0f : 0.10206207261596575f;
#pragma unroll
                                    for (int i = 0; i < 8; ++i) r[i] = r[i] * sigmoidf(r[i]) * sc;
                                    ux4 pk; pk.x = pg8::cvt_pk_bf16(r[0], r[1]); pk.y = pg8::cvt_pk_bf16(r[2], r[3]); pk.z = pg8::cvt_pk_bf16(r[4], r[5]); pk.w = pg8::cvt_pk_bf16(r[6], r[7]);
                                    if (which == 0) *(LAS ux4*)(Qs + s * 104 + 8 * cg) = pk;
                                    else { *(LAS ux4*)(Ks + s * 104 + 8 * cg) = pk; const float es = eArr[s]; LAS bf16* d = KTe + (8 * cg) * 72 + s;
#pragma unroll
                                        for (int i = 0; i < 8; ++i) d[72 * i] = f2bf(r[i] * es); }
                                }
                            } else {
#pragma unroll
                                for (int kq = 0; kq < 2; ++kq) {
                                    const int idx = tidv + NTHR * kq;
                                    if (idx < 768) {
                                        const int which = idx / 384, rem = idx % 384, cg = rem >> 6, s = rem & 63;
                                        float x1[8], x2[8]; { uint4 xu; xu.x = rg[kq].x; xu.y = rg[kq].y; xu.z = rg[kq].z; xu.w = rg[kq].w; unpack8(xu, x1); xu.x = rg[2 + kq].x; xu.y = rg[2 + kq].y; xu.z = rg[2 + kq].z; xu.w = rg[2 + kq].w; unpack8(xu, x2); }
                                        const unsigned rpw[8] = {rg[4 + 2 * kq].x, rg[4 + 2 * kq].y, rg[4 + 2 * kq].z, rg[4 + 2 * kq].w, rg[5 + 2 * kq].x, rg[5 + 2 * kq].y, rg[5 + 2 * kq].z, rg[5 + 2 * kq].w};
                                        float o1[8], o2[8]; const float sc = which ? 0.10206207261596575f : 1.0f;
#pragma unroll
                                        for (int q8 = 0; q8 < 8; ++q8) { const h2_t cs_ = __builtin_bit_cast(h2_t, rpw[q8]); const float c0 = (float)cs_.x, s0 = (float)cs_.y;
                                            o1[q8] = (x1[q8] * c0 - x2[q8] * s0) * sc; o2[q8] = (x2[q8] * c0 + x1[q8] * s0) * sc; }
                                        ux4 p1; p1.x = pg8::cvt_pk_bf16(o1[0], o1[1]); p1.y = pg8::cvt_pk_bf16(o1[2], o1[3]); p1.z = pg8::cvt_pk_bf16(o1[4], o1[5]); p1.w = pg8::cvt_pk_bf16(o1[6], o1[7]);
                                        ux4 p2; p2.x = pg8::cvt_pk_bf16(o2[0], o2[1]); p2.y = pg8::cvt_pk_bf16(o2[2], o2[3]); p2.z = pg8::cvt_pk_bf16(o2[4], o2[5]); p2.w = pg8::cvt_pk_bf16(o2[6], o2[7]);
                                        LAS bf16* dst = which ? Ks : Qs;
                                        *(LAS ux4*)(dst + s * 104 + 8 * cg) = p1; *(LAS ux4*)(dst + s * 104 + 48 + 8 * cg) = p2;
                                        if (which) { const float es = eArr[s]; LAS bf16* d = KTe + (8 * cg) * 72 + s;
#pragma unroll
                                            for (int i = 0; i < 8; ++i) { d[72 * i] = f2bf(o1[i] * es); d[72 * (48 + i)] = f2bf(o2[i] * es); } }
                                    }
                                }
                            }
                            if (c + 1 < SEQ / 64) LINATT_LOAD_RAW(c + 1);
                            LDS_BARRIER(); __builtin_amdgcn_sched_barrier(0);
                            {
                                bx8 yq[3];
#pragma unroll
                                for (int kk = 0; kk < 3; ++kk) yq[kk] = *(const LAS bx8*)(Qs + (16 * jt + tokv) * 104 + 32 * kk + 8 * sgv);
                                const int j = 16 * jt + tokv; const float Mj = MArr[j];
#pragma unroll
                                for (int q2 = 0; q2 < 2; ++q2) {
                                    const int st = 2 * half + q2; fx4 d = (fx4){0.f, 0.f, 0.f, 0.f};
                                    if (st <= jt) {
#pragma unroll
                                        for (int kk = 0; kk < 3; ++kk) { const bx8 xk = *(const LAS bx8*)(Ks + (16 * st + tokv) * 104 + 32 * kk + 8 * sgv); d = __builtin_amdgcn_mfma_f32_16x16x32_bf16(xk, yq[kk], d, 0, 0, 0); }
#pragma unroll
                                        for (int r = 0; r < 4; ++r) { const int s = 16 * st + 4 * sgv + r; d[r] = (s <= j) ? d[r] * __expf(aArr[s] - Mj) : 0.f; }
                                    }
                                    ux2 pw; pw.x = pg8::cvt_pk_bf16(d[0], d[1]); pw.y = pg8::cvt_pk_bf16(d[2], d[3]);
                                    *(LAS ux2*)(Ps + j * 72 + 16 * st + 4 * sgv) = pw;
                                }
                            }
                            LDS_BARRIER();
                            __builtin_amdgcn_sched_barrier(0);
                            if (kind == 1) {
                                const int j = tidv >> 3, part = tidv & 7; float dq = 0.f, dp = 0.f;
#pragma unroll
                                for (int i = 0; i < 12; ++i) dq += bf2f(Qs[j * 104 + part * 12 + i]) * nArr[part * 12 + i];
#pragma unroll
                                for (int s = 0; s < 8; ++s) dp += bf2f(Ps[j * 72 + part * 8 + s]);
                                float dn = interArr[j] * dq + dp; dn += sh_xor(dn, 1, lane); dn += sh_xor(dn, 2, lane); dn += sh_xor(dn, 4, lane);
                                if (part == 0) denArr[j] = dn;
                            }
                            __builtin_amdgcn_sched_barrier(0);
                            fx4 acc[6];
                            const size_t orow = row0 + 16 * jt + tokv;
                            ux2 ogate[6];
#pragma unroll
                            for (int x = 0; x < 6; ++x) ogate[x] = *(const ux2*)(proj + orow * LDP + 1536 + h * 192 + 16 * (6 * half + x) + 4 * sgv);
                            {
                                bx8 yq[3];
#pragma unroll
                                for (int kk = 0; kk < 3; ++kk) yq[kk] = *(const LAS bx8*)(Qs + (16 * jt + tokv) * 104 + 32 * kk + 8 * sgv);
#pragma unroll
                                for (int x = 0; x < 6; ++x) { acc[x] = (fx4){0.f, 0.f, 0.f, 0.f}; const int ct = 6 * half + x;
#pragma unroll
                                    for (int kk = 0; kk < 3; ++kk) { const bx8 xc = *(const LAS bx8*)(CT + (16 * ct + tokv) * 104 + 32 * kk + 8 * sgv); acc[x] = __builtin_amdgcn_mfma_f32_16x16x32_bf16(xc, yq[kk], acc[x], 0, 0, 0); } }
                                __builtin_amdgcn_sched_barrier(0);
                                const float in_j = interArr[16 * jt + tokv];
#pragma unroll
                                for (int x = 0; x < 6; ++x) acc[x] = acc[x] * in_j;
                                bx8 yp[2];
#pragma unroll
                                for (int kk = 0; kk < 2; ++kk) yp[kk] = *(const LAS bx8*)(Ps + (16 * jt + tokv) * 72 + 32 * kk + 8 * sgv);
#pragma unroll
                                for (int x = 0; x < 6; ++x) { const int ct = 6 * half + x;
#pragma unroll
                                    for (int kk = 0; kk < 2; ++kk) { const bx8 xv = *(const LAS bx8*)(VT + (16 * ct + tokv) * 72 + 32 * kk + 8 * sgv); acc[x] = __builtin_amdgcn_mfma_f32_16x16x32_bf16(xv, yp[kk], acc[x], 0, 0, 0); } }
                            }
                            __builtin_amdgcn_sched_barrier(0);
                            {
                                const float sa = scal[0];
                                bx8 yv[3][2];
#pragma unroll
                                for (int x = 0; x < 3; ++x)
#pragma unroll
                                    for (int kk = 0; kk < 2; ++kk) yv[x][kk] = *(const LAS bx8*)(VT + (16 * (ctU + x) + tokv) * 72 + 32 * kk + 8 * sgv);
#pragma unroll
                                for (int x = 0; x < 3; ++x) { bx8 xk[2];
#pragma unroll
                                    for (int kk = 0; kk < 2; ++kk) xk[kk] = *(const LAS bx8*)(KTe + (16 * (itU + x) + tokv) * 72 + 32 * kk + 8 * sgv);
#pragma unroll
                                    for (int y = 0; y < 3; ++y) { Cst[x][y] = Cst[x][y] * sa;
#pragma unroll
                                        for (int kk = 0; kk < 2; ++kk) Cst[x][y] = __builtin_amdgcn_mfma_f32_16x16x32_bf16(xk[kk], yv[y][kk], Cst[x][y], 0, 0, 0); } }
                                if (kind == 1 && tidv < 96) { float sn = 0.f;
#pragma unroll 8
                                    for (int s = 0; s < 64; ++s) sn += bf2f(KTe[tidv * 72 + s]);
                                    nreg = sa * nreg + sn; }
                            }
                            __builtin_amdgcn_sched_barrier(0);
                            LDS_BARRIER();
                            {
                                const int j = 16 * jt + tokv;
                                if (kind == 1) { const float dv = 1.0f / fmaxf(fabsf(denArr[j]), clampArr[j]);
#pragma unroll
                                    for (int x = 0; x < 6; ++x) acc[x] = acc[x] * dv; }
                                float s1 = 0.f, s2 = 0.f;
#pragma unroll
                                for (int x = 0; x < 6; ++x)
#pragma unroll
                                    for (int r = 0; r < 4; ++r) { s1 += acc[x][r]; s2 += acc[x][r] * acc[x][r]; }
                                s1 += sh_xor(s1, 16, lane); s1 += sh_xor(s1, 32, lane); s2 += sh_xor(s2, 16, lane); s2 += sh_xor(s2, 32, lane);
                                if (sgv == 0) { stat[(j * 2 + half) * 2 + 0] = s1; stat[(j * 2 + half) * 2 + 1] = s2; }
                            }
                            LDS_BARRIER();
                            {
                                const int j = 16 * jt + tokv;
                                const float mean = (stat[j * 4 + 0] + stat[j * 4 + 2]) * (1.0f / 192.0f);
                                const float var = (stat[j * 4 + 1] + stat[j * 4 + 3]) * (1.0f / 192.0f) - mean * mean;
                                const float rstd = 1.0f / sqrtf(fmaxf(var, 0.f) + LN_EPS);
#pragma unroll
                                for (int x = 0; x < 6; ++x) { const int colh = 16 * (6 * half + x) + 4 * sgv; const float4 g4 = *(const float4*)(norm_g + h * 192 + colh);
                                    const float o0 = __uint_as_float(ogate[x].x << 16), o1 = __uint_as_float(ogate[x].x & 0xffff0000u), o2 = __uint_as_float(ogate[x].y << 16), o3 = __uint_as_float(ogate[x].y & 0xffff0000u);
                                    float g0, g1, g2, g3;
                                    if (kind == 1) { g0 = sigmoidf(o0); g1 = sigmoidf(o1); g2 = sigmoidf(o2); g3 = sigmoidf(o3); } else { g0 = o0 * sigmoidf(o0); g1 = o1 * sigmoidf(o1); g2 = o2 * sigmoidf(o2); g3 = o3 * sigmoidf(o3); }
                                    ux2 ov; ov.x = pg8::cvt_pk_bf16((acc[x][0] - mean) * rstd * g4.x * g0, (acc[x][1] - mean) * rstd * g4.y * g1); ov.y = pg8::cvt_pk_bf16((acc[x][2] - mean) * rstd * g4.z * g2, (acc[x][3] - mean) * rstd * g4.w * g3);
                                    *(ux2*)(cat + orow * D + h * 192 + colh) = ov; }
#pragma unroll
                                for (int x = 0; x < 3; ++x)
#pragma unroll
                                    for (int y = 0; y < 3; ++y) { ux2 cw; cw.x = pg8::cvt_pk_bf16(Cst[x][y][0], Cst[x][y][1]); cw.y = pg8::cvt_pk_bf16(Cst[x][y][2], Cst[x][y][3]);
                                        *(LAS ux2*)(CT + (16 * (ctU + y) + tokv) * 104 + 16 * (itU + x) + 4 * sgv) = cw; }
                                if (kind == 1 && tidv < 96) nArr[tidv] = nreg;
                            }
                        }
                    }
                }
#else
                LAS float* sq = ldsf; LAS float* sk = ldsf + 96; LAS float* sg = ldsf + 192; LAS float* sred = ldsf + 256;
                const float* conv_q = (const float*)ARGP(17); const float* conv_k = (const float*)ARGP(18);
                const float* b_i = (const float*)ARGP(19); const float* b_f = (const float*)ARGP(20);
                const float* norm_g = (const float*)(kind == 1 ? ARGP(21) : ARGP(23));
                for (int unit = bid; unit < NB * 4; unit += G) {
                    const int b = unit >> 2, h = unit & 3;
                    const float gamma = 1.0f - exp2f(-5.0f - (float)h);
                    float C[96];
#pragma unroll
                    for (int i = 0; i < 96; ++i) C[i] = 0.f;
                    for (int t = 0; t < SEQ; ++t) {
                        const size_t row = (size_t)b * SEQ + t; const bf16* pr = proj + row * LDP;
                        if (tid < 192) {
                            const int c = tid % 96; const bool isk = tid >= 96; const int ch = h * 96 + c; const int col = (isk ? 384 : 0) + ch;
                            float s;
                            if (kind == 1) {
                                const float* cw = isk ? conv_k : conv_q; s = 0.f;
#pragma unroll
                                for (int w = 0; w < 4; ++w) { const int tt = t - 3 + w; if (tt >= 0) s += cw[w * 384 + ch] * bf2f(proj[((size_t)b * SEQ + tt) * LDP + col]); }
                                s = s * sigmoidf(s); if (!isk) s *= 0.10206207261596575f;
                            } else {
                                const int i = c % 48; const bool first = c < 48; const int cb = (isk ? 384 : 0) + h * 96;
                                const float t1 = bf2f(pr[cb + i]), t2 = bf2f(pr[cb + 48 + i]);
                                typedef _Float16 h2_t __attribute__((ext_vector_type(2))); const h2_t cs_ = __builtin_bit_cast(h2_t, ((const unsigned*)rope)[row * 48 + i]); const float cs = (float)cs_.x, sn = (float)cs_.y;
                                s = first ? (t1 * cs - t2 * sn) : (t2 * cs + t1 * sn); if (isk) s *= 0.10206207261596575f;
                            }
                            (isk ? sk : sq)[c] = s;
                        }
                        if (tid == 192) {
                            if (kind == 1) { const float ig = bf2f(pr[2304 + h]) + b_i[h], fg = bf2f(pr[2308 + h]) + b_f[h]; sg[0] = sigmoidf(fg); sg[1] = __expf(ig); }
                            else { sg[0] = gamma; sg[1] = 1.0f; }
                        }
                        __syncthreads();
                        const float f = sg[0], ei = sg[1];
                        float num = 0.f;
                        if (tid < 193) {
                            const float v = tid < 192 ? bf2f(pr[768 + h * 192 + tid]) : 1.0f;
#pragma unroll
                            for (int i = 0; i < 96; ++i) { C[i] = f * C[i] + (ei * sk[i]) * v; num += sq[i] * C[i]; if ((i & 15) == 15) asm volatile("" ::: "memory"); }
                            if (tid == 192) sg[2] = num;
                        }
                        __syncthreads();
                        float hv = num;
                        if (kind == 1) hv = num / fmaxf(fabsf(sg[2]), 1.0f);
                        float s1 = (tid < 192) ? hv : 0.f; s1 = wave_sum(s1, lane); if (lane == 0) sred[wave] = s1;
                        __syncthreads();
                        const float mean = (sred[0] + sred[1] + sred[2]) * (1.0f / 192.0f);
                        float dv = (tid < 192) ? (hv - mean) : 0.f; float s2 = wave_sum(dv * dv, lane); if (lane == 0) sred[8 + wave] = s2;
                        __syncthreads();
                        const float var = (sred[8] + sred[9] + sred[10]) * (1.0f / 192.0f);
                        if (tid < 192) {
                            const float yn = dv * (1.0f / sqrtf(var + LN_EPS)) * norm_g[h * 192 + tid];
                            const float ov = bf2f(pr[1536 + h * 192 + tid]);
                            const float outv = (kind == 1) ? sigmoidf(ov) * yn : (ov * sigmoidf(ov)) * yn;
                            cat[row * D + h * 192 + tid] = f2bf(outv);
                        }
                    }
                }
#endif
            }
            }
#if BG_CONV && FAST_MOE
            {
                if (kind != 0) {
                __syncthreads();
                LAS float* scr = ldsf + wave * (64 * 65);
                unsigned* qh = ctl + CW_CQ + 64 * L;
                const int Lfirst = (L == 1) ? 1 : 3, nlay = (L == 1) ? 2 : 1;
                for (;;) {
                    int it = 0; if (lane == 0) it = (int)__hip_atomic_fetch_add(qh, 1u, __ATOMIC_RELAXED, __HIP_MEMORY_SCOPE_AGENT);
                    it = __builtin_amdgcn_readfirstlane(it);
                    if (it >= nlay * NEXP * (512 + 256)) break;
                    const int Lc = Lfirst + it / (NEXP * (512 + 256)); it = it % (NEXP * (512 + 256));
                    if (it < NEXP * 512) { const int le = Lc * NEXP + (it >> 9);
#if MOE_FP8
                        tr_item8((const float*)ARGP(42) + (size_t)le * D * 2 * DEXP, 2 * DEXP, D, wgu8 + (size_t)le * 2 * DEXP * D, 32, it & 511, scr, lane, GU_WS, [](int d) { const int tile = d >> 8, q = d & 255; return q < 128 ? tile * 128 + q : DEXP + tile * 128 + (q - 128); });
#else
                        tr_item((const float*)ARGP(42) + (size_t)le * D * 2 * DEXP, 2 * DEXP, D, wgu_t + (size_t)le * 2 * DEXP * D, 32, it & 511, scr, lane, [](int d) { const int tile = d >> 8, q = d & 255; return q < 128 ? tile * 128 + q : DEXP + tile * 128 + (q - 128); });
#endif
                    }
                    else { const int r = it - NEXP * 512; const int le = Lc * NEXP + (r >> 8);
#if MOE_FP8
                        tr_item8((const float*)ARGP(44) + (size_t)le * DEXP * D, D, DEXP, wdn8 + (size_t)le * D * DEXP, 16, r & 255, scr, lane, DN_WS, [](int d) { return d; });
#else
                        tr_item((const float*)ARGP(44) + (size_t)le * DEXP * D, D, DEXP, wdn_t + (size_t)le * D * DEXP, 16, r & 255, scr, lane, [](int d) { return d; });
#endif
                    }
                }
                }
            }
#endif
            REPS(13) { if (rep_) __syncthreads();
#if FAST_XATTN
            {
                typedef pg8::bf16x8 bx8; typedef pg8::f32x4 fx4;
                LAS bf16* Kt = (LAS bf16*)lds;
                LAS bf16* Vt = (LAS bf16*)(lds + 36864);
                const int tok = lane & 15, sg = lane >> 4;
                for (int unit = bid; unit < NB * 4 * 8; unit += G) {
                    const int b = unit >> 5, head = (unit >> 3) & 3, qt = unit & 7;
                    __syncthreads();
                    const bf16* kg = memK + (size_t)(b * 4 + head) * 256 * 64; const bf16* vg = memVT + (size_t)(b * 4 + head) * 64 * 256;
                    for (int c = tid; c < 2048; c += NTHR) { const int key = c >> 3, d8 = (c & 7) * 8; *(LAS pg8::u32x4*)(Kt + key * 72 + d8) = *(const pg8::u32x4*)(kg + key * 64 + d8); }
                    for (int c = tid; c < 2048; c += NTHR) { const int d = c >> 5, m = (c & 31) * 8; const pg8::u32x4 v = *(const pg8::u32x4*)(vg + d * 256 + m);
                        const int a = m >> 5, w = m & 31, tp = w >> 4, sk = (w & 15) >> 2;
                        pg8::u32x2 lo; lo.x = v.x; lo.y = v.y; pg8::u32x2 hi2; hi2.x = v.z; hi2.y = v.w;
                        *(LAS pg8::u32x2*)(Vt + d * 264 + 32 * a + 8 * sk + 4 * tp) = lo; *(LAS pg8::u32x2*)(Vt + d * 264 + 32 * a + 8 * (sk + 1) + 4 * tp) = hi2; }
                    __syncthreads();
#pragma unroll 1
                    for (int qi = 0; qi < 2; ++qi) {
                        const size_t row = (size_t)b * SEQ + qt * 256 + wave * 32 + qi * 16 + tok;
                        const bf16* qp = proj + row * LDP + xq_off + head * 64 + 8 * sg;
                        const bx8 q0 = __builtin_bit_cast(bx8, *(const uint4*)qp), q1 = __builtin_bit_cast(bx8, *(const uint4*)(qp + 32));
                        fx4 s[16];
#pragma unroll
                        for (int kt = 0; kt < 16; ++kt) { const bx8 k0 = *(const LAS bx8*)(Kt + (16 * kt + tok) * 72 + 8 * sg), k1 = *(const LAS bx8*)(Kt + (16 * kt + tok) * 72 + 32 + 8 * sg);
                            s[kt] = __builtin_amdgcn_mfma_f32_16x16x32_bf16(k0, q0, (fx4){0.f, 0.f, 0.f, 0.f}, 0, 0, 0); s[kt] = __builtin_amdgcn_mfma_f32_16x16x32_bf16(k1, q1, s[kt], 0, 0, 0); }
                        float mx = -3.0e38f;
#pragma unroll
                        for (int kt = 0; kt < 16; ++kt) mx = fmaxf(fmaxf(fmaxf(s[kt][0], s[kt][1]), fmaxf(s[kt][2], s[kt][3])), mx);
                        mx = fmaxf(mx, sh_xor(mx, 16, lane)); mx = fmaxf(mx, sh_xor(mx, 32, lane));
                        float sum = 0.f;
#pragma unroll
                        for (int kt = 0; kt < 16; ++kt)
#pragma unroll
                            for (int r = 0; r < 4; ++r) { const float pe = __expf((s[kt][r] - mx) * 0.125f); s[kt][r] = pe; sum += pe; }
                        sum += sh_xor(sum, 16, lane); sum += sh_xor(sum, 32, lane);
                        fx4 o[4];
#pragma unroll
                        for (int dt = 0; dt < 4; ++dt) o[dt] = (fx4){0.f, 0.f, 0.f, 0.f};
#pragma unroll
                        for (int a = 0; a < 8; ++a) {
                            uint4 pw; pw.x = pg8::cvt_pk_bf16(s[2 * a][0], s[2 * a][1]); pw.y = pg8::cvt_pk_bf16(s[2 * a][2], s[2 * a][3]); pw.z = pg8::cvt_pk_bf16(s[2 * a + 1][0], s[2 * a + 1][1]); pw.w = pg8::cvt_pk_bf16(s[2 * a + 1][2], s[2 * a + 1][3]);
                            const bx8 pf = __builtin_bit_cast(bx8, pw);
#pragma unroll
                            for (int dt = 0; dt < 4; ++dt) { const bx8 vf = *(const LAS bx8*)(Vt + (16 * dt + tok) * 264 + 32 * a + 8 * sg); o[dt] = __builtin_amdgcn_mfma_f32_16x16x32_bf16(vf, pf, o[dt], 0, 0, 0); }
                        }
                        const float inv = 1.0f / sum; bf16* op = cat + row * D + MIXW + head * 64 + 4 * sg;
#pragma unroll
                        for (int dt = 0; dt < 4; ++dt) { uint2 ov; ov.x = pg8::cvt_pk_bf16(o[dt][0] * inv, o[dt][1] * inv); ov.y = pg8::cvt_pk_bf16(o[dt][2] * inv, o[dt][3] * inv); *(uint2*)(op + 16 * dt) = ov; }
                    }
                }
            }
#else
            for (int wu = bid * NWAVES + wave; wu < (T / 16) * 4; wu += G * NWAVES) {
                const int head = wu & 3, row = (wu >> 2) * 16 + (lane >> 2), part = lane & 3, b = row / SEQ;
                float q[16], acc[16];
                { const bf16* qp = proj + (size_t)row * LDP + xq_off + head * 64 + part * 16;
                  unpack8(*(const uint4*)qp, q); unpack8(*(const uint4*)(qp + 8), q + 8);
#pragma unroll
                  for (int d = 0; d < 16; ++d) { q[d] *= 0.125f; acc[d] = 0.f; } }
                float mx = -3.0e38f, l = 0.f;
                const bf16* kb = memK + (size_t)(b * 4 + head) * 256 * 64 + part * 16; const bf16* vb = memV + (size_t)(b * 4 + head) * 256 * 64 + part * 16;
                for (int m = 0; m < NMEM; ++m) {
                    float kk[16]; unpack8(*(const uint4*)(kb + m * 64), kk); unpack8(*(const uint4*)(kb + m * 64 + 8), kk + 8);
                    float s = 0.f;
#pragma unroll
                    for (int j = 0; j < 16; ++j) s += q[j] * kk[j];
                    s += sh_xor(s, 1, lane); s += sh_xor(s, 2, lane);
                    const float mn = fmaxf(mx, s); const float corr = __expf(mx - mn), pv = __expf(s - mn); mx = mn; l = l * corr + pv;
                    float vv[16]; unpack8(*(const uint4*)(vb + m * 64), vv); unpack8(*(const uint4*)(vb + m * 64 + 8), vv + 8);
#pragma unroll
                    for (int j = 0; j < 16; ++j) acc[j] = acc[j] * corr + pv * vv[j];
                }
                const float il = 1.0f / l; bf16* op = cat + (size_t)row * D + MIXW + head * 64 + part * 16;
#pragma unroll
                for (int c = 0; c < 2; ++c) { uint4 o; o.x = pk2(acc[8 * c + 0] * il, acc[8 * c + 1] * il); o.y = pk2(acc[8 * c + 2] * il, acc[8 * c + 3] * il);
                    o.z = pk2(acc[8 * c + 4] * il, acc[8 * c + 5] * il); o.w = pk2(acc[8 * c + 6] * il, acc[8 * c + 7] * il); *(uint4*)(op + 8 * c) = o; }
            }
#endif
        } }
        SEAM(P + LP_MIXA);

        if (IN(P + LP_MIXB)) {
            PHASE_IDS();
            REPS(4) { if (rep_) __syncthreads();
            if (kind == 0) {
                const float* w_glu = (const float*)(L == 0 ? ARGP(14) : ARGP(33)); const float* b_glu = (const float*)(L == 0 ? ARGP(15) : ARGP(34));
#if FAST_DENSE
                { (void)w_glu; pg8::Gemm g{yg, wglu_t + (size_t)(L == 0 ? 0 : 1) * MiB, MIXW, nullptr}; pg8::StaticOrder S; S.init(T, MIXW, G, bid); pg8::EpiGlu E{cat, D, yg, MIXW, b_glu}; pg8::gemm_phase(lds, g, S, E, wave); }
#else
                oracle_gemm(ldsf, T, MIXW, MIXW,
                    [&](int) { return 0; },
                    [&](int m, int k) { return bf2f(yg[(size_t)m * MIXW + k]); },
                    [&](int k, int n, int) { return w_glu[(size_t)k * MIXW + n]; },
                    [&](int m0, int n0, float (&acc)[4][8], int) {
#pragma unroll
                        for (int i = 0; i < 4; ++i)
#pragma unroll
                            for (int j = 0; j < 8; ++j) { const int m = m0 + i, n = n0 + j; const float z = acc[i][j] + b_glu[n]; const float yv = bf2f(yg[(size_t)m * MIXW + n]);
                                cat[(size_t)m * D + n] = f2bf(yv * sigmoidf(z)); }
                    });
#endif
            }
        } }
        if (kind == 0) SEAM(P + LP_MIXB);

        if (IN(P + LP_OUTPROJ)) {
            PHASE_IDS();
            REPS(5) { if (rep_) __syncthreads();
            const float* w_out = (const float*)ARGP(35) + (size_t)L * D * D;
#if FAST_DENSE
            { (void)w_out; pg8::Gemm g{cat, wout_t + (size_t)L * D * D, D, nullptr}; pg8::StaticOrder S; S.init(T, D, G, bid);
#if RES_BF16
              pg8::EpiResBf16 E{(bf16*)y2, hb, D, DN_ALPHA}; pg8::gemm_phase(lds, g, S, E, wave); }
#else
              pg8::EpiResF32 E{y2, hf, D, DN_ALPHA}; pg8::gemm_phase(lds, g, S, E, wave); }
#endif
#else
            oracle_gemm(ldsf, T, D, D,
                [&](int) { return 0; },
                [&](int m, int k) { return bf2f(cat[(size_t)m * D + k]); },
                [&](int k, int n, int) { return w_out[(size_t)k * D + n]; },
                [&](int m0, int n0, float (&acc)[4][8], int) {
#pragma unroll
                    for (int i = 0; i < 4; ++i)
#pragma unroll
                        for (int j = 0; j < 8; ++j) { const size_t o = (size_t)(m0 + i) * D + n0 + j; y2[o] = DN_ALPHA * hf[o] + acc[i][j]; }
                });
#endif
        } }
        SEAM(P + LP_OUTPROJ);

        if (IN(P + LP_LN1)) {
            PHASE_IDS();
            REPS(8) { if (rep_) __syncthreads();
            const float* g1 = (const float*)ARGP(36) + L * D; const float* b1 = (const float*)ARGP(37) + L * D;
            const float* rw = (const float*)ARGP(40) + (size_t)L * D * NEXP; const float* rb = (const float*)ARGP(41) + L * NEXP;
#if FAST_LN1
            {
            typedef pg8::bf16x8 bx8; typedef pg8::f32x4 fx4; typedef pg8::u32x4 ux4;
            LAS bf16* RWH = (LAS bf16*)lds;
            LAS float* stg = (LAS float*)(lds + 66048 + wave * 8320);
            LAS int* hist = (LAS int*)(lds + 66048 + 8 * 8320); LAS int* lbase = hist + 32;
            const bf16* rwh_g = rwt + (size_t)(L * 2 + 0) * NEXP * D; const bf16* rwl_g = rwt + (size_t)(L * 2 + 1) * NEXP * D;
            for (int c = tid; c < 4096; c += NTHR) { const int e = c >> 7, k8 = (c & 127) * 8; *(LAS ux4*)(RWH + e * 1032 + k8) = *(const ux4*)(rwh_g + e * 1024 + k8); }
            if (tid < 32) hist[tid] = 0;
            __syncthreads();
            const int tok = lane & 15, sg = lane >> 4;
            for (int wt = bid * NWAVES + wave; wt < T / 8; wt += G * NWAVES) {
                float4 v[8][4];
#pragma unroll
                for (int rr = 0; rr < 8; ++rr)
#pragma unroll
                    for (int j = 0; j < 4; ++j) {
#if RES_BF16
                        const uint2 yv_ = *(const uint2*)((const bf16*)y2 + ((size_t)wt * 8 + rr) * D + (lane + 64 * j) * 4);
                        v[rr][j] = make_float4(__uint_as_float(yv_.x << 16), __uint_as_float(yv_.x & 0xffff0000u), __uint_as_float(yv_.y << 16), __uint_as_float(yv_.y & 0xffff0000u));
#else
                        v[rr][j] = *(const float4*)(y2 + ((size_t)wt * 8 + rr) * D + (lane + 64 * j) * 4);
#endif
                    }
#pragma unroll
                for (int rr = 0; rr < 8; ++rr) {
                    float s = 0.f;
#pragma unroll
                    for (int j = 0; j < 4; ++j) s += (v[rr][j].x + v[rr][j].y) + (v[rr][j].z + v[rr][j].w);
                    const float mean = wave_sum(s, lane) * (1.0f / D); float s2 = 0.f;
#pragma unroll
                    for (int j = 0; j < 4; ++j) { v[rr][j].x -= mean; v[rr][j].y -= mean; v[rr][j].z -= mean; v[rr][j].w -= mean; s2 += (v[rr][j].x * v[rr][j].x + v[rr][j].y * v[rr][j].y) + (v[rr][j].z * v[rr][j].z + v[rr][j].w * v[rr][j].w); }
                    const float rstd = 1.0f / sqrtf(wave_sum(s2, lane) * (1.0f / D) + LN_EPS);
                    const size_t row = (size_t)wt * 8 + rr;
#pragma unroll
                    for (int j = 0; j < 4; ++j) { const int cc = (lane + 64 * j) * 4; const float4 gg = *(const float4*)(g1 + cc), bb = *(const float4*)(b1 + cc);
                        float4 o; o.x = v[rr][j].x * rstd * gg.x + bb.x; o.y = v[rr][j].y * rstd * gg.y + bb.y; o.z = v[rr][j].z * rstd * gg.z + bb.z; o.w = v[rr][j].w * rstd * gg.w + bb.w;
                        v[rr][j] = o;
#if RES_BF16
                        { uint2 ob; ob.x = pg8::cvt_pk_bf16(o.x, o.y); ob.y = pg8::cvt_pk_bf16(o.z, o.w); *(uint2*)(hb + row * D + cc) = ob; }
#else
                        *(float4*)(hf + row * D + cc) = o;
#endif
#if MOE_FP8 && MOE_GATHER
                        { int w8 = __builtin_amdgcn_cvt_pk_fp8_f32(o.x, o.y, 0, false); w8 = __builtin_amdgcn_cvt_pk_fp8_f32(o.z, o.w, w8, true); *(int*)(hb8 + row * D + cc) = w8; }
#elif !RES_BF16
                        { uint2 ob; ob.x = pg8::cvt_pk_bf16(o.x, o.y); ob.y = pg8::cvt_pk_bf16(o.z, o.w); *(uint2*)(hb + row * D + cc) = ob; }
#endif
                    }
                }
                fx4 lacc[2]; lacc[0] = (fx4){0.f, 0.f, 0.f, 0.f}; lacc[1] = (fx4){0.f, 0.f, 0.f, 0.f};
#pragma unroll
                for (int j = 0; j < 4; ++j) {
#pragma unroll
                    for (int rr = 0; rr < 8; ++rr) *(LAS fx4*)(stg + rr * 260 + lane * 4) = (fx4){v[rr][j].x, v[rr][j].y, v[rr][j].z, v[rr][j].w};
                    asm volatile("s_waitcnt lgkmcnt(0)" ::: "memory");
#pragma unroll 2
                    for (int kk = 0; kk < 8; ++kk) {
                        fx4 f0 = (fx4){0.f, 0.f, 0.f, 0.f}, f1 = f0;
                        if (tok < 8) { f0 = *(const LAS fx4*)(stg + tok * 260 + 32 * kk + 8 * sg); f1 = *(const LAS fx4*)(stg + tok * 260 + 32 * kk + 8 * sg + 4); }
                        ux4 hw, lw;
                        hw.x = pg8::cvt_pk_bf16(f0[0], f0[1]); hw.y = pg8::cvt_pk_bf16(f0[2], f0[3]); hw.z = pg8::cvt_pk_bf16(f1[0], f1[1]); hw.w = pg8::cvt_pk_bf16(f1[2], f1[3]);
                        lw.x = pg8::cvt_pk_bf16(f0[0] - __uint_as_float(hw.x << 16), f0[1] - __uint_as_float(hw.x & 0xffff0000u)); lw.y = pg8::cvt_pk_bf16(f0[2] - __uint_as_float(hw.y << 16), f0[3] - __uint_as_float(hw.y & 0xffff0000u));
                        lw.z = pg8::cvt_pk_bf16(f1[0] - __uint_as_float(hw.z << 16), f1[1] - __uint_as_float(hw.z & 0xffff0000u)); lw.w = pg8::cvt_pk_bf16(f1[2] - __uint_as_float(hw.w << 16), f1[3] - __uint_as_float(hw.w & 0xffff0000u));
                        const bx8 yh = __builtin_bit_cast(bx8, hw), yl = __builtin_bit_cast(bx8, lw);
#pragma unroll
                        for (int t = 0; t < 2; ++t) { const int kcol = 256 * j + 32 * kk + 8 * sg;
                            const bx8 xh = *(const LAS bx8*)(RWH + (16 * t + tok) * 1032 + kcol); const bx8 xl = __builtin_bit_cast(bx8, *(const ux4*)(rwl_g + (16 * t + tok) * 1024 + kcol));
                            lacc[t] = __builtin_amdgcn_mfma_f32_16x16x32_bf16(xh, yh, lacc[t], 0, 0, 0); lacc[t] = __builtin_amdgcn_mfma_f32_16x16x32_bf16(xl, yh, lacc[t], 0, 0, 0); lacc[t] = __builtin_amdgcn_mfma_f32_16x16x32_bf16(xh, yl, lacc[t], 0, 0, 0); }
                    }
                    asm volatile("s_waitcnt lgkmcnt(0)" ::: "memory");
                }
                float lv[8];
#pragma unroll
                for (int t = 0; t < 2; ++t) { const float4 rb4 = *(const float4*)(rb + 16 * t + 4 * sg); lv[4 * t + 0] = lacc[t][0] + rb4.x; lv[4 * t + 1] = lacc[t][1] + rb4.y; lv[4 * t + 2] = lacc[t][2] + rb4.z; lv[4 * t + 3] = lacc[t][3] + rb4.w; }
                float tv[4]; int ti[4];
#pragma unroll
                for (int k = 0; k < 4; ++k) {
                    float bv = -3.0e38f; int bi = 0;
#pragma unroll
                    for (int q = 0; q < 8; ++q) { const int e = 16 * (q >> 2) + 4 * sg + (q & 3); if (lv[q] > bv) { bv = lv[q]; bi = e; } }
#pragma unroll
                    for (int o = 16; o <= 32; o <<= 1) { const float ov = sh_xor(bv, o, lane); const int oi = sh_xor(bi, o, lane); if (ov > bv || (ov == bv && oi < bi)) { bv = ov; bi = oi; } }
                    tv[k] = bv; ti[k] = bi;
#pragma unroll
                    for (int q = 0; q < 8; ++q) { const int e = 16 * (q >> 2) + 4 * sg + (q & 3); if (e == bi) lv[q] = -3.0e38f; }
                }
                if (sg == 0 && tok < 8) {
                    const size_t row = (size_t)wt * 8 + tok; float ex[4], sum = 0.f;
#pragma unroll
                    for (int k = 0; k < 4; ++k) { ex[k] = __expf(tv[k] - tv[0]); sum += ex[k]; }
                    const float inv = 1.0f / sum;
                    *(int4*)(top_e + row * 4) = make_int4(ti[0], ti[1], ti[2], ti[3]); *(float4*)(top_g + row * 4) = make_float4(ex[0] * inv, ex[1] * inv, ex[2] * inv, ex[3] * inv);
#pragma unroll
                    for (int k = 0; k < 4; ++k) ti[k] |= atomicAdd((int*)&hist[ti[k]], 1) << 8;
                }
#if MOE_SPARSE
                __syncthreads();
                if (tid < 32) { const int hc = hist[tid]; lbase[tid] = hc ? (int)atomicAdd(ctl + CW_CNT + 64 * L + tid, (unsigned)hc) : 0; hist[tid] = 0; }
                __syncthreads();
                if (sg == 0 && tok < 8) { const size_t row = (size_t)wt * 8 + tok; int dd[4];
#pragma unroll
                    for (int k = 0; k < 4; ++k) { const int e = ti[k] & 255; dd[k] = e * T + lbase[e] + (ti[k] >> 8); row_tok[dd[k]] = (int)row; }
                    *(int4*)(dest + row * 4) = make_int4(dd[0], dd[1], dd[2], dd[3]); }
#endif
            }
#if !MOE_SPARSE
            __syncthreads();
            if (rep_ == 0 && tid < 32 && hist[tid] != 0) atomicAdd(ctl + CW_CNT + 64 * L + tid, (unsigned)hist[tid]);
#endif
            __syncthreads();
            }
#else
            LAS float* rows = ldsf; LAS float* lg = ldsf + 16 * 1024; LAS int* hist = (LAS int*)(ldsf + 16 * 1024 + 512);
            if (tid < 32) hist[tid] = 0;
            __syncthreads();
            for (int tile = bid; tile < T / 16; tile += G) {
#pragma unroll
                for (int rr = 0; rr < 2; ++rr) {
                    const int r = 2 * wave + rr; const size_t row = (size_t)tile * 16 + r;
                    float4 v[4]; float s = 0.f;
#pragma unroll
                    for (int j = 0; j < 4; ++j) { v[j] = *(const float4*)(y2 + row * D + (lane + 64 * j) * 4); s += (v[j].x + v[j].y) + (v[j].z + v[j].w); }
                    const float mean = wave_sum(s, lane) * (1.0f / D); float s2 = 0.f;
#pragma unroll
                    for (int j = 0; j < 4; ++j) { v[j].x -= mean; v[j].y -= mean; v[j].z -= mean; v[j].w -= mean; s2 += (v[j].x * v[j].x + v[j].y * v[j].y) + (v[j].z * v[j].z + v[j].w * v[j].w); }
                    const float rstd = 1.0f / sqrtf(wave_sum(s2, lane) * (1.0f / D) + LN_EPS);
#pragma unroll
                    for (int j = 0; j < 4; ++j) { const int c = (lane + 64 * j) * 4; const float4 gg = *(const float4*)(g1 + c), bb = *(const float4*)(b1 + c);
                        float4 o; o.x = v[j].x * rstd * gg.x + bb.x; o.y = v[j].y * rstd * gg.y + bb.y; o.z = v[j].z * rstd * gg.z + bb.z; o.w = v[j].w * rstd * gg.w + bb.w;
                        *(float4*)(hf + row * D + c) = o; uint2 ob; ob.x = pk2(o.x, o.y); ob.y = pk2(o.z, o.w); *(uint2*)(hb + row * D + c) = ob;
                        rows[r * 1024 + c + 0] = o.x; rows[r * 1024 + c + 1] = o.y; rows[r * 1024 + c + 2] = o.z; rows[r * 1024 + c + 3] = o.w; }
                }
                __syncthreads();
                { const int r = tid >> 5, e = tid & 31; float a = rb[e];
                  for (int k = 0; k < D; ++k) a += rows[r * 1024 + k] * rw[(size_t)k * NEXP + e];
                  lg[r * 32 + e] = a; }
                __syncthreads();
                if (tid < 16) {
                    const size_t row = (size_t)tile * 16 + tid; float tv[4]; int ti[4];
#pragma unroll
                    for (int k = 0; k < 4; ++k) { float best = -3.0e38f; int bi = 0;
                        for (int e = 0; e < NEXP; ++e) { const float v = lg[tid * 32 + e]; if (v > best) { best = v; bi = e; } }
                        tv[k] = best; ti[k] = bi; lg[tid * 32 + bi] = -3.0e38f; }
                    float ex[4], sum = 0.f;
#pragma unroll
                    for (int k = 0; k < 4; ++k) { ex[k] = __expf(tv[k] - tv[0]); sum += ex[k]; }
#pragma unroll
                    for (int k = 0; k < 4; ++k) { top_e[row * 4 + k] = ti[k]; top_g[row * 4 + k] = ex[k] / sum; atomicAdd((int*)&hist[ti[k]], 1); }
                }
                __syncthreads();
            }
            if (rep_ == 0 && tid < 32 && hist[tid] != 0) atomicAdd(ctl + CW_CNT + 64 * L + tid, (unsigned)hist[tid]);
            __syncthreads();
#endif
        } }
        SEAM(P + LP_LN1);

        if (!MOE_SPARSE && IN(P + LP_DISP)) {
            PHASE_IDS();
            REPS(9) { if (rep_) __syncthreads();
            LAS int* pstart = (LAS int*)ldsf; LAS int* lh = pstart + 32; LAS int* lbase = pstart + 64; LAS int* ldest = pstart + 128;
            if (tid == 0) { int a = 0; for (int e = 0; e < NEXP; ++e) { const int c = (int)__hip_atomic_load(ctl + CW_CNT + 64 * L + e, __ATOMIC_RELAXED, __HIP_MEMORY_SCOPE_AGENT); pstart[e] = a; a += ((c + MOEBLK - 1) / MOEBLK) * MOEBLK; } }
            __syncthreads();
#if MOE_GATHER
            for (int idx = bid * NTHR + tid; idx < NEXP * MOEBLK; idx += G * NTHR) { const int e = idx >> 8, r = idx & 255; const int cnt = (int)__hip_atomic_load(ctl + CW_CNT + 64 * L + e, __ATOMIC_RELAXED, __HIP_MEMORY_SCOPE_AGENT);
                const int padded = ((cnt + MOEBLK - 1) / MOEBLK) * MOEBLK; if (cnt + r < padded) row_tok[pstart[e] + cnt + r] = 0; }
#endif
            for (int tile = bid; tile < T * TOPK / NTHR; tile += G) {
                if (tid < 32) lh[tid] = 0;
                __syncthreads();
                const int pair = tile * NTHR + tid; const int e = top_e[pair];
                int dd;
                if (rep_ == 0) {
                const int rank = atomicAdd((int*)&lh[e], 1);
                __syncthreads();
                if (tid < 32) lbase[tid] = lh[tid] ? (int)atomicAdd(ctl + CW_CUR + 64 * L + tid, (unsigned)lh[tid]) : 0;
                __syncthreads();
                dd = pstart[e] + lbase[e] + rank; dest[pair] = dd; } else dd = dest[pair];
                ldest[tid] = dd;
#if MOE_GATHER
                if (rep_ == 0) row_tok[dd] = pair >> 2;
#endif
                __syncthreads();
#if !MOE_GATHER
                for (int i = 0; i < 64; ++i) { const int pp = wave * 64 + i; const int d2 = ldest[pp]; const int tt = (tile * NTHR + pp) >> 2;
                    const uint4* src = (const uint4*)(hb + (size_t)tt * D); uint4* dst = (uint4*)(xr + (size_t)d2 * D);
                    dst[lane] = src[lane]; dst[lane + 64] = src[lane + 64]; }
#endif
                __syncthreads();
            }
        } }
        if (!MOE_SPARSE) SEAM(P + LP_DISP);

        if (IN(P + LP_GU) || IN(P + LP_DOWN)) {
            PHASE_IDS();
            LAS int* pend = (LAS int*)(lds + LDS_MISC + 512);
            if (tid == 0) { int a = 0; for (int e = 0; e < NEXP; ++e) { const int c = (int)__hip_atomic_load(ctl + CW_CNT + 64 * L + e, __ATOMIC_RELAXED, __HIP_MEMORY_SCOPE_AGENT); a += ((c + MOEBLK - 1) / MOEBLK) * MOEBLK; pend[e] = a; } }
            __syncthreads();
        }
        if (IN(P + LP_GU)) {
            PHASE_IDS();
            REPS(6) { if (rep_) __syncthreads();
            const LAS int* pend = (const LAS int*)(lds + LDS_MISC + 512);
            const int nrows = pend[NEXP - 1];
            const float* wgu = (const float*)ARGP(42) + (size_t)L * NEXP * D * 2 * DEXP; const float* bgu = (const float*)ARGP(43) + (size_t)L * NEXP * 2 * DEXP;
#if FAST_MOE
            { (void)wgu; pg8::MoeOrder S{pend, nrows / 256, 8, G, vcu};
#if MOE_GATHER && MOE_FP8
              pg8::EpiSwiglu<true> E{act8, bgu, 1.0f / GU_WS};
              LAS int* rmapL = (LAS int*)(lds + LDS_RMAP);
              { pg8::Unit uu; for (int i = 0; i < 15 && S.next(i, uu); ++i) { if (tid < 256) { const int rt_ = row_tok[uu.pm * 256 + tid]; rmapL[i * 256 + tid] = rt_ < 0 ? 0 : (rt_ < T ? rt_ : T - 1); } } }
              __syncthreads();
              pg8::Gemm g{(const pg8::bf16_t*)hb8, (const pg8::bf16_t*)(wgu8 + (size_t)L * NEXP * 2 * DEXP * D), D, rmapL}; pg8::gemm_phase<pg8::EpiSwiglu<true>, pg8::MoeOrder, true, true, true, true>(lds, g, S, E, wave);
#elif MOE_GATHER
              pg8::EpiSwiglu<false> E{act, bgu, 1.0f};
              LAS int* rmapL = (LAS int*)(lds + LDS_RMAP);
              { pg8::Unit uu; for (int i = 0; i < 15 && S.next(i, uu); ++i) { if (tid < 256) { const int rt_ = row_tok[uu.pm * 256 + tid]; rmapL[i * 256 + tid] = rt_ < 0 ? 0 : (rt_ < T ? rt_ : T - 1); } } }
              __syncthreads();
              pg8::Gemm g{hb, wgu_t + (size_t)L * NEXP * 2 * DEXP * D, D, rmapL}; pg8::gemm_phase<pg8::EpiSwiglu<false>, pg8::MoeOrder, true, true, true>(lds, g, S, E, wave);
#else
              pg8::EpiSwiglu<false> E{act, bgu, 1.0f};
              pg8::Gemm g{xr, wgu_t + (size_t)L * NEXP * 2 * DEXP * D, D, nullptr}; pg8::gemm_phase(lds, g, S, E, wave);
#endif
            }
#else
            oracle_gemm(ldsf, nrows, 2 * DEXP, D,
                [&](int tm) { return expert_of_block(pend, tm >> 1); },
                [&](int m, int k) { return bf2f(xr[(size_t)m * D + k]); },
                [&](int k, int n, int e) { const int tn = n >> 7, v = n & 127; const int c = tn * 64 + (v >> 1) + ((v & 1) ? DEXP : 0); return wgu[((size_t)e * D + k) * (2 * DEXP) + c]; },
                [&](int m0, int n0, float (&acc)[4][8], int e) {
                    const int tn = n0 >> 7, v0 = n0 & 127;
#pragma unroll
                    for (int i = 0; i < 4; ++i)
#pragma unroll
                        for (int jj = 0; jj < 4; ++jj) { const int c = tn * 64 + (v0 >> 1) + jj;
                            const float xg = fminf(acc[i][2 * jj] + bgu[(size_t)e * 2 * DEXP + c], 7.0f);
                            const float xl = fminf(fmaxf(acc[i][2 * jj + 1] + bgu[(size_t)e * 2 * DEXP + DEXP + c], -7.0f), 7.0f);
                            act[(size_t)(m0 + i) * DEXP + c] = f2bf(xg * sigmoidf(1.702f * xg) * (xl + 1.0f)); }
                });
#endif
        } }
        SEAM(P + LP_GU);

        if (IN(P + LP_DOWN)) {
            PHASE_IDS();
            REPS(7) { if (rep_) __syncthreads();
            const LAS int* pend = (const LAS int*)(lds + LDS_MISC + 512);
            const int nrows = pend[NEXP - 1];
            const float* wd = (const float*)ARGP(44) + (size_t)L * NEXP * DEXP * D; const float* bd = (const float*)ARGP(45) + (size_t)L * NEXP * D;
#if FAST_MOE
            { (void)wd; pg8::MoeOrder S{pend, nrows / 256, 4, G, vcu};
#if MOE_FP8 && MOE_GATHER
              pg8::Gemm g{(const pg8::bf16_t*)act8, (const pg8::bf16_t*)(wdn8 + (size_t)L * NEXP * D * DEXP), DEXP, nullptr};
#if YR_FP8
              pg8::EpiBf16T<true> E{(unsigned char*)yr, D, bd, D, 1.0f / DN_WS};
              pg8::gemm_phase<pg8::EpiBf16T<true>, pg8::MoeOrder, true, true, false, true>(lds, g, S, E, wave);
#else
              pg8::EpiBf16 E{yr, D, bd, D, 1.0f / DN_WS};
              pg8::gemm_phase<pg8::EpiBf16, pg8::MoeOrder, true, true, false, true>(lds, g, S, E, wave);
#endif
#else
              pg8::Gemm g{act, wdn_t + (size_t)L * NEXP * D * DEXP, DEXP, nullptr}; pg8::EpiBf16 E{yr, D, bd, D, 1.0f}; pg8::gemm_phase(lds, g, S, E, wave);
#endif
            }
#else
            oracle_gemm(ldsf, nrows, D, DEXP,
                [&](int tm) { return expert_of_block(pend, tm >> 1); },
                [&](int m, int k) { return bf2f(act[(size_t)m * DEXP + k]); },
                [&](int k, int n, int e) { return wd[((size_t)e * DEXP + k) * D + n]; },
                [&](int m0, int n0, float (&acc)[4][8], int e) {
#pragma unroll
                    for (int i = 0; i < 4; ++i)
#pragma unroll
                        for (int j = 0; j < 8; ++j) yr[(size_t)(m0 + i) * D + n0 + j] = f2bf(acc[i][j] + bd[(size_t)e * D + n0 + j]);
                });
#endif
        } }
        SEAM(P + LP_DOWN);

        if (IN(P + LP_COMB)) {
            PHASE_IDS();
            REPS(10) { const bool dummy_ = (rep_ == 0) && ((REP_MASK >> 10) & 1);
            const float* g2 = (const float*)ARGP(38) + L * D; const float* b2 = (const float*)ARGP(39) + L * D;
            const int l32 = lane & 31, hw = lane >> 5;
            for (int row = 2 * (bid * NWAVES + wave) + hw; row < T; row += 2 * G * NWAVES) {
                int dd[4]; float gg[4];
                { const int4 d4 = *(const int4*)(dest + (size_t)row * 4); const float4 g4 = *(const float4*)(top_g + (size_t)row * 4); dd[0] = d4.x; dd[1] = d4.y; dd[2] = d4.z; dd[3] = d4.w; gg[0] = g4.x; gg[1] = g4.y; gg[2] = g4.z; gg[3] = g4.w; }
                float4 v[8]; float s = 0.f;
#pragma unroll
                for (int j = 0; j < 8; ++j) { const int c = (l32 + 32 * j) * 4;
#if RES_BF16
                    const uint2 hv_ = *(const uint2*)(hb + (size_t)row * D + c); const float4 hv = make_float4(__uint_as_float(hv_.x << 16), __uint_as_float(hv_.x & 0xffff0000u), __uint_as_float(hv_.y << 16), __uint_as_float(hv_.y & 0xffff0000u));
#else
                    const float4 hv = *(const float4*)(hf + (size_t)row * D + c);
#endif
                    float4 a; a.x = DN_ALPHA * hv.x; a.y = DN_ALPHA * hv.y; a.z = DN_ALPHA * hv.z; a.w = DN_ALPHA * hv.w;
                    float mo[4] = {0.f, 0.f, 0.f, 0.f};
#pragma unroll
                    for (int k = 0; k < 4; ++k) {
#if YR_FP8 && MOE_FP8 && MOE_GATHER
                        typedef float f32x2_ __attribute__((ext_vector_type(2)));
                        const int yw = *(const int*)((const unsigned char*)yr + (size_t)dd[k] * D + c); const f32x2_ y01 = __builtin_amdgcn_cvt_pk_f32_fp8(yw, false), y23 = __builtin_amdgcn_cvt_pk_f32_fp8(yw, true);
                        mo[0] += gg[k] * y01.x; mo[1] += gg[k] * y01.y; mo[2] += gg[k] * y23.x; mo[3] += gg[k] * y23.y;
#else
                        const uint2 yv = *(const uint2*)(yr + (size_t)dd[k] * D + c);
                        mo[0] += gg[k] * __uint_as_float(yv.x << 16); mo[1] += gg[k] * __uint_as_float(yv.x & 0xffff0000u);
                        mo[2] += gg[k] * __uint_as_float(yv.y << 16); mo[3] += gg[k] * __uint_as_float(yv.y & 0xffff0000u);
#endif
                    }
                    a.x += mo[0]; a.y += mo[1]; a.z += mo[2]; a.w += mo[3];
                    v[j] = a; s += (a.x + a.y) + (a.z + a.w); }
#pragma unroll
                for (int o = 1; o < 32; o <<= 1) s += sh_xor(s, o, lane);
                const float mean = s * (1.0f / D); float s2 = 0.f;
#pragma unroll
                for (int j = 0; j < 8; ++j) { v[j].x -= mean; v[j].y -= mean; v[j].z -= mean; v[j].w -= mean; s2 += (v[j].x * v[j].x + v[j].y * v[j].y) + (v[j].z * v[j].z + v[j].w * v[j].w); }
#pragma unroll
                for (int o = 1; o < 32; o <<= 1) s2 += sh_xor(s2, o, lane);
                const float rstd = 1.0f / sqrtf(s2 * (1.0f / D) + LN_EPS);
#pragma unroll
                for (int j = 0; j < 8; ++j) { const int c = (l32 + 32 * j) * 4; const float4 gv = *(const float4*)(g2 + c), bv = *(const float4*)(b2 + c);
                    float4 o; o.x = v[j].x * rstd * gv.x + bv.x; o.y = v[j].y * rstd * gv.y + bv.y; o.z = v[j].z * rstd * gv.z + bv.z; o.w = v[j].w * rstd * gv.w + bv.w;
                    if (dummy_) *(float4*)(y2 + (size_t)row * D + c) = o;
                    else if (L == DEPTH - 1) *(float4*)(((float*)ARGP(46)) + (size_t)row * D + c) = o;
                    else {
#if !RES_BF16
                        *(float4*)(hf + (size_t)row * D + c) = o;
#endif
                        uint2 ob; ob.x = pg8::cvt_pk_bf16(o.x, o.y); ob.y = pg8::cvt_pk_bf16(o.z, o.w); *(uint2*)(hb + (size_t)row * D + c) = ob; } }
            }
        } }
        SEAM(P + LP_COMB);
    }
#undef IN
#undef SEAM
}

extern "C" void kernel_launch(void* const* d_in, const int* in_sizes, int n_in, void* d_out, int out_size, void* d_ws, size_t ws_size, hipStream_t stream) {
    static int grid = 0;
    if (grid == 0) {
        if (n_in != 46 || out_size != T * D || ws_size < WS_END) { fprintf(stderr, "kernel_launch: unexpected problem (n_in %d, out %d, ws %zu < %zu)\n", n_in, out_size, ws_size, (size_t)WS_END); grid = -1; return; }
        int dev = 0, cus = 0, per_cu = 0;
        if (hipGetDevice(&dev) != hipSuccess || hipDeviceGetAttribute(&cus, hipDeviceAttributeMultiprocessorCount, dev) != hipSuccess) { grid = -1; return; }
        if (hipFuncSetAttribute((const void*)mk_fwd, hipFuncAttributeMaxDynamicSharedMemorySize, LDS_BYTES) != hipSuccess) { fprintf(stderr, "kernel_launch: hipFuncSetAttribute failed\n"); grid = -1; return; }
        if (hipOccupancyMaxActiveBlocksPerMultiprocessor(&per_cu, (const void*)mk_fwd, NTHR, LDS_BYTES) != hipSuccess || per_cu < 1) fprintf(stderr, "kernel_launch: occupancy query says %d\n", per_cu);
        (void)hipGetLastError();
        grid = cus;
    }
    if (grid < 0) return;
    (void)hipMemsetAsync((char*)d_ws + WS_CTL, 0, CTL_BYTES, stream);
    Args a{};
    for (int i = 0; i < 46; ++i) a.in[i] = d_in[i];
    a.out = (float*)d_out; a.ws = (unsigned char*)d_ws;
#if MK_ONE_LAUNCH
    a.ph_lo = 0; a.ph_hi = PH_TOTAL;
    hipLaunchKernelGGL(mk_fwd, dim3(grid), dim3(NTHR), LDS_BYTES, stream, a);
#else
    for (int p = 0; p < PH_TOTAL; ++p) {
        const int j = (p - PH_L0) % PH_PER_LAYER, L = (p - PH_L0) / PH_PER_LAYER;
        if (p >= PH_L0 && j == LP_MIXB && (L % 3) != 0) continue;
        a.ph_lo = p; a.ph_hi = p + 1;
        hipLaunchKernelGGL(mk_fwd, dim3(grid), dim3(NTHR), LDS_BYTES, stream, a);
    }
#endif
}
```

```cpp
#include <hip/hip_runtime.h>
#include <cstdio>
#include <cstdint>

#ifndef MK_ONE_LAUNCH
#define MK_ONE_LAUNCH 1
#endif

#ifndef FAST_DENSE
#define FAST_DENSE 1
#endif
#ifndef FAST_MOE
#define FAST_MOE 1
#endif
#ifndef REP_MASK
#define REP_MASK 0
#endif
#define REPS(k) for (int rep_ = 0; rep_ < 1 + ((REP_MASK >> (k)) & 1); ++rep_)
#ifndef FAST_S5
#define FAST_S5 1
#endif
#ifndef MOE_SPARSE
#define MOE_SPARSE 0
#endif
#ifndef YR_FP8
#define YR_FP8 0
#endif
#ifndef NT_STORES
#define NT_STORES 0
#endif
#ifndef WT_STORES
#define WT_STORES 0
#endif
#ifndef RES_BF16
#define RES_BF16 1
#endif
#ifndef BG_ALL
#define BG_ALL 1
#endif
#ifndef LINATT_V2
#define LINATT_V2 1
#endif
#ifndef MOE_FP8
#define MOE_FP8 1
#endif
#ifndef MOE_GATHER
#define MOE_GATHER 1
#endif
#ifndef BG_CONV
#define BG_CONV 1
#endif
#ifndef FAST_LN1
#define FAST_LN1 1
#endif
#ifndef FAST_XATTN
#define FAST_XATTN 1
#endif
#ifndef FAST_LINATT
#define FAST_LINATT 1
#endif
#define LAS __attribute__((address_space(3)))
typedef unsigned short bf16;

#ifndef MOE_SPARSE
#define MOE_SPARSE 0
#endif
#if MOE_SPARSE
#define MOE_SPARSE_ROWS (32 * 16384)
#else
#define MOE_SPARSE_ROWS (16384 * 4 + 32 * 256)
#endif
constexpr int NB = 8, SEQ = 2048, T = NB * SEQ, D = 1024, MIXW = 768, XW = 256, NMEM = 256, DEPTH = 4;
constexpr int NEXP = 32, TOPK = 4, DEXP = 1024, MOEBLK = 256;
constexpr int NROWS_MAX = MOE_SPARSE_ROWS;
constexpr int LDP = 2816;
constexpr float LN_EPS = 1e-5f;
constexpr float DN_ALPHA = 1.6817928305074290f;
constexpr int NWAVES = 8, NTHR = 512;

constexpr size_t MiB = (size_t)1 << 20;
constexpr size_t WS_CTL = 0, CTL_BYTES = 1 * MiB;
constexpr size_t WS_HF = 1 * MiB;
constexpr size_t WS_Y2 = WS_HF + (size_t)T * D * 4;
constexpr size_t WS_HB = WS_Y2 + (size_t)T * D * 4;
constexpr size_t WS_PROJ = WS_HB + (size_t)T * D * 2;
constexpr size_t WS_YG = WS_PROJ + (size_t)T * LDP * 2;
constexpr size_t WS_CAT = WS_YG + (size_t)T * MIXW * 2;
constexpr size_t WS_TOPE = WS_CAT + (size_t)T * D * 2;
constexpr size_t WS_TOPG = WS_TOPE + (size_t)T * 4 * 4;
constexpr size_t WS_DEST = WS_TOPG + (size_t)T * 4 * 4;
constexpr size_t WS_XR = WS_DEST + (size_t)T * 4 * 4;
constexpr size_t WS_ACT = WS_XR + (size_t)(T * TOPK + NEXP * MOEBLK) * D * 2;
constexpr size_t WS_YR = WS_ACT + (size_t)NROWS_MAX * DEXP * 2;
constexpr size_t WS_MEMK = WS_YR + (size_t)NROWS_MAX * D * 2;
constexpr size_t WS_MEMV = WS_MEMK + 1 * MiB;
constexpr size_t WS_MEMVT = WS_MEMV + 1 * MiB;
constexpr size_t WS_ROPE = WS_MEMVT + 1 * MiB;
constexpr size_t WS_WIN = WS_ROPE + (size_t)T * 48 * 2 * 4;
constexpr size_t WS_WGLU = WS_WIN + 4 * 6 * MiB;
constexpr size_t WS_WOUT = WS_WGLU + 2 * 2 * MiB;
constexpr size_t WS_WMEM = WS_WOUT + 4 * 2 * MiB;
constexpr size_t WS_MEMB = WS_WMEM + 1 * MiB;
constexpr size_t WS_WGU = WS_MEMB + 4 * MiB;
constexpr size_t WS_WDN = WS_WGU + (size_t)DEPTH * NEXP * 2 * DEXP * D * 2;
constexpr size_t WS_RWT = WS_WDN + (size_t)DEPTH * NEXP * D * DEXP * 2;
constexpr size_t WS_RTOK = WS_RWT + (size_t)DEPTH * 2 * NEXP * D * 2;
constexpr size_t WS_END = WS_RTOK + (size_t)NROWS_MAX * 4;
constexpr int CW_BAR = 4096;
constexpr int CW_CNT = 16384;
constexpr int CW_CUR = 16384 + 1024;
constexpr int CW_CQ = 16384 + 2048;

constexpr int LDS_BYTES = 163840;
constexpr int LDS_RMAP = 147456;
constexpr int LDS_MISC = 131072 + 8192;

__device__ __forceinline__ float bf2f(bf16 v) { return __uint_as_float(((unsigned)v) << 16); }
__device__ __forceinline__ bf16 f2bf(float f) { unsigned u = __float_as_uint(f); return (bf16)((u + 0x7fffu + ((u >> 16) & 1u)) >> 16); }
__device__ __forceinline__ unsigned pk2(float lo, float hi) { return (unsigned)f2bf(lo) | ((unsigned)f2bf(hi) << 16); }
__device__ __forceinline__ int sh_idx_i(int v, int src, int) { return __builtin_amdgcn_ds_bpermute(src << 2, v); }
__device__ __forceinline__ float sh_idx(float v, int src, int lane) { return __int_as_float(sh_idx_i(__float_as_int(v), src, lane)); }
__device__ __forceinline__ unsigned sh_idx(unsigned v, int src, int lane) { return (unsigned)sh_idx_i((int)v, src, lane); }
__device__ __forceinline__ float sh_xor(float v, int m, int lane) { return __int_as_float(__builtin_amdgcn_ds_bpermute((lane ^ m) << 2, __float_as_int(v))); }
__device__ __forceinline__ int sh_xor(int v, int m, int lane) { return __builtin_amdgcn_ds_bpermute((lane ^ m) << 2, v); }
__device__ __forceinline__ float sh_up(float v, int d, int lane) { const int s = lane - d; return __int_as_float(__builtin_amdgcn_ds_bpermute((s < 0 ? lane : s) << 2, __float_as_int(v))); }
__device__ __forceinline__ float wave_sum(float v, int lane) {
#pragma unroll
    for (int o = 1; o < 64; o <<= 1) v += sh_xor(v, o, lane);
    return v;
}
__device__ __forceinline__ float sigmoidf(float x) { return __builtin_amdgcn_rcpf(1.0f + __expf(-x)); }
__device__ __forceinline__ void unpack8(uint4 v, float* f) {
    f[0] = __uint_as_float(v.x << 16); f[1] = __uint_as_float(v.x & 0xffff0000u);
    f[2] = __uint_as_float(v.y << 16); f[3] = __uint_as_float(v.y & 0xffff0000u);
    f[4] = __uint_as_float(v.z << 16); f[5] = __uint_as_float(v.z & 0xffff0000u);
    f[6] = __uint_as_float(v.w << 16); f[7] = __uint_as_float(v.w & 0xffff0000u);
}
__device__ __forceinline__ void sincos_rad(float ang, float& s, float& c) {
    float r = ang * 0.15915494309189535f; r -= rintf(r);
    s = __builtin_amdgcn_sinf(r); c = __builtin_amdgcn_cosf(r);
}
__device__ __forceinline__ float gelu_tanh(float x) {
    const float u = 0.7978845608028654f * (x + 0.044715f * x * x * x);
    const float e = __expf(2.0f * u);
    const float th = 1.0f - 2.0f / (e + 1.0f);
    return 0.5f * x * (1.0f + th);
}

__device__ __forceinline__ int lane_id_opaque() { int l; asm volatile("v_mbcnt_lo_u32_b32 %0, -1, 0\n\tv_mbcnt_hi_u32_b32 %0, -1, %0" : "=v"(l)); return l; }
__device__ __forceinline__ bool wg_leader(int wave) { return wave == 0 && lane_id_opaque() == 0; }

#define XB_TMO      128
#define XB_XCNT(j)  (256  + 64 * (j))
#define XB_XSUB(j)  (1280 + 64 * (j))
#define XB_XGEN(j)  (2304 + 64 * (j))
#define XB_TOP      3328
#define XB_TOPGEN   3392
#define XCD_BAR_WORDS 3456
#define XB_SPIN_CAP (1u << 24)
__device__ __forceinline__ unsigned xb_ld(unsigned* p)              { return __hip_atomic_load(p, __ATOMIC_RELAXED, __HIP_MEMORY_SCOPE_AGENT); }
__device__ __forceinline__ unsigned xb_add(unsigned* p, unsigned v) { return __hip_atomic_fetch_add(p, v, __ATOMIC_RELAXED, __HIP_MEMORY_SCOPE_AGENT); }
__device__ __forceinline__ unsigned xb_xcc_id() { return (unsigned)__builtin_amdgcn_s_getreg((3 << 11) | 20) & 0xFu; }
#define XB_SPIN(cond, bar) do { unsigned _sp = 0; while (cond) { __builtin_amdgcn_s_sleep(1); \
    if ((++_sp & 255u) == 0u) { if (xb_ld(&(bar)[XB_TMO])) break; if (_sp > XB_SPIN_CAP) { atomicAdd(&(bar)[XB_TMO], 1u); break; } } } } while (0)
struct XcdBarrier { unsigned* bar; unsigned x; volatile LAS unsigned* st; };
__device__ __forceinline__ XcdBarrier xcd_barrier_post(unsigned* bar, volatile LAS unsigned* st, int wave) {
    XcdBarrier b; b.bar = bar; b.x = xb_xcc_id(); b.st = st;
    if (wg_leader(wave)) (void)xb_add(&bar[XB_XCNT(b.x)], 1u);
    return b;
}
__device__ __forceinline__ void xcd_barrier_complete(unsigned* bar, unsigned x, unsigned& nloc, unsigned& nx) {
    const unsigned G = gridDim.x * gridDim.y * gridDim.z;
    unsigned sum, cnt, mine, sp = 0u;
    for (;;) {
        sum = 0u; cnt = 0u; mine = 0u;
#pragma unroll
        for (unsigned j = 0; j < 16; ++j) { const unsigned c = xb_ld(&bar[XB_XCNT(j)]); sum += c; cnt += (c > 0u) ? 1u : 0u; mine = (j == x) ? c : mine; }
        if (sum == G) break;
        __builtin_amdgcn_s_sleep(1);
        if ((++sp & 255u) == 0u) { if (xb_ld(&bar[XB_TMO])) break; if (sp > XB_SPIN_CAP) { atomicAdd(&bar[XB_TMO], 1u); break; } }
    }
    nloc = mine > 0u ? mine : 1u; nx = cnt > 0u ? cnt : 1u;
}
__device__ __forceinline__ void xcd_barrier(const XcdBarrier& b, int wave) {
    asm volatile("s_waitcnt vmcnt(0)" ::: "memory");
    __syncthreads();
    if (wg_leader(wave)) {
        unsigned* bar = b.bar; asm volatile("" : "+s"(bar));
        __builtin_amdgcn_s_waitcnt(0);
        unsigned nloc = b.st[0], nx = b.st[1];
        if (nloc == 0u) { xcd_barrier_complete(bar, b.x, nloc, nx); b.st[0] = nloc; b.st[1] = nx; }
        const unsigned old = xb_add(&bar[XB_XSUB(b.x)], 1u);
        const unsigned gen = old / nloc;
        if (old + 1u == (gen + 1u) * nloc) {
            __builtin_amdgcn_fence(__ATOMIC_RELEASE, "agent");
            asm volatile("s_waitcnt vmcnt(0)" ::: "memory");
            const unsigned og = xb_add(&bar[XB_TOP], 1u);
            const unsigned tg = og / nx;
            if (og + 1u == (tg + 1u) * nx) xb_add(&bar[XB_TOPGEN], 1u);
            else XB_SPIN(xb_ld(&bar[XB_TOPGEN]) == tg, bar);
            __builtin_amdgcn_fence(__ATOMIC_ACQUIRE, "agent");
            xb_add(&bar[XB_XGEN(b.x)], 1u);
            asm volatile("s_waitcnt vmcnt(0)" ::: "memory");
        } else {
            XB_SPIN(xb_ld(&bar[XB_XGEN(b.x)]) == gen, bar);
            __builtin_amdgcn_fence(__ATOMIC_ACQUIRE, "agent");
            asm volatile("s_waitcnt vmcnt(0)" ::: "memory");
        }
    }
    __syncthreads();
}


namespace pg8 {
#define PG8_LAS __attribute__((address_space(3)))
typedef unsigned short bf16_t;
typedef short bf16x8 __attribute__((ext_vector_type(8)));
typedef float f32x4 __attribute__((ext_vector_type(4)));
typedef unsigned u32x4 __attribute__((ext_vector_type(4)));
typedef unsigned u32x2 __attribute__((ext_vector_type(2)));
typedef int i32x4 __attribute__((ext_vector_type(4)));
typedef int i32x8 __attribute__((ext_vector_type(8)));
constexpr int BM = 256, BK = 64, HALF = 128, HTB = HALF * BK * 2, STAGE_BYTES = 8 * HTB, NXCD = 8, WGM = 8;
__host__ __device__ __forceinline__ int lds_byte(int r, int c) { const int st = (r >> 4) * 2 + (c >> 5), rr = r & 15, cc = c & 31, ob = rr * 64 + cc * 2; return st * 1024 + (ob ^ (((ob >> 9) & 1) << 5)); }
__host__ __device__ __forceinline__ void stage_rc(int b, int& R, int& C) { const int st = b / 1024, sb = b % 1024, swz = sb ^ (((sb >> 9) & 1) << 5); R = (st >> 1) * 16 + swz / 64; C = (st & 1) * 32 + (swz % 64) / 2; }
__host__ __device__ __forceinline__ int perm32(int rho) { const int n = rho >> 4, i = rho & 15; return 8 * (i >> 2) + 4 * n + (i & 3); }
struct Unit { int pm, pn, pb, e; };
struct Gemm { const bf16_t* A; const bf16_t* Bt; int K; const PG8_LAS int* rowmap; };
struct StaticOrder {
    int nM, nN, nwg, G, c;
    __device__ __forceinline__ void init(int M, int N, int G_, int c_) { nM = M / BM; nN = N / BM; nwg = nM * nN; G = G_; c = c_; }
    __device__ __forceinline__ bool next(int i, Unit& u) const {
        const long L = (long)i * G + c; if (L >= nwg) return false;
        int wgid = (int)L; { const int q = nwg / NXCD, r = nwg % NXCD, xcd = wgid % NXCD, off = wgid / NXCD; wgid = (xcd < r ? xcd * (q + 1) : r * (q + 1) + (xcd - r) * q) + off; }
        const int nig = WGM * nN, gid = wgid / nig, fm = gid * WGM, gsz = (nM - fm) < WGM ? (nM - fm) : WGM;
        u.pm = fm + ((wgid % nig) % gsz); u.pn = (wgid % nig) / gsz; u.pb = u.pn; u.e = 0; return true;
    }
    __device__ __forceinline__ void a_ready(const Unit&) const {}
    __device__ __forceinline__ void done(const Unit&) const {}
};
struct MoeOrder {
    const PG8_LAS int* pend; int nb, ntn, G, vc;
    __device__ __forceinline__ bool next(int i, Unit& u) const {
        const int U = nb * ntn, per = G >> 3, chunk = (U + 7) >> 3, x = vc / per, r = vc - x * per;
        const int off = i * per + r; if (off >= chunk) return false;
        const long L = (long)x * chunk + off; if (L >= (long)U) return false;
        const int rb = (int)(L / ntn), pn = (int)(L % ntn); const int start = rb * 256; int e = 0, prev = 0;
#pragma unroll
        for (int j = 0; j < 32; ++j) { const int pj = pend[j]; if (start >= pj) { e += 1; prev = pj; } }
        e = e < 31 ? e : 31; e = __builtin_amdgcn_readfirstlane(e); prev = __builtin_amdgcn_readfirstlane(prev);
#if MOE_SPARSE
        u.pm = e * (16384 / 256) + (rb - prev / 256);
#else
        u.pm = rb;
#endif
        u.pn = pn; u.pb = e * ntn + pn; u.e = e; return true;
    }
    __device__ __forceinline__ void a_ready(const Unit&) const {}
    __device__ __forceinline__ void done(const Unit&) const {}
};
__device__ __forceinline__ unsigned cvt_pk_bf16(float lo, float hi) { unsigned r; asm volatile("v_cvt_pk_bf16_f32 %0, %1, %2" : "=v"(r) : "v"(lo), "v"(hi)); return r; }
__device__ __forceinline__ float fsig(float x) { return __builtin_amdgcn_rcpf(1.0f + __expf(-x)); }
#if WT_STORES
__device__ __forceinline__ void st16(void* p, u32x4 v) { asm volatile("global_store_dwordx4 %0, %1, off sc1\n\ts_nop 0" :: "v"(p), "v"(v) : "memory"); }
__device__ __forceinline__ void st8(void* p, u32x2 v) { asm volatile("global_store_dwordx2 %0, %1, off sc1\n\ts_nop 0" :: "v"(p), "v"(v) : "memory"); }
#elif NT_STORES
__device__ __forceinline__ void st16(void* p, u32x4 v) { __builtin_nontemporal_store(v, (u32x4*)p); }
__device__ __forceinline__ void st8(void* p, u32x2 v) { __builtin_nontemporal_store(v, (u32x2*)p); }
#else
__device__ __forceinline__ void st16(void* p, u32x4 v) { *(u32x4*)p = v; }
__device__ __forceinline__ void st8(void* p, u32x2 v) { *(u32x2*)p = v; }
#endif
template <bool OUT8> struct EpiBf16T {
    static constexpr bool PERM = true, AFTER_DRAIN = false;
    void* O; int ldc; const float* bias; int bias_estride; float scale;
    __device__ __forceinline__ void operator()(const f32x4 (&acc)[2][2][4][2], const Unit& u, int wr, int wc, int fr, int fq) const {
        const int row0 = u.pm * BM + wr * 64 + fr, col0 = u.pn * BM + wc * 32 + 8 * fq;
        f32x4 bv[2][2];
#pragma unroll
        for (int bj = 0; bj < 2; ++bj)
#pragma unroll
            for (int n = 0; n < 2; ++n) bv[bj][n] = bias ? *(const f32x4*)(bias + (size_t)u.e * bias_estride + col0 + bj * HALF + 4 * n) : (f32x4){0.f, 0.f, 0.f, 0.f};
#pragma unroll
        for (int ai = 0; ai < 2; ++ai)
#pragma unroll
            for (int m = 0; m < 4; ++m) { const size_t ro = (size_t)(row0 + ai * HALF + m * 16) * ldc + col0;
#pragma unroll
                for (int bj = 0; bj < 2; ++bj) { const f32x4 v0 = acc[ai][bj][m][0] * scale + bv[bj][0], v1 = acc[ai][bj][m][1] * scale + bv[bj][1];
                    if constexpr (OUT8) { int w0 = __builtin_amdgcn_cvt_pk_fp8_f32(v0[0], v0[1], 0, false); w0 = __builtin_amdgcn_cvt_pk_fp8_f32(v0[2], v0[3], w0, true); int w1 = __builtin_amdgcn_cvt_pk_fp8_f32(v1[0], v1[1], 0, false); w1 = __builtin_amdgcn_cvt_pk_fp8_f32(v1[2], v1[3], w1, true);
                        u32x2 w; w.x = (unsigned)w0; w.y = (unsigned)w1; st8((unsigned char*)O + ro + bj * HALF, w); }
                    else { u32x4 w; w.x = cvt_pk_bf16(v0[0], v0[1]); w.y = cvt_pk_bf16(v0[2], v0[3]); w.z = cvt_pk_bf16(v1[0], v1[1]); w.w = cvt_pk_bf16(v1[2], v1[3]);
                        st16((bf16_t*)O + ro + bj * HALF, w); } } }
    }
};
typedef EpiBf16T<false> EpiBf16;
struct EpiGlu {
    static constexpr bool PERM = true, AFTER_DRAIN = false;
    bf16_t* O; int ldc; const bf16_t* Y; int ldy; const float* bias;
    __device__ __forceinline__ void operator()(const f32x4 (&acc)[2][2][4][2], const Unit& u, int wr, int wc, int fr, int fq) const {
        const int row0 = u.pm * BM + wr * 64 + fr, col0 = u.pn * BM + wc * 32 + 8 * fq;
        f32x4 bv[2][2];
#pragma unroll
        for (int bj = 0; bj < 2; ++bj)
#pragma unroll
            for (int n = 0; n < 2; ++n) bv[bj][n] = *(const f32x4*)(bias + col0 + bj * HALF + 4 * n);
#pragma unroll
        for (int ai = 0; ai < 2; ++ai)
#pragma unroll
            for (int m = 0; m < 4; ++m) { const size_t r = (size_t)(row0 + ai * HALF + m * 16);
#pragma unroll
                for (int bj = 0; bj < 2; ++bj) { const int c = col0 + bj * HALF; const u32x4 yv = *(const u32x4*)(Y + r * ldy + c);
                    const f32x4 z0 = acc[ai][bj][m][0] + bv[bj][0], z1 = acc[ai][bj][m][1] + bv[bj][1];
                    float y[8]; y[0] = __uint_as_float(yv.x << 16); y[1] = __uint_as_float(yv.x & 0xffff0000u); y[2] = __uint_as_float(yv.y << 16); y[3] = __uint_as_float(yv.y & 0xffff0000u);
                    y[4] = __uint_as_float(yv.z << 16); y[5] = __uint_as_float(yv.z & 0xffff0000u); y[6] = __uint_as_float(yv.w << 16); y[7] = __uint_as_float(yv.w & 0xffff0000u);
                    u32x4 w; w.x = cvt_pk_bf16(y[0] * fsig(z0[0]), y[1] * fsig(z0[1])); w.y = cvt_pk_bf16(y[2] * fsig(z0[2]), y[3] * fsig(z0[3]));
                    w.z = cvt_pk_bf16(y[4] * fsig(z1[0]), y[5] * fsig(z1[1])); w.w = cvt_pk_bf16(y[6] * fsig(z1[2]), y[7] * fsig(z1[3]));
                    st16(O + r * ldc + c, w); } }
    }
};
struct EpiResF32 {
    static constexpr bool PERM = false, AFTER_DRAIN = false;
    float* C; const float* R; int ldc; float alpha;
    __device__ __forceinline__ void operator()(const f32x4 (&acc)[2][2][4][2], const Unit& u, int wr, int wc, int fr, int fq) const {
        const int row0 = u.pm * BM + wr * 64 + fr, col0 = u.pn * BM + wc * 32 + 4 * fq;
#pragma unroll
        for (int ai = 0; ai < 2; ++ai)
#pragma unroll
            for (int m = 0; m < 4; ++m) { const size_t off = (size_t)(row0 + ai * HALF + m * 16) * ldc + col0;
#pragma unroll
                for (int bj = 0; bj < 2; ++bj)
#pragma unroll
                    for (int n = 0; n < 2; ++n) { const f32x4 rv = *(const f32x4*)(R + off + bj * HALF + n * 16); *(f32x4*)(C + off + bj * HALF + n * 16) = rv * alpha + acc[ai][bj][m][n]; } }
    }
};
struct EpiResBf16 {
    static constexpr bool PERM = true, AFTER_DRAIN = false;
    bf16_t* O; const bf16_t* R; int ldc; float alpha;
    __device__ __forceinline__ void operator()(const f32x4 (&acc)[2][2][4][2], const Unit& u, int wr, int wc, int fr, int fq) const {
        const int row0 = u.pm * BM + wr * 64 + fr, col0 = u.pn * BM + wc * 32 + 8 * fq;
#pragma unroll
        for (int ai = 0; ai < 2; ++ai)
#pragma unroll
            for (int m = 0; m < 4; ++m) { const size_t off = (size_t)(row0 + ai * HALF + m * 16) * ldc + col0;
#pragma unroll
                for (int bj = 0; bj < 2; ++bj) { const u32x4 rv = *(const u32x4*)(R + off + bj * HALF); const f32x4 a0 = acc[ai][bj][m][0], a1 = acc[ai][bj][m][1];
                    u32x4 w; w.x = cvt_pk_bf16(__uint_as_float(rv.x << 16) * alpha + a0[0], __uint_as_float(rv.x & 0xffff0000u) * alpha + a0[1]); w.y = cvt_pk_bf16(__uint_as_float(rv.y << 16) * alpha + a0[2], __uint_as_float(rv.y & 0xffff0000u) * alpha + a0[3]);
                    w.z = cvt_pk_bf16(__uint_as_float(rv.z << 16) * alpha + a1[0], __uint_as_float(rv.z & 0xffff0000u) * alpha + a1[1]); w.w = cvt_pk_bf16(__uint_as_float(rv.w << 16) * alpha + a1[2], __uint_as_float(rv.w & 0xffff0000u) * alpha + a1[3]);
                    st16(O + off + bj * HALF, w); } }
    }
};
template <bool OUT8> struct EpiSwiglu {
    static constexpr bool PERM = true, AFTER_DRAIN = false;
    void* O; const float* bgu; float scale;
    __device__ __forceinline__ void operator()(const f32x4 (&acc)[2][2][4][2], const Unit& u, int wr, int wc, int fr, int fq) const {
        const int row0 = u.pm * BM + wr * 64 + fr, cidx = u.pn * HALF + wc * 32 + 8 * fq;
        const float* bg = bgu + (size_t)u.e * 2048 + cidx;
        f32x4 bG[2], bL[2];
#pragma unroll
        for (int n = 0; n < 2; ++n) { bG[n] = *(const f32x4*)(bg + 4 * n); bL[n] = *(const f32x4*)(bg + 1024 + 4 * n); }
#pragma unroll
        for (int ai = 0; ai < 2; ++ai)
#pragma unroll
            for (int m = 0; m < 4; ++m) { const size_t ro = (size_t)(row0 + ai * HALF + m * 16) * 1024 + cidx; float o[8];
#pragma unroll
                for (int n = 0; n < 2; ++n) { const f32x4 g = acc[ai][0][m][n] * scale + bG[n], l = acc[ai][1][m][n] * scale + bL[n];
#pragma unroll
                    for (int j = 0; j < 4; ++j) { const float xg = fminf(g[j], 7.0f), xl = fminf(fmaxf(l[j], -7.0f), 7.0f); o[4 * n + j] = xg * fsig(1.702f * xg) * (xl + 1.0f); } }
                if constexpr (OUT8) { int w0 = __builtin_amdgcn_cvt_pk_fp8_f32(o[0], o[1], 0, false); w0 = __builtin_amdgcn_cvt_pk_fp8_f32(o[2], o[3], w0, true); int w1 = __builtin_amdgcn_cvt_pk_fp8_f32(o[4], o[5], 0, false); w1 = __builtin_amdgcn_cvt_pk_fp8_f32(o[6], o[7], w1, true);
                    u32x2 w; w.x = (unsigned)w0; w.y = (unsigned)w1; st8((unsigned char*)O + ro, w); }
                else { u32x4 w; w.x = cvt_pk_bf16(o[0], o[1]); w.y = cvt_pk_bf16(o[2], o[3]); w.z = cvt_pk_bf16(o[4], o[5]); w.w = cvt_pk_bf16(o[6], o[7]);
                    st16((bf16_t*)O + ro, w); } }
    }
};
struct EpiMem {
    static constexpr bool PERM = false, AFTER_DRAIN = false;
    bf16_t* mk; bf16_t* mv; bf16_t* mvt;
    __device__ __forceinline__ void operator()(const f32x4 (&acc)[2][2][4][2], const Unit& u, int wr, int wc, int fr, int fq) const {
        const int row0 = u.pm * BM + wr * 64 + fr, col0 = u.pn * BM + wc * 32 + 4 * fq;
#pragma unroll
        for (int ai = 0; ai < 2; ++ai)
#pragma unroll
            for (int m = 0; m < 4; ++m) { const int r = row0 + ai * HALF + m * 16, b = r >> 8, key = r & 255;
#pragma unroll
                for (int bj = 0; bj < 2; ++bj)
#pragma unroll
                    for (int n = 0; n < 2; ++n) { const int c = col0 + bj * HALF + n * 16, cc = c & 255, head = cc >> 6, d = cc & 63; const f32x4 v = acc[ai][bj][m][n];
                        u32x2 w; w.x = cvt_pk_bf16(v[0], v[1]); w.y = cvt_pk_bf16(v[2], v[3]);
                        const size_t o = ((size_t)(b * 4 + head) * 256 + key) * 64 + d;
                        if (c < 256) *(u32x2*)(mk + o) = w;
                        else { *(u32x2*)(mv + o) = w; bf16_t* t = mvt + ((size_t)(b * 4 + head) * 64 + d) * 256 + key;
                            t[0] = (bf16_t)(w.x & 0xffffu); t[256] = (bf16_t)(w.x >> 16); t[512] = (bf16_t)(w.y & 0xffffu); t[768] = (bf16_t)(w.y >> 16); } } }
    }
};
template <class Epi, class Sched, bool ALIGN_EPI = true, bool SP2 = true, bool GATHER = false, bool FP8 = false>
__device__ __forceinline__ void gemm_phase(PG8_LAS unsigned char* lds, const Gemm g, const Sched& S, const Epi& E, const int wave_) {
    const int tid_ = wave_ * 64 + lane_id_opaque();
    const int tid = tid_, wid = wave_, lane = tid & 63, wr = wid >> 2, wc = wid & 3, fr = lane & 15, fq = lane >> 4;
    const int K = g.K, rowb = FP8 ? K : 2 * K  , nt = rowb / (BK * 2);
    unsigned voffA[2], voffB[2];
#pragma unroll
    for (int i = 0; i < 2; ++i) { int R, C; stage_rc(tid * 16 + i * 8192, R, C); const int Rb = Epi::PERM ? ((R & ~31) + perm32(R & 31)) : R;
        voffA[i] = (unsigned)(R * rowb + C * 2); voffB[i] = (unsigned)(Rb * rowb + C * 2); }
    const size_t kstep = (size_t)(BK * 2);
    const size_t hstep = (size_t)HALF * rowb;
    const size_t tstep = 2 * hstep;
    const unsigned ldsw = (unsigned)wid * 1024u;
    int aoffv[2], boffv[2];
#pragma unroll
    for (int k = 0; k < 2; ++k) { const int p = FP8 ? 2 * fq + k : 4 * k + fq; aoffv[k] = lds_byte(wr * 64 + fr, (p & 3) * 8) + (p >> 2) * 1024; boffv[k] = lds_byte(wc * 32 + fr, (p & 3) * 8) + (p >> 2) * 1024; }
#define PG8_SA(b, h) (((b) * 2 + (h)) * HTB)
#define PG8_SB(b, h) ((4 + (b) * 2 + (h)) * HTB)
#define PG8_STAGE(bufoff, gbase, voff) do { _Pragma("unroll") for (int _i = 0; _i < 2; ++_i) \
        __builtin_amdgcn_global_load_lds((const unsigned*)((const char*)(gbase) + (voff)[_i]), (PG8_LAS unsigned*)(lds + (bufoff) + ldsw + _i * 8192), 16, 0, 0); } while (0)
#define PG8_VSEL_0(h, i) vgC[h][i]
#define PG8_VSEL_1(h, i) (last ? vgX[h][i] : vgC[h][i])
#define PG8_STAGE_A(bufoff, gbase, h, set) do { if constexpr (GATHER) { _Pragma("unroll") for (int _i = 0; _i < 2; ++_i) \
        __builtin_amdgcn_global_load_lds((const unsigned*)((const char*)(gbase) + PG8_VSEL_##set(h, _i)), (PG8_LAS unsigned*)(lds + (bufoff) + ldsw + _i * 8192), 16, 0, 0); } \
    else { PG8_STAGE(bufoff, (gbase) + (h) * hstep, voffA); } } while (0)
#define PG8_LDA(dst, b, h) do { if constexpr (FP8) { _Pragma("unroll") for (int m = 0; m < 4; ++m) { const i32x4 lo_ = *(const PG8_LAS i32x4*)(lds + PG8_SA(b, h) + aoffv[0] + m * 2048), hi_ = *(const PG8_LAS i32x4*)(lds + PG8_SA(b, h) + aoffv[1] + m * 2048); dst##8[m] = __builtin_shufflevector(lo_, hi_, 0, 1, 2, 3, 4, 5, 6, 7); } } \
    else { _Pragma("unroll") for (int m = 0; m < 4; ++m) _Pragma("unroll") for (int k = 0; k < 2; ++k) dst[m][k] = *(const PG8_LAS bf16x8*)(lds + PG8_SA(b, h) + aoffv[k] + m * 2048); } } while (0)
#define PG8_LDB(dst, b, h) do { if constexpr (FP8) { _Pragma("unroll") for (int n = 0; n < 2; ++n) { const i32x4 lo_ = *(const PG8_LAS i32x4*)(lds + PG8_SB(b, h) + boffv[0] + n * 2048), hi_ = *(const PG8_LAS i32x4*)(lds + PG8_SB(b, h) + boffv[1] + n * 2048); dst##8[n] = __builtin_shufflevector(lo_, hi_, 0, 1, 2, 3, 4, 5, 6, 7); } } \
    else { _Pragma("unroll") for (int n = 0; n < 2; ++n) _Pragma("unroll") for (int k = 0; k < 2; ++k) dst[n][k] = *(const PG8_LAS bf16x8*)(lds + PG8_SB(b, h) + boffv[k] + n * 2048); } } while (0)
#define PG8_MMA(ai, bj, At, Bt) do { __builtin_amdgcn_s_setprio(1); _Pragma("unroll") for (int m = 0; m < 4; ++m) _Pragma("unroll") for (int n = 0; n < 2; ++n) { \
        if constexpr (FP8) { acc[ai][bj][m][n] = __builtin_amdgcn_mfma_scale_f32_16x16x128_f8f6f4(Bt##8[n], At##8[m], acc[ai][bj][m][n], 0, 0, 0, 0x7f7f7f7f, 0, 0x7f7f7f7f); } \
        else { _Pragma("unroll") for (int k = 0; k < 2; ++k) acc[ai][bj][m][n] = __builtin_amdgcn_mfma_f32_16x16x32_bf16(Bt[n][k], At[m][k], acc[ai][bj][m][n], 0, 0, 0); } } \
        if constexpr (FP8) { _Pragma("unroll") for (int m = 0; m < 4; ++m) asm volatile("" : "+v"(acc[ai][bj][m][0]), "+v"(acc[ai][bj][m][1])); }     \
        __builtin_amdgcn_s_setprio(0); } while (0)
#define PG8_WAIT_V(n) asm volatile("s_waitcnt vmcnt(" #n ")" ::: "memory")
#define PG8_WAIT_L(n) asm volatile("s_waitcnt lgkmcnt(" #n ")" ::: "memory")
#define PG8_BAR __builtin_amdgcn_s_barrier()
#define PG8_SCHED __builtin_amdgcn_sched_barrier(0)
    Unit cur, nxt; int ui = 0;
    if (!S.next(0, cur)) return;
    f32x4 acc[2][2][4][2];
#pragma unroll
    for (int a = 0; a < 2; ++a)
#pragma unroll
        for (int b = 0; b < 2; ++b)
#pragma unroll
            for (int m = 0; m < 4; ++m)
#pragma unroll
                for (int n = 0; n < 2; ++n) acc[a][b][m][n] = (f32x4){0.f, 0.f, 0.f, 0.f};
    bf16x8 At[4][2], B0[2][2], B1[2][2];
    i32x8 At8[4], B08[2], B18[2];
    unsigned vgC[2][2], vgX[2][2];
#define PG8_GOFF(dst, pm_) do { const int t_ = wave_ * 64 + lane_id_opaque();   _Pragma("unroll") for (int _i = 0; _i < 2; ++_i) { int gR_, gC_; stage_rc(t_ * 16 + _i * 8192, gR_, gC_); _Pragma("unroll") for (int _h = 0; _h < 2; ++_h) \
        dst[_h][_i] = (unsigned)(g.rowmap[(pm_) * BM + _h * HALF + gR_] * rowb + gC_ * 2); } } while (0)
    if constexpr (GATHER) { PG8_GOFF(vgC, 0); }
    const char* cA = GATHER ? (const char*)g.A : (const char*)g.A + (size_t)cur.pm * tstep; const char* cB = (const char*)g.Bt + (size_t)cur.pb * tstep;
    S.a_ready(cur);
    if constexpr (SP2) {
        PG8_STAGE(PG8_SB(0, 0), cB, voffB); PG8_STAGE(PG8_SB(0, 1), cB + hstep, voffB); PG8_STAGE_A(PG8_SA(0, 0), cA, 0, 0); PG8_STAGE_A(PG8_SA(0, 1), cA, 1, 0);
        if (wr == 1) PG8_BAR;
        PG8_WAIT_V(2); PG8_BAR;
        PG8_STAGE(PG8_SB(1, 0), cB + kstep, voffB); PG8_STAGE_A(PG8_SA(1, 0), cA + kstep, 0, 0); PG8_STAGE(PG8_SB(1, 1), cB + hstep + kstep, voffB);
        PG8_WAIT_V(6); PG8_BAR;
    } else {
        PG8_STAGE(PG8_SB(0, 0), cB, voffB); PG8_STAGE_A(PG8_SA(0, 0), cA, 0, 0); PG8_STAGE(PG8_SB(0, 1), cB + hstep, voffB); PG8_STAGE_A(PG8_SA(0, 1), cA, 1, 0);
        if (wr == 1) PG8_BAR;
        PG8_WAIT_V(4); PG8_BAR;
        PG8_STAGE(PG8_SB(1, 0), cB + kstep, voffB); PG8_STAGE_A(PG8_SA(1, 0), cA + kstep, 0, 0); PG8_STAGE(PG8_SB(1, 1), cB + hstep + kstep, voffB);
        PG8_WAIT_V(6); PG8_BAR;
    }
    for (;;) {
        const bool has_next = S.next(ui + 1, nxt);
        if constexpr (GATHER) { if (has_next) PG8_GOFF(vgX, ui + 1); else { _Pragma("unroll") for (int _h = 0; _h < 2; ++_h) _Pragma("unroll") for (int _i = 0; _i < 2; ++_i) vgX[_h][_i] = vgC[_h][_i]; } }
        const char* nA = GATHER ? (const char*)g.A : (has_next ? (const char*)g.A + (size_t)nxt.pm * tstep : cA); const char* nB = has_next ? (const char*)g.Bt + (size_t)nxt.pb * tstep : cB;
        for (int t = 0; t < nt; t += 2) {
            const bool last = (t == nt - 2);
            const char* a1 = cA + (size_t)(t + 1) * kstep;
            const char* a2 = last ? nA : cA + (size_t)(t + 2) * kstep; const char* b2 = last ? nB : cB + (size_t)(t + 2) * kstep;
            const char* a3 = a2 + kstep; const char* b3 = b2 + kstep;
            if (last && has_next) S.a_ready(nxt);
            if constexpr (SP2) {
            PG8_LDB(B0, 0, 0); PG8_LDB(B1, 0, 1); PG8_SCHED; PG8_LDA(At, 0, 0); PG8_STAGE_A(PG8_SA(1, 1), a1, 1, 0);
            PG8_WAIT_V(8); PG8_WAIT_L(0); PG8_BAR; PG8_MMA(0, 0, At, B0); PG8_MMA(0, 1, At, B1); PG8_BAR; PG8_SCHED;
            PG8_LDA(At, 0, 1); PG8_STAGE(PG8_SB(0, 0), b2, voffB); PG8_STAGE(PG8_SB(0, 1), b2 + hstep, voffB); PG8_STAGE_A(PG8_SA(0, 0), a2, 0, 1);
            PG8_WAIT_V(8); PG8_WAIT_L(0); PG8_BAR; PG8_MMA(1, 0, At, B0); PG8_MMA(1, 1, At, B1); PG8_BAR; PG8_SCHED;
            PG8_LDB(B0, 1, 0); PG8_LDB(B1, 1, 1); PG8_SCHED; PG8_LDA(At, 1, 0); PG8_STAGE_A(PG8_SA(0, 1), a2, 1, 1);
            PG8_WAIT_V(8); PG8_WAIT_L(0); PG8_BAR; PG8_MMA(0, 0, At, B0); PG8_MMA(0, 1, At, B1); PG8_BAR; PG8_SCHED;
            PG8_LDA(At, 1, 1); PG8_STAGE(PG8_SB(1, 0), b3, voffB); PG8_STAGE(PG8_SB(1, 1), b3 + hstep, voffB); PG8_STAGE_A(PG8_SA(1, 0), a3, 0, 1);
            PG8_WAIT_V(8); PG8_WAIT_L(0); PG8_BAR; PG8_MMA(1, 0, At, B0); PG8_MMA(1, 1, At, B1); PG8_BAR; PG8_SCHED;
            } else {
            PG8_LDB(B0, 0, 0); PG8_SCHED; PG8_LDA(At, 0, 0); PG8_STAGE_A(PG8_SA(1, 1), a1, 1, 0);
            PG8_WAIT_L(8); PG8_BAR; PG8_WAIT_L(0); PG8_MMA(0, 0, At, B0); PG8_BAR; PG8_SCHED;
            PG8_LDB(B1, 0, 1); PG8_STAGE(PG8_SB(0, 0), b2, voffB);
            PG8_BAR; PG8_WAIT_L(0); PG8_MMA(0, 1, At, B1); PG8_BAR;
            PG8_LDA(At, 0, 1); PG8_STAGE_A(PG8_SA(0, 0), a2, 0, 1);
            PG8_BAR; PG8_WAIT_L(0); PG8_MMA(1, 0, At, B0); PG8_BAR; PG8_SCHED;
            PG8_STAGE(PG8_SB(0, 1), b2 + hstep, voffB);
            PG8_WAIT_V(6); PG8_BAR; PG8_MMA(1, 1, At, B1); PG8_BAR;
            PG8_LDB(B0, 1, 0); PG8_SCHED; PG8_LDA(At, 1, 0); PG8_STAGE_A(PG8_SA(0, 1), a2, 1, 1);
            PG8_WAIT_L(8); PG8_BAR; PG8_WAIT_L(0); PG8_MMA(0, 0, At, B0); PG8_BAR; PG8_SCHED;
            PG8_LDB(B1, 1, 1); PG8_STAGE(PG8_SB(1, 0), b3, voffB);
            PG8_BAR; PG8_WAIT_L(0); PG8_MMA(0, 1, At, B1); PG8_BAR;
            PG8_LDA(At, 1, 1); PG8_STAGE_A(PG8_SA(1, 0), a3, 0, 1);
            PG8_BAR; PG8_WAIT_L(0); PG8_MMA(1, 0, At, B0); PG8_BAR; PG8_SCHED;
            PG8_STAGE(PG8_SB(1, 1), b3 + hstep, voffB);
            PG8_WAIT_V(6); PG8_BAR; PG8_MMA(1, 1, At, B1); PG8_BAR;
            }
        }
        if constexpr (ALIGN_EPI) { if (wr == 0) PG8_BAR; }
        if constexpr (!Epi::AFTER_DRAIN) { const int l2_ = lane_id_opaque(); E(acc, cur, wr, wc, l2_ & 15, l2_ >> 4); S.done(cur); }
        if (!has_next) break;
#pragma unroll
        for (int a = 0; a < 2; ++a)
#pragma unroll
            for (int b = 0; b < 2; ++b)
#pragma unroll
                for (int m = 0; m < 4; ++m)
#pragma unroll
                    for (int n = 0; n < 2; ++n) acc[a][b][m][n] = (f32x4){0.f, 0.f, 0.f, 0.f};
        cur = nxt; cA = nA; cB = nB; ++ui;
        if constexpr (GATHER) { _Pragma("unroll") for (int _h = 0; _h < 2; ++_h) _Pragma("unroll") for (int _i = 0; _i < 2; ++_i) vgC[_h][_i] = vgX[_h][_i]; }
        if constexpr (ALIGN_EPI) { if (wr == 1) PG8_BAR; }
    }
    PG8_WAIT_V(0);
    if constexpr (!ALIGN_EPI) { if (wr == 0) PG8_BAR; }
    PG8_BAR;
    if constexpr (Epi::AFTER_DRAIN) { E.fused(acc, cur, wr, wc, fr, fq, lds, wid, lane); S.done(cur); }
#undef PG8_GOFF
#undef PG8_SA
#undef PG8_SB
#undef PG8_STAGE
#undef PG8_STAGE_A
#undef PG8_VSEL_0
#undef PG8_VSEL_1
#undef PG8_LDA
#undef PG8_LDB
#undef PG8_MMA
#undef PG8_WAIT_V
#undef PG8_WAIT_L
#undef PG8_BAR
#undef PG8_SCHED
}
}

template <class TC, class LA, class LB, class EP>
__device__ __forceinline__ void oracle_gemm(LAS float* lds, int M, int N, int K, TC tilectx, LA loadA, LB loadB, EP epi) {
    LAS float* As = lds; LAS float* Bs = lds + 16 * 132;
    int tid = threadIdx.x; asm volatile("" : "+v"(tid)); const int ty = tid >> 4, tx = tid & 15;
    const int ntm = M / 128, ntn = (N + 127) / 128;
    for (int tile = blockIdx.x; tile < ntm * ntn; tile += gridDim.x) {
        const int tm = tile / ntn, tn = tile % ntn;
        const int ctx = tilectx(tm);
        float acc[4][8];
#pragma unroll
        for (int i = 0; i < 4; ++i)
#pragma unroll
            for (int j = 0; j < 8; ++j) acc[i][j] = 0.f;
        for (int k0 = 0; k0 < K; k0 += 16) {
#pragma unroll
            for (int i = 0; i < 4; ++i) { const int idx = tid + 512 * i; const int r = idx >> 4, kk = idx & 15; As[kk * 132 + r] = loadA(tm * 128 + r, k0 + kk); }
#pragma unroll
            for (int i = 0; i < 4; ++i) { const int idx = tid + 512 * i; const int kk = idx >> 7, n = idx & 127; Bs[kk * 132 + n] = loadB(k0 + kk, tn * 128 + n, ctx); }
            __syncthreads();
#pragma unroll 2
            for (int kk = 0; kk < 16; ++kk) {
                float a[4], b[8];
#pragma unroll
                for (int i = 0; i < 4; ++i) a[i] = As[kk * 132 + ty * 4 + i];
#pragma unroll
                for (int j = 0; j < 8; ++j) b[j] = Bs[kk * 132 + tx * 8 + j];
#pragma unroll
                for (int i = 0; i < 4; ++i)
#pragma unroll
                    for (int j = 0; j < 8; ++j) acc[i][j] += a[i] * b[j];
            }
            __syncthreads();
        }
        epi(tm * 128 + ty * 4, tn * 128 + tx * 8, acc, ctx);
    }
}


template <class MAP>
__device__ __forceinline__ void tr_item(const float* W, int ldw, int K, bf16* WT, int nblk, int item, LAS float* scr, int lane, MAP map) {
    const int kb = item / nblk, nb = item % nblk, k0 = kb * 64, n0 = nb * 64;
    const int s = map(n0 + lane);
    const float* wp = W + (size_t)k0 * ldw + (s >= 0 ? s : 0);
#pragma unroll 8
    for (int i = 0; i < 64; ++i) scr[i * 65 + lane] = (s >= 0) ? wp[(size_t)i * ldw] : 0.f;
    asm volatile("s_waitcnt lgkmcnt(0)" ::: "memory");
    const int c = lane & 7;
#pragma unroll
    for (int j = 0; j < 8; ++j) { const int n = (lane >> 3) + 8 * j; const LAS float* sp = scr + (8 * c) * 65 + n;
        uint4 o; o.x = pg8::cvt_pk_bf16(sp[0], sp[65]); o.y = pg8::cvt_pk_bf16(sp[130], sp[195]); o.z = pg8::cvt_pk_bf16(sp[260], sp[325]); o.w = pg8::cvt_pk_bf16(sp[390], sp[455]);
        *(uint4*)(WT + (size_t)(n0 + n) * K + k0 + 8 * c) = o; }
    asm volatile("s_waitcnt lgkmcnt(0)" ::: "memory");
}

template <int DEEP, class MAP>
__device__ __forceinline__ void tr_item8(const float* W, int ldw, int K, unsigned char* WT8, int nblk, int item, LAS float* scr, int lane, float scale, MAP map) {
    const int kb = item / nblk, nb = item % nblk, k0 = kb * 64, n0 = nb * 64;
    const int s = map(n0 + lane);
    const float* wp = W + (size_t)k0 * ldw + (s >= 0 ? s : 0);
    if constexpr (DEEP) {
#pragma unroll
        for (int h2 = 0; h2 < 2; ++h2) { float v[32];
#pragma unroll
            for (int i = 0; i < 32; ++i) v[i] = (s >= 0) ? wp[(size_t)(32 * h2 + i) * ldw] : 0.f;
#pragma unroll
            for (int i = 0; i < 32; ++i) scr[(32 * h2 + i) * 65 + lane] = v[i] * scale; }
    } else {
#pragma unroll 8
        for (int i = 0; i < 64; ++i) scr[i * 65 + lane] = (s >= 0) ? wp[(size_t)i * ldw] * scale : 0.f;
    }
    asm volatile("s_waitcnt lgkmcnt(0)" ::: "memory");
    const int c = lane & 7;
#pragma unroll
    for (int j = 0; j < 8; ++j) { const int n = (lane >> 3) + 8 * j; const LAS float* sp = scr + (8 * c) * 65 + n;
        int w0 = __builtin_amdgcn_cvt_pk_fp8_f32(sp[0], sp[65], 0, false); w0 = __builtin_amdgcn_cvt_pk_fp8_f32(sp[130], sp[195], w0, true);
        int w1 = __builtin_amdgcn_cvt_pk_fp8_f32(sp[260], sp[325], 0, false); w1 = __builtin_amdgcn_cvt_pk_fp8_f32(sp[390], sp[455], w1, true);
        uint2 o; o.x = (unsigned)w0; o.y = (unsigned)w1; *(uint2*)(WT8 + (size_t)(n0 + n) * K + k0 + 8 * c) = o; }
    asm volatile("s_waitcnt lgkmcnt(0)" ::: "memory");
}

struct Args { const void* in[46]; float* out; unsigned char* ws; int ph_lo, ph_hi; };

enum { PH_PRO = 0, PH_MEM = 1, PH_L0 = 2, PH_PER_LAYER = 9, PH_TOTAL = 2 + 9 * DEPTH };
enum { LP_INPROJ = 0, LP_MIXA = 1, LP_MIXB = 2, LP_OUTPROJ = 3, LP_LN1 = 4, LP_DISP = 5, LP_GU = 6, LP_DOWN = 7, LP_COMB = 8 };

__device__ __forceinline__ int expert_of_block(const LAS int* pend, int rb) {
    const int start = rb * MOEBLK; int e = 0;
#pragma unroll
    for (int i = 0; i < NEXP; ++i) e += (start >= pend[i]) ? 1 : 0;
    return e < NEXP - 1 ? e : NEXP - 1;
}

typedef const void* const __attribute__((address_space(4)))* KARG;
__global__ void __launch_bounds__(NTHR, 2) mk_fwd(Args args) {
    extern __shared__ __attribute__((aligned(16))) unsigned char lds_raw[];
    LAS unsigned char* lds = (LAS unsigned char*)lds_raw;
    LAS float* ldsf = (LAS float*)lds;
    volatile LAS unsigned* MISC = (volatile LAS unsigned*)(lds + LDS_MISC);
    const int tid0 = threadIdx.x, wave0 = __builtin_amdgcn_readfirstlane(tid0 >> 6);
    const int G = gridDim.x, bid = blockIdx.x;
#define LDS_BARRIER() do { asm volatile("s_waitcnt lgkmcnt(0)" ::: "memory"); __builtin_amdgcn_s_barrier(); asm volatile("" ::: "memory"); } while (0)
#define ARGP(i) ((const void*)kp_[i])
#define PHASE_IDS() int wave = wave0; asm volatile("" : "+s"(wave)); KARG kp_ = (KARG)__builtin_amdgcn_kernarg_segment_ptr(); asm volatile("" : "+s"(kp_)); unsigned char* ws = ws0; asm volatile("" : "+s"(ws)); unsigned* const ctl = (unsigned*)(ws + WS_CTL); (void)ctl; const int tid = wave * 64 + lane_id_opaque(); const int lane = tid & 63; (void)lane
    unsigned char* const ws0 = args.ws;
    unsigned* const ctl0 = (unsigned*)(ws0 + WS_CTL);
#define hf ((float*)(ws + WS_HF))
#define y2 ((float*)(ws + WS_Y2))
#define hb ((bf16*)(ws + WS_HB))
#define proj ((bf16*)(ws + WS_PROJ))
#define yg ((bf16*)(ws + WS_YG))
#define cat ((bf16*)(ws + WS_CAT))
#define top_e ((int*)(ws + WS_TOPE))
#define top_g ((float*)(ws + WS_TOPG))
#define dest ((int*)(ws + WS_DEST))
#define xr ((bf16*)(ws + WS_XR))
#define act ((bf16*)(ws + WS_ACT))
#define yr ((bf16*)(ws + WS_YR))
#define memK ((bf16*)(ws + WS_MEMK))
#define memV ((bf16*)(ws + WS_MEMV))
#define memVT ((bf16*)(ws + WS_MEMVT))
#define rope ((float*)(ws + WS_ROPE))
#define win_t ((bf16*)(ws + WS_WIN))
#define wglu_t ((bf16*)(ws + WS_WGLU))
#define wout_t ((bf16*)(ws + WS_WOUT))
#define wmem_t ((bf16*)(ws + WS_WMEM))
#define memb ((bf16*)(ws + WS_MEMB))
#define wgu_t ((bf16*)(ws + WS_WGU))
#define wdn_t ((bf16*)(ws + WS_WDN))
#define rwt ((bf16*)(ws + WS_RWT))
#define row_tok ((int*)(ws + WS_RTOK))
#define wgu8 (ws + WS_WGU)
#define wdn8 (ws + WS_WDN)
#define act8 (ws + WS_ACT)
#define hb8 (ws + WS_XR)
    constexpr float GU_WS = 32.0f, DN_WS = 64.0f;
    const int vcu = (G % 8 == 0) ? (bid % 8) * (G / 8) + bid / 8 : bid;

    if (tid0 < 64) MISC[tid0] = 0u;
    __syncthreads();
    const int lo = args.ph_lo, hi = args.ph_hi;
    XcdBarrier bar; bar.bar = ctl0 + CW_BAR; bar.x = 0; bar.st = MISC;
    if (hi - lo > 1) bar = xcd_barrier_post(ctl0 + CW_BAR, MISC, wave0);
#define IN(k) (lo <= (k) && (k) < hi)
#define SEAM(k) do { if (IN(k) && IN((k) + 1)) xcd_barrier(bar, wave0); } while (0)

    if (IN(PH_PRO)) {
            PHASE_IDS();
            REPS(0) { if (rep_) __syncthreads();
        {
            LAS float* scr = ldsf + wave * (64 * 65);
            const int gw = vcu * NWAVES + wave, NGW = G * NWAVES;
            constexpr int PRO_LAYERS = BG_CONV ? ((BG_ALL && LINATT_V2) ? 0 : 1) : DEPTH;
            constexpr int N_GU = FAST_MOE ? PRO_LAYERS * NEXP * 512 : 0, N_DN = FAST_MOE ? PRO_LAYERS * NEXP * 256 : 0;
            constexpr int N_IN0 = FAST_DENSE ? 256 : 0, N_IN1 = FAST_DENSE ? 704 : 0, N_IN2 = FAST_DENSE ? 640 : 0, N_IN3 = N_IN0, N_GLU = FAST_DENSE ? 144 : 0, N_OUT = FAST_DENSE ? 256 : 0, N_MEM = FAST_DENSE ? 64 : 0;
            constexpr int NITEMS = N_GU + N_DN + N_IN0 + N_IN1 + N_IN2 + N_IN3 + 2 * N_GLU + 4 * N_OUT + 2 * N_MEM;
            for (int it = gw; it < NITEMS; it += NGW) {
                int r = it;
                if (r < N_GU) { const int le = r >> 9;
#if MOE_FP8
                    tr_item8<0>((const float*)ARGP(42) + (size_t)le * D * 2 * DEXP, 2 * DEXP, D, wgu8 + (size_t)le * 2 * DEXP * D, 32, r & 511, scr, lane, GU_WS, [](int d) { const int tile = d >> 8, q = d & 255; return q < 128 ? tile * 128 + q : DEXP + tile * 128 + (q - 128); });
#else
                    tr_item((const float*)ARGP(42) + (size_t)le * D * 2 * DEXP, 2 * DEXP, D, wgu_t + (size_t)le * 2 * DEXP * D, 32, r & 511, scr, lane, [](int d) { const int tile = d >> 8, q = d & 255; return q < 128 ? tile * 128 + q : DEXP + tile * 128 + (q - 128); });
#endif
                    continue; } r -= N_GU;
                if (r < N_DN) { const int le = r >> 8;
#if MOE_FP8
                    tr_item8<0>((const float*)ARGP(44) + (size_t)le * DEXP * D, D, DEXP, wdn8 + (size_t)le * D * DEXP, 16, r & 255, scr, lane, DN_WS, [](int d) { return d; });
#else
                    tr_item((const float*)ARGP(44) + (size_t)le * DEXP * D, D, DEXP, wdn_t + (size_t)le * D * DEXP, 16, r & 255, scr, lane, [](int d) { return d; });
#endif
                    continue; } r -= N_DN;
                if (r < N_IN0) { tr_item((const float*)ARGP(5), 1024, D, win_t, 16, r, scr, lane, [](int d) { return d; }); continue; } r -= N_IN0;
                if (r < N_IN1) { tr_item((const float*)ARGP(16), 2568, D, win_t + (size_t)1 * 3 * MiB, 44, r, scr, lane, [](int d) { return d < 2568 ? d : -1; }); continue; } r -= N_IN1;
                if (r < N_IN2) { tr_item((const float*)ARGP(22), 2560, D, win_t + (size_t)2 * 3 * MiB, 40, r, scr, lane, [](int d) { return d; }); continue; } r -= N_IN2;
                if (r < N_IN3) { tr_item((const float*)ARGP(24), 1024, D, win_t + (size_t)3 * 3 * MiB, 16, r, scr, lane, [](int d) { return d; }); continue; } r -= N_IN3;
                if (r < N_GLU) { tr_item((const float*)ARGP(14), MIXW, MIXW, wglu_t, 12, r, scr, lane, [](int d) { return d; }); continue; } r -= N_GLU;
                if (r < N_GLU) { tr_item((const float*)ARGP(33), MIXW, MIXW, wglu_t + (size_t)1 * MiB, 12, r, scr, lane, [](int d) { return d; }); continue; } r -= N_GLU;
                if (r < 4 * N_OUT) { const int l = r >> 8; tr_item((const float*)ARGP(35) + (size_t)l * D * D, D, D, wout_t + (size_t)l * D * D, 16, r & 255, scr, lane, [](int d) { return d; }); continue; } r -= 4 * N_OUT;
                if (r < N_MEM) { tr_item((const float*)ARGP(3), 256, D, wmem_t, 4, r, scr, lane, [](int d) { return d; }); continue; } r -= N_MEM;
                tr_item((const float*)ARGP(4), 256, D, wmem_t + (size_t)256 * D, 4, r, scr, lane, [](int d) { return d; });
            }
            const float* mem = (const float*)ARGP(1);
            for (size_t i = ((size_t)bid * NTHR + tid) * 4; i < (size_t)NB * NMEM * D; i += (size_t)G * NTHR * 4) {
                const float4 v = *(const float4*)(mem + i); uint2 o; o.x = pg8::cvt_pk_bf16(v.x, v.y); o.y = pg8::cvt_pk_bf16(v.z, v.w); *(uint2*)(memb + i) = o; }
        }
        {
            const float* rwf = (const float*)ARGP(40);
            for (int i = bid * NTHR + tid; i < DEPTH * NEXP * D; i += G * NTHR) { const int l = i / (NEXP * D), rem = i % (NEXP * D), e = rem / D, k = rem % D;
                const float v = rwf[((size_t)l * D + k) * NEXP + e]; const bf16 hi_ = f2bf(v); const bf16 lo_ = f2bf(v - bf2f(hi_));
                rwt[((size_t)(l * 2 + 0) * NEXP + e) * D + k] = hi_; rwt[((size_t)(l * 2 + 1) * NEXP + e) * D + k] = lo_; }
        }
        const float* x = (const float*)ARGP(0);
        for (size_t i = ((size_t)bid * NTHR + tid) * 4; i < (size_t)T * D; i += (size_t)G * NTHR * 4) {
            const float4 v = *(const float4*)(x + i);
#if !RES_BF16
            *(float4*)(hf + i) = v;
#endif
            uint2 o; o.x = pk2(v.x, v.y); o.y = pk2(v.z, v.w); *(uint2*)(hb + i) = o;
        }
        const int* pos = (const int*)ARGP(2);
        for (int idx = bid * NTHR + tid; idx < T * 48; idx += G * NTHR) {
            const int t = idx / 48, i = idx % 48;
            const double inv = exp(-((double)(2 * i) / 96.0) * 9.210340371976184);
            double r = (double)pos[t] * inv * 0.15915494309189535; r -= rint(r);
            const float rf = (float)r;
            typedef _Float16 h2_t __attribute__((ext_vector_type(2))); h2_t cs_; cs_.x = (_Float16)__builtin_amdgcn_cosf(rf); cs_.y = (_Float16)__builtin_amdgcn_sinf(rf);
            ((unsigned*)rope)[idx] = __builtin_bit_cast(unsigned, cs_);
        }
    } }
    SEAM(PH_PRO);

    if (IN(PH_MEM)) {
            PHASE_IDS();
            REPS(1) { if (rep_) __syncthreads();
#if FAST_DENSE
        { pg8::Gemm g{memb, wmem_t, D, nullptr}; pg8::StaticOrder S; S.init(NB * NMEM, 512, G, bid); pg8::EpiMem E{memK, memV, memVT}; pg8::gemm_phase(lds, g, S, E, wave); }
#else
        const float* mem = (const float*)ARGP(1); const float* wk = (const float*)ARGP(3); const float* wv = (const float*)ARGP(4);
        oracle_gemm(ldsf, NB * NMEM, 512, D,
            [&](int) { return 0; },
            [&](int m, int k) { return mem[(size_t)m * D + k]; },
            [&](int k, int n, int) { return n < 256 ? wk[(size_t)k * 256 + n] : wv[(size_t)k * 256 + n - 256]; },
            [&](int m0, int n0, float (&acc)[4][8], int) {
#pragma unroll
                for (int i = 0; i < 4; ++i)
#pragma unroll
                    for (int j = 0; j < 8; ++j) { const int m = m0 + i, n = n0 + j; const int b = m >> 8, key = m & 255; const int nn = n & 255, head = nn >> 6, d = nn & 63; const bf16 v = f2bf(acc[i][j]);
                        if (n < 256) memK[((size_t)(b * 4 + head) * 256 + key) * 64 + d] = v;
                        else { memV[((size_t)(b * 4 + head) * 256 + key) * 64 + d] = v; memVT[((size_t)(b * 4 + head) * 64 + d) * 256 + key] = v; } }
            });
#endif
    } }

    for (int L = 0; L < DEPTH; ++L) {
        const int P = PH_L0 + PH_PER_LAYER * L;
        const int kind = L % 3;
        const int Nin = (kind == 0) ? 1024 : (kind == 1 ? 2568 : 2560);
        const int xq_off = (kind == 0) ? 768 : (kind == 1 ? 2312 : 2304);

        if (IN(P + LP_INPROJ)) {
            PHASE_IDS();
            REPS(2) { if (rep_) __syncthreads();
#if FAST_DENSE
            { const int Npad = (kind == 0) ? 1024 : (kind == 1 ? 2816 : 2560);
              pg8::Gemm g{hb, win_t + (size_t)L * 3 * MiB, D, nullptr}; pg8::StaticOrder S; S.init(T, Npad, G, bid); pg8::EpiBf16 E{proj, LDP, nullptr, 0, 1.0f}; pg8::gemm_phase(lds, g, S, E, wave); }
#else
            const float* w_in = (const float*)(L == 0 ? ARGP(5) : L == 1 ? ARGP(16) : L == 2 ? ARGP(22) : ARGP(24));
            oracle_gemm(ldsf, T, Nin, D,
                [&](int) { return 0; },
                [&](int m, int k) { return bf2f(hb[(size_t)m * D + k]); },
                [&](int k, int n, int) { return n < Nin ? w_in[(size_t)k * Nin + n] : 0.f; },
                [&](int m0, int n0, float (&acc)[4][8], int) {
#pragma unroll
                    for (int i = 0; i < 4; ++i)
#pragma unroll
                        for (int j = 0; j < 8; ++j) if (n0 + j < Nin) proj[(size_t)(m0 + i) * LDP + n0 + j] = f2bf(acc[i][j]);
                });
#endif
        } }
        SEAM(P + LP_INPROJ);

        if (IN(P + LP_MIXA)) {
            PHASE_IDS();
            REPS(kind == 0 ? 11 : 12) { if (rep_) __syncthreads();
            if (kind == 0) {
                const int o = (L == 0) ? 6 : 25;
                const float* a_re = (const float*)args.in[o + 0]; const float* a_im = (const float*)args.in[o + 1]; const float* log_dt = (const float*)args.in[o + 2];
                const float* b_re = (const float*)args.in[o + 3]; const float* b_im = (const float*)args.in[o + 4]; const float* c_re = (const float*)args.in[o + 5];
                const float* c_im = (const float*)args.in[o + 6]; const float* d_skip = (const float*)args.in[o + 7];
#if FAST_S5
                typedef pg8::bf16x8 bx8; typedef pg8::f32x4 fx4;
                LAS float* BU = (LAS float*)(lds + wave * 32768);
                LAS bf16* XS = (LAS bf16*)(lds + wave * 32768 + 16896);
                for (int unit = wave * G + vcu; wave < 4 && unit < NB * 48; unit += G * 4) {
                    const int b = unit / 48, g = unit % 48, p = lane, tok = lane & 15, sg = lane >> 4;
                    const float lre = fminf(a_re[g * 64 + p], -1e-4f), lim = a_im[g * 64 + p];
                    const float dt = __expf(log_dt[g]);
                    const float mag = __expf(dt * lre); float sn, cs; sincos_rad(dt * lim, sn, cs);
                    const float abr = mag * cs, abi = mag * sn;
                    const float den = lre * lre + lim * lim, nr = abr - 1.0f;
                    const float cr = (nr * lre + abi * lim) / den, ci = (abi * lre - nr * lim) / den;
                    bx8 Bf[8], Cf[4];
#pragma unroll
                    for (int tI = 0; tI < 4; ++tI) {
                        const int sp = 16 * tI + tok; const float crs = sh_idx(cr, sp, lane), cis = sh_idx(ci, sp, lane);
                        unsigned wr_[4] = {0u, 0u, 0u, 0u}, wi_[4] = {0u, 0u, 0u, 0u};
                        if (sg < 2) { const float4* pr_ = (const float4*)(b_re + (size_t)(g * 64 + sp) * 16 + 8 * sg); const float4* pi_ = (const float4*)(b_im + (size_t)(g * 64 + sp) * 16 + 8 * sg);
                            const float4 r0 = pr_[0], r1 = pr_[1], i0 = pi_[0], i1 = pi_[1];
                            const float br[8] = {r0.x, r0.y, r0.z, r0.w, r1.x, r1.y, r1.z, r1.w}, bi[8] = {i0.x, i0.y, i0.z, i0.w, i1.x, i1.y, i1.z, i1.w};
#pragma unroll
                            for (int q = 0; q < 4; ++q) { wr_[q] = pk2(crs * br[2 * q] - cis * bi[2 * q], crs * br[2 * q + 1] - cis * bi[2 * q + 1]); wi_[q] = pk2(crs * bi[2 * q] + cis * br[2 * q], crs * bi[2 * q + 1] + cis * br[2 * q + 1]); } }
                        uint4 a4; a4.x = wr_[0]; a4.y = wr_[1]; a4.z = wr_[2]; a4.w = wr_[3]; Bf[tI] = __builtin_bit_cast(bx8, a4);
                        uint4 b4; b4.x = wi_[0]; b4.y = wi_[1]; b4.z = wi_[2]; b4.w = wi_[3]; Bf[4 + tI] = __builtin_bit_cast(bx8, b4);
                    }
#pragma unroll
                    for (int j = 0; j < 4; ++j) {
                        const float4 c4 = *(const float4*)(c_re + (size_t)(g * 16 + tok) * 64 + 16 * j + 4 * sg), d4 = *(const float4*)(c_im + (size_t)(g * 16 + tok) * 64 + 16 * j + 4 * sg);
                        uint4 a4; a4.x = pk2(c4.x, -d4.x); a4.y = pk2(c4.y, -d4.y); a4.z = pk2(c4.z, -d4.z); a4.w = pk2(c4.w, -d4.w); Cf[j] = __builtin_bit_cast(bx8, a4);
                    }
                    const float4 dsk4 = *(const float4*)(d_skip + g * 16 + 4 * sg);
                    float sxr = 0.f, sxi = 0.f;
                    const bf16* ubase = proj + (size_t)b * SEQ * LDP + g * 16;
                    uint4 unx[4]; uint2 uex[4];
#pragma unroll
                    for (int q = 0; q < 4; ++q) { unx[q] = make_uint4(0u, 0u, 0u, 0u); if (sg < 2) unx[q] = *(const uint4*)(ubase + (size_t)(16 * q + tok) * LDP + 8 * sg); uex[q] = *(const uint2*)(ubase + (size_t)(16 * q + tok) * LDP + 4 * sg); }
                    fx4 dnx[8];
                    { const bx8 uf0 = __builtin_bit_cast(bx8, unx[0]);
#pragma unroll
                      for (int tI = 0; tI < 8; ++tI) { const fx4 d = __builtin_amdgcn_mfma_f32_16x16x32_bf16(Bf[tI], uf0, (fx4){0.f, 0.f, 0.f, 0.f}, 0, 0, 0); *(LAS fx4*)(BU + tok * 132 + 16 * tI + 4 * sg) = d; } }
                    uint2 ue_prev = make_uint2(0u, 0u);
                    for (int t64 = 0; t64 < SEQ; t64 += 64) {
                        uint4 ucu[4]; uint2 uec[4];
#pragma unroll
                        for (int q = 0; q < 4; ++q) { ucu[q] = unx[q]; uec[q] = uex[q]; }
                        if (t64 + 64 < SEQ) {
#pragma unroll
                            for (int q = 0; q < 4; ++q) { if (sg < 2) unx[q] = *(const uint4*)(ubase + (size_t)(t64 + 64 + 16 * q + tok) * LDP + 8 * sg); uex[q] = *(const uint2*)(ubase + (size_t)(t64 + 64 + 16 * q + tok) * LDP + 4 * sg); } }
#pragma unroll
                        for (int q = 0; q < 4; ++q) {
                            const int t0 = t64 + 16 * q, cb = q & 1, nb = cb ^ 1;
                            LAS float* BUc = BU + cb * (16 * 132); LAS float* BUn = BU + nb * (16 * 132);
                            LAS bf16* XSc = XS + cb * (16 * 136); LAS bf16* XSp = XS + nb * (16 * 136);
                            float bre[16], bim[16];
#pragma unroll
                            for (int t = 0; t < 16; ++t) { bre[t] = BUc[t * 132 + p]; bim[t] = BUc[t * 132 + 64 + p]; }
                            const bool has_next = (t0 + 16 < SEQ);
                            { const bx8 ufn = __builtin_bit_cast(bx8, (q < 3) ? ucu[(q + 1) & 3] : unx[0]);
#pragma unroll
                              for (int tI = 0; tI < 8; ++tI) dnx[tI] = __builtin_amdgcn_mfma_f32_16x16x32_bf16(Bf[tI], ufn, (fx4){0.f, 0.f, 0.f, 0.f}, 0, 0, 0); }
                            fx4 y = (fx4){0.f, 0.f, 0.f, 0.f};
                            if (t0 > 0) {
#pragma unroll
                                for (int j = 0; j < 4; ++j) { const bx8 xf = *(const LAS bx8*)(XSp + tok * 136 + 32 * j + 8 * sg); y = __builtin_amdgcn_mfma_f32_16x16x32_bf16(Cf[j], xf, y, 0, 0, 0); } }
#pragma unroll
                            for (int t = 0; t < 16; ++t) { const float nxr = abr * sxr - abi * sxi + bre[t], nxi = abr * sxi + abi * sxr + bim[t]; sxr = nxr; sxi = nxi;
                                *(LAS unsigned*)(XSc + t * 136 + 2 * p) = pg8::cvt_pk_bf16(sxr, sxi); }
                            if (has_next) {
#pragma unroll
                                for (int tI = 0; tI < 8; ++tI) *(LAS fx4*)(BUn + tok * 132 + 16 * tI + 4 * sg) = dnx[tI]; }
                            if (t0 > 0) {
                                const float u0 = __uint_as_float(ue_prev.x << 16), u1 = __uint_as_float(ue_prev.x & 0xffff0000u), u2 = __uint_as_float(ue_prev.y << 16), u3 = __uint_as_float(ue_prev.y & 0xffff0000u);
                                uint2 o; o.x = pg8::cvt_pk_bf16(gelu_tanh(y[0] + dsk4.x * u0), gelu_tanh(y[1] + dsk4.y * u1)); o.y = pg8::cvt_pk_bf16(gelu_tanh(y[2] + dsk4.z * u2), gelu_tanh(y[3] + dsk4.w * u3));
                                *(uint2*)(yg + (size_t)(b * SEQ + t0 - 16 + tok) * MIXW + g * 16 + 4 * sg) = o; }
                            ue_prev = uec[q];
                        }
                    }
                    {
                        LAS bf16* XSp = XS + 1 * (16 * 136);
                        fx4 y = (fx4){0.f, 0.f, 0.f, 0.f};
#pragma unroll
                        for (int j = 0; j < 4; ++j) { const bx8 xf = *(const LAS bx8*)(XSp + tok * 136 + 32 * j + 8 * sg); y = __builtin_amdgcn_mfma_f32_16x16x32_bf16(Cf[j], xf, y, 0, 0, 0); }
                        const float u0 = __uint_as_float(ue_prev.x << 16), u1 = __uint_as_float(ue_prev.x & 0xffff0000u), u2 = __uint_as_float(ue_prev.y << 16), u3 = __uint_as_float(ue_prev.y & 0xffff0000u);
                        uint2 o; o.x = pg8::cvt_pk_bf16(gelu_tanh(y[0] + dsk4.x * u0), gelu_tanh(y[1] + dsk4.y * u1)); o.y = pg8::cvt_pk_bf16(gelu_tanh(y[2] + dsk4.z * u2), gelu_tanh(y[3] + dsk4.w * u3));
                        *(uint2*)(yg + (size_t)(b * SEQ + SEQ - 16 + tok) * MIXW + g * 16 + 4 * sg) = o;
                    }
                }
#else
                for (int unit = bid * NWAVES + wave; unit < NB * 48; unit += G * NWAVES) {
                    const int b = unit / 48, g = unit % 48, p = lane;
                    const float lre = fminf(a_re[g * 64 + p], -1e-4f), lim = a_im[g * 64 + p];
                    const float dt = __expf(log_dt[g]);
                    const float mag = __expf(dt * lre); float sn, cs; sincos_rad(dt * lim, sn, cs);
                    const float abr = mag * cs, abi = mag * sn;
                    const float den = lre * lre + lim * lim, nr = abr - 1.0f;
                    const float cr = (nr * lre + abi * lim) / den, ci = (abi * lre - nr * lim) / den;
                    float Br[16], Bi[16], Cr[16], Ci[16];
#pragma unroll
                    for (int h = 0; h < 16; ++h) { const float br = b_re[(size_t)(g * 64 + p) * 16 + h], bi = b_im[(size_t)(g * 64 + p) * 16 + h];
                        Br[h] = cr * br - ci * bi; Bi[h] = cr * bi + ci * br; Cr[h] = c_re[(size_t)(g * 16 + h) * 64 + p]; Ci[h] = c_im[(size_t)(g * 16 + h) * 64 + p]; }
                    const float dsk = d_skip[g * 16 + (lane & 15)];
                    float sxr = 0.f, sxi = 0.f;
                    for (int t = 0; t < SEQ; ++t) {
                        const bf16* up = proj + (size_t)(b * SEQ + t) * LDP + g * 16;
                        float u[16]; unpack8(*(const uint4*)up, u); unpack8(*(const uint4*)(up + 8), u + 8);
                        float bur = 0.f, bui = 0.f;
#pragma unroll
                        for (int h = 0; h < 16; ++h) { bur += Br[h] * u[h]; bui += Bi[h] * u[h]; }
                        const float nxr = abr * sxr - abi * sxi + bur, nxi = abr * sxi + abi * sxr + bui; sxr = nxr; sxi = nxi;
                        float myy = 0.f;
#pragma unroll
                        for (int h = 0; h < 16; ++h) { float v = Cr[h] * sxr - Ci[h] * sxi; v = wave_sum(v, lane); myy = (lane == h) ? v : myy; }
                        if (lane < 16) { const float uu = bf2f(up[lane]); const float y = gelu_tanh(myy + dsk * uu); yg[(size_t)(b * SEQ + t) * MIXW + g * 16 + lane] = f2bf(y); }
                    }
                }
#endif
            } else {
#if FAST_LINATT && LINATT_V2
                {
                    typedef pg8::bf16x8 bx8; typedef pg8::f32x4 fx4; typedef pg8::u32x4 ux4; typedef pg8::u32x2 ux2;
                    typedef _Float16 h2_t __attribute__((ext_vector_type(2)));
                    LAS bf16* Qs = (LAS bf16*)lds;
                    LAS bf16* Ks = (LAS bf16*)(lds + 13312);
                    LAS bf16* KTe = (LAS bf16*)(lds + 26624);
                    LAS bf16* VT = (LAS bf16*)(lds + 40448);
                    LAS bf16* Ps = (LAS bf16*)(lds + 68096);
                    LAS bf16* CT = (LAS bf16*)(lds + 77312);
                    LAS float* fa = (LAS float*)(lds + 117248);
                    LAS float* aArr = fa, *MArr = fa + 64, *interArr = fa + 128, *clampArr = fa + 192, *eArr = fa + 256, *denArr = fa + 320, *nArr = fa + 384  , *stat = fa + 480  ;
                    const float* conv_q = (const float*)ARGP(17); const float* conv_k = (const float*)ARGP(18);
                    const float* b_i = (const float*)ARGP(19); const float* b_f = (const float*)ARGP(20);
                    const float* norm_g = (const float*)(kind == 1 ? ARGP(21) : ARGP(23));
                    constexpr int CHB = 62208;
                    unsigned char* const LB = (unsigned char*)(ws + WS_ACT);
#define LINATT_PIECE_LDS(p) ((p) < 768 ? (((p) / 12) * 104 + ((p) % 12) * 8) * 2 : (p) < 1536 ? 13312 + ((((p) - 768) / 12) * 104 + (((p) - 768) % 12) * 8) * 2 : \
                             (p) < 2304 ? 26624 + ((((p) - 1536) >> 3) * 72 + (((p) - 1536) & 7) * 8) * 2 : 40448 + ((((p) - 2304) >> 3) * 72 + (((p) - 2304) & 7) * 8) * 2)
                    for (int unit = bid; unit < NB * 4 * 8; unit += G) {
                        const int b = unit >> 5, h = (unit >> 3) & 3, c0 = (unit & 7) * 4;
                        const float lgam = __logf(1.0f - exp2f(-5.0f - (float)h));
                        ux4 rv[3], rg[8]; float rig = 0.f, rfg = 0.f;
#pragma unroll
                        for (int q = 0; q < 8; ++q) rg[q] = (ux4){0u, 0u, 0u, 0u};
#define LINATT_LOAD_RAW(cc) do { const size_t r0_ = (size_t)b * SEQ + (size_t)(cc) * 64; \
                            _Pragma("unroll") for (int kq = 0; kq < 3; ++kq) { const int idx = tidv + NTHR * kq, cg = idx >> 6, s = idx & 63; rv[kq] = *(const ux4*)(proj + (r0_ + s) * LDP + 768 + h * 192 + 8 * cg); } \
                            if (kind == 1) { _Pragma("unroll") for (int kq = 0; kq < 3; ++kq) { const int idx = tidv + NTHR * kq, which = idx / 768, rem = idx % 768, cg = rem >> 6, s = rem & 63; \
                                    rg[kq] = *(const ux4*)(proj + (r0_ + s) * LDP + which * 384 + h * 96 + 8 * cg); } \
                                if (wave == 0) { const bf16* pr = proj + (r0_ + lanev) * LDP; rig = bf2f(pr[2304 + h]); rfg = bf2f(pr[2308 + h]); } } \
                            else { _Pragma("unroll") for (int kq = 0; kq < 2; ++kq) { const int idx = tidv + NTHR * kq; if (idx < 768) { const int which = idx / 384, rem = idx % 384, cg = rem >> 6, s = rem & 63; \
                                    const bf16* xp = proj + (r0_ + s) * LDP + which * 384 + h * 96 + 8 * cg; rg[kq] = *(const ux4*)xp; rg[2 + kq] = *(const ux4*)(xp + 48); \
                                    const ux4* rp = (const ux4*)((const unsigned*)rope + (r0_ + s) * 48 + 8 * cg); rg[4 + 2 * kq] = rp[0]; rg[5 + 2 * kq] = rp[1]; } } } } while (0)
                        { int tidv = tid; asm volatile("" : "+v"(tidv)); const int lanev = tidv & 63; (void)lanev;
                          if (kind == 1 && c0 > 0) {
                              const size_t rp_ = (size_t)b * SEQ + (size_t)(c0 - 1) * 64;
#pragma unroll
                              for (int kq = 0; kq < 3; ++kq) { const int idx = tidv + NTHR * kq, which = idx / 768, rem = idx % 768, cg = rem >> 6, s = rem & 63; rg[3 + kq] = *(const ux4*)(proj + (rp_ + s) * LDP + which * 384 + h * 96 + 8 * cg); } }
                          LINATT_LOAD_RAW(c0); }
                        for (int cc = 0; cc < 4; ++cc) {
                            const int c = c0 + cc;
                            int tidv = tid; asm volatile("" : "+v"(tidv));
                            const int lanev = tidv & 63;
                            unsigned char* const img = LB + (size_t)((b * 4 + h) * 32 + c) * CHB;
                            if (wave == 0) {
                                float lf, ig;
                                if (kind == 1) { ig = rig + b_i[h]; const float fg = rfg + b_f[h]; lf = fminf(fg, 0.f) - __logf(1.0f + __expf(-fabsf(fg))); }
                                else { ig = 0.f; lf = lgam; }
                                float bc = lf;
#pragma unroll
                                for (int o = 1; o < 64; o <<= 1) { const float t = sh_up(bc, o, lanev); if (lanev >= o) bc += t; }
                                const float a = ig - bc; float A = a;
#pragma unroll
                                for (int o = 1; o < 64; o <<= 1) { const float t = sh_up(A, o, lanev); if (lanev >= o) A = fmaxf(A, t); }
                                float* gp = (float*)(img + 61440); gp[lanev] = a; gp[64 + lanev] = A; gp[128 + lanev] = bc;
                            }
#pragma unroll
                            for (int kq = 0; kq < 3; ++kq) {
                                const int idx = tidv + NTHR * kq, cg = idx >> 6, s = idx & 63; const ux4 v = rv[kq];
                                LAS bf16* d = VT + (8 * cg) * 72 + s;
                                d[0] = (bf16)(v.x & 0xffffu); d[72] = (bf16)(v.x >> 16); d[144] = (bf16)(v.y & 0xffffu); d[216] = (bf16)(v.y >> 16);
                                d[288] = (bf16)(v.z & 0xffffu); d[360] = (bf16)(v.z >> 16); d[432] = (bf16)(v.w & 0xffffu); d[504] = (bf16)(v.w >> 16);
                            }
                            if (kind == 1) {
#pragma unroll
                                for (int kq = 0; kq < 3; ++kq) {
                                    const int idx = tidv + NTHR * kq, which = idx / 768, rem = idx % 768, cg = rem >> 6, s = rem & 63;
                                    const int ch = h * 96 + 8 * cg;
                                    const float* cw = (which ? conv_k : conv_q) + ch;
                                    float r[8];
                                    { float x[8]; uint4 xu; xu.x = rg[kq].x; xu.y = rg[kq].y; xu.z = rg[kq].z; xu.w = rg[kq].w; unpack8(xu, x);
                                      const float4 w0 = *(const float4*)(cw + 3 * 384), w1 = *(const float4*)(cw + 3 * 384 + 4);
                                      r[0] = w0.x * x[0]; r[1] = w0.y * x[1]; r[2] = w0.z * x[2]; r[3] = w0.w * x[3]; r[4] = w1.x * x[4]; r[5] = w1.y * x[5]; r[6] = w1.z * x[6]; r[7] = w1.w * x[7]; }
#pragma unroll
                                    for (int dl = 1; dl <= 3; ++dl) {
                                        const int sl = (lanev - dl) & 63; uint4 xu;
                                        { const unsigned c0 = sh_idx(rg[kq].x, sl, lanev), p0 = sh_idx(rg[3 + kq].x, sl, lanev); xu.x = (lanev >= dl) ? c0 : p0; }
                                        { const unsigned c0 = sh_idx(rg[kq].y, sl, lanev), p0 = sh_idx(rg[3 + kq].y, sl, lanev); xu.y = (lanev >= dl) ? c0 : p0; }
                                        { const unsigned c0 = sh_idx(rg[kq].z, sl, lanev), p0 = sh_idx(rg[3 + kq].z, sl, lanev); xu.z = (lanev >= dl) ? c0 : p0; }
                                        { const unsigned c0 = sh_idx(rg[kq].w, sl, lanev), p0 = sh_idx(rg[3 + kq].w, sl, lanev); xu.w = (lanev >= dl) ? c0 : p0; }
                                        float x[8]; unpack8(xu, x);
                                        const float4 w0 = *(const float4*)(cw + (3 - dl) * 384), w1 = *(const float4*)(cw + (3 - dl) * 384 + 4);
                                        r[0] += w0.x * x[0]; r[1] += w0.y * x[1]; r[2] += w0.z * x[2]; r[3] += w0.w * x[3]; r[4] += w1.x * x[4]; r[5] += w1.y * x[5]; r[6] += w1.z * x[6]; r[7] += w1.w * x[7];
                                    }
                                    rg[3 + kq] = rg[kq];
                                    const float sc = which ? 1.0f : 0.10206207261596575f;
#pragma unroll
                                    for (int i = 0; i < 8; ++i) r[i] = r[i] * sigmoidf(r[i]) * sc;
                                    ux4 pk; pk.x = pg8::cvt_pk_bf16(r[0], r[1]); pk.y = pg8::cvt_pk_bf16(r[2], r[3]); pk.z = pg8::cvt_pk_bf16(r[4], r[5]); pk.w = pg8::cvt_pk_bf16(r[6], r[7]);
                                    if (which == 0) *(LAS ux4*)(Qs + s * 104 + 8 * cg) = pk;
                                    else { *(LAS ux4*)(Ks + s * 104 + 8 * cg) = pk; const float es = 1.0f; LAS bf16* d = KTe + (8 * cg) * 72 + s;
#pragma unroll
                                        for (int i = 0; i < 8; ++i) d[72 * i] = f2bf(r[i] * es); }
                                }
                            } else {
#pragma unroll
                                for (int kq = 0; kq < 2; ++kq) {
                                    const int idx = tidv + NTHR * kq;
                                    if (idx < 768) {
                                        const int which = idx / 384, rem = idx % 384, cg = rem >> 6, s = rem & 63;
                                        float x1[8], x2[8]; { uint4 xu; xu.x = rg[kq].x; xu.y = rg[kq].y; xu.z = rg[kq].z; xu.w = rg[kq].w; unpack8(xu, x1); xu.x = rg[2 + kq].x; xu.y = rg[2 + kq].y; xu.z = rg[2 + kq].z; xu.w = rg[2 + kq].w; unpack8(xu, x2); }
                                        const unsigned rpw[8] = {rg[4 + 2 * kq].x, rg[4 + 2 * kq].y, rg[4 + 2 * kq].z, rg[4 + 2 * kq].w, rg[5 + 2 * kq].x, rg[5 + 2 * kq].y, rg[5 + 2 * kq].z, rg[5 + 2 * kq].w};
                                        float o1[8], o2[8]; const float sc = which ? 0.10206207261596575f : 1.0f;
#pragma unroll
                                        for (int q8 = 0; q8 < 8; ++q8) { const h2_t cs_ = __builtin_bit_cast(h2_t, rpw[q8]); const float c0 = (float)cs_.x, s0 = (float)cs_.y;
                                            o1[q8] = (x1[q8] * c0 - x2[q8] * s0) * sc; o2[q8] = (x2[q8] * c0 + x1[q8] * s0) * sc; }
                                        ux4 p1; p1.x = pg8::cvt_pk_bf16(o1[0], o1[1]); p1.y = pg8::cvt_pk_bf16(o1[2], o1[3]); p1.z = pg8::cvt_pk_bf16(o1[4], o1[5]); p1.w = pg8::cvt_pk_bf16(o1[6], o1[7]);
                                        ux4 p2; p2.x = pg8::cvt_pk_bf16(o2[0], o2[1]); p2.y = pg8::cvt_pk_bf16(o2[2], o2[3]); p2.z = pg8::cvt_pk_bf16(o2[4], o2[5]); p2.w = pg8::cvt_pk_bf16(o2[6], o2[7]);
                                        LAS bf16* dst = which ? Ks : Qs;
                                        *(LAS ux4*)(dst + s * 104 + 8 * cg) = p1; *(LAS ux4*)(dst + s * 104 + 48 + 8 * cg) = p2;
                                        if (which) { const float es = 1.0f; LAS bf16* d = KTe + (8 * cg) * 72 + s;
#pragma unroll
                                            for (int i = 0; i < 8; ++i) { d[72 * i] = f2bf(o1[i] * es); d[72 * (48 + i)] = f2bf(o2[i] * es); } }
                                    }
                                }
                            }
                            if (cc + 1 < 4) LINATT_LOAD_RAW(c + 1);
                            LDS_BARRIER();
#pragma unroll
                            for (int k = 0; k < 8; ++k) { const int p = tidv + NTHR * k; if (p < 3840) *(ux4*)(img + (size_t)p * 16) = *(const LAS ux4*)(lds + LINATT_PIECE_LDS(p)); }
                            LDS_BARRIER();
                        }
                    }
#undef LINATT_LOAD_RAW
                    xcd_barrier(bar, wave0);
                    const int tok = lane & 15, sg = lane >> 4; (void)tok; (void)sg;
                    for (int unit = bid; unit < NB * 4 * 4; unit += G) {
                        const int b = unit >> 4, h = (unit >> 2) & 3, jt = unit & 3;
                        fx4 Cst[3][3];
#pragma unroll
                        for (int x = 0; x < 3; ++x)
#pragma unroll
                            for (int y = 0; y < 3; ++y) Cst[x][y] = (fx4){0.f, 0.f, 0.f, 0.f};
                        float nreg = 0.f, m_prev = 0.f;
                        __syncthreads();
                        for (int i = tid; i < 192 * 104 / 2; i += NTHR) ((LAS unsigned*)CT)[i] = 0u;
                        if (tid < 96) nArr[tid] = 0.f;
                        const int ctU = 3 * (wave & 3), itU = 3 * (wave >> 2);
                        ux4 rgp[8]; float g_a = 0.f, g_A = 0.f, g_b = 0.f, g_A63 = 0.f, g_b63 = 0.f;
#define LINATT_LOAD_IMG(cc) do { const unsigned char* im_ = LB + (size_t)((b * 4 + h) * 32 + (cc)) * CHB; \
                            _Pragma("unroll") for (int k = 0; k < 8; ++k) { const int p = tidv + NTHR * k; rgp[k] = *(const ux4*)(im_ + (size_t)(p < 3840 ? p : 3839) * 16); } \
                            const float* gp_ = (const float*)(im_ + 61440); if (tidv < 64) { g_a = gp_[tidv]; g_A = gp_[64 + tidv]; g_b = gp_[128 + tidv]; } g_A63 = gp_[64 + 63]; g_b63 = gp_[128 + 63]; } while (0)
                        { int tidv = tid; asm volatile("" : "+v"(tidv)); LINATT_LOAD_IMG(0); }
                        for (int c = 0; c < SEQ / 64; ++c) {
                            const size_t row0 = (size_t)b * SEQ + c * 64;
                            int tidv = tid; asm volatile("" : "+v"(tidv));
                            const int lanev = tidv & 63, tokv = lanev & 15, sgv = lanev >> 4;
#pragma unroll
                            for (int k = 0; k < 8; ++k) { const int p = tidv + NTHR * k; if (p < 3840) *(LAS ux4*)(lds + LINATT_PIECE_LDS(p)) = rgp[k]; }
                            const float M63 = (kind == 1) ? fmaxf(m_prev, g_A63) : -g_b63;
                            const float sa_c = __expf(m_prev - M63);
                            if (tidv < 64) { const float M = (kind == 1) ? fmaxf(m_prev, g_A) : -g_b;
                                aArr[tidv] = g_a; MArr[tidv] = M; interArr[tidv] = __expf(m_prev - M); clampArr[tidv] = __expf(-(g_b + M)); eArr[tidv] = __expf(g_a - M63); }
                            if (kind == 1) m_prev = g_b63 + M63;
                            if (c + 1 < SEQ / 64) LINATT_LOAD_IMG(c + 1);
                            LDS_BARRIER(); __builtin_amdgcn_sched_barrier(0);
                            if (wave < 4) {
                                const int st = wave, j = 16 * jt + tokv; fx4 d = (fx4){0.f, 0.f, 0.f, 0.f};
                                if (st <= jt) {
                                    const float Mj = MArr[j];
#pragma unroll
                                    for (int kk = 0; kk < 3; ++kk) { const bx8 yq = *(const LAS bx8*)(Qs + j * 104 + 32 * kk + 8 * sgv), xk = *(const LAS bx8*)(Ks + (16 * st + tokv) * 104 + 32 * kk + 8 * sgv); d = __builtin_amdgcn_mfma_f32_16x16x32_bf16(xk, yq, d, 0, 0, 0); }
#pragma unroll
                                    for (int r = 0; r < 4; ++r) { const int s = 16 * st + 4 * sgv + r; d[r] = (s <= j) ? d[r] * __expf(aArr[s] - Mj) : 0.f; }
                                }
                                ux2 pw; pw.x = pg8::cvt_pk_bf16(d[0], d[1]); pw.y = pg8::cvt_pk_bf16(d[2], d[3]);
                                *(LAS ux2*)(Ps + j * 72 + 16 * st + 4 * sgv) = pw;
                            }
                            LDS_BARRIER();
                            __builtin_amdgcn_sched_barrier(0);
                            if (kind == 1) {
                                const int j = 16 * jt + (tidv >> 5), part = tidv & 31; float dq = 0.f, dp = 0.f;
#pragma unroll
                                for (int i = 0; i < 3; ++i) dq += bf2f(Qs[j * 104 + part * 3 + i]) * nArr[part * 3 + i];
#pragma unroll
                                for (int s = 0; s < 2; ++s) dp += bf2f(Ps[j * 72 + part * 2 + s]);
                                float dn = interArr[j] * dq + dp; dn += sh_xor(dn, 1, lane); dn += sh_xor(dn, 2, lane); dn += sh_xor(dn, 4, lane); dn += sh_xor(dn, 8, lane); dn += sh_xor(dn, 16, lane);
                                if (part == 0) denArr[j] = dn;
                            }
                            __builtin_amdgcn_sched_barrier(0);
                            constexpr int NXT = 2;
                            const int nx = (wave < 4) ? 2 : 1;
                            fx4 acc[NXT];
                            const size_t orow = row0 + 16 * jt + tokv;
                            ux2 ogate[NXT];
#pragma unroll
                            for (int x = 0; x < NXT; ++x) { ogate[x] = (ux2){0u, 0u}; if (x < nx) ogate[x] = *(const ux2*)(proj + orow * LDP + 1536 + h * 192 + 16 * (wave + 8 * x) + 4 * sgv); }
                            {
                                bx8 yq[3];
#pragma unroll
                                for (int kk = 0; kk < 3; ++kk) yq[kk] = *(const LAS bx8*)(Qs + (16 * jt + tokv) * 104 + 32 * kk + 8 * sgv);
#pragma unroll
                                for (int x = 0; x < NXT; ++x) { acc[x] = (fx4){0.f, 0.f, 0.f, 0.f}; const int ct = wave + 8 * x;
                                    if (x < nx) {
#pragma unroll
                                    for (int kk = 0; kk < 3; ++kk) { const bx8 xc = *(const LAS bx8*)(CT + (16 * ct + tokv) * 104 + 32 * kk + 8 * sgv); acc[x] = __builtin_amdgcn_mfma_f32_16x16x32_bf16(xc, yq[kk], acc[x], 0, 0, 0); } } }
                                __builtin_amdgcn_sched_barrier(0);
                                const float in_j = interArr[16 * jt + tokv];
#pragma unroll
                                for (int x = 0; x < NXT; ++x) acc[x] = acc[x] * in_j;
                                bx8 yp[2];
#pragma unroll
                                for (int kk = 0; kk < 2; ++kk) yp[kk] = *(const LAS bx8*)(Ps + (16 * jt + tokv) * 72 + 32 * kk + 8 * sgv);
#pragma unroll
                                for (int x = 0; x < NXT; ++x) { const int ct = wave + 8 * x;
                                    if (x < nx) {
#pragma unroll
                                    for (int kk = 0; kk < 2; ++kk) { const bx8 xv = *(const LAS bx8*)(VT + (16 * ct + tokv) * 72 + 32 * kk + 8 * sgv); acc[x] = __builtin_amdgcn_mfma_f32_16x16x32_bf16(xv, yp[kk], acc[x], 0, 0, 0); } } }
                            }
                            __builtin_amdgcn_sched_barrier(0);
                            {
                                const float sa = sa_c;
                                bx8 yv[3][2];
#pragma unroll
                                for (int x = 0; x < 3; ++x)
#pragma unroll
                                    for (int kk = 0; kk < 2; ++kk) yv[x][kk] = *(const LAS bx8*)(VT + (16 * (ctU + x) + tokv) * 72 + 32 * kk + 8 * sgv);
                                float ev[2][8];
#pragma unroll
                                for (int kk = 0; kk < 2; ++kk) { const fx4 e0 = *(const LAS fx4*)(eArr + 32 * kk + 8 * sgv), e1 = *(const LAS fx4*)(eArr + 32 * kk + 8 * sgv + 4);
                                    ev[kk][0] = e0[0]; ev[kk][1] = e0[1]; ev[kk][2] = e0[2]; ev[kk][3] = e0[3]; ev[kk][4] = e1[0]; ev[kk][5] = e1[1]; ev[kk][6] = e1[2]; ev[kk][7] = e1[3]; }
#pragma unroll
                                for (int x = 0; x < 3; ++x) { bx8 xk[2];
#pragma unroll
                                    for (int kk = 0; kk < 2; ++kk) { const ux4 rawk = *(const LAS ux4*)(KTe + (16 * (itU + x) + tokv) * 72 + 32 * kk + 8 * sgv); ux4 sk;
                                        sk.x = pg8::cvt_pk_bf16(__uint_as_float(rawk.x << 16) * ev[kk][0], __uint_as_float(rawk.x & 0xffff0000u) * ev[kk][1]); sk.y = pg8::cvt_pk_bf16(__uint_as_float(rawk.y << 16) * ev[kk][2], __uint_as_float(rawk.y & 0xffff0000u) * ev[kk][3]);
                                        sk.z = pg8::cvt_pk_bf16(__uint_as_float(rawk.z << 16) * ev[kk][4], __uint_as_float(rawk.z & 0xffff0000u) * ev[kk][5]); sk.w = pg8::cvt_pk_bf16(__uint_as_float(rawk.w << 16) * ev[kk][6], __uint_as_float(rawk.w & 0xffff0000u) * ev[kk][7]);
                                        xk[kk] = __builtin_bit_cast(bx8, sk); }
#pragma unroll
                                    for (int y = 0; y < 3; ++y) { Cst[x][y] = Cst[x][y] * sa;
#pragma unroll
                                        for (int kk = 0; kk < 2; ++kk) Cst[x][y] = __builtin_amdgcn_mfma_f32_16x16x32_bf16(xk[kk], yv[y][kk], Cst[x][y], 0, 0, 0); } }
                                if (kind == 1 && tidv < 96) { float sn = 0.f;
#pragma unroll 8
                                    for (int s = 0; s < 64; ++s) sn += bf2f(KTe[tidv * 72 + s]) * eArr[s];
                                    nreg = sa * nreg + sn; }
                            }
                            __builtin_amdgcn_sched_barrier(0);
                            LDS_BARRIER();
                            {
                                const int j = 16 * jt + tokv;
                                if (kind == 1) { const float dv = 1.0f / fmaxf(fabsf(denArr[j]), clampArr[j]);
#pragma unroll
                                    for (int x = 0; x < NXT; ++x) acc[x] = acc[x] * dv; }
                                float s1 = 0.f, s2 = 0.f;
#pragma unroll
                                for (int x = 0; x < NXT; ++x)
#pragma unroll
                                    for (int r = 0; r < 4; ++r) { s1 += acc[x][r]; s2 += acc[x][r] * acc[x][r]; }
                                s1 += sh_xor(s1, 16, lane); s1 += sh_xor(s1, 32, lane); s2 += sh_xor(s2, 16, lane); s2 += sh_xor(s2, 32, lane);
                                if (sgv == 0) { stat[(tokv * 8 + wave) * 2 + 0] = s1; stat[(tokv * 8 + wave) * 2 + 1] = s2; }
                            }
                            LDS_BARRIER();
                            {
                                const int j = 16 * jt + tokv;
                                float t1 = 0.f, t2 = 0.f;
#pragma unroll
                                for (int w8 = 0; w8 < 8; ++w8) { t1 += stat[(tokv * 8 + w8) * 2 + 0]; t2 += stat[(tokv * 8 + w8) * 2 + 1]; }
                                const float mean = t1 * (1.0f / 192.0f);
                                const float var = t2 * (1.0f / 192.0f) - mean * mean; (void)j;
                                const float rstd = 1.0f / sqrtf(fmaxf(var, 0.f) + LN_EPS);
#pragma unroll
                                for (int x = 0; x < NXT; ++x) if (x < nx) { const int colh = 16 * (wave + 8 * x) + 4 * sgv; const float4 g4 = *(const float4*)(norm_g + h * 192 + colh);
                                    const float o0 = __uint_as_float(ogate[x].x << 16), o1 = __uint_as_float(ogate[x].x & 0xffff0000u), o2 = __uint_as_float(ogate[x].y << 16), o3 = __uint_as_float(ogate[x].y & 0xffff0000u);
                                    float g0, g1, g2, g3;
                                    if (kind == 1) { g0 = sigmoidf(o0); g1 = sigmoidf(o1); g2 = sigmoidf(o2); g3 = sigmoidf(o3); } else { g0 = o0 * sigmoidf(o0); g1 = o1 * sigmoidf(o1); g2 = o2 * sigmoidf(o2); g3 = o3 * sigmoidf(o3); }
                                    ux2 ov; ov.x = pg8::cvt_pk_bf16((acc[x][0] - mean) * rstd * g4.x * g0, (acc[x][1] - mean) * rstd * g4.y * g1); ov.y = pg8::cvt_pk_bf16((acc[x][2] - mean) * rstd * g4.z * g2, (acc[x][3] - mean) * rstd * g4.w * g3);
                                    *(ux2*)(cat + orow * D + h * 192 + colh) = ov; }
#pragma unroll
                                for (int x = 0; x < 3; ++x)
#pragma unroll
                                    for (int y = 0; y < 3; ++y) { ux2 cw; cw.x = pg8::cvt_pk_bf16(Cst[x][y][0], Cst[x][y][1]); cw.y = pg8::cvt_pk_bf16(Cst[x][y][2], Cst[x][y][3]);
                                        *(LAS ux2*)(CT + (16 * (ctU + y) + tokv) * 104 + 16 * (itU + x) + 4 * sgv) = cw; }
                                if (kind == 1 && tidv < 96) nArr[tidv] = nreg;
                            }
                        }
                    }
                }
#elif FAST_LINATT
                {
                    typedef pg8::bf16x8 bx8; typedef pg8::f32x4 fx4; typedef pg8::u32x4 ux4; typedef pg8::u32x2 ux2;
                    LAS bf16* Qs = (LAS bf16*)lds;
                    LAS bf16* Ks = (LAS bf16*)(lds + 13312);
                    LAS bf16* KTe = (LAS bf16*)(lds + 26624);
                    LAS bf16* VT = (LAS bf16*)(lds + 40448);
                    LAS bf16* Ps = (LAS bf16*)(lds + 68096);
                    LAS bf16* CT = (LAS bf16*)(lds + 77312);
                    LAS float* fa = (LAS float*)(lds + 117248);
                    LAS float* aArr = fa, *MArr = fa + 64, *interArr = fa + 128, *clampArr = fa + 192, *eArr = fa + 256, *denArr = fa + 320, *nArr = fa + 384  , *stat = fa + 480  , *scal = fa + 736;
                    const float* conv_q = (const float*)ARGP(17); const float* conv_k = (const float*)ARGP(18);
                    const float* b_i = (const float*)ARGP(19); const float* b_f = (const float*)ARGP(20);
                    const float* norm_g = (const float*)(kind == 1 ? ARGP(21) : ARGP(23));
                    const int tok = lane & 15, sg = lane >> 4;
                    for (int unit = bid; unit < NB * 4; unit += G) {
                        const int b = unit >> 2, h = unit & 3;
                        const float lgam = __logf(1.0f - exp2f(-5.0f - (float)h));
                        fx4 Cst[3][3];
#pragma unroll
                        for (int x = 0; x < 3; ++x)
#pragma unroll
                            for (int y = 0; y < 3; ++y) Cst[x][y] = (fx4){0.f, 0.f, 0.f, 0.f};
                        float nreg = 0.f, m_prev = 0.f;
                        __syncthreads();
                        for (int i = tid; i < 192 * 104 / 2; i += NTHR) ((LAS unsigned*)CT)[i] = 0u;
                        if (tid < 96) nArr[tid] = 0.f;
                        const int ctU = 3 * (wave & 3), itU = 3 * (wave >> 2);
                        const int jt = wave & 3, half = wave >> 2;
                        typedef _Float16 h2_t __attribute__((ext_vector_type(2)));
                        ux4 rv[3], rg[8]; float rig = 0.f, rfg = 0.f;
#pragma unroll
                        for (int q = 0; q < 8; ++q) rg[q] = (ux4){0u, 0u, 0u, 0u};
#define LINATT_LOAD_RAW(cc) do { const size_t r0_ = (size_t)b * SEQ + (size_t)(cc) * 64; \
                            _Pragma("unroll") for (int kq = 0; kq < 3; ++kq) { const int idx = tidv + NTHR * kq, cg = idx >> 6, s = idx & 63; rv[kq] = *(const ux4*)(proj + (r0_ + s) * LDP + 768 + h * 192 + 8 * cg); } \
                            if (kind == 1) { _Pragma("unroll") for (int kq = 0; kq < 3; ++kq) { const int idx = tidv + NTHR * kq, which = idx / 768, rem = idx % 768, cg = rem >> 6, s = rem & 63; \
                                    rg[kq] = *(const ux4*)(proj + (r0_ + s) * LDP + which * 384 + h * 96 + 8 * cg); } \
                                if (wave == 0) { const bf16* pr = proj + (r0_ + lanev) * LDP; rig = bf2f(pr[2304 + h]); rfg = bf2f(pr[2308 + h]); } } \
                            else { _Pragma("unroll") for (int kq = 0; kq < 2; ++kq) { const int idx = tidv + NTHR * kq; if (idx < 768) { const int which = idx / 384, rem = idx % 384, cg = rem >> 6, s = rem & 63; \
                                    const bf16* xp = proj + (r0_ + s) * LDP + which * 384 + h * 96 + 8 * cg; rg[kq] = *(const ux4*)xp; rg[2 + kq] = *(const ux4*)(xp + 48); \
                                    const ux4* rp = (const ux4*)((const unsigned*)rope + (r0_ + s) * 48 + 8 * cg); rg[4 + 2 * kq] = rp[0]; rg[5 + 2 * kq] = rp[1]; } } } } while (0)
                        { int tidv = tid; asm volatile("" : "+v"(tidv)); const int lanev = tidv & 63; LINATT_LOAD_RAW(0); }
                        for (int c = 0; c < SEQ / 64; ++c) {
                            const size_t row0 = (size_t)b * SEQ + c * 64;
                            int tidv = tid; asm volatile("" : "+v"(tidv));
                            const int lanev = tidv & 63, tokv = lanev & 15, sgv = lanev >> 4;
                            if (wave == 0) {
                                float lf, ig;
                                if (kind == 1) { ig = rig + b_i[h]; const float fg = rfg + b_f[h]; lf = fminf(fg, 0.f) - __logf(1.0f + __expf(-fabsf(fg))); }
                                else { ig = 0.f; lf = lgam; }
                                float bc = lf;
#pragma unroll
                                for (int o = 1; o < 64; o <<= 1) { const float t = sh_up(bc, o, lanev); if (lanev >= o) bc += t; }
                                const float a = ig - bc; float M;
                                if (kind == 1) { float A = a;
#pragma unroll
                                    for (int o = 1; o < 64; o <<= 1) { const float t = sh_up(A, o, lanev); if (lanev >= o) A = fmaxf(A, t); }
                                    M = fmaxf(m_prev, A); }
                                else M = -bc;
                                const float M63 = sh_idx(M, 63, lane), btot = sh_idx(bc, 63, lane);
                                aArr[lanev] = a; MArr[lanev] = M; interArr[lanev] = __expf(m_prev - M); clampArr[lanev] = __expf(-(bc + M)); eArr[lanev] = __expf(a - M63);
                                if (lanev == 0) scal[0] = __expf(m_prev - M63);
                                if (kind == 1) m_prev = btot + M63;
                            }
                            LDS_BARRIER();
#pragma unroll
                            for (int kq = 0; kq < 3; ++kq) {
                                const int idx = tidv + NTHR * kq, cg = idx >> 6, s = idx & 63; const ux4 v = rv[kq];
                                LAS bf16* d = VT + (8 * cg) * 72 + s;
                                d[0] = (bf16)(v.x & 0xffffu); d[72] = (bf16)(v.x >> 16); d[144] = (bf16)(v.y & 0xffffu); d[216] = (bf16)(v.y >> 16);
                                d[288] = (bf16)(v.z & 0xffffu); d[360] = (bf16)(v.z >> 16); d[432] = (bf16)(v.w & 0xffffu); d[504] = (bf16)(v.w >> 16);
                            }
                            if (kind == 1) {
#pragma unroll
                                for (int kq = 0; kq < 3; ++kq) {
                                    const int idx = tidv + NTHR * kq, which = idx / 768, rem = idx % 768, cg = rem >> 6, s = rem & 63;
                                    const int ch = h * 96 + 8 * cg;
                                    const float* cw = (which ? conv_k : conv_q) + ch;
                                    float r[8];
                                    { float x[8]; uint4 xu; xu.x = rg[kq].x; xu.y = rg[kq].y; xu.z = rg[kq].z; xu.w = rg[kq].w; unpack8(xu, x);
                                      const float4 w0 = *(const float4*)(cw + 3 * 384), w1 = *(const float4*)(cw + 3 * 384 + 4);
                                      r[0] = w0.x * x[0]; r[1] = w0.y * x[1]; r[2] = w0.z * x[2]; r[3] = w0.w * x[3]; r[4] = w1.x * x[4]; r[5] = w1.y * x[5]; r[6] = w1.z * x[6]; r[7] = w1.w * x[7]; }
#pragma unroll
                                    for (int dl = 1; dl <= 3; ++dl) {
                                        const int sl = (lanev - dl) & 63; uint4 xu;
                                        { const unsigned c0 = sh_idx(rg[kq].x, sl, lanev), p0 = sh_idx(rg[3 + kq].x, sl, lanev); xu.x = (lanev >= dl) ? c0 : p0; }
                                        { const unsigned c0 = sh_idx(rg[kq].y, sl, lanev), p0 = sh_idx(rg[3 + kq].y, sl, lanev); xu.y = (lanev >= dl) ? c0 : p0; }
                                        { const unsigned c0 = sh_idx(rg[kq].z, sl, lanev), p0 = sh_idx(rg[3 + kq].z, sl, lanev); xu.z = (lanev >= dl) ? c0 : p0; }
                                        { const unsigned c0 = sh_idx(rg[kq].w, sl, lanev), p0 = sh_idx(rg[3 + kq].w, sl, lanev); xu.w = (lanev >= dl) ? c0 : p0; }
                                        float x[8]; unpack8(xu, x);
                                        const float4 w0 = *(const float4*)(cw + (3 - dl) * 384), w1 = *(const float4*)(cw + (3 - dl) * 384 + 4);
                                        r[0] += w0.x * x[0]; r[1] += w0.y * x[1]; r[2] += w0.z * x[2]; r[3] += w0.w * x[3]; r[4] += w1.x * x[4]; r[5] += w1.y * x[5]; r[6] += w1.z * x[6]; r[7] += w1.w * x[7];
                                    }
                                    rg[3 + kq] = rg[kq];
                                    const float sc = which ? 1.0f : 0.10206207261596575f;
#pragma unroll
                                    for (int i = 0; i < 8; ++i) r[i] = r[i] * sigmoidf(r[i]) * sc;
                                    ux4 pk; pk.x = pg8::cvt_pk_bf16(r[0], r[1]); pk.y = pg8::cvt_pk_bf16(r[2], r[3]); pk.z = pg8::cvt_pk_bf16(r[4], r[5]); pk.w = pg8::cvt_pk_bf16(r[6], r[7]);
                                    if (which == 0) *(LAS ux4*)(Qs + s * 104 + 8 * cg) = pk;
                                    else { *(LAS ux4*)(Ks + s * 104 + 8 * cg) = pk; const float es = eArr[s]; LAS bf16* d = KTe + (8 * cg) * 72 + s;
#pragma unroll
                                        for (int i = 0; i < 8; ++i) d[72 * i] = f2bf(r[i] * es); }
                                }
                            } else {
#pragma unroll
                                for (int kq = 0; kq < 2; ++kq) {
                                    const int idx = tidv + NTHR * kq;
                                    if (idx < 768) {
                                        const int which = idx / 384, rem = idx % 384, cg = rem >> 6, s = rem & 63;
                                        float x1[8], x2[8]; { uint4 xu; xu.x = rg[kq].x; xu.y = rg[kq].y; xu.z = rg[kq].z; xu.w = rg[kq].w; unpack8(xu, x1); xu.x = rg[2 + kq].x; xu.y = rg[2 + kq].y; xu.z = rg[2 + kq].z; xu.w = rg[2 + kq].w; unpack8(xu, x2); }
                                        const unsigned rpw[8] = {rg[4 + 2 * kq].x, rg[4 + 2 * kq].y, rg[4 + 2 * kq].z, rg[4 + 2 * kq].w, rg[5 + 2 * kq].x, rg[5 + 2 * kq].y, rg[5 + 2 * kq].z, rg[5 + 2 * kq].w};
                                        float o1[8], o2[8]; const float sc = which ? 0.10206207261596575f : 1.0f;
#pragma unroll
                                        for (int q8 = 0; q8 < 8; ++q8) { const h2_t cs_ = __builtin_bit_cast(h2_t, rpw[q8]); const float c0 = (float)cs_.x, s0 = (float)cs_.y;
                                            o1[q8] = (x1[q8] * c0 - x2[q8] * s0) * sc; o2[q8] = (x2[q8] * c0 + x1[q8] * s0) * sc; }
                                        ux4 p1; p1.x = pg8::cvt_pk_bf16(o1[0], o1[1]); p1.y = pg8::cvt_pk_bf16(o1[2], o1[3]); p1.z = pg8::cvt_pk_bf16(o1[4], o1[5]); p1.w = pg8::cvt_pk_bf16(o1[6], o1[7]);
                                        ux4 p2; p2.x = pg8::cvt_pk_bf16(o2[0], o2[1]); p2.y = pg8::cvt_pk_bf16(o2[2], o2[3]); p2.z = pg8::cvt_pk_bf16(o2[4], o2[5]); p2.w = pg8::cvt_pk_bf16(o2[6], o2[7]);
                                        LAS bf16* dst = which ? Ks : Qs;
                                        *(LAS ux4*)(dst + s * 104 + 8 * cg) = p1; *(LAS ux4*)(dst + s * 104 + 48 + 8 * cg) = p2;
                                        if (which) { const float es = eArr[s]; LAS bf16* d = KTe + (8 * cg) * 72 + s;
#pragma unroll
                                            for (int i = 0; i < 8; ++i) { d[72 * i] = f2bf(o1[i] * es); d[72 * (48 + i)] = f2bf(o2[i] * es); } }
                                    }
                                }
                            }
                            if (c + 1 < SEQ / 64) LINATT_LOAD_RAW(c + 1);
                            LDS_BARRIER(); __builtin_amdgcn_sched_barrier(0);
                            {
                                bx8 yq[3];
#pragma unroll
                                for (int kk = 0; kk < 3; ++kk) yq[kk] = *(const LAS bx8*)(Qs + (16 * jt + tokv) * 104 + 32 * kk + 8 * sgv);
                                const int j = 16 * jt + tokv; const float Mj = MArr[j];
#pragma unroll
                                for (int q2 = 0; q2 < 2; ++q2) {
                                    const int st = 2 * half + q2; fx4 d = (fx4){0.f, 0.f, 0.f, 0.f};
                                    if (st <= jt) {
#pragma unroll
                                        for (int kk = 0; kk < 3; ++kk) { const bx8 xk = *(const LAS bx8*)(Ks + (16 * st + tokv) * 104 + 32 * kk + 8 * sgv); d = __builtin_amdgcn_mfma_f32_16x16x32_bf16(xk, yq[kk], d, 0, 0, 0); }
#pragma unroll
                                        for (int r = 0; r < 4; ++r) { const int s = 16 * st + 4 * sgv + r; d[r] = (s <= j) ? d[r] * __expf(aArr[s] - Mj) : 0.f; }
                                    }
                                    ux2 pw; pw.x = pg8::cvt_pk_bf16(d[0], d[1]); pw.y = pg8::cvt_pk_bf16(d[2], d[3]);
                                    *(LAS ux2*)(Ps + j * 72 + 16 * st + 4 * sgv) = pw;
                                }
                            }
                            LDS_BARRIER();
                            __builtin_amdgcn_sched_barrier(0);
                            if (kind == 1) {
                                const int j = tidv >> 3, part = tidv & 7; float dq = 0.f, dp = 0.f;
#pragma unroll
                                for (int i = 0; i < 12; ++i) dq += bf2f(Qs[j * 104 + part * 12 + i]) * nArr[part * 12 + i];
#pragma unroll
                                for (int s = 0; s < 8; ++s) dp += bf2f(Ps[j * 72 + part * 8 + s]);
                                float dn = interArr[j] * dq + dp; dn += sh_xor(dn, 1, lane); dn += sh_xor(dn, 2, lane); dn += sh_xor(dn, 4, lane);
                                if (part == 0) denArr[j] = dn;
                            }
                            __builtin_amdgcn_sched_barrier(0);
                            fx4 acc[6];
                            const size_t orow = row0 + 16 * jt + tokv;
                            ux2 ogate[6];
#pragma unroll
                            for (int x = 0; x < 6; ++x) ogate[x] = *(const ux2*)(proj + orow * LDP + 1536 + h * 192 + 16 * (6 * half + x) + 4 * sgv);
                            {
                                bx8 yq[3];
#pragma unroll
                                for (int kk = 0; kk < 3; ++kk) yq[kk] = *(const LAS bx8*)(Qs + (16 * jt + tokv) * 104 + 32 * kk + 8 * sgv);
#pragma unroll
                                for (int x = 0; x < 6; ++x) { acc[x] = (fx4){0.f, 0.f, 0.f, 0.f}; const int ct = 6 * half + x;
#pragma unroll
                                    for (int kk = 0; kk < 3; ++kk) { const bx8 xc = *(const LAS bx8*)(CT + (16 * ct + tokv) * 104 + 32 * kk + 8 * sgv); acc[x] = __builtin_amdgcn_mfma_f32_16x16x32_bf16(xc, yq[kk], acc[x], 0, 0, 0); } }
                                __builtin_amdgcn_sched_barrier(0);
                                const float in_j = interArr[16 * jt + tokv];
#pragma unroll
                                for (int x = 0; x < 6; ++x) acc[x] = acc[x] * in_j;
                                bx8 yp[2];
#pragma unroll
                                for (int kk = 0; kk < 2; ++kk) yp[kk] = *(const LAS bx8*)(Ps + (16 * jt + tokv) * 72 + 32 * kk + 8 * sgv);
#pragma unroll
                                for (int x = 0; x < 6; ++x) { const int ct = 6 * half + x;
#pragma unroll
                                    for (int kk = 0; kk < 2; ++kk) { const bx8 xv = *(const LAS bx8*)(VT + (16 * ct + tokv) * 72 + 32 * kk + 8 * sgv); acc[x] = __builtin_amdgcn_mfma_f32_16x16x32_bf16(xv, yp[kk], acc[x], 0, 0, 0); } }
                            }
                            __builtin_amdgcn_sched_barrier(0);
                            {
                                const float sa = scal[0];
                                bx8 yv[3][2];
#pragma unroll
                                for (int x = 0; x < 3; ++x)
#pragma unroll
                                    for (int kk = 0; kk < 2; ++kk) yv[x][kk] = *(const LAS bx8*)(VT + (16 * (ctU + x) + tokv) * 72 + 32 * kk + 8 * sgv);
#pragma unroll
                                for (int x = 0; x < 3; ++x) { bx8 xk[2];
#pragma unroll
                                    for (int kk = 0; kk < 2; ++kk) xk[kk] = *(const LAS bx8*)(KTe + (16 * (itU + x) + tokv) * 72 + 32 * kk + 8 * sgv);
#pragma unroll
                                    for (int y = 0; y < 3; ++y) { Cst[x][y] = Cst[x][y] * sa;
#pragma unroll
                                        for (int kk = 0; kk < 2; ++kk) Cst[x][y] = __builtin_amdgcn_mfma_f32_16x16x32_bf16(xk[kk], yv[y][kk], Cst[x][y], 0, 0, 0); } }
                                if (kind == 1 && tidv < 96) { float sn = 0.f;
#pragma unroll 8
                                    for (int s = 0; s < 64; ++s) sn += bf2f(KTe[tidv * 72 + s]);
                                    nreg = sa * nreg + sn; }
                            }
                            __builtin_amdgcn_sched_barrier(0);
                            LDS_BARRIER();
                            {
                                const int j = 16 * jt + tokv;
                                if (kind == 1) { const float dv = 1.0f / fmaxf(fabsf(denArr[j]), clampArr[j]);
#pragma unroll
                                    for (int x = 0; x < 6; ++x) acc[x] = acc[x] * dv; }
                                float s1 = 0.f, s2 = 0.f;
#pragma unroll
                                for (int x = 0; x < 6; ++x)
#pragma unroll
                                    for (int r = 0; r < 4; ++r) { s1 += acc[x][r]; s2 += acc[x][r] * acc[x][r]; }
                                s1 += sh_xor(s1, 16, lane); s1 += sh_xor(s1, 32, lane); s2 += sh_xor(s2, 16, lane); s2 += sh_xor(s2, 32, lane);
                                if (sgv == 0) { stat[(j * 2 + half) * 2 + 0] = s1; stat[(j * 2 + half) * 2 + 1] = s2; }
                            }
                            LDS_BARRIER();
                            {
                                const int j = 16 * jt + tokv;
                                const float mean = (stat[j * 4 + 0] + stat[j * 4 + 2]) * (1.0f / 192.0f);
                                const float var = (stat[j * 4 + 1] + stat[j * 4 + 3]) * (1.0f / 192.0f) - mean * mean;
                                const float rstd = 1.0f / sqrtf(fmaxf(var, 0.f) + LN_EPS);
#pragma unroll
                                for (int x = 0; x < 6; ++x) { const int colh = 16 * (6 * half + x) + 4 * sgv; const float4 g4 = *(const float4*)(norm_g + h * 192 + colh);
                                    const float o0 = __uint_as_float(ogate[x].x << 16), o1 = __uint_as_float(ogate[x].x & 0xffff0000u), o2 = __uint_as_float(ogate[x].y << 16), o3 = __uint_as_float(ogate[x].y & 0xffff0000u);
                                    float g0, g1, g2, g3;
                                    if (kind == 1) { g0 = sigmoidf(o0); g1 = sigmoidf(o1); g2 = sigmoidf(o2); g3 = sigmoidf(o3); } else { g0 = o0 * sigmoidf(o0); g1 = o1 * sigmoidf(o1); g2 = o2 * sigmoidf(o2); g3 = o3 * sigmoidf(o3); }
                                    ux2 ov; ov.x = pg8::cvt_pk_bf16((acc[x][0] - mean) * rstd * g4.x * g0, (acc[x][1] - mean) * rstd * g4.y * g1); ov.y = pg8::cvt_pk_bf16((acc[x][2] - mean) * rstd * g4.z * g2, (acc[x][3] - mean) * rstd * g4.w * g3);
                                    *(ux2*)(cat + orow * D + h * 192 + colh) = ov; }
#pragma unroll
                                for (int x = 0; x < 3; ++x)
#pragma unroll
                                    for (int y = 0; y < 3; ++y) { ux2 cw; cw.x = pg8::cvt_pk_bf16(Cst[x][y][0], Cst[x][y][1]); cw.y = pg8::cvt_pk_bf16(Cst[x][y][2], Cst[x][y][3]);
                                        *(LAS ux2*)(CT + (16 * (ctU + y) + tokv) * 104 + 16 * (itU + x) + 4 * sgv) = cw; }
                                if (kind == 1 && tidv < 96) nArr[tidv] = nreg;
                            }
                        }
                    }
                }
#else
                LAS float* sq = ldsf; LAS float* sk = ldsf + 96; LAS float* sg = ldsf + 192; LAS float* sred = ldsf + 256;
                const float* conv_q = (const float*)ARGP(17); const float* conv_k = (const float*)ARGP(18);
                const float* b_i = (const float*)ARGP(19); const float* b_f = (const float*)ARGP(20);
                const float* norm_g = (const float*)(kind == 1 ? ARGP(21) : ARGP(23));
                for (int unit = bid; unit < NB * 4; unit += G) {
                    const int b = unit >> 2, h = unit & 3;
                    const float gamma = 1.0f - exp2f(-5.0f - (float)h);
                    float C[96];
#pragma unroll
                    for (int i = 0; i < 96; ++i) C[i] = 0.f;
                    for (int t = 0; t < SEQ; ++t) {
                        const size_t row = (size_t)b * SEQ + t; const bf16* pr = proj + row * LDP;
                        if (tid < 192) {
                            const int c = tid % 96; const bool isk = tid >= 96; const int ch = h * 96 + c; const int col = (isk ? 384 : 0) + ch;
                            float s;
                            if (kind == 1) {
                                const float* cw = isk ? conv_k : conv_q; s = 0.f;
#pragma unroll
                                for (int w = 0; w < 4; ++w) { const int tt = t - 3 + w; if (tt >= 0) s += cw[w * 384 + ch] * bf2f(proj[((size_t)b * SEQ + tt) * LDP + col]); }
                                s = s * sigmoidf(s); if (!isk) s *= 0.10206207261596575f;
                            } else {
                                const int i = c % 48; const bool first = c < 48; const int cb = (isk ? 384 : 0) + h * 96;
                                const float t1 = bf2f(pr[cb + i]), t2 = bf2f(pr[cb + 48 + i]);
                                typedef _Float16 h2_t __attribute__((ext_vector_type(2))); const h2_t cs_ = __builtin_bit_cast(h2_t, ((const unsigned*)rope)[row * 48 + i]); const float cs = (float)cs_.x, sn = (float)cs_.y;
                                s = first ? (t1 * cs - t2 * sn) : (t2 * cs + t1 * sn); if (isk) s *= 0.10206207261596575f;
                            }
                            (isk ? sk : sq)[c] = s;
                        }
                        if (tid == 192) {
                            if (kind == 1) { const float ig = bf2f(pr[2304 + h]) + b_i[h], fg = bf2f(pr[2308 + h]) + b_f[h]; sg[0] = sigmoidf(fg); sg[1] = __expf(ig); }
                            else { sg[0] = gamma; sg[1] = 1.0f; }
                        }
                        __syncthreads();
                        const float f = sg[0], ei = sg[1];
                        float num = 0.f;
                        if (tid < 193) {
                            const float v = tid < 192 ? bf2f(pr[768 + h * 192 + tid]) : 1.0f;
#pragma unroll
                            for (int i = 0; i < 96; ++i) { C[i] = f * C[i] + (ei * sk[i]) * v; num += sq[i] * C[i]; if ((i & 15) == 15) asm volatile("" ::: "memory"); }
                            if (tid == 192) sg[2] = num;
                        }
                        __syncthreads();
                        float hv = num;
                        if (kind == 1) hv = num / fmaxf(fabsf(sg[2]), 1.0f);
                        float s1 = (tid < 192) ? hv : 0.f; s1 = wave_sum(s1, lane); if (lane == 0) sred[wave] = s1;
                        __syncthreads();
                        const float mean = (sred[0] + sred[1] + sred[2]) * (1.0f / 192.0f);
                        float dv = (tid < 192) ? (hv - mean) : 0.f; float s2 = wave_sum(dv * dv, lane); if (lane == 0) sred[8 + wave] = s2;
                        __syncthreads();
                        const float var = (sred[8] + sred[9] + sred[10]) * (1.0f / 192.0f);
                        if (tid < 192) {
                            const float yn = dv * (1.0f / sqrtf(var + LN_EPS)) * norm_g[h * 192 + tid];
                            const float ov = bf2f(pr[1536 + h * 192 + tid]);
                            const float outv = (kind == 1) ? sigmoidf(ov) * yn : (ov * sigmoidf(ov)) * yn;
                            cat[row * D + h * 192 + tid] = f2bf(outv);
                        }
                    }
                }
#endif
            }
            }
#if BG_CONV && FAST_MOE
            {
                const bool bg_here = (BG_ALL && LINATT_V2) ? true : (kind != 0);
                if (bg_here) {
                const bool s5_overlap = (kind == 0) && (G >= 192);
                if (!s5_overlap) __syncthreads();
                LAS float* scr = !s5_overlap ? ldsf + wave * (64 * 65) : (wave < 2 ? ldsf + wave * 8192 : ldsf + 16384 + (wave - 2) * (64 * 65));
                unsigned* qh = ctl + CW_CQ + 64 * L;
                constexpr int PERL = NEXP * (512 + 256), HALF2 = LINATT_V2 ? PERL / 2 : PERL;
                const int g0 = (BG_ALL && LINATT_V2) ? L * PERL : ((L == 1) ? PERL : 2 * PERL + HALF2), g1 = (BG_ALL && LINATT_V2) ? (L + 1) * PERL : ((L == 1) ? 2 * PERL + HALF2 : 4 * PERL);
                if (!s5_overlap || wave < 6)
                for (;;) {
                    int it = 0; if (lane == 0) it = (int)__hip_atomic_fetch_add(qh, 1u, __ATOMIC_RELAXED, __HIP_MEMORY_SCOPE_AGENT);
                    it = __builtin_amdgcn_readfirstlane(it) + g0;
                    if (it >= g1) break;
                    const int Lc = it / PERL; it = it % PERL;
                    if (it < NEXP * 512) { const int le = Lc * NEXP + (it >> 9);
#if MOE_FP8
                        tr_item8<LINATT_V2>((const float*)ARGP(42) + (size_t)le * D * 2 * DEXP, 2 * DEXP, D, wgu8 + (size_t)le * 2 * DEXP * D, 32, it & 511, scr, lane, GU_WS, [](int d) { const int tile = d >> 8, q = d & 255; return q < 128 ? tile * 128 + q : DEXP + tile * 128 + (q - 128); });
#else
                        tr_item((const float*)ARGP(42) + (size_t)le * D * 2 * DEXP, 2 * DEXP, D, wgu_t + (size_t)le * 2 * DEXP * D, 32, it & 511, scr, lane, [](int d) { const int tile = d >> 8, q = d & 255; return q < 128 ? tile * 128 + q : DEXP + tile * 128 + (q - 128); });
#endif
                    }
                    else { const int r = it - NEXP * 512; const int le = Lc * NEXP + (r >> 8);
#if MOE_FP8
                        tr_item8<LINATT_V2>((const float*)ARGP(44) + (size_t)le * DEXP * D, D, DEXP, wdn8 + (size_t)le * D * DEXP, 16, r & 255, scr, lane, DN_WS, [](int d) { return d; });
#else
                        tr_item((const float*)ARGP(44) + (size_t)le * DEXP * D, D, DEXP, wdn_t + (size_t)le * D * DEXP, 16, r & 255, scr, lane, [](int d) { return d; });
#endif
                    }
                }
                }
            }
#endif
            REPS(13) { if (rep_) __syncthreads();
#if FAST_XATTN
            {
                typedef pg8::bf16x8 bx8; typedef pg8::f32x4 fx4;
                LAS bf16* Kt = (LAS bf16*)lds;
                LAS bf16* Vt = (LAS bf16*)(lds + 36864);
                const int tok = lane & 15, sg = lane >> 4;
                const int xa_skip = (LINATT_V2 && kind != 0 && G > 192) ? 128 : 0;
                for (int unit = bid - xa_skip; unit >= 0 && unit < NB * 4 * 8; unit += G - xa_skip) {
                    const int b = unit >> 5, head = (unit >> 3) & 3, qt = unit & 7;
                    __syncthreads();
                    const bf16* kg = memK + (size_t)(b * 4 + head) * 256 * 64; const bf16* vg = memVT + (size_t)(b * 4 + head) * 64 * 256;
                    for (int c = tid; c < 2048; c += NTHR) { const int key = c >> 3, d8 = (c & 7) * 8; *(LAS pg8::u32x4*)(Kt + key * 72 + d8) = *(const pg8::u32x4*)(kg + key * 64 + d8); }
                    for (int c = tid; c < 2048; c += NTHR) { const int d = c >> 5, m = (c & 31) * 8; const pg8::u32x4 v = *(const pg8::u32x4*)(vg + d * 256 + m);
                        const int a = m >> 5, w = m & 31, tp = w >> 4, sk = (w & 15) >> 2;
                        pg8::u32x2 lo; lo.x = v.x; lo.y = v.y; pg8::u32x2 hi2; hi2.x = v.z; hi2.y = v.w;
                        *(LAS pg8::u32x2*)(Vt + d * 264 + 32 * a + 8 * sk + 4 * tp) = lo; *(LAS pg8::u32x2*)(Vt + d * 264 + 32 * a + 8 * (sk + 1) + 4 * tp) = hi2; }
                    __syncthreads();
#pragma unroll 1
                    for (int qi = 0; qi < 2; ++qi) {
                        const size_t row = (size_t)b * SEQ + qt * 256 + wave * 32 + qi * 16 + tok;
                        const bf16* qp = proj + row * LDP + xq_off + head * 64 + 8 * sg;
                        const bx8 q0 = __builtin_bit_cast(bx8, *(const uint4*)qp), q1 = __builtin_bit_cast(bx8, *(const uint4*)(qp + 32));
                        fx4 s[16];
#pragma unroll
                        for (int kt = 0; kt < 16; ++kt) { const bx8 k0 = *(const LAS bx8*)(Kt + (16 * kt + tok) * 72 + 8 * sg), k1 = *(const LAS bx8*)(Kt + (16 * kt + tok) * 72 + 32 + 8 * sg);
                            s[kt] = __builtin_amdgcn_mfma_f32_16x16x32_bf16(k0, q0, (fx4){0.f, 0.f, 0.f, 0.f}, 0, 0, 0); s[kt] = __builtin_amdgcn_mfma_f32_16x16x32_bf16(k1, q1, s[kt], 0, 0, 0); }
                        float mx = -3.0e38f;
#pragma unroll
                        for (int kt = 0; kt < 16; ++kt) mx = fmaxf(fmaxf(fmaxf(s[kt][0], s[kt][1]), fmaxf(s[kt][2], s[kt][3])), mx);
                        mx = fmaxf(mx, sh_xor(mx, 16, lane)); mx = fmaxf(mx, sh_xor(mx, 32, lane));
                        float sum = 0.f;
#pragma unroll
                        for (int kt = 0; kt < 16; ++kt)
#pragma unroll
                            for (int r = 0; r < 4; ++r) { const float pe = __expf((s[kt][r] - mx) * 0.125f); s[kt][r] = pe; sum += pe; }
                        sum += sh_xor(sum, 16, lane); sum += sh_xor(sum, 32, lane);
                        fx4 o[4];
#pragma unroll
                        for (int dt = 0; dt < 4; ++dt) o[dt] = (fx4){0.f, 0.f, 0.f, 0.f};
#pragma unroll
                        for (int a = 0; a < 8; ++a) {
                            uint4 pw; pw.x = pg8::cvt_pk_bf16(s[2 * a][0], s[2 * a][1]); pw.y = pg8::cvt_pk_bf16(s[2 * a][2], s[2 * a][3]); pw.z = pg8::cvt_pk_bf16(s[2 * a + 1][0], s[2 * a + 1][1]); pw.w = pg8::cvt_pk_bf16(s[2 * a + 1][2], s[2 * a + 1][3]);
                            const bx8 pf = __builtin_bit_cast(bx8, pw);
#pragma unroll
                            for (int dt = 0; dt < 4; ++dt) { const bx8 vf = *(const LAS bx8*)(Vt + (16 * dt + tok) * 264 + 32 * a + 8 * sg); o[dt] = __builtin_amdgcn_mfma_f32_16x16x32_bf16(vf, pf, o[dt], 0, 0, 0); }
                        }
                        const float inv = 1.0f / sum; bf16* op = cat + row * D + MIXW + head * 64 + 4 * sg;
#pragma unroll
                        for (int dt = 0; dt < 4; ++dt) { uint2 ov; ov.x = pg8::cvt_pk_bf16(o[dt][0] * inv, o[dt][1] * inv); ov.y = pg8::cvt_pk_bf16(o[dt][2] * inv, o[dt][3] * inv); *(uint2*)(op + 16 * dt) = ov; }
                    }
                }
            }
#else
            for (int wu = bid * NWAVES + wave; wu < (T / 16) * 4; wu += G * NWAVES) {
                const int head = wu & 3, row = (wu >> 2) * 16 + (lane >> 2), part = lane & 3, b = row / SEQ;
                float q[16], acc[16];
                { const bf16* qp = proj + (size_t)row * LDP + xq_off + head * 64 + part * 16;
                  unpack8(*(const uint4*)qp, q); unpack8(*(const uint4*)(qp + 8), q + 8);
#pragma unroll
                  for (int d = 0; d < 16; ++d) { q[d] *= 0.125f; acc[d] = 0.f; } }
                float mx = -3.0e38f, l = 0.f;
                const bf16* kb = memK + (size_t)(b * 4 + head) * 256 * 64 + part * 16; const bf16* vb = memV + (size_t)(b * 4 + head) * 256 * 64 + part * 16;
                for (int m = 0; m < NMEM; ++m) {
                    float kk[16]; unpack8(*(const uint4*)(kb + m * 64), kk); unpack8(*(const uint4*)(kb + m * 64 + 8), kk + 8);
                    float s = 0.f;
#pragma unroll
                    for (int j = 0; j < 16; ++j) s += q[j] * kk[j];
                    s += sh_xor(s, 1, lane); s += sh_xor(s, 2, lane);
                    const float mn = fmaxf(mx, s); const float corr = __expf(mx - mn), pv = __expf(s - mn); mx = mn; l = l * corr + pv;
                    float vv[16]; unpack8(*(const uint4*)(vb + m * 64), vv); unpack8(*(const uint4*)(vb + m * 64 + 8), vv + 8);
#pragma unroll
                    for (int j = 0; j < 16; ++j) acc[j] = acc[j] * corr + pv * vv[j];
                }
                const float il = 1.0f / l; bf16* op = cat + (size_t)row * D + MIXW + head * 64 + part * 16;
#pragma unroll
                for (int c = 0; c < 2; ++c) { uint4 o; o.x = pk2(acc[8 * c + 0] * il, acc[8 * c + 1] * il); o.y = pk2(acc[8 * c + 2] * il, acc[8 * c + 3] * il);
                    o.z = pk2(acc[8 * c + 4] * il, acc[8 * c + 5] * il); o.w = pk2(acc[8 * c + 6] * il, acc[8 * c + 7] * il); *(uint4*)(op + 8 * c) = o; }
            }
#endif
        } }
        SEAM(P + LP_MIXA);

        if (IN(P + LP_MIXB)) {
            PHASE_IDS();
            REPS(4) { if (rep_) __syncthreads();
            if (kind == 0) {
                const float* w_glu = (const float*)(L == 0 ? ARGP(14) : ARGP(33)); const float* b_glu = (const float*)(L == 0 ? ARGP(15) : ARGP(34));
#if FAST_DENSE
                { (void)w_glu; pg8::Gemm g{yg, wglu_t + (size_t)(L == 0 ? 0 : 1) * MiB, MIXW, nullptr}; pg8::StaticOrder S; S.init(T, MIXW, G, bid); pg8::EpiGlu E{cat, D, yg, MIXW, b_glu}; pg8::gemm_phase(lds, g, S, E, wave); }
#else
                oracle_gemm(ldsf, T, MIXW, MIXW,
                    [&](int) { return 0; },
                    [&](int m, int k) { return bf2f(yg[(size_t)m * MIXW + k]); },
                    [&](int k, int n, int) { return w_glu[(size_t)k * MIXW + n]; },
                    [&](int m0, int n0, float (&acc)[4][8], int) {
#pragma unroll
                        for (int i = 0; i < 4; ++i)
#pragma unroll
                            for (int j = 0; j < 8; ++j) { const int m = m0 + i, n = n0 + j; const float z = acc[i][j] + b_glu[n]; const float yv = bf2f(yg[(size_t)m * MIXW + n]);
                                cat[(size_t)m * D + n] = f2bf(yv * sigmoidf(z)); }
                    });
#endif
            }
        } }
        if (kind == 0) SEAM(P + LP_MIXB);

        if (IN(P + LP_OUTPROJ)) {
            PHASE_IDS();
            REPS(5) { if (rep_) __syncthreads();
            const float* w_out = (const float*)ARGP(35) + (size_t)L * D * D;
#if FAST_DENSE
            { (void)w_out; pg8::Gemm g{cat, wout_t + (size_t)L * D * D, D, nullptr}; pg8::StaticOrder S; S.init(T, D, G, bid);
#if RES_BF16
              pg8::EpiResBf16 E{(bf16*)y2, hb, D, DN_ALPHA}; pg8::gemm_phase(lds, g, S, E, wave); }
#else
              pg8::EpiResF32 E{y2, hf, D, DN_ALPHA}; pg8::gemm_phase(lds, g, S, E, wave); }
#endif
#else
            oracle_gemm(ldsf, T, D, D,
                [&](int) { return 0; },
                [&](int m, int k) { return bf2f(cat[(size_t)m * D + k]); },
                [&](int k, int n, int) { return w_out[(size_t)k * D + n]; },
                [&](int m0, int n0, float (&acc)[4][8], int) {
#pragma unroll
                    for (int i = 0; i < 4; ++i)
#pragma unroll
                        for (int j = 0; j < 8; ++j) { const size_t o = (size_t)(m0 + i) * D + n0 + j; y2[o] = DN_ALPHA * hf[o] + acc[i][j]; }
                });
#endif
        } }
        SEAM(P + LP_OUTPROJ);

        if (IN(P + LP_LN1)) {
            PHASE_IDS();
            REPS(8) { if (rep_) __syncthreads();
            const float* g1 = (const float*)ARGP(36) + L * D; const float* b1 = (const float*)ARGP(37) + L * D;
            const float* rw = (const float*)ARGP(40) + (size_t)L * D * NEXP; const float* rb = (const float*)ARGP(41) + L * NEXP;
#if FAST_LN1
            {
            typedef pg8::bf16x8 bx8; typedef pg8::f32x4 fx4; typedef pg8::u32x4 ux4;
            LAS bf16* RWH = (LAS bf16*)lds;
            LAS float* stg = (LAS float*)(lds + 66048 + wave * 8320);
            LAS int* hist = (LAS int*)(lds + 66048 + 8 * 8320); LAS int* lbase = hist + 32;
            const bf16* rwh_g = rwt + (size_t)(L * 2 + 0) * NEXP * D; const bf16* rwl_g = rwt + (size_t)(L * 2 + 1) * NEXP * D;
            for (int c = tid; c < 4096; c += NTHR) { const int e = c >> 7, k8 = (c & 127) * 8; *(LAS ux4*)(RWH + e * 1032 + k8) = *(const ux4*)(rwh_g + e * 1024 + k8); }
            if (tid < 32) hist[tid] = 0;
            __syncthreads();
            const int tok = lane & 15, sg = lane >> 4;
            for (int wt = bid * NWAVES + wave; wt < T / 8; wt += G * NWAVES) {
                float4 v[8][4];
#pragma unroll
                for (int rr = 0; rr < 8; ++rr)
#pragma unroll
                    for (int j = 0; j < 4; ++j) {
#if RES_BF16
                        const uint2 yv_ = *(const uint2*)((const bf16*)y2 + ((size_t)wt * 8 + rr) * D + (lane + 64 * j) * 4);
                        v[rr][j] = make_float4(__uint_as_float(yv_.x << 16), __uint_as_float(yv_.x & 0xffff0000u), __uint_as_float(yv_.y << 16), __uint_as_float(yv_.y & 0xffff0000u));
#else
                        v[rr][j] = *(const float4*)(y2 + ((size_t)wt * 8 + rr) * D + (lane + 64 * j) * 4);
#endif
                    }
#pragma unroll
                for (int rr = 0; rr < 8; ++rr) {
                    float s = 0.f;
#pragma unroll
                    for (int j = 0; j < 4; ++j) s += (v[rr][j].x + v[rr][j].y) + (v[rr][j].z + v[rr][j].w);
                    const float mean = wave_sum(s, lane) * (1.0f / D); float s2 = 0.f;
#pragma unroll
                    for (int j = 0; j < 4; ++j) { v[rr][j].x -= mean; v[rr][j].y -= mean; v[rr][j].z -= mean; v[rr][j].w -= mean; s2 += (v[rr][j].x * v[rr][j].x + v[rr][j].y * v[rr][j].y) + (v[rr][j].z * v[rr][j].z + v[rr][j].w * v[rr][j].w); }
                    const float rstd = 1.0f / sqrtf(wave_sum(s2, lane) * (1.0f / D) + LN_EPS);
                    const size_t row = (size_t)wt * 8 + rr;
#pragma unroll
                    for (int j = 0; j < 4; ++j) { const int cc = (lane + 64 * j) * 4; const float4 gg = *(const float4*)(g1 + cc), bb = *(const float4*)(b1 + cc);
                        float4 o; o.x = v[rr][j].x * rstd * gg.x + bb.x; o.y = v[rr][j].y * rstd * gg.y + bb.y; o.z = v[rr][j].z * rstd * gg.z + bb.z; o.w = v[rr][j].w * rstd * gg.w + bb.w;
                        v[rr][j] = o;
#if RES_BF16
                        { uint2 ob; ob.x = pg8::cvt_pk_bf16(o.x, o.y); ob.y = pg8::cvt_pk_bf16(o.z, o.w); *(uint2*)(hb + row * D + cc) = ob; }
#else
                        *(float4*)(hf + row * D + cc) = o;
#endif
#if MOE_FP8 && MOE_GATHER
                        { int w8 = __builtin_amdgcn_cvt_pk_fp8_f32(o.x, o.y, 0, false); w8 = __builtin_amdgcn_cvt_pk_fp8_f32(o.z, o.w, w8, true); *(int*)(hb8 + row * D + cc) = w8; }
#elif !RES_BF16
                        { uint2 ob; ob.x = pg8::cvt_pk_bf16(o.x, o.y); ob.y = pg8::cvt_pk_bf16(o.z, o.w); *(uint2*)(hb + row * D + cc) = ob; }
#endif
                    }
                }
                fx4 lacc[2]; lacc[0] = (fx4){0.f, 0.f, 0.f, 0.f}; lacc[1] = (fx4){0.f, 0.f, 0.f, 0.f};
#pragma unroll
                for (int j = 0; j < 4; ++j) {
#pragma unroll
                    for (int rr = 0; rr < 8; ++rr) *(LAS fx4*)(stg + rr * 260 + lane * 4) = (fx4){v[rr][j].x, v[rr][j].y, v[rr][j].z, v[rr][j].w};
                    asm volatile("s_waitcnt lgkmcnt(0)" ::: "memory");
#pragma unroll 2
                    for (int kk = 0; kk < 8; ++kk) {
                        fx4 f0 = (fx4){0.f, 0.f, 0.f, 0.f}, f1 = f0;
                        if (tok < 8) { f0 = *(const LAS fx4*)(stg + tok * 260 + 32 * kk + 8 * sg); f1 = *(const LAS fx4*)(stg + tok * 260 + 32 * kk + 8 * sg + 4); }
                        ux4 hw, lw;
                        hw.x = pg8::cvt_pk_bf16(f0[0], f0[1]); hw.y = pg8::cvt_pk_bf16(f0[2], f0[3]); hw.z = pg8::cvt_pk_bf16(f1[0], f1[1]); hw.w = pg8::cvt_pk_bf16(f1[2], f1[3]);
                        lw.x = pg8::cvt_pk_bf16(f0[0] - __uint_as_float(hw.x << 16), f0[1] - __uint_as_float(hw.x & 0xffff0000u)); lw.y = pg8::cvt_pk_bf16(f0[2] - __uint_as_float(hw.y << 16), f0[3] - __uint_as_float(hw.y & 0xffff0000u));
                        lw.z = pg8::cvt_pk_bf16(f1[0] - __uint_as_float(hw.z << 16), f1[1] - __uint_as_float(hw.z & 0xffff0000u)); lw.w = pg8::cvt_pk_bf16(f1[2] - __uint_as_float(hw.w << 16), f1[3] - __uint_as_float(hw.w & 0xffff0000u));
                        const bx8 yh = __builtin_bit_cast(bx8, hw), yl = __builtin_bit_cast(bx8, lw);
#pragma unroll
                        for (int t = 0; t < 2; ++t) { const int kcol = 256 * j + 32 * kk + 8 * sg;
                            const bx8 xh = *(const LAS bx8*)(RWH + (16 * t + tok) * 1032 + kcol); const bx8 xl = __builtin_bit_cast(bx8, *(const ux4*)(rwl_g + (16 * t + tok) * 1024 + kcol));
                            lacc[t] = __builtin_amdgcn_mfma_f32_16x16x32_bf16(xh, yh, lacc[t], 0, 0, 0); lacc[t] = __builtin_amdgcn_mfma_f32_16x16x32_bf16(xl, yh, lacc[t], 0, 0, 0); lacc[t] = __builtin_amdgcn_mfma_f32_16x16x32_bf16(xh, yl, lacc[t], 0, 0, 0); }
                    }
                    asm volatile("s_waitcnt lgkmcnt(0)" ::: "memory");
                }
                float lv[8];
#pragma unroll
                for (int t = 0; t < 2; ++t) { const float4 rb4 = *(const float4*)(rb + 16 * t + 4 * sg); lv[4 * t + 0] = lacc[t][0] + rb4.x; lv[4 * t + 1] = lacc[t][1] + rb4.y; lv[4 * t + 2] = lacc[t][2] + rb4.z; lv[4 * t + 3] = lacc[t][3] + rb4.w; }
                float tv[4]; int ti[4];
#pragma unroll
                for (int k = 0; k < 4; ++k) {
                    float bv = -3.0e38f; int bi = 0;
#pragma unroll
                    for (int q = 0; q < 8; ++q) { const int e = 16 * (q >> 2) + 4 * sg + (q & 3); if (lv[q] > bv) { bv = lv[q]; bi = e; } }
#pragma unroll
                    for (int o = 16; o <= 32; o <<= 1) { const float ov = sh_xor(bv, o, lane); const int oi = sh_xor(bi, o, lane); if (ov > bv || (ov == bv && oi < bi)) { bv = ov; bi = oi; } }
                    tv[k] = bv; ti[k] = bi;
#pragma unroll
                    for (int q = 0; q < 8; ++q) { const int e = 16 * (q >> 2) + 4 * sg + (q & 3); if (e == bi) lv[q] = -3.0e38f; }
                }
                if (sg == 0 && tok < 8) {
                    const size_t row = (size_t)wt * 8 + tok; float ex[4], sum = 0.f;
#pragma unroll
                    for (int k = 0; k < 4; ++k) { ex[k] = __expf(tv[k] - tv[0]); sum += ex[k]; }
                    const float inv = 1.0f / sum;
                    *(int4*)(top_e + row * 4) = make_int4(ti[0], ti[1], ti[2], ti[3]); *(float4*)(top_g + row * 4) = make_float4(ex[0] * inv, ex[1] * inv, ex[2] * inv, ex[3] * inv);
#pragma unroll
                    for (int k = 0; k < 4; ++k) ti[k] |= atomicAdd((int*)&hist[ti[k]], 1) << 8;
                }
#if MOE_SPARSE
                __syncthreads();
                if (tid < 32) { const int hc = hist[tid]; lbase[tid] = hc ? (int)atomicAdd(ctl + CW_CNT + 64 * L + tid, (unsigned)hc) : 0; hist[tid] = 0; }
                __syncthreads();
                if (sg == 0 && tok < 8) { const size_t row = (size_t)wt * 8 + tok; int dd[4];
#pragma unroll
                    for (int k = 0; k < 4; ++k) { const int e = ti[k] & 255; dd[k] = e * T + lbase[e] + (ti[k] >> 8); row_tok[dd[k]] = (int)row; }
                    *(int4*)(dest + row * 4) = make_int4(dd[0], dd[1], dd[2], dd[3]); }
#endif
            }
#if !MOE_SPARSE
            __syncthreads();
            if (rep_ == 0 && tid < 32 && hist[tid] != 0) atomicAdd(ctl + CW_CNT + 64 * L + tid, (unsigned)hist[tid]);
#endif
            __syncthreads();
            }
#else
            LAS float* rows = ldsf; LAS float* lg = ldsf + 16 * 1024; LAS int* hist = (LAS int*)(ldsf + 16 * 1024 + 512);
            if (tid < 32) hist[tid] = 0;
            __syncthreads();
            for (int tile = bid; tile < T / 16; tile += G) {
#pragma unroll
                for (int rr = 0; rr < 2; ++rr) {
                    const int r = 2 * wave + rr; const size_t row = (size_t)tile * 16 + r;
                    float4 v[4]; float s = 0.f;
#pragma unroll
                    for (int j = 0; j < 4; ++j) { v[j] = *(const float4*)(y2 + row * D + (lane + 64 * j) * 4); s += (v[j].x + v[j].y) + (v[j].z + v[j].w); }
                    const float mean = wave_sum(s, lane) * (1.0f / D); float s2 = 0.f;
#pragma unroll
                    for (int j = 0; j < 4; ++j) { v[j].x -= mean; v[j].y -= mean; v[j].z -= mean; v[j].w -= mean; s2 += (v[j].x * v[j].x + v[j].y * v[j].y) + (v[j].z * v[j].z + v[j].w * v[j].w); }
                    const float rstd = 1.0f / sqrtf(wave_sum(s2, lane) * (1.0f / D) + LN_EPS);
#pragma unroll
                    for (int j = 0; j < 4; ++j) { const int c = (lane + 64 * j) * 4; const float4 gg = *(const float4*)(g1 + c), bb = *(const float4*)(b1 + c);
                        float4 o; o.x = v[j].x * rstd * gg.x + bb.x; o.y = v[j].y * rstd * gg.y + bb.y; o.z = v[j].z * rstd * gg.z + bb.z; o.w = v[j].w * rstd * gg.w + bb.w;
                        *(float4*)(hf + row * D + c) = o; uint2 ob; ob.x = pk2(o.x, o.y); ob.y = pk2(o.z, o.w); *(uint2*)(hb + row * D + c) = ob;
                        rows[r * 1024 + c + 0] = o.x; rows[r * 1024 + c + 1] = o.y; rows[r * 1024 + c + 2] = o.z; rows[r * 1024 + c + 3] = o.w; }
                }
                __syncthreads();
                { const int r = tid >> 5, e = tid & 31; float a = rb[e];
                  for (int k = 0; k < D; ++k) a += rows[r * 1024 + k] * rw[(size_t)k * NEXP + e];
                  lg[r * 32 + e] = a; }
                __syncthreads();
                if (tid < 16) {
                    const size_t row = (size_t)tile * 16 + tid; float tv[4]; int ti[4];
#pragma unroll
                    for (int k = 0; k < 4; ++k) { float best = -3.0e38f; int bi = 0;
                        for (int e = 0; e < NEXP; ++e) { const float v = lg[tid * 32 + e]; if (v > best) { best = v; bi = e; } }
                        tv[k] = best; ti[k] = bi; lg[tid * 32 + bi] = -3.0e38f; }
                    float ex[4], sum = 0.f;
#pragma unroll
                    for (int k = 0; k < 4; ++k) { ex[k] = __expf(tv[k] - tv[0]); sum += ex[k]; }
#pragma unroll
                    for (int k = 0; k < 4; ++k) { top_e[row * 4 + k] = ti[k]; top_g[row * 4 + k] = ex[k] / sum; atomicAdd((int*)&hist[ti[k]], 1); }
                }
                __syncthreads();
            }
            if (rep_ == 0 && tid < 32 && hist[tid] != 0) atomicAdd(ctl + CW_CNT + 64 * L + tid, (unsigned)hist[tid]);
            __syncthreads();
#endif
        } }
        SEAM(P + LP_LN1);

        if (!MOE_SPARSE && IN(P + LP_DISP)) {
            PHASE_IDS();
            REPS(9) { if (rep_) __syncthreads();
            LAS int* pstart = (LAS int*)ldsf; LAS int* lh = pstart + 32; LAS int* lbase = pstart + 64; LAS int* ldest = pstart + 128;
            if (tid == 0) { int a = 0; for (int e = 0; e < NEXP; ++e) { const int c = (int)__hip_atomic_load(ctl + CW_CNT + 64 * L + e, __ATOMIC_RELAXED, __HIP_MEMORY_SCOPE_AGENT); pstart[e] = a; a += ((c + MOEBLK - 1) / MOEBLK) * MOEBLK; } }
            __syncthreads();
#if MOE_GATHER
            for (int idx = bid * NTHR + tid; idx < NEXP * MOEBLK; idx += G * NTHR) { const int e = idx >> 8, r = idx & 255; const int cnt = (int)__hip_atomic_load(ctl + CW_CNT + 64 * L + e, __ATOMIC_RELAXED, __HIP_MEMORY_SCOPE_AGENT);
                const int padded = ((cnt + MOEBLK - 1) / MOEBLK) * MOEBLK; if (cnt + r < padded) row_tok[pstart[e] + cnt + r] = 0; }
#endif
            for (int tile = bid; tile < T * TOPK / NTHR; tile += G) {
                if (tid < 32) lh[tid] = 0;
                __syncthreads();
                const int pair = tile * NTHR + tid; const int e = top_e[pair];
                int dd;
                if (rep_ == 0) {
                const int rank = atomicAdd((int*)&lh[e], 1);
                __syncthreads();
                if (tid < 32) lbase[tid] = lh[tid] ? (int)atomicAdd(ctl + CW_CUR + 64 * L + tid, (unsigned)lh[tid]) : 0;
                __syncthreads();
                dd = pstart[e] + lbase[e] + rank; dest[pair] = dd; } else dd = dest[pair];
                ldest[tid] = dd;
#if MOE_GATHER
                if (rep_ == 0) row_tok[dd] = pair >> 2;
#endif
                __syncthreads();
#if !MOE_GATHER
                for (int i = 0; i < 64; ++i) { const int pp = wave * 64 + i; const int d2 = ldest[pp]; const int tt = (tile * NTHR + pp) >> 2;
                    const uint4* src = (const uint4*)(hb + (size_t)tt * D); uint4* dst = (uint4*)(xr + (size_t)d2 * D);
                    dst[lane] = src[lane]; dst[lane + 64] = src[lane + 64]; }
#endif
                __syncthreads();
            }
        } }
        if (!MOE_SPARSE) SEAM(P + LP_DISP);

        if (IN(P + LP_GU) || IN(P + LP_DOWN)) {
            PHASE_IDS();
            LAS int* pend = (LAS int*)(lds + LDS_MISC + 512);
            if (tid == 0) { int a = 0; for (int e = 0; e < NEXP; ++e) { const int c = (int)__hip_atomic_load(ctl + CW_CNT + 64 * L + e, __ATOMIC_RELAXED, __HIP_MEMORY_SCOPE_AGENT); a += ((c + MOEBLK - 1) / MOEBLK) * MOEBLK; pend[e] = a; } }
            __syncthreads();
        }
        if (IN(P + LP_GU)) {
            PHASE_IDS();
            REPS(6) { if (rep_) __syncthreads();
            const LAS int* pend = (const LAS int*)(lds + LDS_MISC + 512);
            const int nrows = pend[NEXP - 1];
            const float* wgu = (const float*)ARGP(42) + (size_t)L * NEXP * D * 2 * DEXP; const float* bgu = (const float*)ARGP(43) + (size_t)L * NEXP * 2 * DEXP;
#if FAST_MOE
            { (void)wgu; pg8::MoeOrder S{pend, nrows / 256, 8, G, vcu};
#if MOE_GATHER && MOE_FP8
              pg8::EpiSwiglu<true> E{act8, bgu, 1.0f / GU_WS};
              LAS int* rmapL = (LAS int*)(lds + LDS_RMAP);
              { pg8::Unit uu; for (int i = 0; i < 15 && S.next(i, uu); ++i) { if (tid < 256) { const int rt_ = row_tok[uu.pm * 256 + tid]; rmapL[i * 256 + tid] = rt_ < 0 ? 0 : (rt_ < T ? rt_ : T - 1); } } }
              __syncthreads();
              pg8::Gemm g{(const pg8::bf16_t*)hb8, (const pg8::bf16_t*)(wgu8 + (size_t)L * NEXP * 2 * DEXP * D), D, rmapL}; pg8::gemm_phase<pg8::EpiSwiglu<true>, pg8::MoeOrder, true, true, true, true>(lds, g, S, E, wave);
#elif MOE_GATHER
              pg8::EpiSwiglu<false> E{act, bgu, 1.0f};
              LAS int* rmapL = (LAS int*)(lds + LDS_RMAP);
              { pg8::Unit uu; for (int i = 0; i < 15 && S.next(i, uu); ++i) { if (tid < 256) { const int rt_ = row_tok[uu.pm * 256 + tid]; rmapL[i * 256 + tid] = rt_ < 0 ? 0 : (rt_ < T ? rt_ : T - 1); } } }
              __syncthreads();
              pg8::Gemm g{hb, wgu_t + (size_t)L * NEXP * 2 * DEXP * D, D, rmapL}; pg8::gemm_phase<pg8::EpiSwiglu<false>, pg8::MoeOrder, true, true, true>(lds, g, S, E, wave);
#else
              pg8::EpiSwiglu<false> E{act, bgu, 1.0f};
              pg8::Gemm g{xr, wgu_t + (size_t)L * NEXP * 2 * DEXP * D, D, nullptr}; pg8::gemm_phase(lds, g, S, E, wave);
#endif
            }
#else
            oracle_gemm(ldsf, nrows, 2 * DEXP, D,
                [&](int tm) { return expert_of_block(pend, tm >> 1); },
                [&](int m, int k) { return bf2f(xr[(size_t)m * D + k]); },
                [&](int k, int n, int e) { const int tn = n >> 7, v = n & 127; const int c = tn * 64 + (v >> 1) + ((v & 1) ? DEXP : 0); return wgu[((size_t)e * D + k) * (2 * DEXP) + c]; },
                [&](int m0, int n0, float (&acc)[4][8], int e) {
                    const int tn = n0 >> 7, v0 = n0 & 127;
#pragma unroll
                    for (int i = 0; i < 4; ++i)
#pragma unroll
                        for (int jj = 0; jj < 4; ++jj) { const int c = tn * 64 + (v0 >> 1) + jj;
                            const float xg = fminf(acc[i][2 * jj] + bgu[(size_t)e * 2 * DEXP + c], 7.0f);
                            const float xl = fminf(fmaxf(acc[i][2 * jj + 1] + bgu[(size_t)e * 2 * DEXP + DEXP + c], -7.0f), 7.0f);
                            act[(size_t)(m0 + i) * DEXP + c] = f2bf(xg * sigmoidf(1.702f * xg) * (xl + 1.0f)); }
                });
#endif
        } }
        SEAM(P + LP_GU);

        if (IN(P + LP_DOWN)) {
            PHASE_IDS();
            REPS(7) { if (rep_) __syncthreads();
            const LAS int* pend = (const LAS int*)(lds + LDS_MISC + 512);
            const int nrows = pend[NEXP - 1];
            const float* wd = (const float*)ARGP(44) + (size_t)L * NEXP * DEXP * D; const float* bd = (const float*)ARGP(45) + (size_t)L * NEXP * D;
#if FAST_MOE
            { (void)wd; pg8::MoeOrder S{pend, nrows / 256, 4, G, vcu};
#if MOE_FP8 && MOE_GATHER
              pg8::Gemm g{(const pg8::bf16_t*)act8, (const pg8::bf16_t*)(wdn8 + (size_t)L * NEXP * D * DEXP), DEXP, nullptr};
#if YR_FP8
              pg8::EpiBf16T<true> E{(unsigned char*)yr, D, bd, D, 1.0f / DN_WS};
              pg8::gemm_phase<pg8::EpiBf16T<true>, pg8::MoeOrder, true, true, false, true>(lds, g, S, E, wave);
#else
              pg8::EpiBf16 E{yr, D, bd, D, 1.0f / DN_WS};
              pg8::gemm_phase<pg8::EpiBf16, pg8::MoeOrder, true, true, false, true>(lds, g, S, E, wave);
#endif
#else
              pg8::Gemm g{act, wdn_t + (size_t)L * NEXP * D * DEXP, DEXP, nullptr}; pg8::EpiBf16 E{yr, D, bd, D, 1.0f}; pg8::gemm_phase(lds, g, S, E, wave);
#endif
            }
#else
            oracle_gemm(ldsf, nrows, D, DEXP,
                [&](int tm) { return expert_of_block(pend, tm >> 1); },
                [&](int m, int k) { return bf2f(act[(size_t)m * DEXP + k]); },
                [&](int k, int n, int e) { return wd[((size_t)e * DEXP + k) * D + n]; },
                [&](int m0, int n0, float (&acc)[4][8], int e) {
#pragma unroll
                    for (int i = 0; i < 4; ++i)
#pragma unroll
                        for (int j = 0; j < 8; ++j) yr[(size_t)(m0 + i) * D + n0 + j] = f2bf(acc[i][j] + bd[(size_t)e * D + n0 + j]);
                });
#endif
        } }
        SEAM(P + LP_DOWN);

        if (IN(P + LP_COMB)) {
            PHASE_IDS();
            REPS(10) { const bool dummy_ = (rep_ == 0) && ((REP_MASK >> 10) & 1);
            const float* g2 = (const float*)ARGP(38) + L * D; const float* b2 = (const float*)ARGP(39) + L * D;
            const int l32 = lane & 31, hw = lane >> 5;
            for (int row = 2 * (bid * NWAVES + wave) + hw; row < T; row += 2 * G * NWAVES) {
                int dd[4]; float gg[4];
                { const int4 d4 = *(const int4*)(dest + (size_t)row * 4); const float4 g4 = *(const float4*)(top_g + (size_t)row * 4); dd[0] = d4.x; dd[1] = d4.y; dd[2] = d4.z; dd[3] = d4.w; gg[0] = g4.x; gg[1] = g4.y; gg[2] = g4.z; gg[3] = g4.w; }
                float4 v[8]; float s = 0.f;
#pragma unroll
                for (int j = 0; j < 8; ++j) { const int c = (l32 + 32 * j) * 4;
#if RES_BF16
                    const uint2 hv_ = *(const uint2*)(hb + (size_t)row * D + c); const float4 hv = make_float4(__uint_as_float(hv_.x << 16), __uint_as_float(hv_.x & 0xffff0000u), __uint_as_float(hv_.y << 16), __uint_as_float(hv_.y & 0xffff0000u));
#else
                    const float4 hv = *(const float4*)(hf + (size_t)row * D + c);
#endif
                    float4 a; a.x = DN_ALPHA * hv.x; a.y = DN_ALPHA * hv.y; a.z = DN_ALPHA * hv.z; a.w = DN_ALPHA * hv.w;
                    float mo[4] = {0.f, 0.f, 0.f, 0.f};
#pragma unroll
                    for (int k = 0; k < 4; ++k) {
#if YR_FP8 && MOE_FP8 && MOE_GATHER
                        typedef float f32x2_ __attribute__((ext_vector_type(2)));
                        const int yw = *(const int*)((const unsigned char*)yr + (size_t)dd[k] * D + c); const f32x2_ y01 = __builtin_amdgcn_cvt_pk_f32_fp8(yw, false), y23 = __builtin_amdgcn_cvt_pk_f32_fp8(yw, true);
                        mo[0] += gg[k] * y01.x; mo[1] += gg[k] * y01.y; mo[2] += gg[k] * y23.x; mo[3] += gg[k] * y23.y;
#else
                        const uint2 yv = *(const uint2*)(yr + (size_t)dd[k] * D + c);
                        mo[0] += gg[k] * __uint_as_float(yv.x << 16); mo[1] += gg[k] * __uint_as_float(yv.x & 0xffff0000u);
                        mo[2] += gg[k] * __uint_as_float(yv.y << 16); mo[3] += gg[k] * __uint_as_float(yv.y & 0xffff0000u);
#endif
                    }
                    a.x += mo[0]; a.y += mo[1]; a.z += mo[2]; a.w += mo[3];
                    v[j] = a; s += (a.x + a.y) + (a.z + a.w); }
#pragma unroll
                for (int o = 1; o < 32; o <<= 1) s += sh_xor(s, o, lane);
                const float mean = s * (1.0f / D); float s2 = 0.f;
#pragma unroll
                for (int j = 0; j < 8; ++j) { v[j].x -= mean; v[j].y -= mean; v[j].z -= mean; v[j].w -= mean; s2 += (v[j].x * v[j].x + v[j].y * v[j].y) + (v[j].z * v[j].z + v[j].w * v[j].w); }
#pragma unroll
                for (int o = 1; o < 32; o <<= 1) s2 += sh_xor(s2, o, lane);
                const float rstd = 1.0f / sqrtf(s2 * (1.0f / D) + LN_EPS);
#pragma unroll
                for (int j = 0; j < 8; ++j) { const int c = (l32 + 32 * j) * 4; const float4 gv = *(const float4*)(g2 + c), bv = *(const float4*)(b2 + c);
                    float4 o; o.x = v[j].x * rstd * gv.x + bv.x; o.y = v[j].y * rstd * gv.y + bv.y; o.z = v[j].z * rstd * gv.z + bv.z; o.w = v[j].w * rstd * gv.w + bv.w;
                    if (dummy_) *(float4*)(y2 + (size_t)row * D + c) = o;
                    else if (L == DEPTH - 1) *(float4*)(((float*)ARGP(46)) + (size_t)row * D + c) = o;
                    else {
#if !RES_BF16
                        *(float4*)(hf + (size_t)row * D + c) = o;
#endif
                        uint2 ob; ob.x = pg8::cvt_pk_bf16(o.x, o.y); ob.y = pg8::cvt_pk_bf16(o.z, o.w); *(uint2*)(hb + (size_t)row * D + c) = ob; } }
            }
        } }
        SEAM(P + LP_COMB);
    }
#undef IN
#undef SEAM
}

extern "C" void kernel_launch(void* const* d_in, const int* in_sizes, int n_in, void* d_out, int out_size, void* d_ws, size_t ws_size, hipStream_t stream) {
    static int grid = 0;
    if (grid == 0) {
        if (n_in != 46 || out_size != T * D || ws_size < WS_END) { fprintf(stderr, "kernel_launch: unexpected problem (n_in %d, out %d, ws %zu < %zu)\n", n_in, out_size, ws_size, (size_t)WS_END); grid = -1; return; }
        int dev = 0, cus = 0, per_cu = 0;
        if (hipGetDevice(&dev) != hipSuccess || hipDeviceGetAttribute(&cus, hipDeviceAttributeMultiprocessorCount, dev) != hipSuccess) { grid = -1; return; }
        if (hipFuncSetAttribute((const void*)mk_fwd, hipFuncAttributeMaxDynamicSharedMemorySize, LDS_BYTES) != hipSuccess) { fprintf(stderr, "kernel_launch: hipFuncSetAttribute failed\n"); grid = -1; return; }
        if (hipOccupancyMaxActiveBlocksPerMultiprocessor(&per_cu, (const void*)mk_fwd, NTHR, LDS_BYTES) != hipSuccess || per_cu < 1) fprintf(stderr, "kernel_launch: occupancy query says %d\n", per_cu);
        (void)hipGetLastError();
        grid = cus;
    }
    if (grid < 0) return;
    (void)hipMemsetAsync((char*)d_ws + WS_CTL, 0, CTL_BYTES, stream);
    Args a{};
    for (int i = 0; i < 46; ++i) a.in[i] = d_in[i];
    a.out = (float*)d_out; a.ws = (unsigned char*)d_ws;
#if MK_ONE_LAUNCH
    a.ph_lo = 0; a.ph_hi = PH_TOTAL;
    hipLaunchKernelGGL(mk_fwd, dim3(grid), dim3(NTHR), LDS_BYTES, stream, a);
#else
    for (int p = 0; p < PH_TOTAL; ++p) {
        const int j = (p - PH_L0) % PH_PER_LAYER, L = (p - PH_L0) / PH_PER_LAYER;
        if (p >= PH_L0 && j == LP_MIXB && (L % 3) != 0) continue;
        a.ph_lo = p; a.ph_hi = p + 1;
        hipLaunchKernelGGL(mk_fwd, dim3(grid), dim3(NTHR), LDS_BYTES, stream, a);
    }
#endif
}
```

```cpp
#include <hip/hip_runtime.h>
#include <cstdio>
#include <cstdint>

#ifndef MK_ONE_LAUNCH
#define MK_ONE_LAUNCH 1
#endif

#ifndef FAST_DENSE
#define FAST_DENSE 1
#endif
#ifndef FAST_MOE
#define FAST_MOE 1
#endif
#ifndef REP_MASK
#define REP_MASK 0
#endif
#define REPS(k) for (int rep_ = 0; rep_ < 1 + ((REP_MASK >> (k)) & 1); ++rep_)
#ifndef FAST_S5
#define FAST_S5 1
#endif
#ifndef MOE_SPARSE
#define MOE_SPARSE 0
#endif
#ifndef YR_FP8
#define YR_FP8 0
#endif
#ifndef NT_STORES
#define NT_STORES 0
#endif
#ifndef WT_STORES
#define WT_STORES 0
#endif
#ifndef RES_BF16
#define RES_BF16 1
#endif
#ifndef BG_ALL
#define BG_ALL 1
#endif
#ifndef LINATT_V2
#define LINATT_V2 1
#endif
#ifndef MOE_FP8
#define MOE_FP8 1
#endif
#ifndef MOE_GATHER
#define MOE_GATHER 1
#endif
#ifndef BG_CONV
#define BG_CONV 1
#endif
#ifndef FAST_LN1
#define FAST_LN1 1
#endif
#ifndef FAST_XATTN
#define FAST_XATTN 1
#endif
#ifndef FAST_LINATT
#define FAST_LINATT 1
#endif
#define LAS __attribute__((address_space(3)))
typedef unsigned short bf16;

#ifndef MOE_SPARSE
#define MOE_SPARSE 0
#endif
#if MOE_SPARSE
#define MOE_SPARSE_ROWS (32 * 16384)
#else
#define MOE_SPARSE_ROWS (16384 * 4 + 32 * 256)
#endif
constexpr int NB = 8, SEQ = 2048, T = NB * SEQ, D = 1024, MIXW = 768, XW = 256, NMEM = 256, DEPTH = 4;
constexpr int NEXP = 32, TOPK = 4, DEXP = 1024, MOEBLK = 256;
constexpr int NROWS_MAX = MOE_SPARSE_ROWS;
constexpr int LDP = 2816;
constexpr float LN_EPS = 1e-5f;
constexpr float DN_ALPHA = 1.6817928305074290f;
constexpr int NWAVES = 8, NTHR = 512;

constexpr size_t MiB = (size_t)1 << 20;
constexpr size_t WS_CTL = 0, CTL_BYTES = 1 * MiB;
constexpr size_t WS_HF = 1 * MiB;
constexpr size_t WS_Y2 = WS_HF + (size_t)T * D * 4;
constexpr size_t WS_HB = WS_Y2 + (size_t)T * D * 4;
constexpr size_t WS_PROJ = WS_HB + (size_t)T * D * 2;
constexpr size_t WS_YG = WS_PROJ + (size_t)T * LDP * 2;
constexpr size_t WS_CAT = WS_YG + (size_t)T * MIXW * 2;
constexpr size_t WS_TOPE = WS_CAT + (size_t)T * D * 2;
constexpr size_t WS_TOPG = WS_TOPE + (size_t)T * 4 * 4;
constexpr size_t WS_DEST = WS_TOPG + (size_t)T * 4 * 4;
constexpr size_t WS_XR = WS_DEST + (size_t)T * 4 * 4;
constexpr size_t WS_ACT = WS_XR + (size_t)(T * TOPK + NEXP * MOEBLK) * D * 2;
constexpr size_t WS_YR = WS_ACT + (size_t)NROWS_MAX * DEXP * 2;
constexpr size_t WS_MEMK = WS_YR + (size_t)NROWS_MAX * D * 2;
constexpr size_t WS_MEMV = WS_MEMK + 1 * MiB;
constexpr size_t WS_MEMVT = WS_MEMV + 1 * MiB;
constexpr size_t WS_ROPE = WS_MEMVT + 1 * MiB;
constexpr size_t WS_WIN = WS_ROPE + (size_t)T * 48 * 2 * 4;
constexpr size_t WS_WGLU = WS_WIN + 4 * 6 * MiB;
constexpr size_t WS_WOUT = WS_WGLU + 2 * 2 * MiB;
constexpr size_t WS_WMEM = WS_WOUT + 4 * 2 * MiB;
constexpr size_t WS_MEMB = WS_WMEM + 1 * MiB;
constexpr size_t WS_WGU = WS_MEMB + 4 * MiB;
constexpr size_t WS_WDN = WS_WGU + (size_t)DEPTH * NEXP * 2 * DEXP * D * 2;
constexpr size_t WS_RWT = WS_WDN + (size_t)DEPTH * NEXP * D * DEXP * 2;
constexpr size_t WS_RTOK = WS_RWT + (size_t)DEPTH * 2 * NEXP * D * 2;
constexpr size_t WS_END = WS_RTOK + (size_t)NROWS_MAX * 4;
constexpr int CW_BAR = 4096;
constexpr int CW_CNT = 16384;
constexpr int CW_CUR = 16384 + 1024;
constexpr int CW_CQ = 16384 + 2048;

constexpr int LDS_BYTES = 163840;
constexpr int LDS_RMAP = 147456;
constexpr int LDS_MISC = 131072 + 8192;

__device__ __forceinline__ float bf2f(bf16 v) { return __uint_as_float(((unsigned)v) << 16); }
__device__ __forceinline__ bf16 f2bf(float f) { unsigned u = __float_as_uint(f); return (bf16)((u + 0x7fffu + ((u >> 16) & 1u)) >> 16); }
__device__ __forceinline__ unsigned pk2(float lo, float hi) { return (unsigned)f2bf(lo) | ((unsigned)f2bf(hi) << 16); }
__device__ __forceinline__ int sh_idx_i(int v, int src, int) { return __builtin_amdgcn_ds_bpermute(src << 2, v); }
__device__ __forceinline__ float sh_idx(float v, int src, int lane) { return __int_as_float(sh_idx_i(__float_as_int(v), src, lane)); }
__device__ __forceinline__ unsigned sh_idx(unsigned v, int src, int lane) { return (unsigned)sh_idx_i((int)v, src, lane); }
__device__ __forceinline__ float sh_xor(float v, int m, int lane) { return __int_as_float(__builtin_amdgcn_ds_bpermute((lane ^ m) << 2, __float_as_int(v))); }
__device__ __forceinline__ int sh_xor(int v, int m, int lane) { return __builtin_amdgcn_ds_bpermute((lane ^ m) << 2, v); }
__device__ __forceinline__ float sh_up(float v, int d, int lane) { const int s = lane - d; return __int_as_float(__builtin_amdgcn_ds_bpermute((s < 0 ? lane : s) << 2, __float_as_int(v))); }
__device__ __forceinline__ float wave_sum(float v, int lane) {
#pragma unroll
    for (int o = 1; o < 64; o <<= 1) v += sh_xor(v, o, lane);
    return v;
}
__device__ __forceinline__ float sigmoidf(float x) { return __builtin_amdgcn_rcpf(1.0f + __expf(-x)); }
__device__ __forceinline__ void unpack8(uint4 v, float* f) {
    f[0] = __uint_as_float(v.x << 16); f[1] = __uint_as_float(v.x & 0xffff0000u);
    f[2] = __uint_as_float(v.y << 16); f[3] = __uint_as_float(v.y & 0xffff0000u);
    f[4] = __uint_as_float(v.z << 16); f[5] = __uint_as_float(v.z & 0xffff0000u);
    f[6] = __uint_as_float(v.w << 16); f[7] = __uint_as_float(v.w & 0xffff0000u);
}
__device__ __forceinline__ void sincos_rad(float ang, float& s, float& c) {
    float r = ang * 0.15915494309189535f; r -= rintf(r);
    s = __builtin_amdgcn_sinf(r); c = __builtin_amdgcn_cosf(r);
}
__device__ __forceinline__ float gelu_tanh(float x) {
    const float u = 0.7978845608028654f * (x + 0.044715f * x * x * x);
    const float e = __expf(2.0f * u);
    const float th = 1.0f - 2.0f / (e + 1.0f);
    return 0.5f * x * (1.0f + th);
}

__device__ __forceinline__ int lane_id_opaque() { int l; asm volatile("v_mbcnt_lo_u32_b32 %0, -1, 0\n\tv_mbcnt_hi_u32_b32 %0, -1, %0" : "=v"(l)); return l; }
__device__ __forceinline__ bool wg_leader(int wave) { return wave == 0 && lane_id_opaque() == 0; }

#define XB_TMO      128
#define XB_XCNT(j)  (256  + 64 * (j))
#define XB_XSUB(j)  (1280 + 64 * (j))
#define XB_XGEN(j)  (2304 + 64 * (j))
#define XB_TOP      3328
#define XB_TOPGEN   3392
#define XCD_BAR_WORDS 3456
#define XB_SPIN_CAP (1u << 24)
__device__ __forceinline__ unsigned xb_ld(unsigned* p)              { return __hip_atomic_load(p, __ATOMIC_RELAXED, __HIP_MEMORY_SCOPE_AGENT); }
__device__ __forceinline__ unsigned xb_add(unsigned* p, unsigned v) { return __hip_atomic_fetch_add(p, v, __ATOMIC_RELAXED, __HIP_MEMORY_SCOPE_AGENT); }
__device__ __forceinline__ unsigned xb_xcc_id() { return (unsigned)__builtin_amdgcn_s_getreg((3 << 11) | 20) & 0xFu; }
#define XB_SPIN(cond, bar) do { unsigned _sp = 0; while (cond) { __builtin_amdgcn_s_sleep(1); \
    if ((++_sp & 255u) == 0u) { if (xb_ld(&(bar)[XB_TMO])) break; if (_sp > XB_SPIN_CAP) { atomicAdd(&(bar)[XB_TMO], 1u); break; } } } } while (0)
struct XcdBarrier { unsigned* bar; unsigned x; volatile LAS unsigned* st; };
__device__ __forceinline__ XcdBarrier xcd_barrier_post(unsigned* bar, volatile LAS unsigned* st, int wave) {
    XcdBarrier b; b.bar = bar; b.x = xb_xcc_id(); b.st = st;
    if (wg_leader(wave)) (void)xb_add(&bar[XB_XCNT(b.x)], 1u);
    return b;
}
__device__ __forceinline__ void xcd_barrier_complete(unsigned* bar, unsigned x, unsigned& nloc, unsigned& nx) {
    const unsigned G = gridDim.x * gridDim.y * gridDim.z;
    unsigned sum, cnt, mine, sp = 0u;
    for (;;) {
        sum = 0u; cnt = 0u; mine = 0u;
#pragma unroll
        for (unsigned j = 0; j < 16; ++j) { const unsigned c = xb_ld(&bar[XB_XCNT(j)]); sum += c; cnt += (c > 0u) ? 1u : 0u; mine = (j == x) ? c : mine; }
        if (sum == G) break;
        __builtin_amdgcn_s_sleep(1);
        if ((++sp & 255u) == 0u) { if (xb_ld(&bar[XB_TMO])) break; if (sp > XB_SPIN_CAP) { atomicAdd(&bar[XB_TMO], 1u); break; } }
    }
    nloc = mine > 0u ? mine : 1u; nx = cnt > 0u ? cnt : 1u;
}
__device__ __forceinline__ void xcd_barrier(const XcdBarrier& b, int wave) {
    asm volatile("s_waitcnt vmcnt(0)" ::: "memory");
    __syncthreads();
    if (wg_leader(wave)) {
        unsigned* bar = b.bar; asm volatile("" : "+s"(bar));
        __builtin_amdgcn_s_waitcnt(0);
        unsigned nloc = b.st[0], nx = b.st[1];
        if (nloc == 0u) { xcd_barrier_complete(bar, b.x, nloc, nx); b.st[0] = nloc; b.st[1] = nx; }
        const unsigned old = xb_add(&bar[XB_XSUB(b.x)], 1u);
        const unsigned gen = old / nloc;
        if (old + 1u == (gen + 1u) * nloc) {
            __builtin_amdgcn_fence(__ATOMIC_RELEASE, "agent");
            asm volatile("s_waitcnt vmcnt(0)" ::: "memory");
            const unsigned og = xb_add(&bar[XB_TOP], 1u);
            const unsigned tg = og / nx;
            if (og + 1u == (tg + 1u) * nx) xb_add(&bar[XB_TOPGEN], 1u);
            else XB_SPIN(xb_ld(&bar[XB_TOPGEN]) == tg, bar);
            __builtin_amdgcn_fence(__ATOMIC_ACQUIRE, "agent");
            xb_add(&bar[XB_XGEN(b.x)], 1u);
            asm volatile("s_waitcnt vmcnt(0)" ::: "memory");
        } else {
            XB_SPIN(xb_ld(&bar[XB_XGEN(b.x)]) == gen, bar);
            __builtin_amdgcn_fence(__ATOMIC_ACQUIRE, "agent");
            asm volatile("s_waitcnt vmcnt(0)" ::: "memory");
        }
    }
    __syncthreads();
}


namespace pg8 {
#define PG8_LAS __attribute__((address_space(3)))
typedef unsigned short bf16_t;
typedef short bf16x8 __attribute__((ext_vector_type(8)));
typedef float f32x4 __attribute__((ext_vector_type(4)));
typedef unsigned u32x4 __attribute__((ext_vector_type(4)));
typedef unsigned u32x2 __attribute__((ext_vector_type(2)));
typedef int i32x4 __attribute__((ext_vector_type(4)));
typedef int i32x8 __attribute__((ext_vector_type(8)));
constexpr int BM = 256, BK = 64, HALF = 128, HTB = HALF * BK * 2, STAGE_BYTES = 8 * HTB, NXCD = 8, WGM = 8;
__host__ __device__ __forceinline__ int lds_byte(int r, int c) { const int st = (r >> 4) * 2 + (c >> 5), rr = r & 15, cc = c & 31, ob = rr * 64 + cc * 2; return st * 1024 + (ob ^ (((ob >> 9) & 1) << 5)); }
__host__ __device__ __forceinline__ void stage_rc(int b, int& R, int& C) { const int st = b / 1024, sb = b % 1024, swz = sb ^ (((sb >> 9) & 1) << 5); R = (st >> 1) * 16 + swz / 64; C = (st & 1) * 32 + (swz % 64) / 2; }
__host__ __device__ __forceinline__ int perm32(int rho) { const int n = rho >> 4, i = rho & 15; return 8 * (i >> 2) + 4 * n + (i & 3); }
struct Unit { int pm, pn, pb, e; };
struct Gemm { const bf16_t* A; const bf16_t* Bt; int K; const PG8_LAS int* rowmap; };
struct StaticOrder {
    int nM, nN, nwg, G, c;
    __device__ __forceinline__ void init(int M, int N, int G_, int c_) { nM = M / BM; nN = N / BM; nwg = nM * nN; G = G_; c = c_; }
    __device__ __forceinline__ bool next(int i, Unit& u) const {
        const long L = (long)i * G + c; if (L >= nwg) return false;
        int wgid = (int)L; { const int q = nwg / NXCD, r = nwg % NXCD, xcd = wgid % NXCD, off = wgid / NXCD; wgid = (xcd < r ? xcd * (q + 1) : r * (q + 1) + (xcd - r) * q) + off; }
        const int nig = WGM * nN, gid = wgid / nig, fm = gid * WGM, gsz = (nM - fm) < WGM ? (nM - fm) : WGM;
        u.pm = fm + ((wgid % nig) % gsz); u.pn = (wgid % nig) / gsz; u.pb = u.pn; u.e = 0; return true;
    }
    __device__ __forceinline__ void a_ready(const Unit&) const {}
    __device__ __forceinline__ void done(const Unit&) const {}
};
struct MoeOrder {
    const PG8_LAS int* pend; int nb, ntn, G, vc;
    __device__ __forceinline__ bool next(int i, Unit& u) const {
        const int U = nb * ntn, per = G >> 3, chunk = (U + 7) >> 3, x = vc / per, r = vc - x * per;
        const int off = i * per + r; if (off >= chunk) return false;
        const long L = (long)x * chunk + off; if (L >= (long)U) return false;
        const int rb = (int)(L / ntn), pn = (int)(L % ntn); const int start = rb * 256; int e = 0, prev = 0;
#pragma unroll
        for (int j = 0; j < 32; ++j) { const int pj = pend[j]; if (start >= pj) { e += 1; prev = pj; } }
        e = e < 31 ? e : 31; e = __builtin_amdgcn_readfirstlane(e); prev = __builtin_amdgcn_readfirstlane(prev);
#if MOE_SPARSE
        u.pm = e * (16384 / 256) + (rb - prev / 256);
#else
        u.pm = rb;
#endif
        u.pn = pn; u.pb = e * ntn + pn; u.e = e; return true;
    }
    __device__ __forceinline__ void a_ready(const Unit&) const {}
    __device__ __forceinline__ void done(const Unit&) const {}
};
__device__ __forceinline__ unsigned cvt_pk_bf16(float lo, float hi) { unsigned r; asm volatile("v_cvt_pk_bf16_f32 %0, %1, %2" : "=v"(r) : "v"(lo), "v"(hi)); return r; }
__device__ __forceinline__ float fsig(float x) { return __builtin_amdgcn_rcpf(1.0f + __expf(-x)); }
#if WT_STORES
__device__ __forceinline__ void st16(void* p, u32x4 v) { asm volatile("global_store_dwordx4 %0, %1, off sc1\n\ts_nop 0" :: "v"(p), "v"(v) : "memory"); }
__device__ __forceinline__ void st8(void* p, u32x2 v) { asm volatile("global_store_dwordx2 %0, %1, off sc1\n\ts_nop 0" :: "v"(p), "v"(v) : "memory"); }
#elif NT_STORES
__device__ __forceinline__ void st16(void* p, u32x4 v) { __builtin_nontemporal_store(v, (u32x4*)p); }
__device__ __forceinline__ void st8(void* p, u32x2 v) { __builtin_nontemporal_store(v, (u32x2*)p); }
#else
__device__ __forceinline__ void st16(void* p, u32x4 v) { *(u32x4*)p = v; }
__device__ __forceinline__ void st8(void* p, u32x2 v) { *(u32x2*)p = v; }
#endif
template <bool OUT8> struct EpiBf16T {
    static constexpr bool PERM = true, AFTER_DRAIN = false;
    void* O; int ldc; const float* bias; int bias_estride; float scale;
    __device__ __forceinline__ void operator()(const f32x4 (&acc)[2][2][4][2], const Unit& u, int wr, int wc, int fr, int fq) const {
        const int row0 = u.pm * BM + wr * 64 + fr, col0 = u.pn * BM + wc * 32 + 8 * fq;
        f32x4 bv[2][2];
#pragma unroll
        for (int bj = 0; bj < 2; ++bj)
#pragma unroll
            for (int n = 0; n < 2; ++n) bv[bj][n] = bias ? *(const f32x4*)(bias + (size_t)u.e * bias_estride + col0 + bj * HALF + 4 * n) : (f32x4){0.f, 0.f, 0.f, 0.f};
#pragma unroll
        for (int ai = 0; ai < 2; ++ai)
#pragma unroll
            for (int m = 0; m < 4; ++m) { const size_t ro = (size_t)(row0 + ai * HALF + m * 16) * ldc + col0;
#pragma unroll
                for (int bj = 0; bj < 2; ++bj) { const f32x4 v0 = acc[ai][bj][m][0] * scale + bv[bj][0], v1 = acc[ai][bj][m][1] * scale + bv[bj][1];
                    if constexpr (OUT8) { int w0 = __builtin_amdgcn_cvt_pk_fp8_f32(v0[0], v0[1], 0, false); w0 = __builtin_amdgcn_cvt_pk_fp8_f32(v0[2], v0[3], w0, true); int w1 = __builtin_amdgcn_cvt_pk_fp8_f32(v1[0], v1[1], 0, false); w1 = __builtin_amdgcn_cvt_pk_fp8_f32(v1[2], v1[3], w1, true);
                        u32x2 w; w.x = (unsigned)w0; w.y = (unsigned)w1; st8((unsigned char*)O + ro + bj * HALF, w); }
                    else { u32x4 w; w.x = cvt_pk_bf16(v0[0], v0[1]); w.y = cvt_pk_bf16(v0[2], v0[3]); w.z = cvt_pk_bf16(v1[0], v1[1]); w.w = cvt_pk_bf16(v1[2], v1[3]);
                        st16((bf16_t*)O + ro + bj * HALF, w); } } }
    }
};
typedef EpiBf16T<false> EpiBf16;
struct EpiGlu {
    static constexpr bool PERM = true, AFTER_DRAIN = false;
    bf16_t* O; int ldc; const bf16_t* Y; int ldy; const float* bias;
    __device__ __forceinline__ void operator()(const f32x4 (&acc)[2][2][4][2], const Unit& u, int wr, int wc, int fr, int fq) const {
        const int row0 = u.pm * BM + wr * 64 + fr, col0 = u.pn * BM + wc * 32 + 8 * fq;
        f32x4 bv[2][2];
#pragma unroll
        for (int bj = 0; bj < 2; ++bj)
#pragma unroll
            for (int n = 0; n < 2; ++n) bv[bj][n] = *(const f32x4*)(bias + col0 + bj * HALF + 4 * n);
#pragma unroll
        for (int ai = 0; ai < 2; ++ai)
#pragma unroll
            for (int m = 0; m < 4; ++m) { const size_t r = (size_t)(row0 + ai * HALF + m * 16);
#pragma unroll
                for (int bj = 0; bj < 2; ++bj) { const int c = col0 + bj * HALF; const u32x4 yv = *(const u32x4*)(Y + r * ldy + c);
                    const f32x4 z0 = acc[ai][bj][m][0] + bv[bj][0], z1 = acc[ai][bj][m][1] + bv[bj][1];
                    float y[8]; y[0] = __uint_as_float(yv.x << 16); y[1] = __uint_as_float(yv.x & 0xffff0000u); y[2] = __uint_as_float(yv.y << 16); y[3] = __uint_as_float(yv.y & 0xffff0000u);
                    y[4] = __uint_as_float(yv.z << 16); y[5] = __uint_as_float(yv.z & 0xffff0000u); y[6] = __uint_as_float(yv.w << 16); y[7] = __uint_as_float(yv.w & 0xffff0000u);
                    u32x4 w; w.x = cvt_pk_bf16(y[0] * fsig(z0[0]), y[1] * fsig(z0[1])); w.y = cvt_pk_bf16(y[2] * fsig(z0[2]), y[3] * fsig(z0[3]));
                    w.z = cvt_pk_bf16(y[4] * fsig(z1[0]), y[5] * fsig(z1[1])); w.w = cvt_pk_bf16(y[6] * fsig(z1[2]), y[7] * fsig(z1[3]));
                    st16(O + r * ldc + c, w); } }
    }
};
struct EpiResF32 {
    static constexpr bool PERM = false, AFTER_DRAIN = false;
    float* C; const float* R; int ldc; float alpha;
    __device__ __forceinline__ void operator()(const f32x4 (&acc)[2][2][4][2], const Unit& u, int wr, int wc, int fr, int fq) const {
        const int row0 = u.pm * BM + wr * 64 + fr, col0 = u.pn * BM + wc * 32 + 4 * fq;
#pragma unroll
        for (int ai = 0; ai < 2; ++ai)
#pragma unroll
            for (int m = 0; m < 4; ++m) { const size_t off = (size_t)(row0 + ai * HALF + m * 16) * ldc + col0;
#pragma unroll
                for (int bj = 0; bj < 2; ++bj)
#pragma unroll
                    for (int n = 0; n < 2; ++n) { const f32x4 rv = *(const f32x4*)(R + off + bj * HALF + n * 16); *(f32x4*)(C + off + bj * HALF + n * 16) = rv * alpha + acc[ai][bj][m][n]; } }
    }
};
struct EpiResBf16 {
    static constexpr bool PERM = true, AFTER_DRAIN = false;
    bf16_t* O; const bf16_t* R; int ldc; float alpha;
    __device__ __forceinline__ void operator()(const f32x4 (&acc)[2][2][4][2], const Unit& u, int wr, int wc, int fr, int fq) const {
        const int row0 = u.pm * BM + wr * 64 + fr, col0 = u.pn * BM + wc * 32 + 8 * fq;
#pragma unroll
        for (int ai = 0; ai < 2; ++ai)
#pragma unroll
            for (int m = 0; m < 4; ++m) { const size_t off = (size_t)(row0 + ai * HALF + m * 16) * ldc + col0;
#pragma unroll
                for (int bj = 0; bj < 2; ++bj) { const u32x4 rv = *(const u32x4*)(R + off + bj * HALF); const f32x4 a0 = acc[ai][bj][m][0], a1 = acc[ai][bj][m][1];
                    u32x4 w; w.x = cvt_pk_bf16(__uint_as_float(rv.x << 16) * alpha + a0[0], __uint_as_float(rv.x & 0xffff0000u) * alpha + a0[1]); w.y = cvt_pk_bf16(__uint_as_float(rv.y << 16) * alpha + a0[2], __uint_as_float(rv.y & 0xffff0000u) * alpha + a0[3]);
                    w.z = cvt_pk_bf16(__uint_as_float(rv.z << 16) * alpha + a1[0], __uint_as_float(rv.z & 0xffff0000u) * alpha + a1[1]); w.w = cvt_pk_bf16(__uint_as_float(rv.w << 16) * alpha + a1[2], __uint_as_float(rv.w & 0xffff0000u) * alpha + a1[3]);
                    st16(O + off + bj * HALF, w); } }
    }
};
template <bool OUT8> struct EpiSwiglu {
    static constexpr bool PERM = true, AFTER_DRAIN = false;
    void* O; const float* bgu; float scale;
    __device__ __forceinline__ void operator()(const f32x4 (&acc)[2][2][4][2], const Unit& u, int wr, int wc, int fr, int fq) const {
        const int row0 = u.pm * BM + wr * 64 + fr, cidx = u.pn * HALF + wc * 32 + 8 * fq;
        const float* bg = bgu + (size_t)u.e * 2048 + cidx;
        f32x4 bG[2], bL[2];
#pragma unroll
        for (int n = 0; n < 2; ++n) { bG[n] = *(const f32x4*)(bg + 4 * n); bL[n] = *(const f32x4*)(bg + 1024 + 4 * n); }
#pragma unroll
        for (int ai = 0; ai < 2; ++ai)
#pragma unroll
            for (int m = 0; m < 4; ++m) { const size_t ro = (size_t)(row0 + ai * HALF + m * 16) * 1024 + cidx; float o[8];
#pragma unroll
                for (int n = 0; n < 2; ++n) { const f32x4 g = acc[ai][0][m][n] * scale + bG[n], l = acc[ai][1][m][n] * scale + bL[n];
#pragma unroll
                    for (int j = 0; j < 4; ++j) { const float xg = fminf(g[j], 7.0f), xl = fminf(fmaxf(l[j], -7.0f), 7.0f); o[4 * n + j] = xg * fsig(1.702f * xg) * (xl + 1.0f); } }
                if constexpr (OUT8) { int w0 = __builtin_amdgcn_cvt_pk_fp8_f32(o[0], o[1], 0, false); w0 = __builtin_amdgcn_cvt_pk_fp8_f32(o[2], o[3], w0, true); int w1 = __builtin_amdgcn_cvt_pk_fp8_f32(o[4], o[5], 0, false); w1 = __builtin_amdgcn_cvt_pk_fp8_f32(o[6], o[7], w1, true);
                    u32x2 w; w.x = (unsigned)w0; w.y = (unsigned)w1; st8((unsigned char*)O + ro, w); }
                else { u32x4 w; w.x = cvt_pk_bf16(o[0], o[1]); w.y = cvt_pk_bf16(o[2], o[3]); w.z = cvt_pk_bf16(o[4], o[5]); w.w = cvt_pk_bf16(o[6], o[7]);
                    st16((bf16_t*)O + ro, w); } }
    }
};
struct EpiMem {
    static constexpr bool PERM = false, AFTER_DRAIN = false;
    bf16_t* mk; bf16_t* mv; bf16_t* mvt;
    __device__ __forceinline__ void operator()(const f32x4 (&acc)[2][2][4][2], const Unit& u, int wr, int wc, int fr, int fq) const {
        const int row0 = u.pm * BM + wr * 64 + fr, col0 = u.pn * BM + wc * 32 + 4 * fq;
#pragma unroll
        for (int ai = 0; ai < 2; ++ai)
#pragma unroll
            for (int m = 0; m < 4; ++m) { const int r = row0 + ai * HALF + m * 16, b = r >> 8, key = r & 255;
#pragma unroll
                for (int bj = 0; bj < 2; ++bj)
#pragma unroll
                    for (int n = 0; n < 2; ++n) { const int c = col0 + bj * HALF + n * 16, cc = c & 255, head = cc >> 6, d = cc & 63; const f32x4 v = acc[ai][bj][m][n];
                        u32x2 w; w.x = cvt_pk_bf16(v[0], v[1]); w.y = cvt_pk_bf16(v[2], v[3]);
                        const size_t o = ((size_t)(b * 4 + head) * 256 + key) * 64 + d;
                        if (c < 256) *(u32x2*)(mk + o) = w;
                        else { *(u32x2*)(mv + o) = w; bf16_t* t = mvt + ((size_t)(b * 4 + head) * 64 + d) * 256 + key;
                            t[0] = (bf16_t)(w.x & 0xffffu); t[256] = (bf16_t)(w.x >> 16); t[512] = (bf16_t)(w.y & 0xffffu); t[768] = (bf16_t)(w.y >> 16); } } }
    }
};
template <class Epi, class Sched, bool ALIGN_EPI = true, bool SP2 = true, bool GATHER = false, bool FP8 = false>
__device__ __forceinline__ void gemm_phase(PG8_LAS unsigned char* lds, const Gemm g, const Sched& S, const Epi& E, const int wave_) {
    const int tid_ = wave_ * 64 + lane_id_opaque();
    const int tid = tid_, wid = wave_, lane = tid & 63, wr = wid >> 2, wc = wid & 3, fr = lane & 15, fq = lane >> 4;
    const int K = g.K, rowb = FP8 ? K : 2 * K  , nt = rowb / (BK * 2);
    unsigned voffA[2], voffB[2];
#pragma unroll
    for (int i = 0; i < 2; ++i) { int R, C; stage_rc(tid * 16 + i * 8192, R, C); const int Rb = Epi::PERM ? ((R & ~31) + perm32(R & 31)) : R;
        voffA[i] = (unsigned)(R * rowb + C * 2); voffB[i] = (unsigned)(Rb * rowb + C * 2); }
    const size_t kstep = (size_t)(BK * 2);
    const size_t hstep = (size_t)HALF * rowb;
    const size_t tstep = 2 * hstep;
    const unsigned ldsw = (unsigned)wid * 1024u;
    int aoffv[2], boffv[2];
#pragma unroll
    for (int k = 0; k < 2; ++k) { const int p = FP8 ? 2 * fq + k : 4 * k + fq; aoffv[k] = lds_byte(wr * 64 + fr, (p & 3) * 8) + (p >> 2) * 1024; boffv[k] = lds_byte(wc * 32 + fr, (p & 3) * 8) + (p >> 2) * 1024; }
#define PG8_SA(b, h) (((b) * 2 + (h)) * HTB)
#define PG8_SB(b, h) ((4 + (b) * 2 + (h)) * HTB)
#define PG8_STAGE(bufoff, gbase, voff) do { _Pragma("unroll") for (int _i = 0; _i < 2; ++_i) \
        __builtin_amdgcn_global_load_lds((const unsigned*)((const char*)(gbase) + (voff)[_i]), (PG8_LAS unsigned*)(lds + (bufoff) + ldsw + _i * 8192), 16, 0, 0); } while (0)
#define PG8_VSEL_0(h, i) vgC[h][i]
#define PG8_VSEL_1(h, i) (last ? vgX[h][i] : vgC[h][i])
#define PG8_STAGE_A(bufoff, gbase, h, set) do { if constexpr (GATHER) { _Pragma("unroll") for (int _i = 0; _i < 2; ++_i) \
        __builtin_amdgcn_global_load_lds((const unsigned*)((const char*)(gbase) + PG8_VSEL_##set(h, _i)), (PG8_LAS unsigned*)(lds + (bufoff) + ldsw + _i * 8192), 16, 0, 0); } \
    else { PG8_STAGE(bufoff, (gbase) + (h) * hstep, voffA); } } while (0)
#define PG8_LDA(dst, b, h) do { if constexpr (FP8) { _Pragma("unroll") for (int m = 0; m < 4; ++m) { const i32x4 lo_ = *(const PG8_LAS i32x4*)(lds + PG8_SA(b, h) + aoffv[0] + m * 2048), hi_ = *(const PG8_LAS i32x4*)(lds + PG8_SA(b, h) + aoffv[1] + m * 2048); dst##8[m] = __builtin_shufflevector(lo_, hi_, 0, 1, 2, 3, 4, 5, 6, 7); } } \
    else { _Pragma("unroll") for (int m = 0; m < 4; ++m) _Pragma("unroll") for (int k = 0; k < 2; ++k) dst[m][k] = *(const PG8_LAS bf16x8*)(lds + PG8_SA(b, h) + aoffv[k] + m * 2048); } } while (0)
#define PG8_LDB(dst, b, h) do { if constexpr (FP8) { _Pragma("unroll") for (int n = 0; n < 2; ++n) { const i32x4 lo_ = *(const PG8_LAS i32x4*)(lds + PG8_SB(b, h) + boffv[0] + n * 2048), hi_ = *(const PG8_LAS i32x4*)(lds + PG8_SB(b, h) + boffv[1] + n * 2048); dst##8[n] = __builtin_shufflevector(lo_, hi_, 0, 1, 2, 3, 4, 5, 6, 7); } } \
    else { _Pragma("unroll") for (int n = 0; n < 2; ++n) _Pragma("unroll") for (int k = 0; k < 2; ++k) dst[n][k] = *(const PG8_LAS bf16x8*)(lds + PG8_SB(b, h) + boffv[k] + n * 2048); } } while (0)
#define PG8_MMA(ai, bj, At, Bt) do { __builtin_amdgcn_s_setprio(1); _Pragma("unroll") for (int m = 0; m < 4; ++m) _Pragma("unroll") for (int n = 0; n < 2; ++n) { \
        if constexpr (FP8) { acc[ai][bj][m][n] = __builtin_amdgcn_mfma_scale_f32_16x16x128_f8f6f4(Bt##8[n], At##8[m], acc[ai][bj][m][n], 0, 0, 0, 0x7f7f7f7f, 0, 0x7f7f7f7f); } \
        else { _Pragma("unroll") for (int k = 0; k < 2; ++k) acc[ai][bj][m][n] = __builtin_amdgcn_mfma_f32_16x16x32_bf16(Bt[n][k], At[m][k], acc[ai][bj][m][n], 0, 0, 0); } } \
        if constexpr (FP8) { _Pragma("unroll") for (int m = 0; m < 4; ++m) asm volatile("" : "+v"(acc[ai][bj][m][0]), "+v"(acc[ai][bj][m][1])); }     \
        __builtin_amdgcn_s_setprio(0); } while (0)
#define PG8_WAIT_V(n) asm volatile("s_waitcnt vmcnt(" #n ")" ::: "memory")
#define PG8_WAIT_L(n) asm volatile("s_waitcnt lgkmcnt(" #n ")" ::: "memory")
#define PG8_BAR __builtin_amdgcn_s_barrier()
#define PG8_SCHED __builtin_amdgcn_sched_barrier(0)
    Unit cur, nxt; int ui = 0;
    if (!S.next(0, cur)) return;
    f32x4 acc[2][2][4][2];
#pragma unroll
    for (int a = 0; a < 2; ++a)
#pragma unroll
        for (int b = 0; b < 2; ++b)
#pragma unroll
            for (int m = 0; m < 4; ++m)
#pragma unroll
                for (int n = 0; n < 2; ++n) acc[a][b][m][n] = (f32x4){0.f, 0.f, 0.f, 0.f};
    bf16x8 At[4][2], B0[2][2], B1[2][2];
    i32x8 At8[4], B08[2], B18[2];
    unsigned vgC[2][2], vgX[2][2];
#define PG8_GOFF(dst, pm_) do { const int t_ = wave_ * 64 + lane_id_opaque();   _Pragma("unroll") for (int _i = 0; _i < 2; ++_i) { int gR_, gC_; stage_rc(t_ * 16 + _i * 8192, gR_, gC_); _Pragma("unroll") for (int _h = 0; _h < 2; ++_h) \
        dst[_h][_i] = (unsigned)(g.rowmap[(pm_) * BM + _h * HALF + gR_] * rowb + gC_ * 2); } } while (0)
    if constexpr (GATHER) { PG8_GOFF(vgC, 0); }
    const char* cA = GATHER ? (const char*)g.A : (const char*)g.A + (size_t)cur.pm * tstep; const char* cB = (const char*)g.Bt + (size_t)cur.pb * tstep;
    S.a_ready(cur);
    if constexpr (SP2) {
        PG8_STAGE(PG8_SB(0, 0), cB, voffB); PG8_STAGE(PG8_SB(0, 1), cB + hstep, voffB); PG8_STAGE_A(PG8_SA(0, 0), cA, 0, 0); PG8_STAGE_A(PG8_SA(0, 1), cA, 1, 0);
        if (wr == 1) PG8_BAR;
        PG8_WAIT_V(2); PG8_BAR;
        PG8_STAGE(PG8_SB(1, 0), cB + kstep, voffB); PG8_STAGE_A(PG8_SA(1, 0), cA + kstep, 0, 0); PG8_STAGE(PG8_SB(1, 1), cB + hstep + kstep, voffB);
        PG8_WAIT_V(6); PG8_BAR;
    } else {
        PG8_STAGE(PG8_SB(0, 0), cB, voffB); PG8_STAGE_A(PG8_SA(0, 0), cA, 0, 0); PG8_STAGE(PG8_SB(0, 1), cB + hstep, voffB); PG8_STAGE_A(PG8_SA(0, 1), cA, 1, 0);
        if (wr == 1) PG8_BAR;
        PG8_WAIT_V(4); PG8_BAR;
        PG8_STAGE(PG8_SB(1, 0), cB + kstep, voffB); PG8_STAGE_A(PG8_SA(1, 0), cA + kstep, 0, 0); PG8_STAGE(PG8_SB(1, 1), cB + hstep + kstep, voffB);
        PG8_WAIT_V(6); PG8_BAR;
    }
    for (;;) {
        const bool has_next = S.next(ui + 1, nxt);
        if constexpr (GATHER) { if (has_next) PG8_GOFF(vgX, ui + 1); else { _Pragma("unroll") for (int _h = 0; _h < 2; ++_h) _Pragma("unroll") for (int _i = 0; _i < 2; ++_i) vgX[_h][_i] = vgC[_h][_i]; } }
        const char* nA = GATHER ? (const char*)g.A : (has_next ? (const char*)g.A + (size_t)nxt.pm * tstep : cA); const char* nB = has_next ? (const char*)g.Bt + (size_t)nxt.pb * tstep : cB;
        for (int t = 0; t < nt; t += 2) {
            const bool last = (t == nt - 2);
            const char* a1 = cA + (size_t)(t + 1) * kstep;
            const char* a2 = last ? nA : cA + (size_t)(t + 2) * kstep; const char* b2 = last ? nB : cB + (size_t)(t + 2) * kstep;
            const char* a3 = a2 + kstep; const char* b3 = b2 + kstep;
            if (last && has_next) S.a_ready(nxt);
            if constexpr (SP2) {
            PG8_LDB(B0, 0, 0); PG8_LDB(B1, 0, 1); PG8_SCHED; PG8_LDA(At, 0, 0); PG8_STAGE_A(PG8_SA(1, 1), a1, 1, 0);
            PG8_WAIT_V(8); PG8_WAIT_L(0); PG8_BAR; PG8_MMA(0, 0, At, B0); PG8_MMA(0, 1, At, B1); PG8_BAR; PG8_SCHED;
            PG8_LDA(At, 0, 1); PG8_STAGE(PG8_SB(0, 0), b2, voffB); PG8_STAGE(PG8_SB(0, 1), b2 + hstep, voffB); PG8_STAGE_A(PG8_SA(0, 0), a2, 0, 1);
            PG8_WAIT_V(8); PG8_WAIT_L(0); PG8_BAR; PG8_MMA(1, 0, At, B0); PG8_MMA(1, 1, At, B1); PG8_BAR; PG8_SCHED;
            PG8_LDB(B0, 1, 0); PG8_LDB(B1, 1, 1); PG8_SCHED; PG8_LDA(At, 1, 0); PG8_STAGE_A(PG8_SA(0, 1), a2, 1, 1);
            PG8_WAIT_V(8); PG8_WAIT_L(0); PG8_BAR; PG8_MMA(0, 0, At, B0); PG8_MMA(0, 1, At, B1); PG8_BAR; PG8_SCHED;
            PG8_LDA(At, 1, 1); PG8_STAGE(PG8_SB(1, 0), b3, voffB); PG8_STAGE(PG8_SB(1, 1), b3 + hstep, voffB); PG8_STAGE_A(PG8_SA(1, 0), a3, 0, 1);
            PG8_WAIT_V(8); PG8_WAIT_L(0); PG8_BAR; PG8_MMA(1, 0, At, B0); PG8_MMA(1, 1, At, B1); PG8_BAR; PG8_SCHED;
            } else {
            PG8_LDB(B0, 0, 0); PG8_SCHED; PG8_LDA(At, 0, 0); PG8_STAGE_A(PG8_SA(1, 1), a1, 1, 0);
            PG8_WAIT_L(8); PG8_BAR; PG8_WAIT_L(0); PG8_MMA(0, 0, At, B0); PG8_BAR; PG8_SCHED;
            PG8_LDB(B1, 0, 1); PG8_STAGE(PG8_SB(0, 0), b2, voffB);
            PG8_BAR; PG8_WAIT_L(0); PG8_MMA(0, 1, At, B1); PG8_BAR;
            PG8_LDA(At, 0, 1); PG8_STAGE_A(PG8_SA(0, 0), a2, 0, 1);
            PG8_BAR; PG8_WAIT_L(0); PG8_MMA(1, 0, At, B0); PG8_BAR; PG8_SCHED;
            PG8_STAGE(PG8_SB(0, 1), b2 + hstep, voffB);
            PG8_WAIT_V(6); PG8_BAR; PG8_MMA(1, 1, At, B1); PG8_BAR;
            PG8_LDB(B0, 1, 0); PG8_SCHED; PG8_LDA(At, 1, 0); PG8_STAGE_A(PG8_SA(0, 1), a2, 1, 1);
            PG8_WAIT_L(8); PG8_BAR; PG8_WAIT_L(0); PG8_MMA(0, 0, At, B0); PG8_BAR; PG8_SCHED;
            PG8_LDB(B1, 1, 1); PG8_STAGE(PG8_SB(1, 0), b3, voffB);
            PG8_BAR; PG8_WAIT_L(0); PG8_MMA(0, 1, At, B1); PG8_BAR;
            PG8_LDA(At, 1, 1); PG8_STAGE_A(PG8_SA(1, 0), a3, 0, 1);
            PG8_BAR; PG8_WAIT_L(0); PG8_MMA(1, 0, At, B0); PG8_BAR; PG8_SCHED;
            PG8_STAGE(PG8_SB(1, 1), b3 + hstep, voffB);
            PG8_WAIT_V(6); PG8_BAR; PG8_MMA(1, 1, At, B1); PG8_BAR;
            }
        }
        if constexpr (ALIGN_EPI) { if (wr == 0) PG8_BAR; }
        if constexpr (!Epi::AFTER_DRAIN) { const int l2_ = lane_id_opaque(); E(acc, cur, wr, wc, l2_ & 15, l2_ >> 4); S.done(cur); }
        if (!has_next) break;
#pragma unroll
        for (int a = 0; a < 2; ++a)
#pragma unroll
            for (int b = 0; b < 2; ++b)
#pragma unroll
                for (int m = 0; m < 4; ++m)
#pragma unroll
                    for (int n = 0; n < 2; ++n) acc[a][b][m][n] = (f32x4){0.f, 0.f, 0.f, 0.f};
        cur = nxt; cA = nA; cB = nB; ++ui;
        if constexpr (GATHER) { _Pragma("unroll") for (int _h = 0; _h < 2; ++_h) _Pragma("unroll") for (int _i = 0; _i < 2; ++_i) vgC[_h][_i] = vgX[_h][_i]; }
        if constexpr (ALIGN_EPI) { if (wr == 1) PG8_BAR; }
    }
    PG8_WAIT_V(0);
    if constexpr (!ALIGN_EPI) { if (wr == 0) PG8_BAR; }
    PG8_BAR;
    if constexpr (Epi::AFTER_DRAIN) { E.fused(acc, cur, wr, wc, fr, fq, lds, wid, lane); S.done(cur); }
#undef PG8_GOFF
#undef PG8_SA
#undef PG8_SB
#undef PG8_STAGE
#undef PG8_STAGE_A
#undef PG8_VSEL_0
#undef PG8_VSEL_1
#undef PG8_LDA
#undef PG8_LDB
#undef PG8_MMA
#undef PG8_WAIT_V
#undef PG8_WAIT_L
#undef PG8_BAR
#undef PG8_SCHED
}
}

template <class TC, class LA, class LB, class EP>
__device__ __forceinline__ void oracle_gemm(LAS float* lds, int M, int N, int K, TC tilectx, LA loadA, LB loadB, EP epi) {
    LAS float* As = lds; LAS float* Bs = lds + 16 * 132;
    int tid = threadIdx.x; asm volatile("" : "+v"(tid)); const int ty = tid >> 4, tx = tid & 15;
    const int ntm = M / 128, ntn = (N + 127) / 128;
    for (int tile = blockIdx.x; tile < ntm * ntn; tile += gridDim.x) {
        const int tm = tile / ntn, tn = tile % ntn;
        const int ctx = tilectx(tm);
        float acc[4][8];
#pragma unroll
        for (int i = 0; i < 4; ++i)
#pragma unroll
            for (int j = 0; j < 8; ++j) acc[i][j] = 0.f;
        for (int k0 = 0; k0 < K; k0 += 16) {
#pragma unroll
            for (int i = 0; i < 4; ++i) { const int idx = tid + 512 * i; const int r = idx >> 4, kk = idx & 15; As[kk * 132 + r] = loadA(tm * 128 + r, k0 + kk); }
#pragma unroll
            for (int i = 0; i < 4; ++i) { const int idx = tid + 512 * i; const int kk = idx >> 7, n = idx & 127; Bs[kk * 132 + n] = loadB(k0 + kk, tn * 128 + n, ctx); }
            __syncthreads();
#pragma unroll 2
            for (int kk = 0; kk < 16; ++kk) {
                float a[4], b[8];
#pragma unroll
                for (int i = 0; i < 4; ++i) a[i] = As[kk * 132 + ty * 4 + i];
#pragma unroll
                for (int j = 0; j < 8; ++j) b[j] = Bs[kk * 132 + tx * 8 + j];
#pragma unroll
                for (int i = 0; i < 4; ++i)
#pragma unroll
                    for (int j = 0; j < 8; ++j) acc[i][j] += a[i] * b[j];
            }
            __syncthreads();
        }
        epi(tm * 128 + ty * 4, tn * 128 + tx * 8, acc, ctx);
    }
}


template <class MAP>
__device__ __forceinline__ void tr_item(const float* W, int ldw, int K, bf16* WT, int nblk, int item, LAS float* scr, int lane, MAP map) {
    const int kb = item / nblk, nb = item % nblk, k0 = kb * 64, n0 = nb * 64;
    const int s = map(n0 + lane);
    const float* wp = W + (size_t)k0 * ldw + (s >= 0 ? s : 0);
#pragma unroll 8
    for (int i = 0; i < 64; ++i) scr[i * 65 + lane] = (s >= 0) ? wp[(size_t)i * ldw] : 0.f;
    asm volatile("s_waitcnt lgkmcnt(0)" ::: "memory");
    const int c = lane & 7;
#pragma unroll
    for (int j = 0; j < 8; ++j) { const int n = (lane >> 3) + 8 * j; const LAS float* sp = scr + (8 * c) * 65 + n;
        uint4 o; o.x = pg8::cvt_pk_bf16(sp[0], sp[65]); o.y = pg8::cvt_pk_bf16(sp[130], sp[195]); o.z = pg8::cvt_pk_bf16(sp[260], sp[325]); o.w = pg8::cvt_pk_bf16(sp[390], sp[455]);
        *(uint4*)(WT + (size_t)(n0 + n) * K + k0 + 8 * c) = o; }
    asm volatile("s_waitcnt lgkmcnt(0)" ::: "memory");
}

template <int DEEP, class MAP>
__device__ __forceinline__ void tr_item8(const float* W, int ldw, int K, unsigned char* WT8, int nblk, int item, LAS float* scr, int lane, float scale, MAP map) {
    const int kb = item / nblk, nb = item % nblk, k0 = kb * 64, n0 = nb * 64;
    const int s = map(n0 + lane);
    const float* wp = W + (size_t)k0 * ldw + (s >= 0 ? s : 0);
    if constexpr (DEEP) {
#pragma unroll
        for (int h2 = 0; h2 < 2; ++h2) { float v[32];
#pragma unroll
            for (int i = 0; i < 32; ++i) v[i] = (s >= 0) ? wp[(size_t)(32 * h2 + i) * ldw] : 0.f;
#pragma unroll
            for (int i = 0; i < 32; ++i) scr[(32 * h2 + i) * 65 + lane] = v[i] * scale; }
    } else {
#pragma unroll 8
        for (int i = 0; i < 64; ++i) scr[i * 65 + lane] = (s >= 0) ? wp[(size_t)i * ldw] * scale : 0.f;
    }
    asm volatile("s_waitcnt lgkmcnt(0)" ::: "memory");
    const int c = lane & 7;
#pragma unroll
    for (int j = 0; j < 8; ++j) { const int n = (lane >> 3) + 8 * j; const LAS float* sp = scr + (8 * c) * 65 + n;
        int w0 = __builtin_amdgcn_cvt_pk_fp8_f32(sp[0], sp[65], 0, false); w0 = __builtin_amdgcn_cvt_pk_fp8_f32(sp[130], sp[195], w0, true);
        int w1 = __builtin_amdgcn_cvt_pk_fp8_f32(sp[260], sp[325], 0, false); w1 = __builtin_amdgcn_cvt_pk_fp8_f32(sp[390], sp[455], w1, true);
        uint2 o; o.x = (unsigned)w0; o.y = (unsigned)w1; *(uint2*)(WT8 + (size_t)(n0 + n) * K + k0 + 8 * c) = o; }
    asm volatile("s_waitcnt lgkmcnt(0)" ::: "memory");
}

struct Args { const void* in[46]; float* out; unsigned char* ws; int ph_lo, ph_hi; };

enum { PH_PRO = 0, PH_MEM = 1, PH_L0 = 2, PH_PER_LAYER = 9, PH_TOTAL = 2 + 9 * DEPTH };
enum { LP_INPROJ = 0, LP_MIXA = 1, LP_MIXB = 2, LP_OUTPROJ = 3, LP_LN1 = 4, LP_DISP = 5, LP_GU = 6, LP_DOWN = 7, LP_COMB = 8 };

__device__ __forceinline__ int expert_of_block(const LAS int* pend, int rb) {
    const int start = rb * MOEBLK; int e = 0;
#pragma unroll
    for (int i = 0; i < NEXP; ++i) e += (start >= pend[i]) ? 1 : 0;
    return e < NEXP - 1 ? e : NEXP - 1;
}

typedef const void* const __attribute__((address_space(4)))* KARG;
__global__ void __launch_bounds__(NTHR, 2) mk_fwd(Args args) {
    extern __shared__ __attribute__((aligned(16))) unsigned char lds_raw[];
    LAS unsigned char* lds = (LAS unsigned char*)lds_raw;
    LAS float* ldsf = (LAS float*)lds;
    volatile LAS unsigned* MISC = (volatile LAS unsigned*)(lds + LDS_MISC);
    const int tid0 = threadIdx.x, wave0 = __builtin_amdgcn_readfirstlane(tid0 >> 6);
    const int G = gridDim.x, bid = blockIdx.x;
#define LDS_BARRIER() do { asm volatile("s_waitcnt lgkmcnt(0)" ::: "memory"); __builtin_amdgcn_s_barrier(); asm volatile("" ::: "memory"); } while (0)
#define ARGP(i) ((const void*)kp_[i])
#define PHASE_IDS() int wave = wave0; asm volatile("" : "+s"(wave)); KARG kp_ = (KARG)__builtin_amdgcn_kernarg_segment_ptr(); asm volatile("" : "+s"(kp_)); unsigned char* ws = ws0; asm volatile("" : "+s"(ws)); unsigned* const ctl = (unsigned*)(ws + WS_CTL); (void)ctl; const int tid = wave * 64 + lane_id_opaque(); const int lane = tid & 63; (void)lane
    unsigned char* const ws0 = args.ws;
    unsigned* const ctl0 = (unsigned*)(ws0 + WS_CTL);
#define hf ((float*)(ws + WS_HF))
#define y2 ((float*)(ws + WS_Y2))
#define hb ((bf16*)(ws + WS_HB))
#define proj ((bf16*)(ws + WS_PROJ))
#define yg ((bf16*)(ws + WS_YG))
#define cat ((bf16*)(ws + WS_CAT))
#define top_e ((int*)(ws + WS_TOPE))
#define top_g ((float*)(ws + WS_TOPG))
#define dest ((int*)(ws + WS_DEST))
#define xr ((bf16*)(ws + WS_XR))
#define act ((bf16*)(ws + WS_ACT))
#define yr ((bf16*)(ws + WS_YR))
#define memK ((bf16*)(ws + WS_MEMK))
#define memV ((bf16*)(ws + WS_MEMV))
#define memVT ((bf16*)(ws + WS_MEMVT))
#define rope ((float*)(ws + WS_ROPE))
#define win_t ((bf16*)(ws + WS_WIN))
#define wglu_t ((bf16*)(ws + WS_WGLU))
#define wout_t ((bf16*)(ws + WS_WOUT))
#define wmem_t ((bf16*)(ws + WS_WMEM))
#define memb ((bf16*)(ws + WS_MEMB))
#define wgu_t ((bf16*)(ws + WS_WGU))
#define wdn_t ((bf16*)(ws + WS_WDN))
#define rwt ((bf16*)(ws + WS_RWT))
#define row_tok ((int*)(ws + WS_RTOK))
#define wgu8 (ws + WS_WGU)
#define wdn8 (ws + WS_WDN)
#define act8 (ws + WS_ACT)
#define hb8 (ws + WS_XR)
    constexpr float GU_WS = 32.0f, DN_WS = 64.0f;
    const int vcu = (G % 8 == 0) ? (bid % 8) * (G / 8) + bid / 8 : bid;

    if (tid0 < 64) MISC[tid0] = 0u;
    __syncthreads();
    const int lo = args.ph_lo, hi = args.ph_hi;
    XcdBarrier bar; bar.bar = ctl0 + CW_BAR; bar.x = 0; bar.st = MISC;
    if (hi - lo > 1) bar = xcd_barrier_post(ctl0 + CW_BAR, MISC, wave0);
#define IN(k) (lo <= (k) && (k) < hi)
#define SEAM(k) do { if (IN(k) && IN((k) + 1)) xcd_barrier(bar, wave0); } while (0)

    if (IN(PH_PRO)) {
            PHASE_IDS();
            REPS(0) { if (rep_) __syncthreads();
        {
            LAS float* scr = ldsf + wave * (64 * 65);
            const int gw = vcu * NWAVES + wave, NGW = G * NWAVES;
            constexpr int PRO_LAYERS = BG_CONV ? ((BG_ALL && LINATT_V2) ? 0 : 1) : DEPTH;
            constexpr int N_GU = FAST_MOE ? PRO_LAYERS * NEXP * 512 : 0, N_DN = FAST_MOE ? PRO_LAYERS * NEXP * 256 : 0;
            constexpr int N_IN0 = FAST_DENSE ? 256 : 0, N_IN1 = FAST_DENSE ? 704 : 0, N_IN2 = FAST_DENSE ? 640 : 0, N_IN3 = N_IN0, N_GLU = FAST_DENSE ? 144 : 0, N_OUT = FAST_DENSE ? 256 : 0, N_MEM = FAST_DENSE ? 64 : 0;
            constexpr int NITEMS = N_GU + N_DN + N_IN0 + N_IN1 + N_IN2 + N_IN3 + 2 * N_GLU + 4 * N_OUT + 2 * N_MEM;
            for (int it = gw; it < NITEMS; it += NGW) {
                int r = it;
                if (r < N_GU) { const int le = r >> 9;
#if MOE_FP8
                    tr_item8<0>((const float*)ARGP(42) + (size_t)le * D * 2 * DEXP, 2 * DEXP, D, wgu8 + (size_t)le * 2 * DEXP * D, 32, r & 511, scr, lane, GU_WS, [](int d) { const int tile = d >> 8, q = d & 255; return q < 128 ? tile * 128 + q : DEXP + tile * 128 + (q - 128); });
#else
                    tr_item((const float*)ARGP(42) + (size_t)le * D * 2 * DEXP, 2 * DEXP, D, wgu_t + (size_t)le * 2 * DEXP * D, 32, r & 511, scr, lane, [](int d) { const int tile = d >> 8, q = d & 255; return q < 128 ? tile * 128 + q : DEXP + tile * 128 + (q - 128); });
#endif
                    continue; } r -= N_GU;
                if (r < N_DN) { const int le = r >> 8;
#if MOE_FP8
                    tr_item8<0>((const float*)ARGP(44) + (size_t)le * DEXP * D, D, DEXP, wdn8 + (size_t)le * D * DEXP, 16, r & 255, scr, lane, DN_WS, [](int d) { return d; });
#else
                    tr_item((const float*)ARGP(44) + (size_t)le * DEXP * D, D, DEXP, wdn_t + (size_t)le * D * DEXP, 16, r & 255, scr, lane, [](int d) { return d; });
#endif
                    continue; } r -= N_DN;
                if (r < N_IN0) { tr_item((const float*)ARGP(5), 1024, D, win_t, 16, r, scr, lane, [](int d) { return d; }); continue; } r -= N_IN0;
                if (r < N_IN1) { tr_item((const float*)ARGP(16), 2568, D, win_t + (size_t)1 * 3 * MiB, 44, r, scr, lane, [](int d) { return d < 2568 ? d : -1; }); continue; } r -= N_IN1;
                if (r < N_IN2) { tr_item((const float*)ARGP(22), 2560, D, win_t + (size_t)2 * 3 * MiB, 40, r, scr, lane, [](int d) { return d; }); continue; } r -= N_IN2;
                if (r < N_IN3) { tr_item((const float*)ARGP(24), 1024, D, win_t + (size_t)3 * 3 * MiB, 16, r, scr, lane, [](int d) { return d; }); continue; } r -= N_IN3;
                if (r < N_GLU) { tr_item((const float*)ARGP(14), MIXW, MIXW, wglu_t, 12, r, scr, lane, [](int d) { return d; }); continue; } r -= N_GLU;
                if (r < N_GLU) { tr_item((const float*)ARGP(33), MIXW, MIXW, wglu_t + (size_t)1 * MiB, 12, r, scr, lane, [](int d) { return d; }); continue; } r -= N_GLU;
                if (r < 4 * N_OUT) { const int l = r >> 8; tr_item((const float*)ARGP(35) + (size_t)l * D * D, D, D, wout_t + (size_t)l * D * D, 16, r & 255, scr, lane, [](int d) { return d; }); continue; } r -= 4 * N_OUT;
                if (r < N_MEM) { tr_item((const float*)ARGP(3), 256, D, wmem_t, 4, r, scr, lane, [](int d) { return d; }); continue; } r -= N_MEM;
                tr_item((const float*)ARGP(4), 256, D, wmem_t + (size_t)256 * D, 4, r, scr, lane, [](int d) { return d; });
            }
            const float* mem = (const float*)ARGP(1);
            for (size_t i = ((size_t)bid * NTHR + tid) * 4; i < (size_t)NB * NMEM * D; i += (size_t)G * NTHR * 4) {
                const float4 v = *(const float4*)(mem + i); uint2 o; o.x = pg8::cvt_pk_bf16(v.x, v.y); o.y = pg8::cvt_pk_bf16(v.z, v.w); *(uint2*)(memb + i) = o; }
        }
        {
            const float* rwf = (const float*)ARGP(40);
            for (int i = bid * NTHR + tid; i < DEPTH * NEXP * D; i += G * NTHR) { const int l = i / (NEXP * D), rem = i % (NEXP * D), e = rem / D, k = rem % D;
                const float v = rwf[((size_t)l * D + k) * NEXP + e]; const bf16 hi_ = f2bf(v); const bf16 lo_ = f2bf(v - bf2f(hi_));
                rwt[((size_t)(l * 2 + 0) * NEXP + e) * D + k] = hi_; rwt[((size_t)(l * 2 + 1) * NEXP + e) * D + k] = lo_; }
        }
        const float* x = (const float*)ARGP(0);
        for (size_t i = ((size_t)bid * NTHR + tid) * 4; i < (size_t)T * D; i += (size_t)G * NTHR * 4) {
            const float4 v = *(const float4*)(x + i);
#if !RES_BF16
            *(float4*)(hf + i) = v;
#endif
            uint2 o; o.x = pk2(v.x, v.y); o.y = pk2(v.z, v.w); *(uint2*)(hb + i) = o;
        }
        const int* pos = (const int*)ARGP(2);
        for (int idx = bid * NTHR + tid; idx < T * 48; idx += G * NTHR) {
            const int t = idx / 48, i = idx % 48;
            const double inv = exp(-((double)(2 * i) / 96.0) * 9.210340371976184);
            double r = (double)pos[t] * inv * 0.15915494309189535; r -= rint(r);
            const float rf = (float)r;
            typedef _Float16 h2_t __attribute__((ext_vector_type(2))); h2_t cs_; cs_.x = (_Float16)__builtin_amdgcn_cosf(rf); cs_.y = (_Float16)__builtin_amdgcn_sinf(rf);
            ((unsigned*)rope)[idx] = __builtin_bit_cast(unsigned, cs_);
        }
    } }
    SEAM(PH_PRO);

    if (IN(PH_MEM)) {
            PHASE_IDS();
            REPS(1) { if (rep_) __syncthreads();
#if FAST_DENSE
        { pg8::Gemm g{memb, wmem_t, D, nullptr}; pg8::StaticOrder S; S.init(NB * NMEM, 512, G, bid); pg8::EpiMem E{memK, memV, memVT}; pg8::gemm_phase(lds, g, S, E, wave); }
#else
        const float* mem = (const float*)ARGP(1); const float* wk = (const float*)ARGP(3); const float* wv = (const float*)ARGP(4);
        oracle_gemm(ldsf, NB * NMEM, 512, D,
            [&](int) { return 0; },
            [&](int m, int k) { return mem[(size_t)m * D + k]; },
            [&](int k, int n, int) { return n < 256 ? wk[(size_t)k * 256 + n] : wv[(size_t)k * 256 + n - 256]; },
            [&](int m0, int n0, float (&acc)[4][8], int) {
#pragma unroll
                for (int i = 0; i < 4; ++i)
#pragma unroll
                    for (int j = 0; j < 8; ++j) { const int m = m0 + i, n = n0 + j; const int b = m >> 8, key = m & 255; const int nn = n & 255, head = nn >> 6, d = nn & 63; const bf16 v = f2bf(acc[i][j]);
                        if (n < 256) memK[((size_t)(b * 4 + head) * 256 + key) * 64 + d] = v;
                        else { memV[((size_t)(b * 4 + head) * 256 + key) * 64 + d] = v; memVT[((size_t)(b * 4 + head) * 64 + d) * 256 + key] = v; } }
            });
#endif
    } }

    for (int L = 0; L < DEPTH; ++L) {
        const int P = PH_L0 + PH_PER_LAYER * L;
        const int kind = L % 3;
        const int Nin = (kind == 0) ? 1024 : (kind == 1 ? 2568 : 2560);
        const int xq_off = (kind == 0) ? 768 : (kind == 1 ? 2312 : 2304);

        if (IN(P + LP_INPROJ)) {
            PHASE_IDS();
            REPS(2) { if (rep_) __syncthreads();
#if FAST_DENSE
            { const int Npad = (kind == 0) ? 1024 : (kind == 1 ? 2816 : 2560);
              pg8::Gemm g{hb, win_t + (size_t)L * 3 * MiB, D, nullptr}; pg8::StaticOrder S; S.init(T, Npad, G, bid); pg8::EpiBf16 E{proj, LDP, nullptr, 0, 1.0f}; pg8::gemm_phase(lds, g, S, E, wave); }
#else
            const float* w_in = (const float*)(L == 0 ? ARGP(5) : L == 1 ? ARGP(16) : L == 2 ? ARGP(22) : ARGP(24));
            oracle_gemm(ldsf, T, Nin, D,
                [&](int) { return 0; },
                [&](int m, int k) { return bf2f(hb[(size_t)m * D + k]); },
                [&](int k, int n, int) { return n < Nin ? w_in[(size_t)k * Nin + n] : 0.f; },
                [&](int m0, int n0, float (&acc)[4][8], int) {
#pragma unroll
                    for (int i = 0; i < 4; ++i)
#pragma unroll
                        for (int j = 0; j < 8; ++j) if (n0 + j < Nin) proj[(size_t)(m0 + i) * LDP + n0 + j] = f2bf(acc[i][j]);
                });
#endif
        } }
        SEAM(P + LP_INPROJ);

        if (IN(P + LP_MIXA)) {
            PHASE_IDS();
            REPS(kind == 0 ? 11 : 12) { if (rep_) __syncthreads();
            if (kind == 0) {
                const int o = (L == 0) ? 6 : 25;
                const float* a_re = (const float*)args.in[o + 0]; const float* a_im = (const float*)args.in[o + 1]; const float* log_dt = (const float*)args.in[o + 2];
                const float* b_re = (const float*)args.in[o + 3]; const float* b_im = (const float*)args.in[o + 4]; const float* c_re = (const float*)args.in[o + 5];
                const float* c_im = (const float*)args.in[o + 6]; const float* d_skip = (const float*)args.in[o + 7];
#if FAST_S5
                typedef pg8::bf16x8 bx8; typedef pg8::f32x4 fx4;
                LAS float* BU = (LAS float*)(lds + wave * 32768);
                LAS bf16* XS = (LAS bf16*)(lds + wave * 32768 + 16896);
                for (int unit = wave * G + vcu; wave < 4 && unit < NB * 48; unit += G * 4) {
                    const int b = unit / 48, g = unit % 48, p = lane, tok = lane & 15, sg = lane >> 4;
                    const float lre = fminf(a_re[g * 64 + p], -1e-4f), lim = a_im[g * 64 + p];
                    const float dt = __expf(log_dt[g]);
                    const float mag = __expf(dt * lre); float sn, cs; sincos_rad(dt * lim, sn, cs);
                    const float abr = mag * cs, abi = mag * sn;
                    const float den = lre * lre + lim * lim, nr = abr - 1.0f;
                    const float cr = (nr * lre + abi * lim) / den, ci = (abi * lre - nr * lim) / den;
                    bx8 Bf[8], Cf[4];
#pragma unroll
                    for (int tI = 0; tI < 4; ++tI) {
                        const int sp = 16 * tI + tok; const float crs = sh_idx(cr, sp, lane), cis = sh_idx(ci, sp, lane);
                        unsigned wr_[4] = {0u, 0u, 0u, 0u}, wi_[4] = {0u, 0u, 0u, 0u};
                        if (sg < 2) { const float4* pr_ = (const float4*)(b_re + (size_t)(g * 64 + sp) * 16 + 8 * sg); const float4* pi_ = (const float4*)(b_im + (size_t)(g * 64 + sp) * 16 + 8 * sg);
                            const float4 r0 = pr_[0], r1 = pr_[1], i0 = pi_[0], i1 = pi_[1];
                            const float br[8] = {r0.x, r0.y, r0.z, r0.w, r1.x, r1.y, r1.z, r1.w}, bi[8] = {i0.x, i0.y, i0.z, i0.w, i1.x, i1.y, i1.z, i1.w};
#pragma unroll
                            for (int q = 0; q < 4; ++q) { wr_[q] = pk2(crs * br[2 * q] - cis * bi[2 * q], crs * br[2 * q + 1] - cis * bi[2 * q + 1]); wi_[q] = pk2(crs * bi[2 * q] + cis * br[2 * q], crs * bi[2 * q + 1] + cis * br[2 * q + 1]); } }
                        uint4 a4; a4.x = wr_[0]; a4.y = wr_[1]; a4.z = wr_[2]; a4.w = wr_[3]; Bf[tI] = __builtin_bit_cast(bx8, a4);
                        uint4 b4; b4.x = wi_[0]; b4.y = wi_[1]; b4.z = wi_[2]; b4.w = wi_[3]; Bf[4 + tI] = __builtin_bit_cast(bx8, b4);
                    }
#pragma unroll
                    for (int j = 0; j < 4; ++j) {
                        const float4 c4 = *(const float4*)(c_re + (size_t)(g * 16 + tok) * 64 + 16 * j + 4 * sg), d4 = *(const float4*)(c_im + (size_t)(g * 16 + tok) * 64 + 16 * j + 4 * sg);
                        uint4 a4; a4.x = pk2(c4.x, -d4.x); a4.y = pk2(c4.y, -d4.y); a4.z = pk2(c4.z, -d4.z); a4.w = pk2(c4.w, -d4.w); Cf[j] = __builtin_bit_cast(bx8, a4);
                    }
                    const float4 dsk4 = *(const float4*)(d_skip + g * 16 + 4 * sg);
                    float sxr = 0.f, sxi = 0.f;
                    const bf16* ubase = proj + (size_t)b * SEQ * LDP + g * 16;
                    uint4 unx[4]; uint2 uex[4];
#pragma unroll
                    for (int q = 0; q < 4; ++q) { unx[q] = make_uint4(0u, 0u, 0u, 0u); if (sg < 2) unx[q] = *(const uint4*)(ubase + (size_t)(16 * q + tok) * LDP + 8 * sg); uex[q] = *(const uint2*)(ubase + (size_t)(16 * q + tok) * LDP + 4 * sg); }
                    fx4 dnx[8];
                    { const bx8 uf0 = __builtin_bit_cast(bx8, unx[0]);
#pragma unroll
                      for (int tI = 0; tI < 8; ++tI) { const fx4 d = __builtin_amdgcn_mfma_f32_16x16x32_bf16(Bf[tI], uf0, (fx4){0.f, 0.f, 0.f, 0.f}, 0, 0, 0); *(LAS fx4*)(BU + tok * 132 + 16 * tI + 4 * sg) = d; } }
                    uint2 ue_prev = make_uint2(0u, 0u);
                    for (int t64 = 0; t64 < SEQ; t64 += 64) {
                        uint4 ucu[4]; uint2 uec[4];
#pragma unroll
                        for (int q = 0; q < 4; ++q) { ucu[q] = unx[q]; uec[q] = uex[q]; }
                        if (t64 + 64 < SEQ) {
#pragma unroll
                            for (int q = 0; q < 4; ++q) { if (sg < 2) unx[q] = *(const uint4*)(ubase + (size_t)(t64 + 64 + 16 * q + tok) * LDP + 8 * sg); uex[q] = *(const uint2*)(ubase + (size_t)(t64 + 64 + 16 * q + tok) * LDP + 4 * sg); } }
#pragma unroll
                        for (int q = 0; q < 4; ++q) {
                            const int t0 = t64 + 16 * q, cb = q & 1, nb = cb ^ 1;
                            LAS float* BUc = BU + cb * (16 * 132); LAS float* BUn = BU + nb * (16 * 132);
                            LAS bf16* XSc = XS + cb * (16 * 136); LAS bf16* XSp = XS + nb * (16 * 136);
                            float bre[16], bim[16];
#pragma unroll
                            for (int t = 0; t < 16; ++t) { bre[t] = BUc[t * 132 + p]; bim[t] = BUc[t * 132 + 64 + p]; }
                            const bool has_next = (t0 + 16 < SEQ);
                            { const bx8 ufn = __builtin_bit_cast(bx8, (q < 3) ? ucu[(q + 1) & 3] : unx[0]);
#pragma unroll
                              for (int tI = 0; tI < 8; ++tI) dnx[tI] = __builtin_amdgcn_mfma_f32_16x16x32_bf16(Bf[tI], ufn, (fx4){0.f, 0.f, 0.f, 0.f}, 0, 0, 0); }
                            fx4 y = (fx4){0.f, 0.f, 0.f, 0.f};
                            if (t0 > 0) {
#pragma unroll
                                for (int j = 0; j < 4; ++j) { const bx8 xf = *(const LAS bx8*)(XSp + tok * 136 + 32 * j + 8 * sg); y = __builtin_amdgcn_mfma_f32_16x16x32_bf16(Cf[j], xf, y, 0, 0, 0); } }
#pragma unroll
                            for (int t = 0; t < 16; ++t) { const float nxr = abr * sxr - abi * sxi + bre[t], nxi = abr * sxi + abi * sxr + bim[t]; sxr = nxr; sxi = nxi;
                                *(LAS unsigned*)(XSc + t * 136 + 2 * p) = pg8::cvt_pk_bf16(sxr, sxi); }
                            if (has_next) {
#pragma unroll
                                for (int tI = 0; tI < 8; ++tI) *(LAS fx4*)(BUn + tok * 132 + 16 * tI + 4 * sg) = dnx[tI]; }
                            if (t0 > 0) {
                                const float u0 = __uint_as_float(ue_prev.x << 16), u1 = __uint_as_float(ue_prev.x & 0xffff0000u), u2 = __uint_as_float(ue_prev.y << 16), u3 = __uint_as_float(ue_prev.y & 0xffff0000u);
                                uint2 o; o.x = pg8::cvt_pk_bf16(gelu_tanh(y[0] + dsk4.x * u0), gelu_tanh(y[1] + dsk4.y * u1)); o.y = pg8::cvt_pk_bf16(gelu_tanh(y[2] + dsk4.z * u2), gelu_tanh(y[3] + dsk4.w * u3));
                                *(uint2*)(yg + (size_t)(b * SEQ + t0 - 16 + tok) * MIXW + g * 16 + 4 * sg) = o; }
                            ue_prev = uec[q];
                        }
                    }
                    {
                        LAS bf16* XSp = XS + 1 * (16 * 136);
                        fx4 y = (fx4){0.f, 0.f, 0.f, 0.f};
#pragma unroll
                        for (int j = 0; j < 4; ++j) { const bx8 xf = *(const LAS bx8*)(XSp + tok * 136 + 32 * j + 8 * sg); y = __builtin_amdgcn_mfma_f32_16x16x32_bf16(Cf[j], xf, y, 0, 0, 0); }
                        const float u0 = __uint_as_float(ue_prev.x << 16), u1 = __uint_as_float(ue_prev.x & 0xffff0000u), u2 = __uint_as_float(ue_prev.y << 16), u3 = __uint_as_float(ue_prev.y & 0xffff0000u);
                        uint2 o; o.x = pg8::cvt_pk_bf16(gelu_tanh(y[0] + dsk4.x * u0), gelu_tanh(y[1] + dsk4.y * u1)); o.y = pg8::cvt_pk_bf16(gelu_tanh(y[2] + dsk4.z * u2), gelu_tanh(y[3] + dsk4.w * u3));
                        *(uint2*)(yg + (size_t)(b * SEQ + SEQ - 16 + tok) * MIXW + g * 16 + 4 * sg) = o;
                    }
                }
#else
                for (int unit = bid * NWAVES + wave; unit < NB * 48; unit += G * NWAVES) {
                    const int b = unit / 48, g = unit % 48, p = lane;
                    const float lre = fminf(a_re[g * 64 + p], -1e-4f), lim = a_im[g * 64 + p];
                    const float dt = __expf(log_dt[g]);
                    const float mag = __expf(dt * lre); float sn, cs; sincos_rad(dt * lim, sn, cs);
                    const float abr = mag * cs, abi = mag * sn;
                    const float den = lre * lre + lim * lim, nr = abr - 1.0f;
                    const float cr = (nr * lre + abi * lim) / den, ci = (abi * lre - nr * lim) / den;
                    float Br[16], Bi[16], Cr[16], Ci[16];
#pragma unroll
                    for (int h = 0; h < 16; ++h) { const float br = b_re[(size_t)(g * 64 + p) * 16 + h], bi = b_im[(size_t)(g * 64 + p) * 16 + h];
                        Br[h] = cr * br - ci * bi; Bi[h] = cr * bi + ci * br; Cr[h] = c_re[(size_t)(g * 16 + h) * 64 + p]; Ci[h] = c_im[(size_t)(g * 16 + h) * 64 + p]; }
                    const float dsk = d_skip[g * 16 + (lane & 15)];
                    float sxr = 0.f, sxi = 0.f;
                    for (int t = 0; t < SEQ; ++t) {
                        const bf16* up = proj + (size_t)(b * SEQ + t) * LDP + g * 16;
                        float u[16]; unpack8(*(const uint4*)up, u); unpack8(*(const uint4*)(up + 8), u + 8);
                        float bur = 0.f, bui = 0.f;
#pragma unroll
                        for (int h = 0; h < 16; ++h) { bur += Br[h] * u[h]; bui += Bi[h] * u[h]; }
                        const float nxr = abr * sxr - abi * sxi + bur, nxi = abr * sxi + abi * sxr + bui; sxr = nxr; sxi = nxi;
                        float myy = 0.f;
#pragma unroll
                        for (int h = 0; h < 16; ++h) { float v = Cr[h] * sxr - Ci[h] * sxi; v = wave_sum(v, lane); myy = (lane == h) ? v : myy; }
                        if (lane < 16) { const float uu = bf2f(up[lane]); const float y = gelu_tanh(myy + dsk * uu); yg[(size_t)(b * SEQ + t) * MIXW + g * 16 + lane] = f2bf(y); }
                    }
                }
#endif
            } else {
#if FAST_LINATT && LINATT_V2
                {
                    typedef pg8::bf16x8 bx8; typedef pg8::f32x4 fx4; typedef pg8::u32x4 ux4; typedef pg8::u32x2 ux2;
                    typedef _Float16 h2_t __attribute__((ext_vector_type(2)));
                    LAS bf16* Qs = (LAS bf16*)lds;
                    LAS bf16* Ks = (LAS bf16*)(lds + 13312);
                    LAS bf16* KTe = (LAS bf16*)(lds + 26624);
                    LAS bf16* VT = (LAS bf16*)(lds + 40448);
                    LAS bf16* Ps = (LAS bf16*)(lds + 68096);
                    LAS bf16* CT = (LAS bf16*)(lds + 77312);
                    LAS float* fa = (LAS float*)(lds + 117248);
                    LAS float* aArr = fa, *MArr = fa + 64, *interArr = fa + 128, *clampArr = fa + 192, *eArr = fa + 256, *denArr = fa + 320, *nArr = fa + 384  , *stat = fa + 480  ;
                    const float* conv_q = (const float*)ARGP(17); const float* conv_k = (const float*)ARGP(18);
                    const float* b_i = (const float*)ARGP(19); const float* b_f = (const float*)ARGP(20);
                    const float* norm_g = (const float*)(kind == 1 ? ARGP(21) : ARGP(23));
                    constexpr int CHB = 62208;
                    unsigned char* const LB = (unsigned char*)(ws + WS_ACT);
#define LINATT_PIECE_LDS(p) ((p) < 768 ? (((p) / 12) * 104 + ((p) % 12) * 8) * 2 : (p) < 1536 ? 13312 + ((((p) - 768) / 12) * 104 + (((p) - 768) % 12) * 8) * 2 : \
                             (p) < 2304 ? 26624 + ((((p) - 1536) >> 3) * 72 + (((p) - 1536) & 7) * 8) * 2 : 40448 + ((((p) - 2304) >> 3) * 72 + (((p) - 2304) & 7) * 8) * 2)
                    for (int unit = bid; unit < NB * 4 * 8; unit += G) {
                        const int b = unit >> 5, h = (unit >> 3) & 3, c0 = (unit & 7) * 4;
                        const float lgam = __logf(1.0f - exp2f(-5.0f - (float)h));
                        ux4 rv[3], rg[8]; float rig = 0.f, rfg = 0.f;
#pragma unroll
                        for (int q = 0; q < 8; ++q) rg[q] = (ux4){0u, 0u, 0u, 0u};
#define LINATT_LOAD_RAW(cc) do { const size_t r0_ = (size_t)b * SEQ + (size_t)(cc) * 64; \
                            _Pragma("unroll") for (int kq = 0; kq < 3; ++kq) { const int idx = tidv + NTHR * kq, cg = idx >> 6, s = idx & 63; rv[kq] = *(const ux4*)(proj + (r0_ + s) * LDP + 768 + h * 192 + 8 * cg); } \
                            if (kind == 1) { _Pragma("unroll") for (int kq = 0; kq < 3; ++kq) { const int idx = tidv + NTHR * kq, which = idx / 768, rem = idx % 768, cg = rem >> 6, s = rem & 63; \
                                    rg[kq] = *(const ux4*)(proj + (r0_ + s) * LDP + which * 384 + h * 96 + 8 * cg); } \
                                if (wave == 0) { const bf16* pr = proj + (r0_ + lanev) * LDP; rig = bf2f(pr[2304 + h]); rfg = bf2f(pr[2308 + h]); } } \
                            else { _Pragma("unroll") for (int kq = 0; kq < 2; ++kq) { const int idx = tidv + NTHR * kq; if (idx < 768) { const int which = idx / 384, rem = idx % 384, cg = rem >> 6, s = rem & 63; \
                                    const bf16* xp = proj + (r0_ + s) * LDP + which * 384 + h * 96 + 8 * cg; rg[kq] = *(const ux4*)xp; rg[2 + kq] = *(const ux4*)(xp + 48); \
                                    const ux4* rp = (const ux4*)((const unsigned*)rope + (r0_ + s) * 48 + 8 * cg); rg[4 + 2 * kq] = rp[0]; rg[5 + 2 * kq] = rp[1]; } } } } while (0)
                        { int tidv = tid; asm volatile("" : "+v"(tidv)); const int lanev = tidv & 63; (void)lanev;
                          if (kind == 1 && c0 > 0) {
                              const size_t rp_ = (size_t)b * SEQ + (size_t)(c0 - 1) * 64;
#pragma unroll
                              for (int kq = 0; kq < 3; ++kq) { const int idx = tidv + NTHR * kq, which = idx / 768, rem = idx % 768, cg = rem >> 6, s = rem & 63; rg[3 + kq] = *(const ux4*)(proj + (rp_ + s) * LDP + which * 384 + h * 96 + 8 * cg); } }
                          LINATT_LOAD_RAW(c0); }
                        for (int cc = 0; cc < 4; ++cc) {
                            const int c = c0 + cc;
                            int tidv = tid; asm volatile("" : "+v"(tidv));
                            const int lanev = tidv & 63;
                            unsigned char* const img = LB + (size_t)((b * 4 + h) * 32 + c) * CHB;
                            if (wave == 0) {
                                float lf, ig;
                                if (kind == 1) { ig = rig + b_i[h]; const float fg = rfg + b_f[h]; lf = fminf(fg, 0.f) - __logf(1.0f + __expf(-fabsf(fg))); }
                                else { ig = 0.f; lf = lgam; }
                                float bc = lf;
#pragma unroll
                                for (int o = 1; o < 64; o <<= 1) { const float t = sh_up(bc, o, lanev); if (lanev >= o) bc += t; }
                                const float a = ig - bc; float A = a;
#pragma unroll
                                for (int o = 1; o < 64; o <<= 1) { const float t = sh_up(A, o, lanev); if (lanev >= o) A = fmaxf(A, t); }
                                float* gp = (float*)(img + 61440); gp[lanev] = a; gp[64 + lanev] = A; gp[128 + lanev] = bc;
                            }
#pragma unroll
                            for (int kq = 0; kq < 3; ++kq) {
                                const int idx = tidv + NTHR * kq, cg = idx >> 6, s = idx & 63; const ux4 v = rv[kq];
                                LAS bf16* d = VT + (8 * cg) * 72 + s;
                                d[0] = (bf16)(v.x & 0xffffu); d[72] = (bf16)(v.x >> 16); d[144] = (bf16)(v.y & 0xffffu); d[216] = (bf16)(v.y >> 16);
                                d[288] = (bf16)(v.z & 0xffffu); d[360] = (bf16)(v.z >> 16); d[432] = (bf16)(v.w & 0xffffu); d[504] = (bf16)(v.w >> 16);
                            }
                            if (kind == 1) {
#pragma unroll
                                for (int kq = 0; kq < 3; ++kq) {
                                    const int idx = tidv + NTHR * kq, which = idx / 768, rem = idx % 768, cg = rem >> 6, s = rem & 63;
                                    const int ch = h * 96 + 8 * cg;
                                    const float* cw = (which ? conv_k : conv_q) + ch;
                                    float r[8];
                                    { float x[8]; uint4 xu; xu.x = rg[kq].x; xu.y = rg[kq].y; xu.z = rg[kq].z; xu.w = rg[kq].w; unpack8(xu, x);
                                      const float4 w0 = *(const float4*)(cw + 3 * 384), w1 = *(const float4*)(cw + 3 * 384 + 4);
                                      r[0] = w0.x * x[0]; r[1] = w0.y * x[1]; r[2] = w0.z * x[2]; r[3] = w0.w * x[3]; r[4] = w1.x * x[4]; r[5] = w1.y * x[5]; r[6] = w1.z * x[6]; r[7] = w1.w * x[7]; }
#pragma unroll
                                    for (int dl = 1; dl <= 3; ++dl) {
                                        const int sl = (lanev - dl) & 63; uint4 xu;
                                        { const unsigned c0 = sh_idx(rg[kq].x, sl, lanev), p0 = sh_idx(rg[3 + kq].x, sl, lanev); xu.x = (lanev >= dl) ? c0 : p0; }
                                        { const unsigned c0 = sh_idx(rg[kq].y, sl, lanev), p0 = sh_idx(rg[3 + kq].y, sl, lanev); xu.y = (lanev >= dl) ? c0 : p0; }
                                        { const unsigned c0 = sh_idx(rg[kq].z, sl, lanev), p0 = sh_idx(rg[3 + kq].z, sl, lanev); xu.z = (lanev >= dl) ? c0 : p0; }
                                        { const unsigned c0 = sh_idx(rg[kq].w, sl, lanev), p0 = sh_idx(rg[3 + kq].w, sl, lanev); xu.w = (lanev >= dl) ? c0 : p0; }
                                        float x[8]; unpack8(xu, x);
                                        const float4 w0 = *(const float4*)(cw + (3 - dl) * 384), w1 = *(const float4*)(cw + (3 - dl) * 384 + 4);
                                        r[0] += w0.x * x[0]; r[1] += w0.y * x[1]; r[2] += w0.z * x[2]; r[3] += w0.w * x[3]; r[4] += w1.x * x[4]; r[5] += w1.y * x[5]; r[6] += w1.z * x[6]; r[7] += w1.w * x[7];
                                    }
                                    rg[3 + kq] = rg[kq];
                                    const float sc = which ? 1.0f : 0.10206207261596575f;
#pragma unroll
                                    for (int i = 0; i < 8; ++i) r[i] = r[i] * sigmoidf(r[i]) * sc;
                                    ux4 pk; pk.x = pg8::cvt_pk_bf16(r[0], r[1]); pk.y = pg8::cvt_pk_bf16(r[2], r[3]); pk.z = pg8::cvt_pk_bf16(r[4], r[5]); pk.w = pg8::cvt_pk_bf16(r[6], r[7]);
                                    if (which == 0) *(LAS ux4*)(Qs + s * 104 + 8 * cg) = pk;
                                    else { *(LAS ux4*)(Ks + s * 104 + 8 * cg) = pk; const float es = 1.0f; LAS bf16* d = KTe + (8 * cg) * 72 + s;
#pragma unroll
                                        for (int i = 0; i < 8; ++i) d[72 * i] = f2bf(r[i] * es); }
                                }
                            } else {
#pragma unroll
                                for (int kq = 0; kq < 2; ++kq) {
                                    const int idx = tidv + NTHR * kq;
                                    if (idx < 768) {
                                        const int which = idx / 384, rem = idx % 384, cg = rem >> 6, s = rem & 63;
                                        float x1[8], x2[8]; { uint4 xu; xu.x = rg[kq].x; xu.y = rg[kq].y; xu.z = rg[kq].z; xu.w = rg[kq].w; unpack8(xu, x1); xu.x = rg[2 + kq].x; xu.y = rg[2 + kq].y; xu.z = rg[2 + kq].z; xu.w = rg[2 + kq].w; unpack8(xu, x2); }
                                        const unsigned rpw[8] = {rg[4 + 2 * kq].x, rg[4 + 2 * kq].y, rg[4 + 2 * kq].z, rg[4 + 2 * kq].w, rg[5 + 2 * kq].x, rg[5 + 2 * kq].y, rg[5 + 2 * kq].z, rg[5 + 2 * kq].w};
                                        float o1[8], o2[8]; const float sc = which ? 0.10206207261596575f : 1.0f;
#pragma unroll
                                        for (int q8 = 0; q8 < 8; ++q8) { const h2_t cs_ = __builtin_bit_cast(h2_t, rpw[q8]); const float c0 = (float)cs_.x, s0 = (float)cs_.y;
                                            o1[q8] = (x1[q8] * c0 - x2[q8] * s0) * sc; o2[q8] = (x2[q8] * c0 + x1[q8] * s0) * sc; }
                                        ux4 p1; p1.x = pg8::cvt_pk_bf16(o1[0], o1[1]); p1.y = pg8::cvt_pk_bf16(o1[2], o1[3]); p1.z = pg8::cvt_pk_bf16(o1[4], o1[5]); p1.w = pg8::cvt_pk_bf16(o1[6], o1[7]);
                                        ux4 p2; p2.x = pg8::cvt_pk_bf16(o2[0], o2[1]); p2.y = pg8::cvt_pk_bf16(o2[2], o2[3]); p2.z = pg8::cvt_pk_bf16(o2[4], o2[5]); p2.w = pg8::cvt_pk_bf16(o2[6], o2[7]);
                                        LAS bf16* dst = which ? Ks : Qs;
                                        *(LAS ux4*)(dst + s * 104 + 8 * cg) = p1; *(LAS ux4*)(dst + s * 104 + 48 + 8 * cg) = p2;
                                        if (which) { const float es = 1.0f; LAS bf16* d = KTe + (8 * cg) * 72 + s;
#pragma unroll
                                            for (int i = 0; i < 8; ++i) { d[72 * i] = f2bf(o1[i] * es); d[72 * (48 + i)] = f2bf(o2[i] * es); } }
                                    }
                                }
                            }
                            if (cc + 1 < 4) LINATT_LOAD_RAW(c + 1);
                            LDS_BARRIER();
#pragma unroll
                            for (int k = 0; k < 8; ++k) { const int p = tidv + NTHR * k; if (p < 3840) *(ux4*)(img + (size_t)p * 16) = *(const LAS ux4*)(lds + LINATT_PIECE_LDS(p)); }
                            LDS_BARRIER();
                        }
                    }
#undef LINATT_LOAD_RAW
                    xcd_barrier(bar, wave0);
                    const int tok = lane & 15, sg = lane >> 4; (void)tok; (void)sg;
                    for (int unit = bid; unit < NB * 4 * 4; unit += G) {
                        const int b = unit >> 4, h = (unit >> 2) & 3, jt = unit & 3;
                        fx4 Cst[3][3];
#pragma unroll
                        for (int x = 0; x < 3; ++x)
#pragma unroll
                            for (int y = 0; y < 3; ++y) Cst[x][y] = (fx4){0.f, 0.f, 0.f, 0.f};
                        float nreg = 0.f, m_prev = 0.f;
                        __syncthreads();
                        for (int i = tid; i < 192 * 104 / 2; i += NTHR) ((LAS unsigned*)CT)[i] = 0u;
                        if (tid < 96) nArr[tid] = 0.f;
                        const int ctU = 3 * (wave & 3), itU = 3 * (wave >> 2);
                        ux4 rgp[8]; float g_a = 0.f, g_A = 0.f, g_b = 0.f, g_A63 = 0.f, g_b63 = 0.f;
#define LINATT_LOAD_IMG(cc) do { const unsigned char* im_ = LB + (size_t)((b * 4 + h) * 32 + (cc)) * CHB; \
                            _Pragma("unroll") for (int k = 0; k < 8; ++k) { const int p = tidv + NTHR * k; rgp[k] = *(const ux4*)(im_ + (size_t)(p < 3840 ? p : 3839) * 16); } \
                            const float* gp_ = (const float*)(im_ + 61440); if (tidv < 64) { g_a = gp_[tidv]; g_A = gp_[64 + tidv]; g_b = gp_[128 + tidv]; } g_A63 = gp_[64 + 63]; g_b63 = gp_[128 + 63]; } while (0)
                        { int tidv = tid; asm volatile("" : "+v"(tidv)); LINATT_LOAD_IMG(0); }
                        for (int c = 0; c < SEQ / 64; ++c) {
                            const size_t row0 = (size_t)b * SEQ + c * 64;
                            int tidv = tid; asm volatile("" : "+v"(tidv));
                            const int lanev = tidv & 63, tokv = lanev & 15, sgv = lanev >> 4;
#pragma unroll
                            for (int k = 0; k < 8; ++k) { const int p = tidv + NTHR * k; if (p < 3840) *(LAS ux4*)(lds + LINATT_PIECE_LDS(p)) = rgp[k]; }
                            const float M63 = (kind == 1) ? fmaxf(m_prev, g_A63) : -g_b63;
                            const float sa_c = __expf(m_prev - M63);
                            if (tidv < 64) { const float M = (kind == 1) ? fmaxf(m_prev, g_A) : -g_b;
                                aArr[tidv] = g_a; MArr[tidv] = M; interArr[tidv] = __expf(m_prev - M); clampArr[tidv] = __expf(-(g_b + M)); eArr[tidv] = __expf(g_a - M63); }
                            if (kind == 1) m_prev = g_b63 + M63;
                            if (c + 1 < SEQ / 64) LINATT_LOAD_IMG(c + 1);
                            LDS_BARRIER(); __builtin_amdgcn_sched_barrier(0);
                            if (wave < 4) {
                                const int st = wave, j = 16 * jt + tokv; fx4 d = (fx4){0.f, 0.f, 0.f, 0.f};
                                if (st <= jt) {
                                    const float Mj = MArr[j];
#pragma unroll
                                    for (int kk = 0; kk < 3; ++kk) { const bx8 yq = *(const LAS bx8*)(Qs + j * 104 + 32 * kk + 8 * sgv), xk = *(const LAS bx8*)(Ks + (16 * st + tokv) * 104 + 32 * kk + 8 * sgv); d = __builtin_amdgcn_mfma_f32_16x16x32_bf16(xk, yq, d, 0, 0, 0); }
#pragma unroll
                                    for (int r = 0; r < 4; ++r) { const int s = 16 * st + 4 * sgv + r; d[r] = (s <= j) ? d[r] * __expf(aArr[s] - Mj) : 0.f; }
                                }
                                ux2 pw; pw.x = pg8::cvt_pk_bf16(d[0], d[1]); pw.y = pg8::cvt_pk_bf16(d[2], d[3]);
                                *(LAS ux2*)(Ps + j * 72 + 16 * st + 4 * sgv) = pw;
                            }
                            LDS_BARRIER();
                            __builtin_amdgcn_sched_barrier(0);
                            if (kind == 1) {
                                const int j = 16 * jt + (tidv >> 5), part = tidv & 31; float dq = 0.f, dp = 0.f;
#pragma unroll
                                for (int i = 0; i < 3; ++i) dq += bf2f(Qs[j * 104 + part * 3 + i]) * nArr[part * 3 + i];
#pragma unroll
                                for (int s = 0; s < 2; ++s) dp += bf2f(Ps[j * 72 + part * 2 + s]);
                                float dn = interArr[j] * dq + dp; dn += sh_xor(dn, 1, lane); dn += sh_xor(dn, 2, lane); dn += sh_xor(dn, 4, lane); dn += sh_xor(dn, 8, lane); dn += sh_xor(dn, 16, lane);
                                if (part == 0) denArr[j] = dn;
                            }
                            __builtin_amdgcn_sched_barrier(0);
                            constexpr int NXT = 2;
                            const int nx = (wave < 4) ? 2 : 1;
                            fx4 acc[NXT];
                            const size_t orow = row0 + 16 * jt + tokv;
                            ux2 ogate[NXT];
#pragma unroll
                            for (int x = 0; x < NXT; ++x) { ogate[x] = (ux2){0u, 0u}; if (x < nx) ogate[x] = *(const ux2*)(proj + orow * LDP + 1536 + h * 192 + 16 * (wave + 8 * x) + 4 * sgv); }
                            {
                                bx8 yq[3];
#pragma unroll
                                for (int kk = 0; kk < 3; ++kk) yq[kk] = *(const LAS bx8*)(Qs + (16 * jt + tokv) * 104 + 32 * kk + 8 * sgv);
#pragma unroll
                                for (int x = 0; x < NXT; ++x) { acc[x] = (fx4){0.f, 0.f, 0.f, 0.f}; const int ct = wave + 8 * x;
                                    if (x < nx) {
#pragma unroll
                                    for (int kk = 0; kk < 3; ++kk) { const bx8 xc = *(const LAS bx8*)(CT + (16 * ct + tokv) * 104 + 32 * kk + 8 * sgv); acc[x] = __builtin_amdgcn_mfma_f32_16x16x32_bf16(xc, yq[kk], acc[x], 0, 0, 0); } } }
                                __builtin_amdgcn_sched_barrier(0);
                                const float in_j = interArr[16 * jt + tokv];
#pragma unroll
                                for (int x = 0; x < NXT; ++x) acc[x] = acc[x] * in_j;
                                bx8 yp[2];
#pragma unroll
                                for (int kk = 0; kk < 2; ++kk) yp[kk] = *(const LAS bx8*)(Ps + (16 * jt + tokv) * 72 + 32 * kk + 8 * sgv);
#pragma unroll
                                for (int x = 0; x < NXT; ++x) { const int ct = wave + 8 * x;
                                    if (x < nx) {
#pragma unroll
                                    for (int kk = 0; kk < 2; ++kk) { const bx8 xv = *(const LAS bx8*)(VT + (16 * ct + tokv) * 72 + 32 * kk + 8 * sgv); acc[x] = __builtin_amdgcn_mfma_f32_16x16x32_bf16(xv, yp[kk], acc[x], 0, 0, 0); } } }
                            }
                            __builtin_amdgcn_sched_barrier(0);
                            {
                                const float sa = sa_c;
                                bx8 yv[3][2];
#pragma unroll
                                for (int x = 0; x < 3; ++x)
#pragma unroll
                                    for (int kk = 0; kk < 2; ++kk) yv[x][kk] = *(const LAS bx8*)(VT + (16 * (ctU + x) + tokv) * 72 + 32 * kk + 8 * sgv);
                                float ev[2][8];
#pragma unroll
                                for (int kk = 0; kk < 2; ++kk) { const fx4 e0 = *(const LAS fx4*)(eArr + 32 * kk + 8 * sgv), e1 = *(const LAS fx4*)(eArr + 32 * kk + 8 * sgv + 4);
                                    ev[kk][0] = e0[0]; ev[kk][1] = e0[1]; ev[kk][2] = e0[2]; ev[kk][3] = e0[3]; ev[kk][4] = e1[0]; ev[kk][5] = e1[1]; ev[kk][6] = e1[2]; ev[kk][7] = e1[3]; }
#pragma unroll
                                for (int x = 0; x < 3; ++x) { bx8 xk[2];
#pragma unroll
                                    for (int kk = 0; kk < 2; ++kk) { const ux4 rawk = *(const LAS ux4*)(KTe + (16 * (itU + x) + tokv) * 72 + 32 * kk + 8 * sgv); ux4 sk;
                                        sk.x = pg8::cvt_pk_bf16(__uint_as_float(rawk.x << 16) * ev[kk][0], __uint_as_float(rawk.x & 0xffff0000u) * ev[kk][1]); sk.y = pg8::cvt_pk_bf16(__uint_as_float(rawk.y << 16) * ev[kk][2], __uint_as_float(rawk.y & 0xffff0000u) * ev[kk][3]);
                                        sk.z = pg8::cvt_pk_bf16(__uint_as_float(rawk.z << 16) * ev[kk][4], __uint_as_float(rawk.z & 0xffff0000u) * ev[kk][5]); sk.w = pg8::cvt_pk_bf16(__uint_as_float(rawk.w << 16) * ev[kk][6], __uint_as_float(rawk.w & 0xffff0000u) * ev[kk][7]);
                                        xk[kk] = __builtin_bit_cast(bx8, sk); }
#pragma unroll
                                    for (int y = 0; y < 3; ++y) { Cst[x][y] = Cst[x][y] * sa;
#pragma unroll
                                        for (int kk = 0; kk < 2; ++kk) Cst[x][y] = __builtin_amdgcn_mfma_f32_16x16x32_bf16(xk[kk], yv[y][kk], Cst[x][y], 0, 0, 0); } }
                                if (kind == 1 && tidv < 96) { float sn = 0.f;
#pragma unroll 8
                                    for (int s = 0; s < 64; ++s) sn += bf2f(KTe[tidv * 72 + s]) * eArr[s];
                                    nreg = sa * nreg + sn; }
                            }
                            __builtin_amdgcn_sched_barrier(0);
                            LDS_BARRIER();
                            {
                                const int j = 16 * jt + tokv;
                                if (kind == 1) { const float dv = 1.0f / fmaxf(fabsf(denArr[j]), clampArr[j]);
#pragma unroll
                                    for (int x = 0; x < NXT; ++x) acc[x] = acc[x] * dv; }
                                float s1 = 0.f, s2 = 0.f;
#pragma unroll
                                for (int x = 0; x < NXT; ++x)
#pragma unroll
                                    for (int r = 0; r < 4; ++r) { s1 += acc[x][r]; s2 += acc[x][r] * acc[x][r]; }
                                s1 += sh_xor(s1, 16, lane); s1 += sh_xor(s1, 32, lane); s2 += sh_xor(s2, 16, lane); s2 += sh_xor(s2, 32, lane);
                                if (sgv == 0) { stat[(tokv * 8 + wave) * 2 + 0] = s1; stat[(tokv * 8 + wave) * 2 + 1] = s2; }
                            }
                            LDS_BARRIER();
                            {
                                const int j = 16 * jt + tokv;
                                float t1 = 0.f, t2 = 0.f;
#pragma unroll
                                for (int w8 = 0; w8 < 8; ++w8) { t1 += stat[(tokv * 8 + w8) * 2 + 0]; t2 += stat[(tokv * 8 + w8) * 2 + 1]; }
                                const float mean = t1 * (1.0f / 192.0f);
                                const float var = t2 * (1.0f / 192.0f) - mean * mean; (void)j;
                                const float rstd = 1.0f / sqrtf(fmaxf(var, 0.f) + LN_EPS);
#pragma unroll
                                for (int x = 0; x < NXT; ++x) if (x < nx) { const int colh = 16 * (wave + 8 * x) + 4 * sgv; const float4 g4 = *(const float4*)(norm_g + h * 192 + colh);
                                    const float o0 = __uint_as_float(ogate[x].x << 16), o1 = __uint_as_float(ogate[x].x & 0xffff0000u), o2 = __uint_as_float(ogate[x].y << 16), o3 = __uint_as_float(ogate[x].y & 0xffff0000u);
                                    float g0, g1, g2, g3;
                                    if (kind == 1) { g0 = sigmoidf(o0); g1 = sigmoidf(o1); g2 = sigmoidf(o2); g3 = sigmoidf(o3); } else { g0 = o0 * sigmoidf(o0); g1 = o1 * sigmoidf(o1); g2 = o2 * sigmoidf(o2); g3 = o3 * sigmoidf(o3); }
                                    ux2 ov; ov.x = pg8::cvt_pk_bf16((acc[x][0] - mean) * rstd * g4.x * g0, (acc[x][1] - mean) * rstd * g4.y * g1); ov.y = pg8::cvt_pk_bf16((acc[x][2] - mean) * rstd * g4.z * g2, (acc[x][3] - mean) * rstd * g4.w * g3);
                                    *(ux2*)(cat + orow * D + h * 192 + colh) = ov; }
#pragma unroll
                                for (int x = 0; x < 3; ++x)
#pragma unroll
                                    for (int y = 0; y < 3; ++y) { ux2 cw; cw.x = pg8::cvt_pk_bf16(Cst[x][y][0], Cst[x][y][1]); cw.y = pg8::cvt_pk_bf16(Cst[x][y][2], Cst[x][y][3]);
                                        *(LAS ux2*)(CT + (16 * (ctU + y) + tokv) * 104 + 16 * (itU + x) + 4 * sgv) = cw; }
                                if (kind == 1 && tidv < 96) nArr[tidv] = nreg;
                            }
                        }
                    }
                }
#elif FAST_LINATT
                {
                    typedef pg8::bf16x8 bx8; typedef pg8::f32x4 fx4; typedef pg8::u32x4 ux4; typedef pg8::u32x2 ux2;
                    LAS bf16* Qs = (LAS bf16*)lds;
                    LAS bf16* Ks = (LAS bf16*)(lds + 13312);
                    LAS bf16* KTe = (LAS bf16*)(lds + 26624);
                    LAS bf16* VT = (LAS bf16*)(lds + 40448);
                    LAS bf16* Ps = (LAS bf16*)(lds + 68096);
                    LAS bf16* CT = (LAS bf16*)(lds + 77312);
                    LAS float* fa = (LAS float*)(lds + 117248);
                    LAS float* aArr = fa, *MArr = fa + 64, *interArr = fa + 128, *clampArr = fa + 192, *eArr = fa + 256, *denArr = fa + 320, *nArr = fa + 384  , *stat = fa + 480  , *scal = fa + 736;
                    const float* conv_q = (const float*)ARGP(17); const float* conv_k = (const float*)ARGP(18);
                    const float* b_i = (const float*)ARGP(19); const float* b_f = (const float*)ARGP(20);
                    const float* norm_g = (const float*)(kind == 1 ? ARGP(21) : ARGP(23));
                    const int tok = lane & 15, sg = lane >> 4;
                    for (int unit = bid; unit < NB * 4; unit += G) {
                        const int b = unit >> 2, h = unit & 3;
                        const float lgam = __logf(1.0f - exp2f(-5.0f - (float)h));
                        fx4 Cst[3][3];
#pragma unroll
                        for (int x = 0; x < 3; ++x)
#pragma unroll
                            for (int y = 0; y < 3; ++y) Cst[x][y] = (fx4){0.f, 0.f, 0.f, 0.f};
                        float nreg = 0.f, m_prev = 0.f;
                        __syncthreads();
                        for (int i = tid; i < 192 * 104 / 2; i += NTHR) ((LAS unsigned*)CT)[i] = 0u;
                        if (tid < 96) nArr[tid] = 0.f;
                        const int ctU = 3 * (wave & 3), itU = 3 * (wave >> 2);
                        const int jt = wave & 3, half = wave >> 2;
                        typedef _Float16 h2_t __attribute__((ext_vector_type(2)));
                        ux4 rv[3], rg[8]; float rig = 0.f, rfg = 0.f;
#pragma unroll
                        for (int q = 0; q < 8; ++q) rg[q] = (ux4){0u, 0u, 0u, 0u};
#define LINATT_LOAD_RAW(cc) do { const size_t r0_ = (size_t)b * SEQ + (size_t)(cc) * 64; \
                            _Pragma("unroll") for (int kq = 0; kq < 3; ++kq) { const int idx = tidv + NTHR * kq, cg = idx >> 6, s = idx & 63; rv[kq] = *(const ux4*)(proj + (r0_ + s) * LDP + 768 + h * 192 + 8 * cg); } \
                            if (kind == 1) { _Pragma("unroll") for (int kq = 0; kq < 3; ++kq) { const int idx = tidv + NTHR * kq, which = idx / 768, rem = idx % 768, cg = rem >> 6, s = rem & 63; \
                                    rg[kq] = *(const ux4*)(proj + (r0_ + s) * LDP + which * 384 + h * 96 + 8 * cg); } \
                                if (wave == 0) { const bf16* pr = proj + (r0_ + lanev) * LDP; rig = bf2f(pr[2304 + h]); rfg = bf2f(pr[2308 + h]); } } \
                            else { _Pragma("unroll") for (int kq = 0; kq < 2; ++kq) { const int idx = tidv + NTHR * kq; if (idx < 768) { const int which = idx / 384, rem = idx % 384, cg = rem >> 6, s = rem & 63; \
                                    const bf16* xp = proj + (r0_ + s) * LDP + which * 384 + h * 96 + 8 * cg; rg[kq] = *(const ux4*)xp; rg[2 + kq] = *(const ux4*)(xp + 48); \
                                    const ux4* rp = (const ux4*)((const unsigned*)rope + (r0_ + s) * 48 + 8 * cg); rg[4 + 2 * kq] = rp[0]; rg[5 + 2 * kq] = rp[1]; } } } } while (0)
                        { int tidv = tid; asm volatile("" : "+v"(tidv)); const int lanev = tidv & 63; LINATT_LOAD_RAW(0); }
                        for (int c = 0; c < SEQ / 64; ++c) {
                            const size_t row0 = (size_t)b * SEQ + c * 64;
                            int tidv = tid; asm volatile("" : "+v"(tidv));
                            const int lanev = tidv & 63, tokv = lanev & 15, sgv = lanev >> 4;
                            if (wave == 0) {
                                float lf, ig;
                                if (kind == 1) { ig = rig + b_i[h]; const float fg = rfg + b_f[h]; lf = fminf(fg, 0.f) - __logf(1.0f + __expf(-fabsf(fg))); }
                                else { ig = 0.f; lf = lgam; }
                                float bc = lf;
#pragma unroll
                                for (int o = 1; o < 64; o <<= 1) { const float t = sh_up(bc, o, lanev); if (lanev >= o) bc += t; }
                                const float a = ig - bc; float M;
                                if (kind == 1) { float A = a;
#pragma unroll
                                    for (int o = 1; o < 64; o <<= 1) { const float t = sh_up(A, o, lanev); if (lanev >= o) A = fmaxf(A, t); }
                                    M = fmaxf(m_prev, A); }
                                else M = -bc;
                                const float M63 = sh_idx(M, 63, lane), btot = sh_idx(bc, 63, lane);
                                aArr[lanev] = a; MArr[lanev] = M; interArr[lanev] = __expf(m_prev - M); clampArr[lanev] = __expf(-(bc + M)); eArr[lanev] = __expf(a - M63);
                                if (lanev == 0) scal[0] = __expf(m_prev - M63);
                                if (kind == 1) m_prev = btot + M63;
                            }
                            LDS_BARRIER();
#pragma unroll
                            for (int kq = 0; kq < 3; ++kq) {
                                const int idx = tidv + NTHR * kq, cg = idx >> 6, s = idx & 63; const ux4 v = rv[kq];
                                LAS bf16* d = VT + (8 * cg) * 72 + s;
                                d[0] = (bf16)(v.x & 0xffffu); d[72] = (bf16)(v.x >> 16); d[144] = (bf16)(v.y & 0xffffu); d[216] = (bf16)(v.y >> 16);
                                d[288] = (bf16)(v.z & 0xffffu); d[360] = (bf16)(v.z >> 16); d[432] = (bf16)(v.w & 0xffffu); d[504] = (bf16)(v.w >> 16);
                            }
                            if (kind == 1) {
#pragma unroll
                                for (int kq = 0; kq < 3; ++kq) {
                                    const int idx = tidv + NTHR * kq, which = idx / 768, rem = idx % 768, cg = rem >> 6, s = rem & 63;
                                    const int ch = h * 96 + 8 * cg;
                                    const float* cw = (which ? conv_k : conv_q) + ch;
                                    float r[8];
                                    { float x[8]; uint4 xu; xu.x = rg[kq].x; xu.y = rg[kq].y; xu.z = rg[kq].z; xu.w = rg[kq].w; unpack8(xu, x);
                                      const float4 w0 = *(const float4*)(cw + 3 * 384), w1 = *(const float4*)(cw + 3 * 384 + 4);
                                      r[0] = w0.x * x[0]; r[1] = w0.y * x[1]; r[2] = w0.z * x[2]; r[3] = w0.w * x[3]; r[4] = w1.x * x[4]; r[5] = w1.y * x[5]; r[6] = w1.z * x[6]; r[7] = w1.w * x[7]; }
#pragma unroll
                                    for (int dl = 1; dl <= 3; ++dl) {
                                        const int sl = (lanev - dl) & 63; uint4 xu;
                                        { const unsigned c0 = sh_idx(rg[kq].x, sl, lanev), p0 = sh_idx(rg[3 + kq].x, sl, lanev); xu.x = (lanev >= dl) ? c0 : p0; }
                                        { const unsigned c0 = sh_idx(rg[kq].y, sl, lanev), p0 = sh_idx(rg[3 + kq].y, sl, lanev); xu.y = (lanev >= dl) ? c0 : p0; }
                                        { const unsigned c0 = sh_idx(rg[kq].z, sl, lanev), p0 = sh_idx(rg[3 + kq].z, sl, lanev); xu.z = (lanev >= dl) ? c0 : p0; }
                                        { const unsigned c0 = sh_idx(rg[kq].w, sl, lanev), p0 = sh_idx(rg[3 + kq].w, sl, lanev); xu.w = (lanev >= dl) ? c0 : p0; }
                                        float x[8]; unpack8(xu, x);
                                        const float4 w0 = *(const float4*)(cw + (3 - dl) * 384), w1 = *(const float4*)(cw + (3 - dl) * 384 + 4);
                                        r[0] += w0.x * x[0]; r[1] += w0.y * x[1]; r[2] += w0.z * x[2]; r[3] += w0.w * x[3]; r[4] += w1.x * x[4]; r[5] += w1.y * x[5]; r[6] += w1.z * x[6]; r[7] += w1.w * x[7];
                                    }
                                    rg[3 + kq] = rg[kq];
                                    const float sc = which ? 1.0f : 0.10206207261596575f;
#pragma unroll
                                    for (int i = 0; i < 8; ++i) r[i] = r[i] * sigmoidf(r[i]) * sc;
                                    ux4 pk; pk.x = pg8::cvt_pk_bf16(r[0], r[1]); pk.y = pg8::cvt_pk_bf16(r[2], r[3]); pk.z = pg8::cvt_pk_bf16(r[4], r[5]); pk.w = pg8::cvt_pk_bf16(r[6], r[7]);
                                    if (which == 0) *(LAS ux4*)(Qs + s * 104 + 8 * cg) = pk;
                                    else { *(LAS ux4*)(Ks + s * 104 + 8 * cg) = pk; const float es = eArr[s]; LAS bf16* d = KTe + (8 * cg) * 72 + s;
#pragma unroll
                                        for (int i = 0; i < 8; ++i) d[72 * i] = f2bf(r[i] * es); }
                                }
                            } else {
#pragma unroll
                                for (int kq = 0; kq < 2; ++kq) {
                                    const int idx = tidv + NTHR * kq;
                                    if (idx < 768) {
                                        const int which = idx / 384, rem = idx % 384, cg = rem >> 6, s = rem & 63;
                                        float x1[8], x2[8]; { uint4 xu; xu.x = rg[kq].x; xu.y = rg[kq].y; xu.z = rg[kq].z; xu.w = rg[kq].w; unpack8(xu, x1); xu.x = rg[2 + kq].x; xu.y = rg[2 + kq].y; xu.z = rg[2 + kq].z; xu.w = rg[2 + kq].w; unpack8(xu, x2); }
                                        const unsigned rpw[8] = {rg[4 + 2 * kq].x, rg[4 + 2 * kq].y, rg[4 + 2 * kq].z, rg[4 + 2 * kq].w, rg[5 + 2 * kq].x, rg[5 + 2 * kq].y, rg[5 + 2 * kq].z, rg[5 + 2 * kq].w};
                                        float o1[8], o2[8]; const float sc = which ? 0.10206207261596575f : 1.0f;
#pragma unroll
                                        for (int q8 = 0; q8 < 8; ++q8) { const h2_t cs_ = __builtin_bit_cast(h2_t, rpw[q8]); const float c0 = (float)cs_.x, s0 = (float)cs_.y;
                                            o1[q8] = (x1[q8] * c0 - x2[q8] * s0) * sc; o2[q8] = (x2[q8] * c0 + x1[q8] * s0) * sc; }
                                        ux4 p1; p1.x = pg8::cvt_pk_bf16(o1[0], o1[1]); p1.y = pg8::cvt_pk_bf16(o1[2], o1[3]); p1.z = pg8::cvt_pk_bf16(o1[4], o1[5]); p1.w = pg8::cvt_pk_bf16(o1[6], o1[7]);
                                        ux4 p2; p2.x = pg8::cvt_pk_bf16(o2[0], o2[1]); p2.y = pg8::cvt_pk_bf16(o2[2], o2[3]); p2.z = pg8::cvt_pk_bf16(o2[4], o2[5]); p2.w = pg8::cvt_pk_bf16(o2[6], o2[7]);
                                        LAS bf16* dst = which ? Ks : Qs;
                                        *(LAS ux4*)(dst + s * 104 + 8 * cg) = p1; *(LAS ux4*)(dst + s * 104 + 48 + 8 * cg) = p2;
                                        if (which) { const float es = eArr[s]; LAS bf16* d = KTe + (8 * cg) * 72 + s;
#pragma unroll
                                            for (int i = 0; i < 8; ++i) { d[72 * i] = f2bf(o1[i] * es); d[72 * (48 + i)] = f2bf(o2[i] * es); } }
                                    }
                                }
                            }
                            if (c + 1 < SEQ / 64) LINATT_LOAD_RAW(c + 1);
                            LDS_BARRIER(); __builtin_amdgcn_sched_barrier(0);
                            {
                                bx8 yq[3];
#pragma unroll
                                for (int kk = 0; kk < 3; ++kk) yq[kk] = *(const LAS bx8*)(Qs + (16 * jt + tokv) * 104 + 32 * kk + 8 * sgv);
                                const int j = 16 * jt + tokv; const float Mj = MArr[j];
#pragma unroll
                                for (int q2 = 0; q2 < 2; ++q2) {
                                    const int st = 2 * half + q2; fx4 d = (fx4){0.f, 0.f, 0.f, 0.f};
                                    if (st <= jt) {
#pragma unroll
                                        for (int kk = 0; kk < 3; ++kk) { const bx8 xk = *(const LAS bx8*)(Ks + (16 * st + tokv) * 104 + 32 * kk + 8 * sgv); d = __builtin_amdgcn_mfma_f32_16x16x32_bf16(xk, yq[kk], d, 0, 0, 0); }
#pragma unroll
                                        for (int r = 0; r < 4; ++r) { const int s = 16 * st + 4 * sgv + r; d[r] = (s <= j) ? d[r] * __expf(aArr[s] - Mj) : 0.f; }
                                    }
                                    ux2 pw; pw.x = pg8::cvt_pk_bf16(d[0], d[1]); pw.y = pg8::cvt_pk_bf16(d[2], d[3]);
                                    *(LAS ux2*)(Ps + j * 72 + 16 * st + 4 * sgv) = pw;
                                }
                            }
                            LDS_BARRIER();
                            __builtin_amdgcn_sched_barrier(0);
                            if (kind == 1) {
                                const int j = tidv >> 3, part = tidv & 7; float dq = 0.f, dp = 0.f;
#pragma unroll
                                for (int i = 0; i < 12; ++i) dq += bf2f(Qs[j * 104 + part * 12 + i]) * nArr[part * 12 + i];
#pragma unroll
                                for (int s = 0; s < 8; ++s) dp += bf2f(Ps[j * 72 + part * 8 + s]);
                                float dn = interArr[j] * dq + dp; dn += sh_xor(dn, 1, lane); dn += sh_xor(dn, 2, lane); dn += sh_xor(dn, 4, lane);
                                if (part == 0) denArr[j] = dn;
                            }
                            __builtin_amdgcn_sched_barrier(0);
                            fx4 acc[6];
                            const size_t orow = row0 + 16 * jt + tokv;
                            ux2 ogate[6];
#pragma unroll
                            for (int x = 0; x < 6; ++x) ogate[x] = *(const ux2*)(proj + orow * LDP + 1536 + h * 192 + 16 * (6 * half + x) + 4 * sgv);
                            {
                                bx8 yq[3];
#pragma unroll
                                for (int kk = 0; kk < 3; ++kk) yq[kk] = *(const LAS bx8*)(Qs + (16 * jt + tokv) * 104 + 32 * kk + 8 * sgv);
#pragma unroll
                                for (int x = 0; x < 6; ++x) { acc[x] = (fx4){0.f, 0.f, 0.f, 0.f}; const int ct = 6 * half + x;
#pragma unroll
                                    for (int kk = 0; kk < 3; ++kk) { const bx8 xc = *(const LAS bx8*)(CT + (16 * ct + tokv) * 104 + 32 * kk + 8 * sgv); acc[x] = __builtin_amdgcn_mfma_f32_16x16x32_bf16(xc, yq[kk], acc[x], 0, 0, 0); } }
                                __builtin_amdgcn_sched_barrier(0);
                                const float in_j = interArr[16 * jt + tokv];
#pragma unroll
                                for (int x = 0; x < 6; ++x) acc[x] = acc[x] * in_j;
                                bx8 yp[2];
#pragma unroll
                                for (int kk = 0; kk < 2; ++kk) yp[kk] = *(const LAS bx8*)(Ps + (16 * jt + tokv) * 72 + 32 * kk + 8 * sgv);
#pragma unroll
                                for (int x = 0; x < 6; ++x) { const int ct = 6 * half + x;
#pragma unroll
                                    for (int kk = 0; kk < 2; ++kk) { const bx8 xv = *(const LAS bx8*)(VT + (16 * ct + tokv) * 72 + 32 * kk + 8 * sgv); acc[x] = __builtin_amdgcn_mfma_f32_16x16x32_bf16(xv, yp[kk], acc[x], 0, 0, 0); } }
                            }
                            __builtin_amdgcn_sched_barrier(0);
                            {
                                const float sa = scal[0];
                                bx8 yv[3][2];
#pragma unroll
                                for (int x = 0; x < 3; ++x)
#pragma unroll
                                    for (int kk = 0; kk < 2; ++kk) yv[x][kk] = *(const LAS bx8*)(VT + (16 * (ctU + x) + tokv) * 72 + 32 * kk + 8 * sgv);
#pragma unroll
                                for (int x = 0; x < 3; ++x) { bx8 xk[2];
#pragma unroll
                                    for (int kk = 0; kk < 2; ++kk) xk[kk] = *(const LAS bx8*)(KTe + (16 * (itU + x) + tokv) * 72 + 32 * kk + 8 * sgv);
#pragma unroll
                                    for (int y = 0; y < 3; ++y) { Cst[x][y] = Cst[x][y] * sa;
#pragma unroll
                                        for (int kk = 0; kk < 2; ++kk) Cst[x][y] = __builtin_amdgcn_mfma_f32_16x16x32_bf16(xk[kk], yv[y][kk], Cst[x][y], 0, 0, 0); } }
                                if (kind == 1 && tidv < 96) { float sn = 0.f;
#pragma unroll 8
                                    for (int s = 0; s < 64; ++s) sn += bf2f(KTe[tidv * 72 + s]);
                                    nreg = sa * nreg + sn; }
                            }
                            __builtin_amdgcn_sched_barrier(0);
                            LDS_BARRIER();
                            {
                                const int j = 16 * jt + tokv;
                                if (kind == 1) { const float dv = 1.0f / fmaxf(fabsf(denArr[j]), clampArr[j]);
#pragma unroll
                                    for (int x = 0; x < 6; ++x) acc[x] = acc[x] * dv; }
                                float s1 = 0.f, s2 = 0.f;
#pragma unroll
                                for (int x = 0; x < 6; ++x)
#pragma unroll
                                    for (int r = 0; r < 4; ++r) { s1 += acc[x][r]; s2 += acc[x][r] * acc[x][r]; }
                                s1 += sh_xor(s1, 16, lane); s1 += sh_xor(s1, 32, lane); s2 += sh_xor(s2, 16, lane); s2 += sh_xor(s2, 32, lane);
                                if (sgv == 0) { stat[(j * 2 + half) * 2 + 0] = s1; stat[(j * 2 + half) * 2 + 1] = s2; }
                            }
                            LDS_BARRIER();
                            {
                                const int j = 16 * jt + tokv;
                                const float mean = (stat[j * 4 + 0] + stat[j * 4 + 2]) * (1.0f / 192.0f);
                                const float var = (stat[j * 4 + 1] + stat[j * 4 + 3]) * (1.0f / 192.0f) - mean * mean;
                                const float rstd = 1.0f / sqrtf(fmaxf(var, 0.f) + LN_EPS);
#pragma unroll
                                for (int x = 0; x < 6; ++x) { const int colh = 16 * (6 * half + x) + 4 * sgv; const float4 g4 = *(const float4*)(norm_g + h * 192 + colh);
                                    const float o0 = __uint_as_float(ogate[x].x << 16), o1 = __uint_as_float(ogate[x].x & 0xffff0000u), o2 = __uint_as_float(ogate[x].y << 16), o3 = __uint_as_float(ogate[x].y & 0xffff0000u);
                                    float g0, g1, g2, g3;
                                    if (kind == 1) { g0 = sigmoidf(o0); g1 = sigmoidf(o1); g2 = sigmoidf(o2); g3 = sigmoidf(o3); } else { g0 = o0 * sigmoidf(o0); g1 = o1 * sigmoidf(o1); g2 = o2 * sigmoidf(o2); g3 = o3 * sigmoidf(o3); }
                                    ux2 ov; ov.x = pg8::cvt_pk_bf16((acc[x][0] - mean) * rstd * g4.x * g0, (acc[x][1] - mean) * rstd * g4.y * g1); ov.y = pg8::cvt_pk_bf16((acc[x][2] - mean) * rstd * g4.z * g2, (acc[x][3] - mean) * rstd * g4.w * g3);
                                    *(ux2*)(cat + orow * D + h * 192 + colh) = ov; }
#pragma unroll
                                for (int x = 0; x < 3; ++x)
#pragma unroll
                                    for (int y = 0; y < 3; ++y) { ux2 cw; cw.x = pg8::cvt_pk_bf16(Cst[x][y][0], Cst[x][y][1]); cw.y = pg8::cvt_pk_bf16(Cst[x][y][2], Cst[x][y][3]);
                                        *(LAS ux2*)(CT + (16 * (ctU + y) + tokv) * 104 + 16 * (itU + x) + 4 * sgv) = cw; }
                                if (kind == 1 && tidv < 96) nArr[tidv] = nreg;
                            }
                        }
                    }
                }
#else
                LAS float* sq = ldsf; LAS float* sk = ldsf + 96; LAS float* sg = ldsf + 192; LAS float* sred = ldsf + 256;
                const float* conv_q = (const float*)ARGP(17); const float* conv_k = (const float*)ARGP(18);
                const float* b_i = (const float*)ARGP(19); const float* b_f = (const float*)ARGP(20);
                const float* norm_g = (const float*)(kind == 1 ? ARGP(21) : ARGP(23));
                for (int unit = bid; unit < NB * 4; unit += G) {
                    const int b = unit >> 2, h = unit & 3;
                    const float gamma = 1.0f - exp2f(-5.0f - (float)h);
                    float C[96];
#pragma unroll
                    for (int i = 0; i < 96; ++i) C[i] = 0.f;
                    for (int t = 0; t < SEQ; ++t) {
                        const size_t row = (size_t)b * SEQ + t; const bf16* pr = proj + row * LDP;
                        if (tid < 192) {
                            const int c = tid % 96; const bool isk = tid >= 96; const int ch = h * 96 + c; const int col = (isk ? 384 : 0) + ch;
                            float s;
                            if (kind == 1) {
                                const float* cw = isk ? conv_k : conv_q; s = 0.f;
#pragma unroll
                                for (int w = 0; w < 4; ++w) { const int tt = t - 3 + w; if (tt >= 0) s += cw[w * 384 + ch] * bf2f(proj[((size_t)b * SEQ + tt) * LDP + col]); }
                                s = s * sigmoidf(s); if (!isk) s *= 0.10206207261596575f;
                            } else {
                                const int i = c % 48; const bool first = c < 48; const int cb = (isk ? 384 : 0) + h * 96;
                                const float t1 = bf2f(pr[cb + i]), t2 = bf2f(pr[cb + 48 + i]);
                                typedef _Float16 h2_t __attribute__((ext_vector_type(2))); const h2_t cs_ = __builtin_bit_cast(h2_t, ((const unsigned*)rope)[row * 48 + i]); const float cs = (float)cs_.x, sn = (float)cs_.y;
                                s = first ? (t1 * cs - t2 * sn) : (t2 * cs + t1 * sn); if (isk) s *= 0.10206207261596575f;
                            }
                            (isk ? sk : sq)[c] = s;
                        }
                        if (tid == 192) {
                            if (kind == 1) { const float ig = bf2f(pr[2304 + h]) + b_i[h], fg = bf2f(pr[2308 + h]) + b_f[h]; sg[0] = sigmoidf(fg); sg[1] = __expf(ig); }
                            else { sg[0] = gamma; sg[1] = 1.0f; }
                        }
                        __syncthreads();
                        const float f = sg[0], ei = sg[1];
                        float num = 0.f;
                        if (tid < 193) {
                            const float v = tid < 192 ? bf2f(pr[768 + h * 192 + tid]) : 1.0f;
#pragma unroll
                            for (int i = 0; i < 96; ++i) { C[i] = f * C[i] + (ei * sk[i]) * v; num += sq[i] * C[i]; if ((i & 15) == 15) asm volatile("" ::: "memory"); }
                            if (tid == 192) sg[2] = num;
                        }
                        __syncthreads();
                        float hv = num;
                        if (kind == 1) hv = num / fmaxf(fabsf(sg[2]), 1.0f);
                        float s1 = (tid < 192) ? hv : 0.f; s1 = wave_sum(s1, lane); if (lane == 0) sred[wave] = s1;
                        __syncthreads();
                        const float mean = (sred[0] + sred[1] + sred[2]) * (1.0f / 192.0f);
                        float dv = (tid < 192) ? (hv - mean) : 0.f; float s2 = wave_sum(dv * dv, lane); if (lane == 0) sred[8 + wave] = s2;
                        __syncthreads();
                        const float var = (sred[8] + sred[9] + sred[10]) * (1.0f / 192.0f);
                        if (tid < 192) {
                            const float yn = dv * (1.0f / sqrtf(var + LN_EPS)) * norm_g[h * 192 + tid];
                            const float ov = bf2f(pr[1536 + h * 192 + tid]);
                            const float outv = (kind == 1) ? sigmoidf(ov) * yn : (ov * sigmoidf(ov)) * yn;
                            cat[row * D + h * 192 + tid] = f2bf(outv);
                        }
                    }
                }
#endif
            }
            }
#if BG_CONV && FAST_MOE
            {
                const bool bg_here = (BG_ALL && LINATT_V2) ? true : (kind != 0);
                if (bg_here) {
                const bool s5_overlap = (kind == 0) && (G >= 192);
                if (!s5_overlap) __syncthreads();
                LAS float* scr = !s5_overlap ? ldsf + wave * (64 * 65) : (wave < 2 ? ldsf + wave * 8192 : ldsf + 16384 + (wave - 2) * (64 * 65));
                unsigned* qh = ctl + CW_CQ + 64 * L;
                constexpr int PERL = NEXP * (512 + 256), HALF2 = LINATT_V2 ? PERL / 2 : PERL;
                const int g0 = (BG_ALL && LINATT_V2) ? L * PERL : ((L == 1) ? PERL : 2 * PERL + HALF2), g1 = (BG_ALL && LINATT_V2) ? (L + 1) * PERL : ((L == 1) ? 2 * PERL + HALF2 : 4 * PERL);
                if (!s5_overlap || wave < 6)
                for (;;) {
                    int it = 0; if (lane == 0) it = (int)__hip_atomic_fetch_add(qh, 1u, __ATOMIC_RELAXED, __HIP_MEMORY_SCOPE_AGENT);
                    it = __builtin_amdgcn_readfirstlane(it) + g0;
                    if (it >= g1) break;
                    const int Lc = it / PERL; it = it % PERL;
                    if (it < NEXP * 512) { const int le = Lc * NEXP + (it >> 9);
#if MOE_FP8
                        tr_item8<LINATT_V2>((const float*)ARGP(42) + (size_t)le * D * 2 * DEXP, 2 * DEXP, D, wgu8 + (size_t)le * 2 * DEXP * D, 32, it & 511, scr, lane, GU_WS, [](int d) { const int tile = d >> 8, q = d & 255; return q < 128 ? tile * 128 + q : DEXP + tile * 128 + (q - 128); });
#else
                        tr_item((const float*)ARGP(42) + (size_t)le * D * 2 * DEXP, 2 * DEXP, D, wgu_t + (size_t)le * 2 * DEXP * D, 32, it & 511, scr, lane, [](int d) { const int tile = d >> 8, q = d & 255; return q < 128 ? tile * 128 + q : DEXP + tile * 128 + (q - 128); });
#endif
                    }
                    else { const int r = it - NEXP * 512; const int le = Lc * NEXP + (r >> 8);
#if MOE_FP8
                        tr_item8<LINATT_V2>((const float*)ARGP(44) + (size_t)le * DEXP * D, D, DEXP, wdn8 + (size_t)le * D * DEXP, 16, r & 255, scr, lane, DN_WS, [](int d) { return d; });
#else
                        tr_item((const float*)ARGP(44) + (size_t)le * DEXP * D, D, DEXP, wdn_t + (size_t)le * D * DEXP, 16, r & 255, scr, lane, [](int d) { return d; });
#endif
                    }
                }
                }
            }
#endif
            REPS(13) { if (rep_) __syncthreads();
#if FAST_XATTN
            {
                typedef pg8::bf16x8 bx8; typedef pg8::f32x4 fx4;
                LAS bf16* Kt = (LAS bf16*)lds;
                LAS bf16* Vt = (LAS bf16*)(lds + 36864);
                const int tok = lane & 15, sg = lane >> 4;
                const int xa_skip = (LINATT_V2 && kind != 0 && G > 192) ? 128 : 0;
                for (int unit = bid - xa_skip; unit >= 0 && unit < NB * 4 * 8; unit += G - xa_skip) {
                    const int b = unit >> 5, head = (unit >> 3) & 3, qt = unit & 7;
                    __syncthreads();
                    const bf16* kg = memK + (size_t)(b * 4 + head) * 256 * 64; const bf16* vg = memVT + (size_t)(b * 4 + head) * 64 * 256;
                    for (int c = tid; c < 2048; c += NTHR) { const int key = c >> 3, d8 = (c & 7) * 8; *(LAS pg8::u32x4*)(Kt + key * 72 + d8) = *(const pg8::u32x4*)(kg + key * 64 + d8); }
                    for (int c = tid; c < 2048; c += NTHR) { const int d = c >> 5, m = (c & 31) * 8; const pg8::u32x4 v = *(const pg8::u32x4*)(vg + d * 256 + m);
                        const int a = m >> 5, w = m & 31, tp = w >> 4, sk = (w & 15) >> 2;
                        pg8::u32x2 lo; lo.x = v.x; lo.y = v.y; pg8::u32x2 hi2; hi2.x = v.z; hi2.y = v.w;
                        *(LAS pg8::u32x2*)(Vt + d * 264 + 32 * a + 8 * sk + 4 * tp) = lo; *(LAS pg8::u32x2*)(Vt + d * 264 + 32 * a + 8 * (sk + 1) + 4 * tp) = hi2; }
                    __syncthreads();
#pragma unroll 1
                    for (int qi = 0; qi < 2; ++qi) {
                        const size_t row = (size_t)b * SEQ + qt * 256 + wave * 32 + qi * 16 + tok;
                        const bf16* qp = proj + row * LDP + xq_off + head * 64 + 8 * sg;
                        const bx8 q0 = __builtin_bit_cast(bx8, *(const uint4*)qp), q1 = __builtin_bit_cast(bx8, *(const uint4*)(qp + 32));
                        fx4 s[16];
#pragma unroll
                        for (int kt = 0; kt < 16; ++kt) { const bx8 k0 = *(const LAS bx8*)(Kt + (16 * kt + tok) * 72 + 8 * sg), k1 = *(const LAS bx8*)(Kt + (16 * kt + tok) * 72 + 32 + 8 * sg);
                            s[kt] = __builtin_amdgcn_mfma_f32_16x16x32_bf16(k0, q0, (fx4){0.f, 0.f, 0.f, 0.f}, 0, 0, 0); s[kt] = __builtin_amdgcn_mfma_f32_16x16x32_bf16(k1, q1, s[kt], 0, 0, 0); }
                        float mx = -3.0e38f;
#pragma unroll
                        for (int kt = 0; kt < 16; ++kt) mx = fmaxf(fmaxf(fmaxf(s[kt][0], s[kt][1]), fmaxf(s[kt][2], s[kt][3])), mx);
                        mx = fmaxf(mx, sh_xor(mx, 16, lane)); mx = fmaxf(mx, sh_xor(mx, 32, lane));
                        float sum = 0.f;
#pragma unroll
                        for (int kt = 0; kt < 16; ++kt)
#pragma unroll
                            for (int r = 0; r < 4; ++r) { const float pe = __expf((s[kt][r] - mx) * 0.125f); s[kt][r] = pe; sum += pe; }
                        sum += sh_xor(sum, 16, lane); sum += sh_xor(sum, 32, lane);
                        fx4 o[4];
#pragma unroll
                        for (int dt = 0; dt < 4; ++dt) o[dt] = (fx4){0.f, 0.f, 0.f, 0.f};
#pragma unroll
                        for (int a = 0; a < 8; ++a) {
                            uint4 pw; pw.x = pg8::cvt_pk_bf16(s[2 * a][0], s[2 * a][1]); pw.y = pg8::cvt_pk_bf16(s[2 * a][2], s[2 * a][3]); pw.z = pg8::cvt_pk_bf16(s[2 * a + 1][0], s[2 * a + 1][1]); pw.w = pg8::cvt_pk_bf16(s[2 * a + 1][2], s[2 * a + 1][3]);
                            const bx8 pf = __builtin_bit_cast(bx8, pw);
#pragma unroll
                            for (int dt = 0; dt < 4; ++dt) { const bx8 vf = *(const LAS bx8*)(Vt + (16 * dt + tok) * 264 + 32 * a + 8 * sg); o[dt] = __builtin_amdgcn_mfma_f32_16x16x32_bf16(vf, pf, o[dt], 0, 0, 0); }
                        }
                        const float inv = 1.0f / sum; bf16* op = cat + row * D + MIXW + head * 64 + 4 * sg;
#pragma unroll
                        for (int dt = 0; dt < 4; ++dt) { uint2 ov; ov.x = pg8::cvt_pk_bf16(o[dt][0] * inv, o[dt][1] * inv); ov.y = pg8::cvt_pk_bf16(o[dt][2] * inv, o[dt][3] * inv); *(uint2*)(op + 16 * dt) = ov; }
                    }
                }
            }
#else
            for (int wu = bid * NWAVES + wave; wu < (T / 16) * 4; wu += G * NWAVES) {
                const int head = wu & 3, row = (wu >> 2) * 16 + (lane >> 2), part = lane & 3, b = row / SEQ;
                float q[16], acc[16];
                { const bf16* qp = proj + (size_t)row * LDP + xq_off + head * 64 + part * 16;
                  unpack8(*(const uint4*)qp, q); unpack8(*(const uint4*)(qp + 8), q + 8);
#pragma unroll
                  for (int d = 0; d < 16; ++d) { q[d] *= 0.125f; acc[d] = 0.f; } }
                float mx = -3.0e38f, l = 0.f;
                const bf16* kb = memK + (size_t)(b * 4 + head) * 256 * 64 + part * 16; const bf16* vb = memV + (size_t)(b * 4 + head) * 256 * 64 + part * 16;
                for (int m = 0; m < NMEM; ++m) {
                    float kk[16]; unpack8(*(const uint4*)(kb + m * 64), kk); unpack8(*(const uint4*)(kb + m * 64 + 8), kk + 8);
                    float s = 0.f;
#pragma unroll
                    for (int j = 0; j < 16; ++j) s += q[j] * kk[j];
                    s += sh_xor(s, 1, lane); s += sh_xor(s, 2, lane);
                    const float mn = fmaxf(mx, s); const float corr = __expf(mx - mn), pv = __expf(s - mn); mx = mn; l = l * corr + pv;
                    float vv[16]; unpack8(*(const uint4*)(vb + m * 64), vv); unpack8(*(const uint4*)(vb + m * 64 + 8), vv + 8);
#pragma unroll
                    for (int j = 0; j < 16; ++j) acc[j] = acc[j] * corr + pv * vv[j];
                }
                const float il = 1.0f / l; bf16* op = cat + (size_t)row * D + MIXW + head * 64 + part * 16;
#pragma unroll
                for (int c = 0; c < 2; ++c) { uint4 o; o.x = pk2(acc[8 * c + 0] * il, acc[8 * c + 1] * il); o.y = pk2(acc[8 * c + 2] * il, acc[8 * c + 3] * il);
                    o.z = pk2(acc[8 * c + 4] * il, acc[8 * c + 5] * il); o.w = pk2(acc[8 * c + 6] * il, acc[8 * c + 7] * il); *(uint4*)(op + 8 * c) = o; }
            }
#endif
        } }
        SEAM(P + LP_MIXA);

        if (IN(P + LP_MIXB)) {
            PHASE_IDS();
            REPS(4) { if (rep_) __syncthreads();
            if (kind == 0) {
                const float* w_glu = (const float*)(L == 0 ? ARGP(14) : ARGP(33)); const float* b_glu = (const float*)(L == 0 ? ARGP(15) : ARGP(34));
#if FAST_DENSE
                { (void)w_glu; pg8::Gemm g{yg, wglu_t + (size_t)(L == 0 ? 0 : 1) * MiB, MIXW, nullptr}; pg8::StaticOrder S; S.init(T, MIXW, G, bid); pg8::EpiGlu E{cat, D, yg, MIXW, b_glu}; pg8::gemm_phase(lds, g, S, E, wave); }
#else
                oracle_gemm(ldsf, T, MIXW, MIXW,
                    [&](int) { return 0; },
                    [&](int m, int k) { return bf2f(yg[(size_t)m * MIXW + k]); },
                    [&](int k, int n, int) { return w_glu[(size_t)k * MIXW + n]; },
                    [&](int m0, int n0, float (&acc)[4][8], int) {
#pragma unroll
                        for (int i = 0; i < 4; ++i)
#pragma unroll
                            for (int j = 0; j < 8; ++j) { const int m = m0 + i, n = n0 + j; const float z = acc[i][j] + b_glu[n]; const float yv = bf2f(yg[(size_t)m * MIXW + n]);
                                cat[(size_t)m * D + n] = f2bf(yv * sigmoidf(z)); }
                    });
#endif
            }
        } }
        if (kind == 0) SEAM(P + LP_MIXB);

        if (IN(P + LP_OUTPROJ)) {
            PHASE_IDS();
            REPS(5) { if (rep_) __syncthreads();
            const float* w_out = (const float*)ARGP(35) + (size_t)L * D * D;
#if FAST_DENSE
            { (void)w_out; pg8::Gemm g{cat, wout_t + (size_t)L * D * D, D, nullptr}; pg8::StaticOrder S; S.init(T, D, G, bid);
#if RES_BF16
              pg8::EpiResBf16 E{(bf16*)y2, hb, D, DN_ALPHA}; pg8::gemm_phase(lds, g, S, E, wave); }
#else
              pg8::EpiResF32 E{y2, hf, D, DN_ALPHA}; pg8::gemm_phase(lds, g, S, E, wave); }
#endif
#else
            oracle_gemm(ldsf, T, D, D,
                [&](int) { return 0; },
                [&](int m, int k) { return bf2f(cat[(size_t)m * D + k]); },
                [&](int k, int n, int) { return w_out[(size_t)k * D + n]; },
                [&](int m0, int n0, float (&acc)[4][8], int) {
#pragma unroll
                    for (int i = 0; i < 4; ++i)
#pragma unroll
                        for (int j = 0; j < 8; ++j) { const size_t o = (size_t)(m0 + i) * D + n0 + j; y2[o] = DN_ALPHA * hf[o] + acc[i][j]; }
                });
#endif
        } }
        SEAM(P + LP_OUTPROJ);

        if (IN(P + LP_LN1)) {
            PHASE_IDS();
            REPS(8) { if (rep_) __syncthreads();
            const float* g1 = (const float*)ARGP(36) + L * D; const float* b1 = (const float*)ARGP(37) + L * D;
            const float* rw = (const float*)ARGP(40) + (size_t)L * D * NEXP; const float* rb = (const float*)ARGP(41) + L * NEXP;
#if FAST_LN1
            {
            typedef pg8::bf16x8 bx8; typedef pg8::f32x4 fx4; typedef pg8::u32x4 ux4;
            LAS bf16* SL = (LAS bf16*)lds;
            LAS float* stg = (LAS float*)(lds + 67584 + wave * 8320);
            LAS int* hist = (LAS int*)(lds + 67584 + 8 * 8320); LAS int* lbase = hist + 32; (void)lbase;
            const bf16* rw_g = rwt + (size_t)(L * 2) * NEXP * D;
#define LN1_SLICE_LOAD(dst, q) do { _Pragma("unroll") for (int i_ = 0; i_ < 4; ++i_) { const int c_ = tid + NTHR * i_; dst[i_] = *(const ux4*)(rw_g + (size_t)((c_ >> 10) * NEXP + ((c_ >> 5) & 31)) * D + 256 * (q) + 8 * (c_ & 31)); } } while (0)
#define LN1_SLICE_STORE(src_, buf) do { _Pragma("unroll") for (int i_ = 0; i_ < 4; ++i_) { const int c_ = tid + NTHR * i_; *(LAS ux4*)(SL + (((buf) * 2 + (c_ >> 10)) * 32 + ((c_ >> 5) & 31)) * 264 + 8 * (c_ & 31)) = src_[i_]; } } while (0)
            { ux4 s0[4]; LN1_SLICE_LOAD(s0, 0); LN1_SLICE_STORE(s0, 0); }
            if (tid < 32) hist[tid] = 0;
            __syncthreads();
            const int tok = lane & 15, sg = lane >> 4;
            for (int wt = bid * NWAVES + wave; wt < T / 8; wt += G * NWAVES) {
                float4 v[8][4];
#pragma unroll
                for (int rr = 0; rr < 8; ++rr)
#pragma unroll
                    for (int j = 0; j < 4; ++j) {
#if RES_BF16
                        const uint2 yv_ = *(const uint2*)((const bf16*)y2 + ((size_t)wt * 8 + rr) * D + (lane + 64 * j) * 4);
                        v[rr][j] = make_float4(__uint_as_float(yv_.x << 16), __uint_as_float(yv_.x & 0xffff0000u), __uint_as_float(yv_.y << 16), __uint_as_float(yv_.y & 0xffff0000u));
#else
                        v[rr][j] = *(const float4*)(y2 + ((size_t)wt * 8 + rr) * D + (lane + 64 * j) * 4);
#endif
                    }
#pragma unroll
                for (int rr = 0; rr < 8; ++rr) {
                    float s = 0.f;
#pragma unroll
                    for (int j = 0; j < 4; ++j) s += (v[rr][j].x + v[rr][j].y) + (v[rr][j].z + v[rr][j].w);
                    const float mean = wave_sum(s, lane) * (1.0f / D); float s2 = 0.f;
#pragma unroll
                    for (int j = 0; j < 4; ++j) { v[rr][j].x -= mean; v[rr][j].y -= mean; v[rr][j].z -= mean; v[rr][j].w -= mean; s2 += (v[rr][j].x * v[rr][j].x + v[rr][j].y * v[rr][j].y) + (v[rr][j].z * v[rr][j].z + v[rr][j].w * v[rr][j].w); }
                    const float rstd = 1.0f / sqrtf(wave_sum(s2, lane) * (1.0f / D) + LN_EPS);
                    const size_t row = (size_t)wt * 8 + rr;
#pragma unroll
                    for (int j = 0; j < 4; ++j) { const int cc = (lane + 64 * j) * 4; const float4 gg = *(const float4*)(g1 + cc), bb = *(const float4*)(b1 + cc);
                        float4 o; o.x = v[rr][j].x * rstd * gg.x + bb.x; o.y = v[rr][j].y * rstd * gg.y + bb.y; o.z = v[rr][j].z * rstd * gg.z + bb.z; o.w = v[rr][j].w * rstd * gg.w + bb.w;
                        v[rr][j] = o;
#if RES_BF16
                        { uint2 ob; ob.x = pg8::cvt_pk_bf16(o.x, o.y); ob.y = pg8::cvt_pk_bf16(o.z, o.w); *(uint2*)(hb + row * D + cc) = ob; }
#else
                        *(float4*)(hf + row * D + cc) = o;
#endif
#if MOE_FP8 && MOE_GATHER
                        { int w8 = __builtin_amdgcn_cvt_pk_fp8_f32(o.x, o.y, 0, false); w8 = __builtin_amdgcn_cvt_pk_fp8_f32(o.z, o.w, w8, true); *(int*)(hb8 + row * D + cc) = w8; }
#elif !RES_BF16
                        { uint2 ob; ob.x = pg8::cvt_pk_bf16(o.x, o.y); ob.y = pg8::cvt_pk_bf16(o.z, o.w); *(uint2*)(hb + row * D + cc) = ob; }
#endif
                    }
                }
                fx4 lacc[2]; lacc[0] = (fx4){0.f, 0.f, 0.f, 0.f}; lacc[1] = (fx4){0.f, 0.f, 0.f, 0.f};
#pragma unroll
                for (int j = 0; j < 4; ++j) {
                    ux4 snx[4]; if (j < 3) LN1_SLICE_LOAD(snx, j + 1);
#pragma unroll
                    for (int rr = 0; rr < 8; ++rr) *(LAS fx4*)(stg + rr * 260 + lane * 4) = (fx4){v[rr][j].x, v[rr][j].y, v[rr][j].z, v[rr][j].w};
                    asm volatile("s_waitcnt lgkmcnt(0)" ::: "memory");
#pragma unroll 2
                    for (int kk = 0; kk < 8; ++kk) {
                        fx4 f0 = (fx4){0.f, 0.f, 0.f, 0.f}, f1 = f0;
                        if (tok < 8) { f0 = *(const LAS fx4*)(stg + tok * 260 + 32 * kk + 8 * sg); f1 = *(const LAS fx4*)(stg + tok * 260 + 32 * kk + 8 * sg + 4); }
                        ux4 hw, lw;
                        hw.x = pg8::cvt_pk_bf16(f0[0], f0[1]); hw.y = pg8::cvt_pk_bf16(f0[2], f0[3]); hw.z = pg8::cvt_pk_bf16(f1[0], f1[1]); hw.w = pg8::cvt_pk_bf16(f1[2], f1[3]);
                        lw.x = pg8::cvt_pk_bf16(f0[0] - __uint_as_float(hw.x << 16), f0[1] - __uint_as_float(hw.x & 0xffff0000u)); lw.y = pg8::cvt_pk_bf16(f0[2] - __uint_as_float(hw.y << 16), f0[3] - __uint_as_float(hw.y & 0xffff0000u));
                        lw.z = pg8::cvt_pk_bf16(f1[0] - __uint_as_float(hw.z << 16), f1[1] - __uint_as_float(hw.z & 0xffff0000u)); lw.w = pg8::cvt_pk_bf16(f1[2] - __uint_as_float(hw.w << 16), f1[3] - __uint_as_float(hw.w & 0xffff0000u));
                        const bx8 yh = __builtin_bit_cast(bx8, hw), yl = __builtin_bit_cast(bx8, lw);
#pragma unroll
                        for (int t = 0; t < 2; ++t) { const int kcol = 32 * kk + 8 * sg;
                            const bx8 xh = *(const LAS bx8*)(SL + (((j & 1) * 2 + 0) * 32 + 16 * t + tok) * 264 + kcol); const bx8 xl = *(const LAS bx8*)(SL + (((j & 1) * 2 + 1) * 32 + 16 * t + tok) * 264 + kcol);
                            lacc[t] = __builtin_amdgcn_mfma_f32_16x16x32_bf16(xh, yh, lacc[t], 0, 0, 0); lacc[t] = __builtin_amdgcn_mfma_f32_16x16x32_bf16(xl, yh, lacc[t], 0, 0, 0); lacc[t] = __builtin_amdgcn_mfma_f32_16x16x32_bf16(xh, yl, lacc[t], 0, 0, 0); }
                    }
                    if (j < 3) LN1_SLICE_STORE(snx, (j + 1) & 1);
                    LDS_BARRIER();
                }
                if (wt + G * NWAVES < T / 8) { ux4 s0[4]; LN1_SLICE_LOAD(s0, 0); LN1_SLICE_STORE(s0, 0); LDS_BARRIER(); }
                float lv[8];
#pragma unroll
                for (int t = 0; t < 2; ++t) { const float4 rb4 = *(const float4*)(rb + 16 * t + 4 * sg); lv[4 * t + 0] = lacc[t][0] + rb4.x; lv[4 * t + 1] = lacc[t][1] + rb4.y; lv[4 * t + 2] = lacc[t][2] + rb4.z; lv[4 * t + 3] = lacc[t][3] + rb4.w; }
                float tv[4]; int ti[4];
#pragma unroll
                for (int k = 0; k < 4; ++k) {
                    float bv = -3.0e38f; int bi = 0;
#pragma unroll
                    for (int q = 0; q < 8; ++q) { const int e = 16 * (q >> 2) + 4 * sg + (q & 3); if (lv[q] > bv) { bv = lv[q]; bi = e; } }
#pragma unroll
                    for (int o = 16; o <= 32; o <<= 1) { const float ov = sh_xor(bv, o, lane); const int oi = sh_xor(bi, o, lane); if (ov > bv || (ov == bv && oi < bi)) { bv = ov; bi = oi; } }
                    tv[k] = bv; ti[k] = bi;
#pragma unroll
                    for (int q = 0; q < 8; ++q) { const int e = 16 * (q >> 2) + 4 * sg + (q & 3); if (e == bi) lv[q] = -3.0e38f; }
                }
                if (sg == 0 && tok < 8) {
                    const size_t row = (size_t)wt * 8 + tok; float ex[4], sum = 0.f;
#pragma unroll
                    for (int k = 0; k < 4; ++k) { ex[k] = __expf(tv[k] - tv[0]); sum += ex[k]; }
                    const float inv = 1.0f / sum;
                    *(int4*)(top_e + row * 4) = make_int4(ti[0], ti[1], ti[2], ti[3]); *(float4*)(top_g + row * 4) = make_float4(ex[0] * inv, ex[1] * inv, ex[2] * inv, ex[3] * inv);
#pragma unroll
                    for (int k = 0; k < 4; ++k) ti[k] |= atomicAdd((int*)&hist[ti[k]], 1) << 8;
                }
#if MOE_SPARSE
                __syncthreads();
                if (tid < 32) { const int hc = hist[tid]; lbase[tid] = hc ? (int)atomicAdd(ctl + CW_CNT + 64 * L + tid, (unsigned)hc) : 0; hist[tid] = 0; }
                __syncthreads();
                if (sg == 0 && tok < 8) { const size_t row = (size_t)wt * 8 + tok; int dd[4];
#pragma unroll
                    for (int k = 0; k < 4; ++k) { const int e = ti[k] & 255; dd[k] = e * T + lbase[e] + (ti[k] >> 8); row_tok[dd[k]] = (int)row; }
                    *(int4*)(dest + row * 4) = make_int4(dd[0], dd[1], dd[2], dd[3]); }
#endif
            }
#if !MOE_SPARSE
            __syncthreads();
            if (rep_ == 0 && tid < 32 && hist[tid] != 0) atomicAdd(ctl + CW_CNT + 64 * L + tid, (unsigned)hist[tid]);
#endif
            __syncthreads();
            }
#else
            LAS float* rows = ldsf; LAS float* lg = ldsf + 16 * 1024; LAS int* hist = (LAS int*)(ldsf + 16 * 1024 + 512);
            if (tid < 32) hist[tid] = 0;
            __syncthreads();
            for (int tile = bid; tile < T / 16; tile += G) {
#pragma unroll
                for (int rr = 0; rr < 2; ++rr) {
                    const int r = 2 * wave + rr; const size_t row = (size_t)tile * 16 + r;
                    float4 v[4]; float s = 0.f;
#pragma unroll
                    for (int j = 0; j < 4; ++j) { v[j] = *(const float4*)(y2 + row * D + (lane + 64 * j) * 4); s += (v[j].x + v[j].y) + (v[j].z + v[j].w); }
                    const float mean = wave_sum(s, lane) * (1.0f / D); float s2 = 0.f;
#pragma unroll
                    for (int j = 0; j < 4; ++j) { v[j].x -= mean; v[j].y -= mean; v[j].z -= mean; v[j].w -= mean; s2 += (v[j].x * v[j].x + v[j].y * v[j].y) + (v[j].z * v[j].z + v[j].w * v[j].w); }
                    const float rstd = 1.0f / sqrtf(wave_sum(s2, lane) * (1.0f / D) + LN_EPS);
#pragma unroll
                    for (int j = 0; j < 4; ++j) { const int c = (lane + 64 * j) * 4; const float4 gg = *(const float4*)(g1 + c), bb = *(const float4*)(b1 + c);
                        float4 o; o.x = v[j].x * rstd * gg.x + bb.x; o.y = v[j].y * rstd * gg.y + bb.y; o.z = v[j].z * rstd * gg.z + bb.z; o.w = v[j].w * rstd * gg.w + bb.w;
                        *(float4*)(hf + row * D + c) = o; uint2 ob; ob.x = pk2(o.x, o.y); ob.y = pk2(o.z, o.w); *(uint2*)(hb + row * D + c) = ob;
                        rows[r * 1024 + c + 0] = o.x; rows[r * 1024 + c + 1] = o.y; rows[r * 1024 + c + 2] = o.z; rows[r * 1024 + c + 3] = o.w; }
                }
                __syncthreads();
                { const int r = tid >> 5, e = tid & 31; float a = rb[e];
                  for (int k = 0; k < D; ++k) a += rows[r * 1024 + k] * rw[(size_t)k * NEXP + e];
                  lg[r * 32 + e] = a; }
                __syncthreads();
                if (tid < 16) {
                    const size_t row = (size_t)tile * 16 + tid; float tv[4]; int ti[4];
#pragma unroll
                    for (int k = 0; k < 4; ++k) { float best = -3.0e38f; int bi = 0;
                        for (int e = 0; e < NEXP; ++e) { const float v = lg[tid * 32 + e]; if (v > best) { best = v; bi = e; } }
                        tv[k] = best; ti[k] = bi; lg[tid * 32 + bi] = -3.0e38f; }
                    float ex[4], sum = 0.f;
#pragma unroll
                    for (int k = 0; k < 4; ++k) { ex[k] = __expf(tv[k] - tv[0]); sum += ex[k]; }
#pragma unroll
                    for (int k = 0; k < 4; ++k) { top_e[row * 4 + k] = ti[k]; top_g[row * 4 + k] = ex[k] / sum; atomicAdd((int*)&hist[ti[k]], 1); }
                }
                __syncthreads();
            }
            if (rep_ == 0 && tid < 32 && hist[tid] != 0) atomicAdd(ctl + CW_CNT + 64 * L + tid, (unsigned)hist[tid]);
            __syncthreads();
#endif
        } }
        SEAM(P + LP_LN1);

        if (!MOE_SPARSE && IN(P + LP_DISP)) {
            PHASE_IDS();
            REPS(9) { if (rep_) __syncthreads();
            LAS int* pstart = (LAS int*)ldsf; LAS int* lh = pstart + 32; LAS int* lbase = pstart + 64; LAS int* ldest = pstart + 128;
            if (tid == 0) { int a = 0; for (int e = 0; e < NEXP; ++e) { const int c = (int)__hip_atomic_load(ctl + CW_CNT + 64 * L + e, __ATOMIC_RELAXED, __HIP_MEMORY_SCOPE_AGENT); pstart[e] = a; a += ((c + MOEBLK - 1) / MOEBLK) * MOEBLK; } }
            __syncthreads();
#if MOE_GATHER
            for (int idx = bid * NTHR + tid; idx < NEXP * MOEBLK; idx += G * NTHR) { const int e = idx >> 8, r = idx & 255; const int cnt = (int)__hip_atomic_load(ctl + CW_CNT + 64 * L + e, __ATOMIC_RELAXED, __HIP_MEMORY_SCOPE_AGENT);
                const int padded = ((cnt + MOEBLK - 1) / MOEBLK) * MOEBLK; if (cnt + r < padded) row_tok[pstart[e] + cnt + r] = 0; }
#endif
            for (int tile = bid; tile < T * TOPK / NTHR; tile += G) {
                if (tid < 32) lh[tid] = 0;
                __syncthreads();
                const int pair = tile * NTHR + tid; const int e = top_e[pair];
                int dd;
                if (rep_ == 0) {
                const int rank = atomicAdd((int*)&lh[e], 1);
                __syncthreads();
                if (tid < 32) lbase[tid] = lh[tid] ? (int)atomicAdd(ctl + CW_CUR + 64 * L + tid, (unsigned)lh[tid]) : 0;
                __syncthreads();
                dd = pstart[e] + lbase[e] + rank; dest[pair] = dd; } else dd = dest[pair];
                ldest[tid] = dd;
#if MOE_GATHER
                if (rep_ == 0) row_tok[dd] = pair >> 2;
#endif
                __syncthreads();
#if !MOE_GATHER
                for (int i = 0; i < 64; ++i) { const int pp = wave * 64 + i; const int d2 = ldest[pp]; const int tt = (tile * NTHR + pp) >> 2;
                    const uint4* src = (const uint4*)(hb + (size_t)tt * D); uint4* dst = (uint4*)(xr + (size_t)d2 * D);
                    dst[lane] = src[lane]; dst[lane + 64] = src[lane + 64]; }
#endif
                __syncthreads();
            }
        } }
        if (!MOE_SPARSE) SEAM(P + LP_DISP);

        if (IN(P + LP_GU) || IN(P + LP_DOWN)) {
            PHASE_IDS();
            LAS int* pend = (LAS int*)(lds + LDS_MISC + 512);
            if (tid == 0) { int a = 0; for (int e = 0; e < NEXP; ++e) { const int c = (int)__hip_atomic_load(ctl + CW_CNT + 64 * L + e, __ATOMIC_RELAXED, __HIP_MEMORY_SCOPE_AGENT); a += ((c + MOEBLK - 1) / MOEBLK) * MOEBLK; pend[e] = a; } }
            __syncthreads();
        }
        if (IN(P + LP_GU)) {
            PHASE_IDS();
            REPS(6) { if (rep_) __syncthreads();
            const LAS int* pend = (const LAS int*)(lds + LDS_MISC + 512);
            const int nrows = pend[NEXP - 1];
            const float* wgu = (const float*)ARGP(42) + (size_t)L * NEXP * D * 2 * DEXP; const float* bgu = (const float*)ARGP(43) + (size_t)L * NEXP * 2 * DEXP;
#if FAST_MOE
            { (void)wgu; pg8::MoeOrder S{pend, nrows / 256, 8, G, vcu};
#if MOE_GATHER && MOE_FP8
              pg8::EpiSwiglu<true> E{act8, bgu, 1.0f / GU_WS};
              LAS int* rmapL = (LAS int*)(lds + LDS_RMAP);
              { pg8::Unit uu; for (int i = 0; i < 15 && S.next(i, uu); ++i) { if (tid < 256) { const int rt_ = row_tok[uu.pm * 256 + tid]; rmapL[i * 256 + tid] = rt_ < 0 ? 0 : (rt_ < T ? rt_ : T - 1); } } }
              __syncthreads();
              pg8::Gemm g{(const pg8::bf16_t*)hb8, (const pg8::bf16_t*)(wgu8 + (size_t)L * NEXP * 2 * DEXP * D), D, rmapL}; pg8::gemm_phase<pg8::EpiSwiglu<true>, pg8::MoeOrder, true, true, true, true>(lds, g, S, E, wave);
#elif MOE_GATHER
              pg8::EpiSwiglu<false> E{act, bgu, 1.0f};
              LAS int* rmapL = (LAS int*)(lds + LDS_RMAP);
              { pg8::Unit uu; for (int i = 0; i < 15 && S.next(i, uu); ++i) { if (tid < 256) { const int rt_ = row_tok[uu.pm * 256 + tid]; rmapL[i * 256 + tid] = rt_ < 0 ? 0 : (rt_ < T ? rt_ : T - 1); } } }
              __syncthreads();
              pg8::Gemm g{hb, wgu_t + (size_t)L * NEXP * 2 * DEXP * D, D, rmapL}; pg8::gemm_phase<pg8::EpiSwiglu<false>, pg8::MoeOrder, true, true, true>(lds, g, S, E, wave);
#else
              pg8::EpiSwiglu<false> E{act, bgu, 1.0f};
              pg8::Gemm g{xr, wgu_t + (size_t)L * NEXP * 2 * DEXP * D, D, nullptr}; pg8::gemm_phase(lds, g, S, E, wave);
#endif
            }
#else
            oracle_gemm(ldsf, nrows, 2 * DEXP, D,
                [&](int tm) { return expert_of_block(pend, tm >> 1); },
                [&](int m, int k) { return bf2f(xr[(size_t)m * D + k]); },
                [&](int k, int n, int e) { const int tn = n >> 7, v = n & 127; const int c = tn * 64 + (v >> 1) + ((v & 1) ? DEXP : 0); return wgu[((size_t)e * D + k) * (2 * DEXP) + c]; },
                [&](int m0, int n0, float (&acc)[4][8], int e) {
                    const int tn = n0 >> 7, v0 = n0 & 127;
#pragma unroll
                    for (int i = 0; i < 4; ++i)
#pragma unroll
                        for (int jj = 0; jj < 4; ++jj) { const int c = tn * 64 + (v0 >> 1) + jj;
                            const float xg = fminf(acc[i][2 * jj] + bgu[(size_t)e * 2 * DEXP + c], 7.0f);
                            const float xl = fminf(fmaxf(acc[i][2 * jj + 1] + bgu[(size_t)e * 2 * DEXP + DEXP + c], -7.0f), 7.0f);
                            act[(size_t)(m0 + i) * DEXP + c] = f2bf(xg * sigmoidf(1.702f * xg) * (xl + 1.0f)); }
                });
#endif
        } }
        SEAM(P + LP_GU);

        if (IN(P + LP_DOWN)) {
            PHASE_IDS();
            REPS(7) { if (rep_) __syncthreads();
            const LAS int* pend = (const LAS int*)(lds + LDS_MISC + 512);
            const int nrows = pend[NEXP - 1];
            const float* wd = (const float*)ARGP(44) + (size_t)L * NEXP * DEXP * D; const float* bd = (const float*)ARGP(45) + (size_t)L * NEXP * D;
#if FAST_MOE
            { (void)wd; pg8::MoeOrder S{pend, nrows / 256, 4, G, vcu};
#if MOE_FP8 && MOE_GATHER
              pg8::Gemm g{(const pg8::bf16_t*)act8, (const pg8::bf16_t*)(wdn8 + (size_t)L * NEXP * D * DEXP), DEXP, nullptr};
#if YR_FP8
              pg8::EpiBf16T<true> E{(unsigned char*)yr, D, bd, D, 1.0f / DN_WS};
              pg8::gemm_phase<pg8::EpiBf16T<true>, pg8::MoeOrder, true, true, false, true>(lds, g, S, E, wave);
#else
              pg8::EpiBf16 E{yr, D, bd, D, 1.0f / DN_WS};
              pg8::gemm_phase<pg8::EpiBf16, pg8::MoeOrder, true, true, false, true>(lds, g, S, E, wave);
#endif
#else
              pg8::Gemm g{act, wdn_t + (size_t)L * NEXP * D * DEXP, DEXP, nullptr}; pg8::EpiBf16 E{yr, D, bd, D, 1.0f}; pg8::gemm_phase(lds, g, S, E, wave);
#endif
            }
#else
            oracle_gemm(ldsf, nrows, D, DEXP,
                [&](int tm) { return expert_of_block(pend, tm >> 1); },
                [&](int m, int k) { return bf2f(act[(size_t)m * DEXP + k]); },
                [&](int k, int n, int e) { return wd[((size_t)e * DEXP + k) * D + n]; },
                [&](int m0, int n0, float (&acc)[4][8], int e) {
#pragma unroll
                    for (int i = 0; i < 4; ++i)
#pragma unroll
                        for (int j = 0; j < 8; ++j) yr[(size_t)(m0 + i) * D + n0 + j] = f2bf(acc[i][j] + bd[(size_t)e * D + n0 + j]);
                });
#endif
        } }
        SEAM(P + LP_DOWN);

        if (IN(P + LP_COMB)) {
            PHASE_IDS();
            REPS(10) { const bool dummy_ = (rep_ == 0) && ((REP_MASK >> 10) & 1);
            const float* g2 = (const float*)ARGP(38) + L * D; const float* b2 = (const float*)ARGP(39) + L * D;
            const int l32 = lane & 31, hw = lane >> 5;
            for (int row = 2 * (bid * NWAVES + wave) + hw; row < T; row += 2 * G * NWAVES) {
                int dd[4]; float gg[4];
                { const int4 d4 = *(const int4*)(dest + (size_t)row * 4); const float4 g4 = *(const float4*)(top_g + (size_t)row * 4); dd[0] = d4.x; dd[1] = d4.y; dd[2] = d4.z; dd[3] = d4.w; gg[0] = g4.x; gg[1] = g4.y; gg[2] = g4.z; gg[3] = g4.w; }
                float4 v[8]; float s = 0.f;
#pragma unroll
                for (int j = 0; j < 8; ++j) { const int c = (l32 + 32 * j) * 4;
#if RES_BF16
                    const uint2 hv_ = *(const uint2*)(hb + (size_t)row * D + c); const float4 hv = make_float4(__uint_as_float(hv_.x << 16), __uint_as_float(hv_.x & 0xffff0000u), __uint_as_float(hv_.y << 16), __uint_as_float(hv_.y & 0xffff0000u));
#else
                    const float4 hv = *(const float4*)(hf + (size_t)row * D + c);
#endif
                    float4 a; a.x = DN_ALPHA * hv.x; a.y = DN_ALPHA * hv.y; a.z = DN_ALPHA * hv.z; a.w = DN_ALPHA * hv.w;
                    float mo[4] = {0.f, 0.f, 0.f, 0.f};
#pragma unroll
                    for (int k = 0; k < 4; ++k) {
#if YR_FP8 && MOE_FP8 && MOE_GATHER
                        typedef float f32x2_ __attribute__((ext_vector_type(2)));
                        const int yw = *(const int*)((const unsigned char*)yr + (size_t)dd[k] * D + c); const f32x2_ y01 = __builtin_amdgcn_cvt_pk_f32_fp8(yw, false), y23 = __builtin_amdgcn_cvt_pk_f32_fp8(yw, true);
                        mo[0] += gg[k] * y01.x; mo[1] += gg[k] * y01.y; mo[2] += gg[k] * y23.x; mo[3] += gg[k] * y23.y;
#else
                        const uint2 yv = *(const uint2*)(yr + (size_t)dd[k] * D + c);
                        mo[0] += gg[k] * __uint_as_float(yv.x << 16); mo[1] += gg[k] * __uint_as_float(yv.x & 0xffff0000u);
                        mo[2] += gg[k] * __uint_as_float(yv.y << 16); mo[3] += gg[k] * __uint_as_float(yv.y & 0xffff0000u);
#endif
                    }
                    a.x += mo[0]; a.y += mo[1]; a.z += mo[2]; a.w += mo[3];
                    v[j] = a; s += (a.x + a.y) + (a.z + a.w); }
#pragma unroll
                for (int o = 1; o < 32; o <<= 1) s += sh_xor(s, o, lane);
                const float mean = s * (1.0f / D); float s2 = 0.f;
#pragma unroll
                for (int j = 0; j < 8; ++j) { v[j].x -= mean; v[j].y -= mean; v[j].z -= mean; v[j].w -= mean; s2 += (v[j].x * v[j].x + v[j].y * v[j].y) + (v[j].z * v[j].z + v[j].w * v[j].w); }
#pragma unroll
                for (int o = 1; o < 32; o <<= 1) s2 += sh_xor(s2, o, lane);
                const float rstd = 1.0f / sqrtf(s2 * (1.0f / D) + LN_EPS);
#pragma unroll
                for (int j = 0; j < 8; ++j) { const int c = (l32 + 32 * j) * 4; const float4 gv = *(const float4*)(g2 + c), bv = *(const float4*)(b2 + c);
                    float4 o; o.x = v[j].x * rstd * gv.x + bv.x; o.y = v[j].y * rstd * gv.y + bv.y; o.z = v[j].z * rstd * gv.z + bv.z; o.w = v[j].w * rstd * gv.w + bv.w;
                    if (dummy_) *(float4*)(y2 + (size_t)row * D + c) = o;
                    else if (L == DEPTH - 1) *(float4*)(((float*)ARGP(46)) + (size_t)row * D + c) = o;
                    else {
#if !RES_BF16
                        *(float4*)(hf + (size_t)row * D + c) = o;
#endif
                        uint2 ob; ob.x = pg8::cvt_pk_bf16(o.x, o.y); ob.y = pg8::cvt_pk_bf16(o.z, o.w); *(uint2*)(hb + (size_t)row * D + c) = ob; } }
            }
        } }
        SEAM(P + LP_COMB);
    }
#undef IN
#undef SEAM
}

extern "C" void kernel_launch(void* const* d_in, const int* in_sizes, int n_in, void* d_out, int out_size, void* d_ws, size_t ws_size, hipStream_t stream) {
    static int grid = 0;
    if (grid == 0) {
        if (n_in != 46 || out_size != T * D || ws_size < WS_END) { fprintf(stderr, "kernel_launch: unexpected problem (n_in %d, out %d, ws %zu < %zu)\n", n_in, out_size, ws_size, (size_t)WS_END); grid = -1; return; }
        int dev = 0, cus = 0, per_cu = 0;
        if (hipGetDevice(&dev) != hipSuccess || hipDeviceGetAttribute(&cus, hipDeviceAttributeMultiprocessorCount, dev) != hipSuccess) { grid = -1; return; }
        if (hipFuncSetAttribute((const void*)mk_fwd, hipFuncAttributeMaxDynamicSharedMemorySize, LDS_BYTES) != hipSuccess) { fprintf(stderr, "kernel_launch: hipFuncSetAttribute failed\n"); grid = -1; return; }
        if (hipOccupancyMaxActiveBlocksPerMultiprocessor(&per_cu, (const void*)mk_fwd, NTHR, LDS_BYTES) != hipSuccess || per_cu < 1) fprintf(stderr, "kernel_launch: occupancy query says %d\n", per_cu);
        (void)hipGetLastError();
        grid = cus;
    }
    if (grid < 0) return;
    (void)hipMemsetAsync((char*)d_ws + WS_CTL, 0, CTL_BYTES, stream);
    Args a{};
    for (int i = 0; i < 46; ++i) a.in[i] = d_in[i];
    a.out = (float*)d_out; a.ws = (unsigned char*)d_ws;
#if MK_ONE_LAUNCH
    a.ph_lo = 0; a.ph_hi = PH_TOTAL;
    hipLaunchKernelGGL(mk_fwd, dim3(grid), dim3(NTHR), LDS_BYTES, stream, a);
#else
    for (int p = 0; p < PH_TOTAL; ++p) {
        const int j = (p - PH_L0) % PH_PER_LAYER, L = (p - PH_L0) / PH_PER_LAYER;
        if (p >= PH_L0 && j == LP_MIXB && (L % 3) != 0) continue;
        a.ph_lo = p; a.ph_hi = p + 1;
        hipLaunchKernelGGL(mk_fwd, dim3(grid), dim3(NTHR), LDS_BYTES, stream, a);
    }
#endif
}
```

```cpp
#include <hip/hip_runtime.h>
#include <cstdio>
#include <cstdint>

#ifndef MK_ONE_LAUNCH
#define MK_ONE_LAUNCH 1
#endif

#ifndef FAST_DENSE
#define FAST_DENSE 1
#endif
#ifndef FAST_MOE
#define FAST_MOE 1
#endif
#ifndef REP_MASK
#define REP_MASK 0
#endif
#define REPS(k) for (int rep_ = 0; rep_ < 1 + ((REP_MASK >> (k)) & 1); ++rep_)
#ifndef FAST_S5
#define FAST_S5 1
#endif
#ifndef MOE_SPARSE
#define MOE_SPARSE 0
#endif
#ifndef YR_FP8
#define YR_FP8 0
#endif
#ifndef NT_STORES
#define NT_STORES 0
#endif
#ifndef WT_STORES
#define WT_STORES 0
#endif
#ifndef RES_BF16
#define RES_BF16 1
#endif
#ifndef BG_ALL
#define BG_ALL 1
#endif
#ifndef LINATT_V2
#define LINATT_V2 1
#endif
#ifndef MOE_FP8
#define MOE_FP8 1
#endif
#ifndef MOE_GATHER
#define MOE_GATHER 1
#endif
#ifndef BG_CONV
#define BG_CONV 1
#endif
#ifndef FAST_LN1
#define FAST_LN1 1
#endif
#ifndef FAST_XATTN
#define FAST_XATTN 1
#endif
#ifndef FAST_LINATT
#define FAST_LINATT 1
#endif
#define LAS __attribute__((address_space(3)))
typedef unsigned short bf16;

#ifndef MOE_SPARSE
#define MOE_SPARSE 0
#endif
#if MOE_SPARSE
#define MOE_SPARSE_ROWS (32 * 16384)
#else
#define MOE_SPARSE_ROWS (16384 * 4 + 32 * 256)
#endif
constexpr int NB = 8, SEQ = 2048, T = NB * SEQ, D = 1024, MIXW = 768, XW = 256, NMEM = 256, DEPTH = 4;
constexpr int NEXP = 32, TOPK = 4, DEXP = 1024, MOEBLK = 256;
constexpr int NROWS_MAX = MOE_SPARSE_ROWS;
constexpr int LDP = 2816;
constexpr float LN_EPS = 1e-5f;
constexpr float DN_ALPHA = 1.6817928305074290f;
constexpr int NWAVES = 8, NTHR = 512;

constexpr size_t MiB = (size_t)1 << 20;
constexpr size_t WS_CTL = 0, CTL_BYTES = 1 * MiB;
constexpr size_t WS_HF = 1 * MiB;
constexpr size_t WS_Y2 = WS_HF + (size_t)T * D * 4;
constexpr size_t WS_HB = WS_Y2 + (size_t)T * D * 4;
constexpr size_t WS_PROJ = WS_HB + (size_t)T * D * 2;
constexpr size_t WS_YG = WS_PROJ + (size_t)T * LDP * 2;
constexpr size_t WS_CAT = WS_YG + (size_t)T * MIXW * 2;
constexpr size_t WS_TOPE = WS_CAT + (size_t)T * D * 2;
constexpr size_t WS_TOPG = WS_TOPE + (size_t)T * 4 * 4;
constexpr size_t WS_DEST = WS_TOPG + (size_t)T * 4 * 4;
constexpr size_t WS_XR = WS_DEST + (size_t)T * 4 * 4;
constexpr size_t WS_ACT = WS_XR + (size_t)(T * TOPK + NEXP * MOEBLK) * D * 2;
constexpr size_t WS_YR = WS_ACT + (size_t)NROWS_MAX * DEXP * 2;
constexpr size_t WS_MEMK = WS_YR + (size_t)NROWS_MAX * D * 2;
constexpr size_t WS_MEMV = WS_MEMK + 1 * MiB;
constexpr size_t WS_MEMVT = WS_MEMV + 1 * MiB;
constexpr size_t WS_ROPE = WS_MEMVT + 1 * MiB;
constexpr size_t WS_WIN = WS_ROPE + (size_t)T * 48 * 2 * 4;
constexpr size_t WS_WGLU = WS_WIN + 4 * 6 * MiB;
constexpr size_t WS_WOUT = WS_WGLU + 2 * 2 * MiB;
constexpr size_t WS_WMEM = WS_WOUT + 4 * 2 * MiB;
constexpr size_t WS_MEMB = WS_WMEM + 1 * MiB;
constexpr size_t WS_WGU = WS_MEMB + 4 * MiB;
constexpr size_t WS_WDN = WS_WGU + (size_t)DEPTH * NEXP * 2 * DEXP * D * 2;
constexpr size_t WS_RWT = WS_WDN + (size_t)DEPTH * NEXP * D * DEXP * 2;
constexpr size_t WS_RTOK = WS_RWT + (size_t)DEPTH * 2 * NEXP * D * 2;
constexpr size_t WS_END = WS_RTOK + (size_t)NROWS_MAX * 4;
constexpr int CW_BAR = 4096;
constexpr int CW_CNT = 16384;
constexpr int CW_CUR = 16384 + 1024;
constexpr int CW_CQ = 16384 + 2048;

constexpr int LDS_BYTES = 163840;
constexpr int LDS_RMAP = 147456;
constexpr int LDS_MISC = 131072 + 8192;

__device__ __forceinline__ float bf2f(bf16 v) { return __uint_as_float(((unsigned)v) << 16); }
__device__ __forceinline__ bf16 f2bf(float f) { unsigned u = __float_as_uint(f); return (bf16)((u + 0x7fffu + ((u >> 16) & 1u)) >> 16); }
__device__ __forceinline__ unsigned pk2(float lo, float hi) { return (unsigned)f2bf(lo) | ((unsigned)f2bf(hi) << 16); }
__device__ __forceinline__ int sh_idx_i(int v, int src, int) { return __builtin_amdgcn_ds_bpermute(src << 2, v); }
__device__ __forceinline__ float sh_idx(float v, int src, int lane) { return __int_as_float(sh_idx_i(__float_as_int(v), src, lane)); }
__device__ __forceinline__ unsigned sh_idx(unsigned v, int src, int lane) { return (unsigned)sh_idx_i((int)v, src, lane); }
__device__ __forceinline__ float sh_xor(float v, int m, int lane) { return __int_as_float(__builtin_amdgcn_ds_bpermute((lane ^ m) << 2, __float_as_int(v))); }
__device__ __forceinline__ int sh_xor(int v, int m, int lane) { return __builtin_amdgcn_ds_bpermute((lane ^ m) << 2, v); }
__device__ __forceinline__ float sh_up(float v, int d, int lane) { const int s = lane - d; return __int_as_float(__builtin_amdgcn_ds_bpermute((s < 0 ? lane : s) << 2, __float_as_int(v))); }
__device__ __forceinline__ float wave_sum(float v, int lane) {
#pragma unroll
    for (int o = 1; o < 64; o <<= 1) v += sh_xor(v, o, lane);
    return v;
}
__device__ __forceinline__ float sigmoidf(float x) { return __builtin_amdgcn_rcpf(1.0f + __expf(-x)); }
__device__ __forceinline__ void unpack8(uint4 v, float* f) {
    f[0] = __uint_as_float(v.x << 16); f[1] = __uint_as_float(v.x & 0xffff0000u);
    f[2] = __uint_as_float(v.y << 16); f[3] = __uint_as_float(v.y & 0xffff0000u);
    f[4] = __uint_as_float(v.z << 16); f[5] = __uint_as_float(v.z & 0xffff0000u);
    f[6] = __uint_as_float(v.w << 16); f[7] = __uint_as_float(v.w & 0xffff0000u);
}
__device__ __forceinline__ void sincos_rad(float ang, float& s, float& c) {
    float r = ang * 0.15915494309189535f; r -= rintf(r);
    s = __builtin_amdgcn_sinf(r); c = __builtin_amdgcn_cosf(r);
}
__device__ __forceinline__ float gelu_tanh(float x) {
    const float u = 0.7978845608028654f * (x + 0.044715f * x * x * x);
    const float e = __expf(2.0f * u);
    const float th = 1.0f - 2.0f / (e + 1.0f);
    return 0.5f * x * (1.0f + th);
}

__device__ __forceinline__ int lane_id_opaque() { int l; asm volatile("v_mbcnt_lo_u32_b32 %0, -1, 0\n\tv_mbcnt_hi_u32_b32 %0, -1, %0" : "=v"(l)); return l; }
__device__ __forceinline__ bool wg_leader(int wave) { return wave == 0 && lane_id_opaque() == 0; }

#define XB_TMO      128
#define XB_XCNT(j)  (256  + 64 * (j))
#define XB_XSUB(j)  (1280 + 64 * (j))
#define XB_XGEN(j)  (2304 + 64 * (j))
#define XB_TOP      3328
#define XB_TOPGEN   3392
#define XCD_BAR_WORDS 3456
#define XB_SPIN_CAP (1u << 24)
__device__ __forceinline__ unsigned xb_ld(unsigned* p)              { return __hip_atomic_load(p, __ATOMIC_RELAXED, __HIP_MEMORY_SCOPE_AGENT); }
__device__ __forceinline__ unsigned xb_add(unsigned* p, unsigned v) { return __hip_atomic_fetch_add(p, v, __ATOMIC_RELAXED, __HIP_MEMORY_SCOPE_AGENT); }
__device__ __forceinline__ unsigned xb_xcc_id() { return (unsigned)__builtin_amdgcn_s_getreg((3 << 11) | 20) & 0xFu; }
#define XB_SPIN(cond, bar) do { unsigned _sp = 0; while (cond) { __builtin_amdgcn_s_sleep(1); \
    if ((++_sp & 255u) == 0u) { if (xb_ld(&(bar)[XB_TMO])) break; if (_sp > XB_SPIN_CAP) { atomicAdd(&(bar)[XB_TMO], 1u); break; } } } } while (0)
struct XcdBarrier { unsigned* bar; unsigned x; volatile LAS unsigned* st; };
__device__ __forceinline__ XcdBarrier xcd_barrier_post(unsigned* bar, volatile LAS unsigned* st, int wave) {
    XcdBarrier b; b.bar = bar; b.x = xb_xcc_id(); b.st = st;
    if (wg_leader(wave)) (void)xb_add(&bar[XB_XCNT(b.x)], 1u);
    return b;
}
__device__ __forceinline__ void xcd_barrier_complete(unsigned* bar, unsigned x, unsigned& nloc, unsigned& nx) {
    const unsigned G = gridDim.x * gridDim.y * gridDim.z;
    unsigned sum, cnt, mine, sp = 0u;
    for (;;) {
        sum = 0u; cnt = 0u; mine = 0u;
#pragma unroll
        for (unsigned j = 0; j < 16; ++j) { const unsigned c = xb_ld(&bar[XB_XCNT(j)]); sum += c; cnt += (c > 0u) ? 1u : 0u; mine = (j == x) ? c : mine; }
        if (sum == G) break;
        __builtin_amdgcn_s_sleep(1);
        if ((++sp & 255u) == 0u) { if (xb_ld(&bar[XB_TMO])) break; if (sp > XB_SPIN_CAP) { atomicAdd(&bar[XB_TMO], 1u); break; } }
    }
    nloc = mine > 0u ? mine : 1u; nx = cnt > 0u ? cnt : 1u;
}
__device__ __forceinline__ void xcd_barrier(const XcdBarrier& b, int wave) {
    asm volatile("s_waitcnt vmcnt(0)" ::: "memory");
    __syncthreads();
    if (wg_leader(wave)) {
        unsigned* bar = b.bar; asm volatile("" : "+s"(bar));
        __builtin_amdgcn_s_waitcnt(0);
        unsigned nloc = b.st[0], nx = b.st[1];
        if (nloc == 0u) { xcd_barrier_complete(bar, b.x, nloc, nx); b.st[0] = nloc; b.st[1] = nx; }
        const unsigned old = xb_add(&bar[XB_XSUB(b.x)], 1u);
        const unsigned gen = old / nloc;
        if (old + 1u == (gen + 1u) * nloc) {
            __builtin_amdgcn_fence(__ATOMIC_RELEASE, "agent");
            asm volatile("s_waitcnt vmcnt(0)" ::: "memory");
            const unsigned og = xb_add(&bar[XB_TOP], 1u);
            const unsigned tg = og / nx;
            if (og + 1u == (tg + 1u) * nx) xb_add(&bar[XB_TOPGEN], 1u);
            else XB_SPIN(xb_ld(&bar[XB_TOPGEN]) == tg, bar);
            __builtin_amdgcn_fence(__ATOMIC_ACQUIRE, "agent");
            xb_add(&bar[XB_XGEN(b.x)], 1u);
            asm volatile("s_waitcnt vmcnt(0)" ::: "memory");
        } else {
            XB_SPIN(xb_ld(&bar[XB_XGEN(b.x)]) == gen, bar);
            __builtin_amdgcn_fence(__ATOMIC_ACQUIRE, "agent");
            asm volatile("s_waitcnt vmcnt(0)" ::: "memory");
        }
    }
    __syncthreads();
}


namespace pg8 {
#define PG8_LAS __attribute__((address_space(3)))
typedef unsigned short bf16_t;
typedef short bf16x8 __attribute__((ext_vector_type(8)));
typedef float f32x4 __attribute__((ext_vector_type(4)));
typedef unsigned u32x4 __attribute__((ext_vector_type(4)));
typedef unsigned u32x2 __attribute__((ext_vector_type(2)));
typedef int i32x4 __attribute__((ext_vector_type(4)));
typedef int i32x8 __attribute__((ext_vector_type(8)));
constexpr int BM = 256, BK = 64, HALF = 128, HTB = HALF * BK * 2, STAGE_BYTES = 8 * HTB, NXCD = 8, WGM = 8;
__host__ __device__ __forceinline__ int lds_byte(int r, int c) { const int st = (r >> 4) * 2 + (c >> 5), rr = r & 15, cc = c & 31, ob = rr * 64 + cc * 2; return st * 1024 + (ob ^ (((ob >> 9) & 1) << 5)); }
__host__ __device__ __forceinline__ void stage_rc(int b, int& R, int& C) { const int st = b / 1024, sb = b % 1024, swz = sb ^ (((sb >> 9) & 1) << 5); R = (st >> 1) * 16 + swz / 64; C = (st & 1) * 32 + (swz % 64) / 2; }
__host__ __device__ __forceinline__ int perm32(int rho) { const int n = rho >> 4, i = rho & 15; return 8 * (i >> 2) + 4 * n + (i & 3); }
struct Unit { int pm, pn, pb, e; };
struct Gemm { const bf16_t* A; const bf16_t* Bt; int K; const PG8_LAS int* rowmap; };
struct StaticOrder {
    int nM, nN, nwg, G, c;
    __device__ __forceinline__ void init(int M, int N, int G_, int c_) { nM = M / BM; nN = N / BM; nwg = nM * nN; G = G_; c = c_; }
    __device__ __forceinline__ bool next(int i, Unit& u) const {
        const long L = (long)i * G + c; if (L >= nwg) return false;
        int wgid = (int)L; { const int q = nwg / NXCD, r = nwg % NXCD, xcd = wgid % NXCD, off = wgid / NXCD; wgid = (xcd < r ? xcd * (q + 1) : r * (q + 1) + (xcd - r) * q) + off; }
        const int nig = WGM * nN, gid = wgid / nig, fm = gid * WGM, gsz = (nM - fm) < WGM ? (nM - fm) : WGM;
        u.pm = fm + ((wgid % nig) % gsz); u.pn = (wgid % nig) / gsz; u.pb = u.pn; u.e = 0; return true;
    }
    __device__ __forceinline__ void a_ready(const Unit&) const {}
    __device__ __forceinline__ void done(const Unit&) const {}
};
struct MoeOrder {
    const PG8_LAS int* pend; int nb, ntn, G, vc;
    __device__ __forceinline__ bool next(int i, Unit& u) const {
        const int U = nb * ntn, per = G >> 3, chunk = (U + 7) >> 3, x = vc / per, r = vc - x * per;
        const int off = i * per + r; if (off >= chunk) return false;
        const long L = (long)x * chunk + off; if (L >= (long)U) return false;
        const int rb = (int)(L / ntn), pn = (int)(L % ntn); const int start = rb * 256; int e = 0, prev = 0;
#pragma unroll
        for (int j = 0; j < 32; ++j) { const int pj = pend[j]; if (start >= pj) { e += 1; prev = pj; } }
        e = e < 31 ? e : 31; e = __builtin_amdgcn_readfirstlane(e); prev = __builtin_amdgcn_readfirstlane(prev);
#if MOE_SPARSE
        u.pm = e * (16384 / 256) + (rb - prev / 256);
#else
        u.pm = rb;
#endif
        u.pn = pn; u.pb = e * ntn + pn; u.e = e; return true;
    }
    __device__ __forceinline__ void a_ready(const Unit&) const {}
    __device__ __forceinline__ void done(const Unit&) const {}
};
__device__ __forceinline__ unsigned cvt_pk_bf16(float lo, float hi) { unsigned r; asm volatile("v_cvt_pk_bf16_f32 %0, %1, %2" : "=v"(r) : "v"(lo), "v"(hi)); return r; }
__device__ __forceinline__ float fsig(float x) { return __builtin_amdgcn_rcpf(1.0f + __expf(-x)); }
#if WT_STORES
__device__ __forceinline__ void st16(void* p, u32x4 v) { asm volatile("global_store_dwordx4 %0, %1, off sc1\n\ts_nop 0" :: "v"(p), "v"(v) : "memory"); }
__device__ __forceinline__ void st8(void* p, u32x2 v) { asm volatile("global_store_dwordx2 %0, %1, off sc1\n\ts_nop 0" :: "v"(p), "v"(v) : "memory"); }
#elif NT_STORES
__device__ __forceinline__ void st16(void* p, u32x4 v) { __builtin_nontemporal_store(v, (u32x4*)p); }
__device__ __forceinline__ void st8(void* p, u32x2 v) { __builtin_nontemporal_store(v, (u32x2*)p); }
#else
__device__ __forceinline__ void st16(void* p, u32x4 v) { *(u32x4*)p = v; }
__device__ __forceinline__ void st8(void* p, u32x2 v) { *(u32x2*)p = v; }
#endif
template <bool OUT8> struct EpiBf16T {
    static constexpr bool PERM = true, AFTER_DRAIN = false;
    void* O; int ldc; const float* bias; int bias_estride; float scale;
    __device__ __forceinline__ void operator()(const f32x4 (&acc)[2][2][4][2], const Unit& u, int wr, int wc, int fr, int fq) const {
        const int row0 = u.pm * BM + wr * 64 + fr, col0 = u.pn * BM + wc * 32 + 8 * fq;
        f32x4 bv[2][2];
#pragma unroll
        for (int bj = 0; bj < 2; ++bj)
#pragma unroll
            for (int n = 0; n < 2; ++n) bv[bj][n] = bias ? *(const f32x4*)(bias + (size_t)u.e * bias_estride + col0 + bj * HALF + 4 * n) : (f32x4){0.f, 0.f, 0.f, 0.f};
#pragma unroll
        for (int ai = 0; ai < 2; ++ai)
#pragma unroll
            for (int m = 0; m < 4; ++m) { const size_t ro = (size_t)(row0 + ai * HALF + m * 16) * ldc + col0;
#pragma unroll
                for (int bj = 0; bj < 2; ++bj) { const f32x4 v0 = acc[ai][bj][m][0] * scale + bv[bj][0], v1 = acc[ai][bj][m][1] * scale + bv[bj][1];
                    if constexpr (OUT8) { int w0 = __builtin_amdgcn_cvt_pk_fp8_f32(v0[0], v0[1], 0, false); w0 = __builtin_amdgcn_cvt_pk_fp8_f32(v0[2], v0[3], w0, true); int w1 = __builtin_amdgcn_cvt_pk_fp8_f32(v1[0], v1[1], 0, false); w1 = __builtin_amdgcn_cvt_pk_fp8_f32(v1[2], v1[3], w1, true);
                        u32x2 w; w.x = (unsigned)w0; w.y = (unsigned)w1; st8((unsigned char*)O + ro + bj * HALF, w); }
                    else { u32x4 w; w.x = cvt_pk_bf16(v0[0], v0[1]); w.y = cvt_pk_bf16(v0[2], v0[3]); w.z = cvt_pk_bf16(v1[0], v1[1]); w.w = cvt_pk_bf16(v1[2], v1[3]);
                        st16((bf16_t*)O + ro + bj * HALF, w); } } }
    }
};
typedef EpiBf16T<false> EpiBf16;
struct EpiGlu {
    static constexpr bool PERM = true, AFTER_DRAIN = false;
    bf16_t* O; int ldc; const bf16_t* Y; int ldy; const float* bias;
    __device__ __forceinline__ void operator()(const f32x4 (&acc)[2][2][4][2], const Unit& u, int wr, int wc, int fr, int fq) const {
        const int row0 = u.pm * BM + wr * 64 + fr, col0 = u.pn * BM + wc * 32 + 8 * fq;
        f32x4 bv[2][2];
#pragma unroll
        for (int bj = 0; bj < 2; ++bj)
#pragma unroll
            for (int n = 0; n < 2; ++n) bv[bj][n] = *(const f32x4*)(bias + col0 + bj * HALF + 4 * n);
#pragma unroll
        for (int ai = 0; ai < 2; ++ai)
#pragma unroll
            for (int m = 0; m < 4; ++m) { const size_t r = (size_t)(row0 + ai * HALF + m * 16);
#pragma unroll
                for (int bj = 0; bj < 2; ++bj) { const int c = col0 + bj * HALF; const u32x4 yv = *(const u32x4*)(Y + r * ldy + c);
                    const f32x4 z0 = acc[ai][bj][m][0] + bv[bj][0], z1 = acc[ai][bj][m][1] + bv[bj][1];
                    float y[8]; y[0] = __uint_as_float(yv.x << 16); y[1] = __uint_as_float(yv.x & 0xffff0000u); y[2] = __uint_as_float(yv.y << 16); y[3] = __uint_as_float(yv.y & 0xffff0000u);
                    y[4] = __uint_as_float(yv.z << 16); y[5] = __uint_as_float(yv.z & 0xffff0000u); y[6] = __uint_as_float(yv.w << 16); y[7] = __uint_as_float(yv.w & 0xffff0000u);
                    u32x4 w; w.x = cvt_pk_bf16(y[0] * fsig(z0[0]), y[1] * fsig(z0[1])); w.y = cvt_pk_bf16(y[2] * fsig(z0[2]), y[3] * fsig(z0[3]));
                    w.z = cvt_pk_bf16(y[4] * fsig(z1[0]), y[5] * fsig(z1[1])); w.w = cvt_pk_bf16(y[6] * fsig(z1[2]), y[7] * fsig(z1[3]));
                    st16(O + r * ldc + c, w); } }
    }
};
struct EpiResF32 {
    static constexpr bool PERM = false, AFTER_DRAIN = false;
    float* C; const float* R; int ldc; float alpha;
    __device__ __forceinline__ void operator()(const f32x4 (&acc)[2][2][4][2], const Unit& u, int wr, int wc, int fr, int fq) const {
        const int row0 = u.pm * BM + wr * 64 + fr, col0 = u.pn * BM + wc * 32 + 4 * fq;
#pragma unroll
        for (int ai = 0; ai < 2; ++ai)
#pragma unroll
            for (int m = 0; m < 4; ++m) { const size_t off = (size_t)(row0 + ai * HALF + m * 16) * ldc + col0;
#pragma unroll
                for (int bj = 0; bj < 2; ++bj)
#pragma unroll
                    for (int n = 0; n < 2; ++n) { const f32x4 rv = *(const f32x4*)(R + off + bj * HALF + n * 16); *(f32x4*)(C + off + bj * HALF + n * 16) = rv * alpha + acc[ai][bj][m][n]; } }
    }
};
struct EpiResBf16 {
    static constexpr bool PERM = true, AFTER_DRAIN = false;
    bf16_t* O; const bf16_t* R; int ldc; float alpha;
    __device__ __forceinline__ void operator()(const f32x4 (&acc)[2][2][4][2], const Unit& u, int wr, int wc, int fr, int fq) const {
        const int row0 = u.pm * BM + wr * 64 + fr, col0 = u.pn * BM + wc * 32 + 8 * fq;
#pragma unroll
        for (int ai = 0; ai < 2; ++ai)
#pragma unroll
            for (int m = 0; m < 4; ++m) { const size_t off = (size_t)(row0 + ai * HALF + m * 16) * ldc + col0;
#pragma unroll
                for (int bj = 0; bj < 2; ++bj) { const u32x4 rv = *(const u32x4*)(R + off + bj * HALF); const f32x4 a0 = acc[ai][bj][m][0], a1 = acc[ai][bj][m][1];
                    u32x4 w; w.x = cvt_pk_bf16(__uint_as_float(rv.x << 16) * alpha + a0[0], __uint_as_float(rv.x & 0xffff0000u) * alpha + a0[1]); w.y = cvt_pk_bf16(__uint_as_float(rv.y << 16) * alpha + a0[2], __uint_as_float(rv.y & 0xffff0000u) * alpha + a0[3]);
                    w.z = cvt_pk_bf16(__uint_as_float(rv.z << 16) * alpha + a1[0], __uint_as_float(rv.z & 0xffff0000u) * alpha + a1[1]); w.w = cvt_pk_bf16(__uint_as_float(rv.w << 16) * alpha + a1[2], __uint_as_float(rv.w & 0xffff0000u) * alpha + a1[3]);
                    st16(O + off + bj * HALF, w); } }
    }
};
template <bool OUT8> struct EpiSwiglu {
    static constexpr bool PERM = true, AFTER_DRAIN = false;
    void* O; const float* bgu; float scale;
    __device__ __forceinline__ void operator()(const f32x4 (&acc)[2][2][4][2], const Unit& u, int wr, int wc, int fr, int fq) const {
        const int row0 = u.pm * BM + wr * 64 + fr, cidx = u.pn * HALF + wc * 32 + 8 * fq;
        const float* bg = bgu + (size_t)u.e * 2048 + cidx;
        f32x4 bG[2], bL[2];
#pragma unroll
        for (int n = 0; n < 2; ++n) { bG[n] = *(const f32x4*)(bg + 4 * n); bL[n] = *(const f32x4*)(bg + 1024 + 4 * n); }
#pragma unroll
        for (int ai = 0; ai < 2; ++ai)
#pragma unroll
            for (int m = 0; m < 4; ++m) { const size_t ro = (size_t)(row0 + ai * HALF + m * 16) * 1024 + cidx; float o[8];
#pragma unroll
                for (int n = 0; n < 2; ++n) { const f32x4 g = acc[ai][0][m][n] * scale + bG[n], l = acc[ai][1][m][n] * scale + bL[n];
#pragma unroll
                    for (int j = 0; j < 4; ++j) { const float xg = fminf(g[j], 7.0f), xl = fminf(fmaxf(l[j], -7.0f), 7.0f); o[4 * n + j] = xg * fsig(1.702f * xg) * (xl + 1.0f); } }
                if constexpr (OUT8) { int w0 = __builtin_amdgcn_cvt_pk_fp8_f32(o[0], o[1], 0, false); w0 = __builtin_amdgcn_cvt_pk_fp8_f32(o[2], o[3], w0, true); int w1 = __builtin_amdgcn_cvt_pk_fp8_f32(o[4], o[5], 0, false); w1 = __builtin_amdgcn_cvt_pk_fp8_f32(o[6], o[7], w1, true);
                    u32x2 w; w.x = (unsigned)w0; w.y = (unsigned)w1; st8((unsigned char*)O + ro, w); }
                else { u32x4 w; w.x = cvt_pk_bf16(o[0], o[1]); w.y = cvt_pk_bf16(o[2], o[3]); w.z = cvt_pk_bf16(o[4], o[5]); w.w = cvt_pk_bf16(o[6], o[7]);
                    st16((bf16_t*)O + ro, w); } }
    }
};
struct EpiMem {
    static constexpr bool PERM = false, AFTER_DRAIN = false;
    bf16_t* mk; bf16_t* mv; bf16_t* mvt;
    __device__ __forceinline__ void operator()(const f32x4 (&acc)[2][2][4][2], const Unit& u, int wr, int wc, int fr, int fq) const {
        const int row0 = u.pm * BM + wr * 64 + fr, col0 = u.pn * BM + wc * 32 + 4 * fq;
#pragma unroll
        for (int ai = 0; ai < 2; ++ai)
#pragma unroll
            for (int m = 0; m < 4; ++m) { const int r = row0 + ai * HALF + m * 16, b = r >> 8, key = r & 255;
#pragma unroll
                for (int bj = 0; bj < 2; ++bj)
#pragma unroll
                    for (int n = 0; n < 2; ++n) { const int c = col0 + bj * HALF + n * 16, cc = c & 255, head = cc >> 6, d = cc & 63; const f32x4 v = acc[ai][bj][m][n];
                        u32x2 w; w.x = cvt_pk_bf16(v[0], v[1]); w.y = cvt_pk_bf16(v[2], v[3]);
                        const size_t o = ((size_t)(b * 4 + head) * 256 + key) * 64 + d;
                        if (c < 256) *(u32x2*)(mk + o) = w;
                        else { *(u32x2*)(mv + o) = w; bf16_t* t = mvt + ((size_t)(b * 4 + head) * 64 + d) * 256 + key;
                            t[0] = (bf16_t)(w.x & 0xffffu); t[256] = (bf16_t)(w.x >> 16); t[512] = (bf16_t)(w.y & 0xffffu); t[768] = (bf16_t)(w.y >> 16); } } }
    }
};
template <class Epi, class Sched, bool ALIGN_EPI = true, bool SP2 = true, bool GATHER = false, bool FP8 = false>
__device__ __forceinline__ void gemm_phase(PG8_LAS unsigned char* lds, const Gemm g, const Sched& S, const Epi& E, const int wave_) {
    const int tid_ = wave_ * 64 + lane_id_opaque();
    const int tid = tid_, wid = wave_, lane = tid & 63, wr = wid >> 2, wc = wid & 3, fr = lane & 15, fq = lane >> 4;
    const int K = g.K, rowb = FP8 ? K : 2 * K  , nt = rowb / (BK * 2);
    unsigned voffA[2], voffB[2];
#pragma unroll
    for (int i = 0; i < 2; ++i) { int R, C; stage_rc(tid * 16 + i * 8192, R, C); const int Rb = Epi::PERM ? ((R & ~31) + perm32(R & 31)) : R;
        voffA[i] = (unsigned)(R * rowb + C * 2); voffB[i] = (unsigned)(Rb * rowb + C * 2); }
    const size_t kstep = (size_t)(BK * 2);
    const size_t hstep = (size_t)HALF * rowb;
    const size_t tstep = 2 * hstep;
    const unsigned ldsw = (unsigned)wid * 1024u;
    int aoffv[2], boffv[2];
#pragma unroll
    for (int k = 0; k < 2; ++k) { const int p = FP8 ? 2 * fq + k : 4 * k + fq; aoffv[k] = lds_byte(wr * 64 + fr, (p & 3) * 8) + (p >> 2) * 1024; boffv[k] = lds_byte(wc * 32 + fr, (p & 3) * 8) + (p >> 2) * 1024; }
#define PG8_SA(b, h) (((b) * 2 + (h)) * HTB)
#define PG8_SB(b, h) ((4 + (b) * 2 + (h)) * HTB)
#define PG8_STAGE(bufoff, gbase, voff) do { _Pragma("unroll") for (int _i = 0; _i < 2; ++_i) \
        __builtin_amdgcn_global_load_lds((const unsigned*)((const char*)(gbase) + (voff)[_i]), (PG8_LAS unsigned*)(lds + (bufoff) + ldsw + _i * 8192), 16, 0, 0); } while (0)
#define PG8_VSEL_0(h, i) vgC[h][i]
#define PG8_VSEL_1(h, i) (last ? vgX[h][i] : vgC[h][i])
#define PG8_STAGE_A(bufoff, gbase, h, set) do { if constexpr (GATHER) { _Pragma("unroll") for (int _i = 0; _i < 2; ++_i) \
        __builtin_amdgcn_global_load_lds((const unsigned*)((const char*)(gbase) + PG8_VSEL_##set(h, _i)), (PG8_LAS unsigned*)(lds + (bufoff) + ldsw + _i * 8192), 16, 0, 0); } \
    else { PG8_STAGE(bufoff, (gbase) + (h) * hstep, voffA); } } while (0)
#define PG8_LDA(dst, b, h) do { if constexpr (FP8) { _Pragma("unroll") for (int m = 0; m < 4; ++m) { const i32x4 lo_ = *(const PG8_LAS i32x4*)(lds + PG8_SA(b, h) + aoffv[0] + m * 2048), hi_ = *(const PG8_LAS i32x4*)(lds + PG8_SA(b, h) + aoffv[1] + m * 2048); dst##8[m] = __builtin_shufflevector(lo_, hi_, 0, 1, 2, 3, 4, 5, 6, 7); } } \
    else { _Pragma("unroll") for (int m = 0; m < 4; ++m) _Pragma("unroll") for (int k = 0; k < 2; ++k) dst[m][k] = *(const PG8_LAS bf16x8*)(lds + PG8_SA(b, h) + aoffv[k] + m * 2048); } } while (0)
#define PG8_LDB(dst, b, h) do { if constexpr (FP8) { _Pragma("unroll") for (int n = 0; n < 2; ++n) { const i32x4 lo_ = *(const PG8_LAS i32x4*)(lds + PG8_SB(b, h) + boffv[0] + n * 2048), hi_ = *(const PG8_LAS i32x4*)(lds + PG8_SB(b, h) + boffv[1] + n * 2048); dst##8[n] = __builtin_shufflevector(lo_, hi_, 0, 1, 2, 3, 4, 5, 6, 7); } } \
    else { _Pragma("unroll") for (int n = 0; n < 2; ++n) _Pragma("unroll") for (int k = 0; k < 2; ++k) dst[n][k] = *(const PG8_LAS bf16x8*)(lds + PG8_SB(b, h) + boffv[k] + n * 2048); } } while (0)
#define PG8_MMA(ai, bj, At, Bt) do { __builtin_amdgcn_s_setprio(1); _Pragma("unroll") for (int m = 0; m < 4; ++m) _Pragma("unroll") for (int n = 0; n < 2; ++n) { \
        if constexpr (FP8) { acc[ai][bj][m][n] = __builtin_amdgcn_mfma_scale_f32_16x16x128_f8f6f4(Bt##8[n], At##8[m], acc[ai][bj][m][n], 0, 0, 0, 0x7f7f7f7f, 0, 0x7f7f7f7f); } \
        else { _Pragma("unroll") for (int k = 0; k < 2; ++k) acc[ai][bj][m][n] = __builtin_amdgcn_mfma_f32_16x16x32_bf16(Bt[n][k], At[m][k], acc[ai][bj][m][n], 0, 0, 0); } } \
        if constexpr (FP8) { _Pragma("unroll") for (int m = 0; m < 4; ++m) asm volatile("" : "+v"(acc[ai][bj][m][0]), "+v"(acc[ai][bj][m][1])); }     \
        __builtin_amdgcn_s_setprio(0); } while (0)
#define PG8_WAIT_V(n) asm volatile("s_waitcnt vmcnt(" #n ")" ::: "memory")
#define PG8_WAIT_L(n) asm volatile("s_waitcnt lgkmcnt(" #n ")" ::: "memory")
#define PG8_BAR __builtin_amdgcn_s_barrier()
#define PG8_SCHED __builtin_amdgcn_sched_barrier(0)
    Unit cur, nxt; int ui = 0;
    if (!S.next(0, cur)) return;
    f32x4 acc[2][2][4][2];
#pragma unroll
    for (int a = 0; a < 2; ++a)
#pragma unroll
        for (int b = 0; b < 2; ++b)
#pragma unroll
            for (int m = 0; m < 4; ++m)
#pragma unroll
                for (int n = 0; n < 2; ++n) acc[a][b][m][n] = (f32x4){0.f, 0.f, 0.f, 0.f};
    bf16x8 At[4][2], B0[2][2], B1[2][2];
    i32x8 At8[4], B08[2], B18[2];
    unsigned vgC[2][2], vgX[2][2];
#define PG8_GOFF(dst, pm_) do { const int t_ = wave_ * 64 + lane_id_opaque();   _Pragma("unroll") for (int _i = 0; _i < 2; ++_i) { int gR_, gC_; stage_rc(t_ * 16 + _i * 8192, gR_, gC_); _Pragma("unroll") for (int _h = 0; _h < 2; ++_h) \
        dst[_h][_i] = (unsigned)(g.rowmap[(pm_) * BM + _h * HALF + gR_] * rowb + gC_ * 2); } } while (0)
    if constexpr (GATHER) { PG8_GOFF(vgC, 0); }
    const char* cA = GATHER ? (const char*)g.A : (const char*)g.A + (size_t)cur.pm * tstep; const char* cB = (const char*)g.Bt + (size_t)cur.pb * tstep;
    S.a_ready(cur);
    if constexpr (SP2) {
        PG8_STAGE(PG8_SB(0, 0), cB, voffB); PG8_STAGE(PG8_SB(0, 1), cB + hstep, voffB); PG8_STAGE_A(PG8_SA(0, 0), cA, 0, 0); PG8_STAGE_A(PG8_SA(0, 1), cA, 1, 0);
        if (wr == 1) PG8_BAR;
        PG8_WAIT_V(2); PG8_BAR;
        PG8_STAGE(PG8_SB(1, 0), cB + kstep, voffB); PG8_STAGE_A(PG8_SA(1, 0), cA + kstep, 0, 0); PG8_STAGE(PG8_SB(1, 1), cB + hstep + kstep, voffB);
        PG8_WAIT_V(6); PG8_BAR;
    } else {
        PG8_STAGE(PG8_SB(0, 0), cB, voffB); PG8_STAGE_A(PG8_SA(0, 0), cA, 0, 0); PG8_STAGE(PG8_SB(0, 1), cB + hstep, voffB); PG8_STAGE_A(PG8_SA(0, 1), cA, 1, 0);
        if (wr == 1) PG8_BAR;
        PG8_WAIT_V(4); PG8_BAR;
        PG8_STAGE(PG8_SB(1, 0), cB + kstep, voffB); PG8_STAGE_A(PG8_SA(1, 0), cA + kstep, 0, 0); PG8_STAGE(PG8_SB(1, 1), cB + hstep + kstep, voffB);
        PG8_WAIT_V(6); PG8_BAR;
    }
    for (;;) {
        const bool has_next = S.next(ui + 1, nxt);
        if constexpr (GATHER) { if (has_next) PG8_GOFF(vgX, ui + 1); else { _Pragma("unroll") for (int _h = 0; _h < 2; ++_h) _Pragma("unroll") for (int _i = 0; _i < 2; ++_i) vgX[_h][_i] = vgC[_h][_i]; } }
        const char* nA = GATHER ? (const char*)g.A : (has_next ? (const char*)g.A + (size_t)nxt.pm * tstep : cA); const char* nB = has_next ? (const char*)g.Bt + (size_t)nxt.pb * tstep : cB;
        for (int t = 0; t < nt; t += 2) {
            const bool last = (t == nt - 2);
            const char* a1 = cA + (size_t)(t + 1) * kstep;
            const char* a2 = last ? nA : cA + (size_t)(t + 2) * kstep; const char* b2 = last ? nB : cB + (size_t)(t + 2) * kstep;
            const char* a3 = a2 + kstep; const char* b3 = b2 + kstep;
            if (last && has_next) S.a_ready(nxt);
            if constexpr (SP2) {
            PG8_LDB(B0, 0, 0); PG8_LDB(B1, 0, 1); PG8_SCHED; PG8_LDA(At, 0, 0); PG8_STAGE_A(PG8_SA(1, 1), a1, 1, 0);
            PG8_WAIT_V(8); PG8_WAIT_L(0); PG8_BAR; PG8_MMA(0, 0, At, B0); PG8_MMA(0, 1, At, B1); PG8_BAR; PG8_SCHED;
            PG8_LDA(At, 0, 1); PG8_STAGE(PG8_SB(0, 0), b2, voffB); PG8_STAGE(PG8_SB(0, 1), b2 + hstep, voffB); PG8_STAGE_A(PG8_SA(0, 0), a2, 0, 1);
            PG8_WAIT_V(8); PG8_WAIT_L(0); PG8_BAR; PG8_MMA(1, 0, At, B0); PG8_MMA(1, 1, At, B1); PG8_BAR; PG8_SCHED;
            PG8_LDB(B0, 1, 0); PG8_LDB(B1, 1, 1); PG8_SCHED; PG8_LDA(At, 1, 0); PG8_STAGE_A(PG8_SA(0, 1), a2, 1, 1);
            PG8_WAIT_V(8); PG8_WAIT_L(0); PG8_BAR; PG8_MMA(0, 0, At, B0); PG8_MMA(0, 1, At, B1); PG8_BAR; PG8_SCHED;
            PG8_LDA(At, 1, 1); PG8_STAGE(PG8_SB(1, 0), b3, voffB); PG8_STAGE(PG8_SB(1, 1), b3 + hstep, voffB); PG8_STAGE_A(PG8_SA(1, 0), a3, 0, 1);
            PG8_WAIT_V(8); PG8_WAIT_L(0); PG8_BAR; PG8_MMA(1, 0, At, B0); PG8_MMA(1, 1, At, B1); PG8_BAR; PG8_SCHED;
            } else {
            PG8_LDB(B0, 0, 0); PG8_SCHED; PG8_LDA(At, 0, 0); PG8_STAGE_A(PG8_SA(1, 1), a1, 1, 0);
            PG8_WAIT_L(8); PG8_BAR; PG8_WAIT_L(0); PG8_MMA(0, 0, At, B0); PG8_BAR; PG8_SCHED;
            PG8_LDB(B1, 0, 1); PG8_STAGE(PG8_SB(0, 0), b2, voffB);
            PG8_BAR; PG8_WAIT_L(0); PG8_MMA(0, 1, At, B1); PG8_BAR;
            PG8_LDA(At, 0, 1); PG8_STAGE_A(PG8_SA(0, 0), a2, 0, 1);
            PG8_BAR; PG8_WAIT_L(0); PG8_MMA(1, 0, At, B0); PG8_BAR; PG8_SCHED;
            PG8_STAGE(PG8_SB(0, 1), b2 + hstep, voffB);
            PG8_WAIT_V(6); PG8_BAR; PG8_MMA(1, 1, At, B1); PG8_BAR;
            PG8_LDB(B0, 1, 0); PG8_SCHED; PG8_LDA(At, 1, 0); PG8_STAGE_A(PG8_SA(0, 1), a2, 1, 1);
            PG8_WAIT_L(8); PG8_BAR; PG8_WAIT_L(0); PG8_MMA(0, 0, At, B0); PG8_BAR; PG8_SCHED;
            PG8_LDB(B1, 1, 1); PG8_STAGE(PG8_SB(1, 0), b3, voffB);
            PG8_BAR; PG8_WAIT_L(0); PG8_MMA(0, 1, At, B1); PG8_BAR;
            PG8_LDA(At, 1, 1); PG8_STAGE_A(PG8_SA(1, 0), a3, 0, 1);
            PG8_BAR; PG8_WAIT_L(0); PG8_MMA(1, 0, At, B0); PG8_BAR; PG8_SCHED;
            PG8_STAGE(PG8_SB(1, 1), b3 + hstep, voffB);
            PG8_WAIT_V(6); PG8_BAR; PG8_MMA(1, 1, At, B1); PG8_BAR;
            }
        }
        if constexpr (ALIGN_EPI) { if (wr == 0) PG8_BAR; }
        if constexpr (!Epi::AFTER_DRAIN) { const int l2_ = lane_id_opaque(); E(acc, cur, wr, wc, l2_ & 15, l2_ >> 4); S.done(cur); }
        if (!has_next) break;
#pragma unroll
        for (int a = 0; a < 2; ++a)
#pragma unroll
            for (int b = 0; b < 2; ++b)
#pragma unroll
                for (int m = 0; m < 4; ++m)
#pragma unroll
                    for (int n = 0; n < 2; ++n) acc[a][b][m][n] = (f32x4){0.f, 0.f, 0.f, 0.f};
        cur = nxt; cA = nA; cB = nB; ++ui;
        if constexpr (GATHER) { _Pragma("unroll") for (int _h = 0; _h < 2; ++_h) _Pragma("unroll") for (int _i = 0; _i < 2; ++_i) vgC[_h][_i] = vgX[_h][_i]; }
        if constexpr (ALIGN_EPI) { if (wr == 1) PG8_BAR; }
    }
    PG8_WAIT_V(0);
    if constexpr (!ALIGN_EPI) { if (wr == 0) PG8_BAR; }
    PG8_BAR;
    if constexpr (Epi::AFTER_DRAIN) { E.fused(acc, cur, wr, wc, fr, fq, lds, wid, lane); S.done(cur); }
#undef PG8_GOFF
#undef PG8_SA
#undef PG8_SB
#undef PG8_STAGE
#undef PG8_STAGE_A
#undef PG8_VSEL_0
#undef PG8_VSEL_1
#undef PG8_LDA
#undef PG8_LDB
#undef PG8_MMA
#undef PG8_WAIT_V
#undef PG8_WAIT_L
#undef PG8_BAR
#undef PG8_SCHED
}
}

template <class TC, class LA, class LB, class EP>
__device__ __forceinline__ void oracle_gemm(LAS float* lds, int M, int N, int K, TC tilectx, LA loadA, LB loadB, EP epi) {
    LAS float* As = lds; LAS float* Bs = lds + 16 * 132;
    int tid = threadIdx.x; asm volatile("" : "+v"(tid)); const int ty = tid >> 4, tx = tid & 15;
    const int ntm = M / 128, ntn = (N + 127) / 128;
    for (int tile = blockIdx.x; tile < ntm * ntn; tile += gridDim.x) {
        const int tm = tile / ntn, tn = tile % ntn;
        const int ctx = tilectx(tm);
        float acc[4][8];
#pragma unroll
        for (int i = 0; i < 4; ++i)
#pragma unroll
            for (int j = 0; j < 8; ++j) acc[i][j] = 0.f;
        for (int k0 = 0; k0 < K; k0 += 16) {
#pragma unroll
            for (int i = 0; i < 4; ++i) { const int idx = tid + 512 * i; const int r = idx >> 4, kk = idx & 15; As[kk * 132 + r] = loadA(tm * 128 + r, k0 + kk); }
#pragma unroll
            for (int i = 0; i < 4; ++i) { const int idx = tid + 512 * i; const int kk = idx >> 7, n = idx & 127; Bs[kk * 132 + n] = loadB(k0 + kk, tn * 128 + n, ctx); }
            __syncthreads();
#pragma unroll 2
            for (int kk = 0; kk < 16; ++kk) {
                float a[4], b[8];
#pragma unroll
                for (int i = 0; i < 4; ++i) a[i] = As[kk * 132 + ty * 4 + i];
#pragma unroll
                for (int j = 0; j < 8; ++j) b[j] = Bs[kk * 132 + tx * 8 + j];
#pragma unroll
                for (int i = 0; i < 4; ++i)
#pragma unroll
                    for (int j = 0; j < 8; ++j) acc[i][j] += a[i] * b[j];
            }
            __syncthreads();
        }
        epi(tm * 128 + ty * 4, tn * 128 + tx * 8, acc, ctx);
    }
}


template <class MAP>
__device__ __forceinline__ void tr_item(const float* W, int ldw, int K, bf16* WT, int nblk, int item, LAS float* scr, int lane, MAP map) {
    const int kb = item / nblk, nb = item % nblk, k0 = kb * 64, n0 = nb * 64;
    const int s = map(n0 + lane);
    const float* wp = W + (size_t)k0 * ldw + (s >= 0 ? s : 0);
#pragma unroll 8
    for (int i = 0; i < 64; ++i) scr[i * 65 + lane] = (s >= 0) ? wp[(size_t)i * ldw] : 0.f;
    asm volatile("s_waitcnt lgkmcnt(0)" ::: "memory");
    const int c = lane & 7;
#pragma unroll
    for (int j = 0; j < 8; ++j) { const int n = (lane >> 3) + 8 * j; const LAS float* sp = scr + (8 * c) * 65 + n;
        uint4 o; o.x = pg8::cvt_pk_bf16(sp[0], sp[65]); o.y = pg8::cvt_pk_bf16(sp[130], sp[195]); o.z = pg8::cvt_pk_bf16(sp[260], sp[325]); o.w = pg8::cvt_pk_bf16(sp[390], sp[455]);
        *(uint4*)(WT + (size_t)(n0 + n) * K + k0 + 8 * c) = o; }
    asm volatile("s_waitcnt lgkmcnt(0)" ::: "memory");
}

template <int DEEP, class MAP>
__device__ __forceinline__ void tr_item8(const float* W, int ldw, int K, unsigned char* WT8, int nblk, int item, LAS float* scr, int lane, float scale, MAP map) {
    const int kb = item / nblk, nb = item % nblk, k0 = kb * 64, n0 = nb * 64;
    const int s = map(n0 + lane);
    const float* wp = W + (size_t)k0 * ldw + (s >= 0 ? s : 0);
    if constexpr (DEEP) {
#pragma unroll
        for (int h2 = 0; h2 < 2; ++h2) { float v[32];
#pragma unroll
            for (int i = 0; i < 32; ++i) v[i] = (s >= 0) ? wp[(size_t)(32 * h2 + i) * ldw] : 0.f;
#pragma unroll
            for (int i = 0; i < 32; ++i) scr[(32 * h2 + i) * 65 + lane] = v[i] * scale; }
    } else {
#pragma unroll 8
        for (int i = 0; i < 64; ++i) scr[i * 65 + lane] = (s >= 0) ? wp[(size_t)i * ldw] * scale : 0.f;
    }
    asm volatile("s_waitcnt lgkmcnt(0)" ::: "memory");
    const int c = lane & 7;
#pragma unroll
    for (int j = 0; j < 8; ++j) { const int n = (lane >> 3) + 8 * j; const LAS float* sp = scr + (8 * c) * 65 + n;
        int w0 = __builtin_amdgcn_cvt_pk_fp8_f32(sp[0], sp[65], 0, false); w0 = __builtin_amdgcn_cvt_pk_fp8_f32(sp[130], sp[195], w0, true);
        int w1 = __builtin_amdgcn_cvt_pk_fp8_f32(sp[260], sp[325], 0, false); w1 = __builtin_amdgcn_cvt_pk_fp8_f32(sp[390], sp[455], w1, true);
        uint2 o; o.x = (unsigned)w0; o.y = (unsigned)w1; *(uint2*)(WT8 + (size_t)(n0 + n) * K + k0 + 8 * c) = o; }
    asm volatile("s_waitcnt lgkmcnt(0)" ::: "memory");
}

struct Args { const void* in[46]; float* out; unsigned char* ws; int ph_lo, ph_hi; };

enum { PH_PRO = 0, PH_MEM = 1, PH_L0 = 2, PH_PER_LAYER = 9, PH_TOTAL = 2 + 9 * DEPTH };
enum { LP_INPROJ = 0, LP_MIXA = 1, LP_MIXB = 2, LP_OUTPROJ = 3, LP_LN1 = 4, LP_DISP = 5, LP_GU = 6, LP_DOWN = 7, LP_COMB = 8 };

__device__ __forceinline__ int expert_of_block(const LAS int* pend, int rb) {
    const int start = rb * MOEBLK; int e = 0;
#pragma unroll
    for (int i = 0; i < NEXP; ++i) e += (start >= pend[i]) ? 1 : 0;
    return e < NEXP - 1 ? e : NEXP - 1;
}

typedef const void* const __attribute__((address_space(4)))* KARG;
__global__ void __launch_bounds__(NTHR, 2) mk_fwd(Args args) {
    extern __shared__ __attribute__((aligned(16))) unsigned char lds_raw[];
    LAS unsigned char* lds = (LAS unsigned char*)lds_raw;
    LAS float* ldsf = (LAS float*)lds;
    volatile LAS unsigned* MISC = (volatile LAS unsigned*)(lds + LDS_MISC);
    const int tid0 = threadIdx.x, wave0 = __builtin_amdgcn_readfirstlane(tid0 >> 6);
    const int G = gridDim.x, bid = blockIdx.x;
#define LDS_BARRIER() do { asm volatile("s_waitcnt lgkmcnt(0)" ::: "memory"); __builtin_amdgcn_s_barrier(); asm volatile("" ::: "memory"); } while (0)
#define ARGP(i) ((const void*)kp_[i])
#define PHASE_IDS() int wave = wave0; asm volatile("" : "+s"(wave)); KARG kp_ = (KARG)__builtin_amdgcn_kernarg_segment_ptr(); asm volatile("" : "+s"(kp_)); unsigned char* ws = ws0; asm volatile("" : "+s"(ws)); unsigned* const ctl = (unsigned*)(ws + WS_CTL); (void)ctl; const int tid = wave * 64 + lane_id_opaque(); const int lane = tid & 63; (void)lane
    unsigned char* const ws0 = args.ws;
    unsigned* const ctl0 = (unsigned*)(ws0 + WS_CTL);
#define hf ((float*)(ws + WS_HF))
#define y2 ((float*)(ws + WS_Y2))
#define hb ((bf16*)(ws + WS_HB))
#define proj ((bf16*)(ws + WS_PROJ))
#define yg ((bf16*)(ws + WS_YG))
#define cat ((bf16*)(ws + WS_CAT))
#define top_e ((int*)(ws + WS_TOPE))
#define top_g ((float*)(ws + WS_TOPG))
#define dest ((int*)(ws + WS_DEST))
#define xr ((bf16*)(ws + WS_XR))
#define act ((bf16*)(ws + WS_ACT))
#define yr ((bf16*)(ws + WS_YR))
#define memK ((bf16*)(ws + WS_MEMK))
#define memV ((bf16*)(ws + WS_MEMV))
#define memVT ((bf16*)(ws + WS_MEMVT))
#define rope ((float*)(ws + WS_ROPE))
#define win_t ((bf16*)(ws + WS_WIN))
#define wglu_t ((bf16*)(ws + WS_WGLU))
#define wout_t ((bf16*)(ws + WS_WOUT))
#define wmem_t ((bf16*)(ws + WS_WMEM))
#define memb ((bf16*)(ws + WS_MEMB))
#define wgu_t ((bf16*)(ws + WS_WGU))
#define wdn_t ((bf16*)(ws + WS_WDN))
#define rwt ((bf16*)(ws + WS_RWT))
#define row_tok ((int*)(ws + WS_RTOK))
#define wgu8 (ws + WS_WGU)
#define wdn8 (ws + WS_WDN)
#define act8 (ws + WS_ACT)
#define hb8 (ws + WS_XR)
    constexpr float GU_WS = 32.0f, DN_WS = 64.0f;
    const int vcu = (G % 8 == 0) ? (bid % 8) * (G / 8) + bid / 8 : bid;

    if (tid0 < 64) MISC[tid0] = 0u;
    __syncthreads();
    const int lo = args.ph_lo, hi = args.ph_hi;
    XcdBarrier bar; bar.bar = ctl0 + CW_BAR; bar.x = 0; bar.st = MISC;
    if (hi - lo > 1) bar = xcd_barrier_post(ctl0 + CW_BAR, MISC, wave0);
#define IN(k) (lo <= (k) && (k) < hi)
#define SEAM(k) do { if (IN(k) && IN((k) + 1)) xcd_barrier(bar, wave0); } while (0)

    if (IN(PH_PRO)) {
            PHASE_IDS();
            REPS(0) { if (rep_) __syncthreads();
        {
            LAS float* scr = ldsf + wave * (64 * 65);
            const int gw = vcu * NWAVES + wave, NGW = G * NWAVES;
            constexpr int PRO_LAYERS = BG_CONV ? ((BG_ALL && LINATT_V2) ? 0 : 1) : DEPTH;
            constexpr int N_GU = FAST_MOE ? PRO_LAYERS * NEXP * 512 : 0, N_DN = FAST_MOE ? PRO_LAYERS * NEXP * 256 : 0;
            constexpr int N_IN0 = FAST_DENSE ? 256 : 0, N_IN1 = FAST_DENSE ? 704 : 0, N_IN2 = FAST_DENSE ? 640 : 0, N_IN3 = N_IN0, N_GLU = FAST_DENSE ? 144 : 0, N_OUT = FAST_DENSE ? 256 : 0, N_MEM = FAST_DENSE ? 64 : 0;
            constexpr int NITEMS = N_GU + N_DN + N_IN0 + N_IN1 + N_IN2 + N_IN3 + 2 * N_GLU + 4 * N_OUT + 2 * N_MEM;
            for (int it = gw; it < NITEMS; it += NGW) {
                int r = it;
                if (r < N_GU) { const int le = r >> 9;
#if MOE_FP8
                    tr_item8<0>((const float*)ARGP(42) + (size_t)le * D * 2 * DEXP, 2 * DEXP, D, wgu8 + (size_t)le * 2 * DEXP * D, 32, r & 511, scr, lane, GU_WS, [](int d) { const int tile = d >> 8, q = d & 255; return q < 128 ? tile * 128 + q : DEXP + tile * 128 + (q - 128); });
#else
                    tr_item((const float*)ARGP(42) + (size_t)le * D * 2 * DEXP, 2 * DEXP, D, wgu_t + (size_t)le * 2 * DEXP * D, 32, r & 511, scr, lane, [](int d) { const int tile = d >> 8, q = d & 255; return q < 128 ? tile * 128 + q : DEXP + tile * 128 + (q - 128); });
#endif
                    continue; } r -= N_GU;
                if (r < N_DN) { const int le = r >> 8;
#if MOE_FP8
                    tr_item8<0>((const float*)ARGP(44) + (size_t)le * DEXP * D, D, DEXP, wdn8 + (size_t)le * D * DEXP, 16, r & 255, scr, lane, DN_WS, [](int d) { return d; });
#else
                    tr_item((const float*)ARGP(44) + (size_t)le * DEXP * D, D, DEXP, wdn_t + (size_t)le * D * DEXP, 16, r & 255, scr, lane, [](int d) { return d; });
#endif
                    continue; } r -= N_DN;
                if (r < N_IN0) { tr_item((const float*)ARGP(5), 1024, D, win_t, 16, r, scr, lane, [](int d) { return d; }); continue; } r -= N_IN0;
                if (r < N_IN1) { tr_item((const float*)ARGP(16), 2568, D, win_t + (size_t)1 * 3 * MiB, 44, r, scr, lane, [](int d) { return d < 2568 ? d : -1; }); continue; } r -= N_IN1;
                if (r < N_IN2) { tr_item((const float*)ARGP(22), 2560, D, win_t + (size_t)2 * 3 * MiB, 40, r, scr, lane, [](int d) { return d; }); continue; } r -= N_IN2;
                if (r < N_IN3) { tr_item((const float*)ARGP(24), 1024, D, win_t + (size_t)3 * 3 * MiB, 16, r, scr, lane, [](int d) { return d; }); continue; } r -= N_IN3;
                if (r < N_GLU) { tr_item((const float*)ARGP(14), MIXW, MIXW, wglu_t, 12, r, scr, lane, [](int d) { return d; }); continue; } r -= N_GLU;
                if (r < N_GLU) { tr_item((const float*)ARGP(33), MIXW, MIXW, wglu_t + (size_t)1 * MiB, 12, r, scr, lane, [](int d) { return d; }); continue; } r -= N_GLU;
                if (r < 4 * N_OUT) { const int l = r >> 8; tr_item((const float*)ARGP(35) + (size_t)l * D * D, D, D, wout_t + (size_t)l * D * D, 16, r & 255, scr, lane, [](int d) { return d; }); continue; } r -= 4 * N_OUT;
                if (r < N_MEM) { tr_item((const float*)ARGP(3), 256, D, wmem_t, 4, r, scr, lane, [](int d) { return d; }); continue; } r -= N_MEM;
                tr_item((const float*)ARGP(4), 256, D, wmem_t + (size_t)256 * D, 4, r, scr, lane, [](int d) { return d; });
            }
            const float* mem = (const float*)ARGP(1);
            for (size_t i = ((size_t)bid * NTHR + tid) * 4; i < (size_t)NB * NMEM * D; i += (size_t)G * NTHR * 4) {
                const float4 v = *(const float4*)(mem + i); uint2 o; o.x = pg8::cvt_pk_bf16(v.x, v.y); o.y = pg8::cvt_pk_bf16(v.z, v.w); *(uint2*)(memb + i) = o; }
        }
        {
            const float* rwf = (const float*)ARGP(40);
            for (int i = bid * NTHR + tid; i < DEPTH * NEXP * D; i += G * NTHR) { const int l = i / (NEXP * D), rem = i % (NEXP * D), e = rem / D, k = rem % D;
                const float v = rwf[((size_t)l * D + k) * NEXP + e]; const bf16 hi_ = f2bf(v); const bf16 lo_ = f2bf(v - bf2f(hi_));
                rwt[((size_t)(l * 2 + 0) * NEXP + e) * D + k] = hi_; rwt[((size_t)(l * 2 + 1) * NEXP + e) * D + k] = lo_; }
        }
        const float* x = (const float*)ARGP(0);
        for (size_t i = ((size_t)bid * NTHR + tid) * 4; i < (size_t)T * D; i += (size_t)G * NTHR * 4) {
            const float4 v = *(const float4*)(x + i);
#if !RES_BF16
            *(float4*)(hf + i) = v;
#endif
            uint2 o; o.x = pk2(v.x, v.y); o.y = pk2(v.z, v.w); *(uint2*)(hb + i) = o;
        }
        const int* pos = (const int*)ARGP(2);
        for (int idx = bid * NTHR + tid; idx < T * 48; idx += G * NTHR) {
            const int t = idx / 48, i = idx % 48;
            const double inv = exp(-((double)(2 * i) / 96.0) * 9.210340371976184);
            double r = (double)pos[t] * inv * 0.15915494309189535; r -= rint(r);
            const float rf = (float)r;
            typedef _Float16 h2_t __attribute__((ext_vector_type(2))); h2_t cs_; cs_.x = (_Float16)__builtin_amdgcn_cosf(rf); cs_.y = (_Float16)__builtin_amdgcn_sinf(rf);
            ((unsigned*)rope)[idx] = __builtin_bit_cast(unsigned, cs_);
        }
    } }
    SEAM(PH_PRO);

    if (IN(PH_MEM)) {
            PHASE_IDS();
            REPS(1) { if (rep_) __syncthreads();
#if FAST_DENSE
        { pg8::Gemm g{memb, wmem_t, D, nullptr}; pg8::StaticOrder S; S.init(NB * NMEM, 512, G, bid); pg8::EpiMem E{memK, memV, memVT}; pg8::gemm_phase(lds, g, S, E, wave); }
#else
        const float* mem = (const float*)ARGP(1); const float* wk = (const float*)ARGP(3); const float* wv = (const float*)ARGP(4);
        oracle_gemm(ldsf, NB * NMEM, 512, D,
            [&](int) { return 0; },
            [&](int m, int k) { return mem[(size_t)m * D + k]; },
            [&](int k, int n, int) { return n < 256 ? wk[(size_t)k * 256 + n] : wv[(size_t)k * 256 + n - 256]; },
            [&](int m0, int n0, float (&acc)[4][8], int) {
#pragma unroll
                for (int i = 0; i < 4; ++i)
#pragma unroll
                    for (int j = 0; j < 8; ++j) { const int m = m0 + i, n = n0 + j; const int b = m >> 8, key = m & 255; const int nn = n & 255, head = nn >> 6, d = nn & 63; const bf16 v = f2bf(acc[i][j]);
                        if (n < 256) memK[((size_t)(b * 4 + head) * 256 + key) * 64 + d] = v;
                        else { memV[((size_t)(b * 4 + head) * 256 + key) * 64 + d] = v; memVT[((size_t)(b * 4 + head) * 64 + d) * 256 + key] = v; } }
            });
#endif
    } }

    for (int L = 0; L < DEPTH; ++L) {
        const int P = PH_L0 + PH_PER_LAYER * L;
        const int kind = L % 3;
        const int Nin = (kind == 0) ? 1024 : (kind == 1 ? 2568 : 2560);
        const int xq_off = (kind == 0) ? 768 : (kind == 1 ? 2312 : 2304);

        if (IN(P + LP_INPROJ)) {
            PHASE_IDS();
            REPS(2) { if (rep_) __syncthreads();
#if FAST_DENSE
            { const int Npad = (kind == 0) ? 1024 : (kind == 1 ? 2816 : 2560);
              pg8::Gemm g{hb, win_t + (size_t)L * 3 * MiB, D, nullptr}; pg8::StaticOrder S; S.init(T, Npad, G, bid); pg8::EpiBf16 E{proj, LDP, nullptr, 0, 1.0f}; pg8::gemm_phase(lds, g, S, E, wave); }
#else
            const float* w_in = (const float*)(L == 0 ? ARGP(5) : L == 1 ? ARGP(16) : L == 2 ? ARGP(22) : ARGP(24));
            oracle_gemm(ldsf, T, Nin, D,
                [&](int) { return 0; },
                [&](int m, int k) { return bf2f(hb[(size_t)m * D + k]); },
                [&](int k, int n, int) { return n < Nin ? w_in[(size_t)k * Nin + n] : 0.f; },
                [&](int m0, int n0, float (&acc)[4][8], int) {
#pragma unroll
                    for (int i = 0; i < 4; ++i)
#pragma unroll
                        for (int j = 0; j < 8; ++j) if (n0 + j < Nin) proj[(size_t)(m0 + i) * LDP + n0 + j] = f2bf(acc[i][j]);
                });
#endif
        } }
        SEAM(P + LP_INPROJ);

        if (IN(P + LP_MIXA)) {
            PHASE_IDS();
            REPS(kind == 0 ? 11 : 12) { if (rep_) __syncthreads();
            if (kind == 0) {
                const int o = (L == 0) ? 6 : 25;
                const float* a_re = (const float*)args.in[o + 0]; const float* a_im = (const float*)args.in[o + 1]; const float* log_dt = (const float*)args.in[o + 2];
                const float* b_re = (const float*)args.in[o + 3]; const float* b_im = (const float*)args.in[o + 4]; const float* c_re = (const float*)args.in[o + 5];
                const float* c_im = (const float*)args.in[o + 6]; const float* d_skip = (const float*)args.in[o + 7];
#if FAST_S5
                typedef pg8::bf16x8 bx8; typedef pg8::f32x4 fx4;
                LAS float* BU = (LAS float*)(lds + wave * 32768);
                LAS bf16* XS = (LAS bf16*)(lds + wave * 32768 + 16896);
                for (int unit = wave * G + vcu; wave < 4 && unit < NB * 48; unit += G * 4) {
                    const int b = unit / 48, g = unit % 48, p = lane, tok = lane & 15, sg = lane >> 4;
                    const float lre = fminf(a_re[g * 64 + p], -1e-4f), lim = a_im[g * 64 + p];
                    const float dt = __expf(log_dt[g]);
                    const float mag = __expf(dt * lre); float sn, cs; sincos_rad(dt * lim, sn, cs);
                    const float abr = mag * cs, abi = mag * sn;
                    const float den = lre * lre + lim * lim, nr = abr - 1.0f;
                    const float cr = (nr * lre + abi * lim) / den, ci = (abi * lre - nr * lim) / den;
                    bx8 Bf[8], Cf[4];
#pragma unroll
                    for (int tI = 0; tI < 4; ++tI) {
                        const int sp = 16 * tI + tok; const float crs = sh_idx(cr, sp, lane), cis = sh_idx(ci, sp, lane);
                        unsigned wr_[4] = {0u, 0u, 0u, 0u}, wi_[4] = {0u, 0u, 0u, 0u};
                        if (sg < 2) { const float4* pr_ = (const float4*)(b_re + (size_t)(g * 64 + sp) * 16 + 8 * sg); const float4* pi_ = (const float4*)(b_im + (size_t)(g * 64 + sp) * 16 + 8 * sg);
                            const float4 r0 = pr_[0], r1 = pr_[1], i0 = pi_[0], i1 = pi_[1];
                            const float br[8] = {r0.x, r0.y, r0.z, r0.w, r1.x, r1.y, r1.z, r1.w}, bi[8] = {i0.x, i0.y, i0.z, i0.w, i1.x, i1.y, i1.z, i1.w};
#pragma unroll
                            for (int q = 0; q < 4; ++q) { wr_[q] = pk2(crs * br[2 * q] - cis * bi[2 * q], crs * br[2 * q + 1] - cis * bi[2 * q + 1]); wi_[q] = pk2(crs * bi[2 * q] + cis * br[2 * q], crs * bi[2 * q + 1] + cis * br[2 * q + 1]); } }
                        uint4 a4; a4.x = wr_[0]; a4.y = wr_[1]; a4.z = wr_[2]; a4.w = wr_[3]; Bf[tI] = __builtin_bit_cast(bx8, a4);
                        uint4 b4; b4.x = wi_[0]; b4.y = wi_[1]; b4.z = wi_[2]; b4.w = wi_[3]; Bf[4 + tI] = __builtin_bit_cast(bx8, b4);
                    }
#pragma unroll
                    for (int j = 0; j < 4; ++j) {
                        const float4 c4 = *(const float4*)(c_re + (size_t)(g * 16 + tok) * 64 + 16 * j + 4 * sg), d4 = *(const float4*)(c_im + (size_t)(g * 16 + tok) * 64 + 16 * j + 4 * sg);
                        uint4 a4; a4.x = pk2(c4.x, -d4.x); a4.y = pk2(c4.y, -d4.y); a4.z = pk2(c4.z, -d4.z); a4.w = pk2(c4.w, -d4.w); Cf[j] = __builtin_bit_cast(bx8, a4);
                    }
                    const float4 dsk4 = *(const float4*)(d_skip + g * 16 + 4 * sg);
                    float sxr = 0.f, sxi = 0.f;
                    const bf16* ubase = proj + (size_t)b * SEQ * LDP + g * 16;
                    uint4 unx[4]; uint2 uex[4];
#pragma unroll
                    for (int q = 0; q < 4; ++q) { unx[q] = make_uint4(0u, 0u, 0u, 0u); if (sg < 2) unx[q] = *(const uint4*)(ubase + (size_t)(16 * q + tok) * LDP + 8 * sg); uex[q] = *(const uint2*)(ubase + (size_t)(16 * q + tok) * LDP + 4 * sg); }
                    fx4 dnx[8];
                    { const bx8 uf0 = __builtin_bit_cast(bx8, unx[0]);
#pragma unroll
                      for (int tI = 0; tI < 8; ++tI) { const fx4 d = __builtin_amdgcn_mfma_f32_16x16x32_bf16(Bf[tI], uf0, (fx4){0.f, 0.f, 0.f, 0.f}, 0, 0, 0); *(LAS fx4*)(BU + tok * 132 + 16 * tI + 4 * sg) = d; } }
                    uint2 ue_prev = make_uint2(0u, 0u);
                    for (int t64 = 0; t64 < SEQ; t64 += 64) {
                        uint4 ucu[4]; uint2 uec[4];
#pragma unroll
                        for (int q = 0; q < 4; ++q) { ucu[q] = unx[q]; uec[q] = uex[q]; }
                        if (t64 + 64 < SEQ) {
#pragma unroll
                            for (int q = 0; q < 4; ++q) { if (sg < 2) unx[q] = *(const uint4*)(ubase + (size_t)(t64 + 64 + 16 * q + tok) * LDP + 8 * sg); uex[q] = *(const uint2*)(ubase + (size_t)(t64 + 64 + 16 * q + tok) * LDP + 4 * sg); } }
#pragma unroll
                        for (int q = 0; q < 4; ++q) {
                            const int t0 = t64 + 16 * q, cb = q & 1, nb = cb ^ 1;
                            LAS float* BUc = BU + cb * (16 * 132); LAS float* BUn = BU + nb * (16 * 132);
                            LAS bf16* XSc = XS + cb * (16 * 136); LAS bf16* XSp = XS + nb * (16 * 136);
                            float bre[16], bim[16];
#pragma unroll
                            for (int t = 0; t < 16; ++t) { bre[t] = BUc[t * 132 + p]; bim[t] = BUc[t * 132 + 64 + p]; }
                            const bool has_next = (t0 + 16 < SEQ);
                            { const bx8 ufn = __builtin_bit_cast(bx8, (q < 3) ? ucu[(q + 1) & 3] : unx[0]);
#pragma unroll
                              for (int tI = 0; tI < 8; ++tI) dnx[tI] = __builtin_amdgcn_mfma_f32_16x16x32_bf16(Bf[tI], ufn, (fx4){0.f, 0.f, 0.f, 0.f}, 0, 0, 0); }
                            fx4 y = (fx4){0.f, 0.f, 0.f, 0.f};
                            if (t0 > 0) {
#pragma unroll
                                for (int j = 0; j < 4; ++j) { const bx8 xf = *(const LAS bx8*)(XSp + tok * 136 + 32 * j + 8 * sg); y = __builtin_amdgcn_mfma_f32_16x16x32_bf16(Cf[j], xf, y, 0, 0, 0); } }
#pragma unroll
                            for (int t = 0; t < 16; ++t) { const float nxr = abr * sxr - abi * sxi + bre[t], nxi = abr * sxi + abi * sxr + bim[t]; sxr = nxr; sxi = nxi;
                                *(LAS unsigned*)(XSc + t * 136 + 2 * p) = pg8::cvt_pk_bf16(sxr, sxi); }
                            if (has_next) {
#pragma unroll
                                for (int tI = 0; tI < 8; ++tI) *(LAS fx4*)(BUn + tok * 132 + 16 * tI + 4 * sg) = dnx[tI]; }
                            if (t0 > 0) {
                                const float u0 = __uint_as_float(ue_prev.x << 16), u1 = __uint_as_float(ue_prev.x & 0xffff0000u), u2 = __uint_as_float(ue_prev.y << 16), u3 = __uint_as_float(ue_prev.y & 0xffff0000u);
                                uint2 o; o.x = pg8::cvt_pk_bf16(gelu_tanh(y[0] + dsk4.x * u0), gelu_tanh(y[1] + dsk4.y * u1)); o.y = pg8::cvt_pk_bf16(gelu_tanh(y[2] + dsk4.z * u2), gelu_tanh(y[3] + dsk4.w * u3));
                                *(uint2*)(yg + (size_t)(b * SEQ + t0 - 16 + tok) * MIXW + g * 16 + 4 * sg) = o; }
                            ue_prev = uec[q];
                        }
                    }
                    {
                        LAS bf16* XSp = XS + 1 * (16 * 136);
                        fx4 y = (fx4){0.f, 0.f, 0.f, 0.f};
#pragma unroll
                        for (int j = 0; j < 4; ++j) { const bx8 xf = *(const LAS bx8*)(XSp + tok * 136 + 32 * j + 8 * sg); y = __builtin_amdgcn_mfma_f32_16x16x32_bf16(Cf[j], xf, y, 0, 0, 0); }
                        const float u0 = __uint_as_float(ue_prev.x << 16), u1 = __uint_as_float(ue_prev.x & 0xffff0000u), u2 = __uint_as_float(ue_prev.y << 16), u3 = __uint_as_float(ue_prev.y & 0xffff0000u);
                        uint2 o; o.x = pg8::cvt_pk_bf16(gelu_tanh(y[0] + dsk4.x * u0), gelu_tanh(y[1] + dsk4.y * u1)); o.y = pg8::cvt_pk_bf16(gelu_tanh(y[2] + dsk4.z * u2), gelu_tanh(y[3] + dsk4.w * u3));
                        *(uint2*)(yg + (size_t)(b * SEQ + SEQ - 16 + tok) * MIXW + g * 16 + 4 * sg) = o;
                    }
                }
#else
                for (int unit = bid * NWAVES + wave; unit < NB * 48; unit += G * NWAVES) {
                    const int b = unit / 48, g = unit % 48, p = lane;
                    const float lre = fminf(a_re[g * 64 + p], -1e-4f), lim = a_im[g * 64 + p];
                    const float dt = __expf(log_dt[g]);
                    const float mag = __expf(dt * lre); float sn, cs; sincos_rad(dt * lim, sn, cs);
                    const float abr = mag * cs, abi = mag * sn;
                    const float den = lre * lre + lim * lim, nr = abr - 1.0f;
                    const float cr = (nr * lre + abi * lim) / den, ci = (abi * lre - nr * lim) / den;
                    float Br[16], Bi[16], Cr[16], Ci[16];
#pragma unroll
                    for (int h = 0; h < 16; ++h) { const float br = b_re[(size_t)(g * 64 + p) * 16 + h], bi = b_im[(size_t)(g * 64 + p) * 16 + h];
                        Br[h] = cr * br - ci * bi; Bi[h] = cr * bi + ci * br; Cr[h] = c_re[(size_t)(g * 16 + h) * 64 + p]; Ci[h] = c_im[(size_t)(g * 16 + h) * 64 + p]; }
                    const float dsk = d_skip[g * 16 + (lane & 15)];
                    float sxr = 0.f, sxi = 0.f;
                    for (int t = 0; t < SEQ; ++t) {
                        const bf16* up = proj + (size_t)(b * SEQ + t) * LDP + g * 16;
                        float u[16]; unpack8(*(const uint4*)up, u); unpack8(*(const uint4*)(up + 8), u + 8);
                        float bur = 0.f, bui = 0.f;
#pragma unroll
                        for (int h = 0; h < 16; ++h) { bur += Br[h] * u[h]; bui += Bi[h] * u[h]; }
                        const float nxr = abr * sxr - abi * sxi + bur, nxi = abr * sxi + abi * sxr + bui; sxr = nxr; sxi = nxi;
                        float myy = 0.f;
#pragma unroll
                        for (int h = 0; h < 16; ++h) { float v = Cr[h] * sxr - Ci[h] * sxi; v = wave_sum(v, lane); myy = (lane == h) ? v : myy; }
                        if (lane < 16) { const float uu = bf2f(up[lane]); const float y = gelu_tanh(myy + dsk * uu); yg[(size_t)(b * SEQ + t) * MIXW + g * 16 + lane] = f2bf(y); }
                    }
                }
#endif
            } else {
#if FAST_LINATT && LINATT_V2
                {
                    typedef pg8::bf16x8 bx8; typedef pg8::f32x4 fx4; typedef pg8::u32x4 ux4; typedef pg8::u32x2 ux2;
                    typedef _Float16 h2_t __attribute__((ext_vector_type(2)));
                    LAS bf16* Qs = (LAS bf16*)lds;
                    LAS bf16* Ks = (LAS bf16*)(lds + 13312);
                    LAS bf16* KTe = (LAS bf16*)(lds + 26624);
                    LAS bf16* VT = (LAS bf16*)(lds + 40448);
                    LAS bf16* Ps = (LAS bf16*)(lds + 68096);
                    LAS bf16* CT = (LAS bf16*)(lds + 77312);
                    LAS float* fa = (LAS float*)(lds + 117248);
                    LAS float* aArr = fa, *MArr = fa + 64, *interArr = fa + 128, *clampArr = fa + 192, *eArr = fa + 256, *denArr = fa + 320, *nArr = fa + 384  , *stat = fa + 480  ;
                    const float* conv_q = (const float*)ARGP(17); const float* conv_k = (const float*)ARGP(18);
                    const float* b_i = (const float*)ARGP(19); const float* b_f = (const float*)ARGP(20);
                    const float* norm_g = (const float*)(kind == 1 ? ARGP(21) : ARGP(23));
                    constexpr int CHB = 62208;
                    unsigned char* const LB = (unsigned char*)(ws + WS_ACT);
#define LINATT_PIECE_LDS(p) ((p) < 768 ? (((p) / 12) * 104 + ((p) % 12) * 8) * 2 : (p) < 1536 ? 13312 + ((((p) - 768) / 12) * 104 + (((p) - 768) % 12) * 8) * 2 : \
                             (p) < 2304 ? 26624 + ((((p) - 1536) >> 3) * 72 + (((p) - 1536) & 7) * 8) * 2 : 40448 + ((((p) - 2304) >> 3) * 72 + (((p) - 2304) & 7) * 8) * 2)
                    for (int unit = bid; unit < NB * 4 * 8; unit += G) {
                        const int b = unit >> 5, h = (unit >> 3) & 3, c0 = (unit & 7) * 4;
                        const float lgam = __logf(1.0f - exp2f(-5.0f - (float)h));
                        ux4 rv[3], rg[8]; float rig = 0.f, rfg = 0.f;
#pragma unroll
                        for (int q = 0; q < 8; ++q) rg[q] = (ux4){0u, 0u, 0u, 0u};
#define LINATT_LOAD_RAW(cc) do { const size_t r0_ = (size_t)b * SEQ + (size_t)(cc) * 64; \
                            _Pragma("unroll") for (int kq = 0; kq < 3; ++kq) { const int idx = tidv + NTHR * kq, cg = idx >> 6, s = idx & 63; rv[kq] = *(const ux4*)(proj + (r0_ + s) * LDP + 768 + h * 192 + 8 * cg); } \
                            if (kind == 1) { _Pragma("unroll") for (int kq = 0; kq < 3; ++kq) { const int idx = tidv + NTHR * kq, which = idx / 768, rem = idx % 768, cg = rem >> 6, s = rem & 63; \
                                    rg[kq] = *(const ux4*)(proj + (r0_ + s) * LDP + which * 384 + h * 96 + 8 * cg); } \
                                if (wave == 0) { const bf16* pr = proj + (r0_ + lanev) * LDP; rig = bf2f(pr[2304 + h]); rfg = bf2f(pr[2308 + h]); } } \
                            else { _Pragma("unroll") for (int kq = 0; kq < 2; ++kq) { const int idx = tidv + NTHR * kq; if (idx < 768) { const int which = idx / 384, rem = idx % 384, cg = rem >> 6, s = rem & 63; \
                                    const bf16* xp = proj + (r0_ + s) * LDP + which * 384 + h * 96 + 8 * cg; rg[kq] = *(const ux4*)xp; rg[2 + kq] = *(const ux4*)(xp + 48); \
                                    const ux4* rp = (const ux4*)((const unsigned*)rope + (r0_ + s) * 48 + 8 * cg); rg[4 + 2 * kq] = rp[0]; rg[5 + 2 * kq] = rp[1]; } } } } while (0)
                        { int tidv = tid; asm volatile("" : "+v"(tidv)); const int lanev = tidv & 63; (void)lanev;
                          if (kind == 1 && c0 > 0) {
                              const size_t rp_ = (size_t)b * SEQ + (size_t)(c0 - 1) * 64;
#pragma unroll
                              for (int kq = 0; kq < 3; ++kq) { const int idx = tidv + NTHR * kq, which = idx / 768, rem = idx % 768, cg = rem >> 6, s = rem & 63; rg[3 + kq] = *(const ux4*)(proj + (rp_ + s) * LDP + which * 384 + h * 96 + 8 * cg); } }
                          LINATT_LOAD_RAW(c0); }
                        for (int cc = 0; cc < 4; ++cc) {
                            const int c = c0 + cc;
                            int tidv = tid; asm volatile("" : "+v"(tidv));
                            const int lanev = tidv & 63;
                            unsigned char* const img = LB + (size_t)((b * 4 + h) * 32 + c) * CHB;
                            if (wave == 0) {
                                float lf, ig;
                                if (kind == 1) { ig = rig + b_i[h]; const float fg = rfg + b_f[h]; lf = fminf(fg, 0.f) - __logf(1.0f + __expf(-fabsf(fg))); }
                                else { ig = 0.f; lf = lgam; }
                                float bc = lf;
#pragma unroll
                                for (int o = 1; o < 64; o <<= 1) { const float t = sh_up(bc, o, lanev); if (lanev >= o) bc += t; }
                                const float a = ig - bc; float A = a;
#pragma unroll
                                for (int o = 1; o < 64; o <<= 1) { const float t = sh_up(A, o, lanev); if (lanev >= o) A = fmaxf(A, t); }
                                float* gp = (float*)(img + 61440); gp[lanev] = a; gp[64 + lanev] = A; gp[128 + lanev] = bc;
                            }
#pragma unroll
                            for (int kq = 0; kq < 3; ++kq) {
                                const int idx = tidv + NTHR * kq, cg = idx >> 6, s = idx & 63; const ux4 v = rv[kq];
                                LAS bf16* d = VT + (8 * cg) * 72 + s;
                                d[0] = (bf16)(v.x & 0xffffu); d[72] = (bf16)(v.x >> 16); d[144] = (bf16)(v.y & 0xffffu); d[216] = (bf16)(v.y >> 16);
                                d[288] = (bf16)(v.z & 0xffffu); d[360] = (bf16)(v.z >> 16); d[432] = (bf16)(v.w & 0xffffu); d[504] = (bf16)(v.w >> 16);
                            }
                            if (kind == 1) {
#pragma unroll
                                for (int kq = 0; kq < 3; ++kq) {
                                    const int idx = tidv + NTHR * kq, which = idx / 768, rem = idx % 768, cg = rem >> 6, s = rem & 63;
                                    const int ch = h * 96 + 8 * cg;
                                    const float* cw = (which ? conv_k : conv_q) + ch;
                                    float r[8];
                                    { float x[8]; uint4 xu; xu.x = rg[kq].x; xu.y = rg[kq].y; xu.z = rg[kq].z; xu.w = rg[kq].w; unpack8(xu, x);
                                      const float4 w0 = *(const float4*)(cw + 3 * 384), w1 = *(const float4*)(cw + 3 * 384 + 4);
                                      r[0] = w0.x * x[0]; r[1] = w0.y * x[1]; r[2] = w0.z * x[2]; r[3] = w0.w * x[3]; r[4] = w1.x * x[4]; r[5] = w1.y * x[5]; r[6] = w1.z * x[6]; r[7] = w1.w * x[7]; }
#pragma unroll
                                    for (int dl = 1; dl <= 3; ++dl) {
                                        const int sl = (lanev - dl) & 63; uint4 xu;
                                        { const unsigned c0 = sh_idx(rg[kq].x, sl, lanev), p0 = sh_idx(rg[3 + kq].x, sl, lanev); xu.x = (lanev >= dl) ? c0 : p0; }
                                        { const unsigned c0 = sh_idx(rg[kq].y, sl, lanev), p0 = sh_idx(rg[3 + kq].y, sl, lanev); xu.y = (lanev >= dl) ? c0 : p0; }
                                        { const unsigned c0 = sh_idx(rg[kq].z, sl, lanev), p0 = sh_idx(rg[3 + kq].z, sl, lanev); xu.z = (lanev >= dl) ? c0 : p0; }
                                        { const unsigned c0 = sh_idx(rg[kq].w, sl, lanev), p0 = sh_idx(rg[3 + kq].w, sl, lanev); xu.w = (lanev >= dl) ? c0 : p0; }
                                        float x[8]; unpack8(xu, x);
                                        const float4 w0 = *(const float4*)(cw + (3 - dl) * 384), w1 = *(const float4*)(cw + (3 - dl) * 384 + 4);
                                        r[0] += w0.x * x[0]; r[1] += w0.y * x[1]; r[2] += w0.z * x[2]; r[3] += w0.w * x[3]; r[4] += w1.x * x[4]; r[5] += w1.y * x[5]; r[6] += w1.z * x[6]; r[7] += w1.w * x[7];
                                    }
                                    rg[3 + kq] = rg[kq];
                                    const float sc = which ? 1.0f : 0.10206207261596575f;
#pragma unroll
                                    for (int i = 0; i < 8; ++i) r[i] = r[i] * sigmoidf(r[i]) * sc;
                                    ux4 pk; pk.x = pg8::cvt_pk_bf16(r[0], r[1]); pk.y = pg8::cvt_pk_bf16(r[2], r[3]); pk.z = pg8::cvt_pk_bf16(r[4], r[5]); pk.w = pg8::cvt_pk_bf16(r[6], r[7]);
                                    if (which == 0) *(LAS ux4*)(Qs + s * 104 + 8 * cg) = pk;
                                    else { *(LAS ux4*)(Ks + s * 104 + 8 * cg) = pk; const float es = 1.0f; LAS bf16* d = KTe + (8 * cg) * 72 + s;
#pragma unroll
                                        for (int i = 0; i < 8; ++i) d[72 * i] = f2bf(r[i] * es); }
                                }
                            } else {
#pragma unroll
                                for (int kq = 0; kq < 2; ++kq) {
                                    const int idx = tidv + NTHR * kq;
                                    if (idx < 768) {
                                        const int which = idx / 384, rem = idx % 384, cg = rem >> 6, s = rem & 63;
                                        float x1[8], x2[8]; { uint4 xu; xu.x = rg[kq].x; xu.y = rg[kq].y; xu.z = rg[kq].z; xu.w = rg[kq].w; unpack8(xu, x1); xu.x = rg[2 + kq].x; xu.y = rg[2 + kq].y; xu.z = rg[2 + kq].z; xu.w = rg[2 + kq].w; unpack8(xu, x2); }
                                        const unsigned rpw[8] = {rg[4 + 2 * kq].x, rg[4 + 2 * kq].y, rg[4 + 2 * kq].z, rg[4 + 2 * kq].w, rg[5 + 2 * kq].x, rg[5 + 2 * kq].y, rg[5 + 2 * kq].z, rg[5 + 2 * kq].w};
                                        float o1[8], o2[8]; const float sc = which ? 0.10206207261596575f : 1.0f;
#pragma unroll
                                        for (int q8 = 0; q8 < 8; ++q8) { const h2_t cs_ = __builtin_bit_cast(h2_t, rpw[q8]); const float c0 = (float)cs_.x, s0 = (float)cs_.y;
                                            o1[q8] = (x1[q8] * c0 - x2[q8] * s0) * sc; o2[q8] = (x2[q8] * c0 + x1[q8] * s0) * sc; }
                                        ux4 p1; p1.x = pg8::cvt_pk_bf16(o1[0], o1[1]); p1.y = pg8::cvt_pk_bf16(o1[2], o1[3]); p1.z = pg8::cvt_pk_bf16(o1[4], o1[5]); p1.w = pg8::cvt_pk_bf16(o1[6], o1[7]);
                                        ux4 p2; p2.x = pg8::cvt_pk_bf16(o2[0], o2[1]); p2.y = pg8::cvt_pk_bf16(o2[2], o2[3]); p2.z = pg8::cvt_pk_bf16(o2[4], o2[5]); p2.w = pg8::cvt_pk_bf16(o2[6], o2[7]);
                                        LAS bf16* dst = which ? Ks : Qs;
                                        *(LAS ux4*)(dst + s * 104 + 8 * cg) = p1; *(LAS ux4*)(dst + s * 104 + 48 + 8 * cg) = p2;
                                        if (which) { const float es = 1.0f; LAS bf16* d = KTe + (8 * cg) * 72 + s;
#pragma unroll
                                            for (int i = 0; i < 8; ++i) { d[72 * i] = f2bf(o1[i] * es); d[72 * (48 + i)] = f2bf(o2[i] * es); } }
                                    }
                                }
                            }
                            if (cc + 1 < 4) LINATT_LOAD_RAW(c + 1);
                            LDS_BARRIER();
#pragma unroll
                            for (int k = 0; k < 8; ++k) { const int p = tidv + NTHR * k; if (p < 3840) *(ux4*)(img + (size_t)p * 16) = *(const LAS ux4*)(lds + LINATT_PIECE_LDS(p)); }
                            LDS_BARRIER();
                        }
                    }
#undef LINATT_LOAD_RAW
                    xcd_barrier(bar, wave0);
                    const int tok = lane & 15, sg = lane >> 4; (void)tok; (void)sg;
                    for (int unit = bid; unit < NB * 4 * 4; unit += G) {
                        const int b = unit >> 4, h = (unit >> 2) & 3, jt = unit & 3;
                        fx4 Cst[3][3];
#pragma unroll
                        for (int x = 0; x < 3; ++x)
#pragma unroll
                            for (int y = 0; y < 3; ++y) Cst[x][y] = (fx4){0.f, 0.f, 0.f, 0.f};
                        float nreg = 0.f, m_prev = 0.f;
                        __syncthreads();
                        for (int i = tid; i < 192 * 104 / 2; i += NTHR) ((LAS unsigned*)CT)[i] = 0u;
                        if (tid < 96) nArr[tid] = 0.f;
                        const int ctU = 3 * (wave & 3), itU = 3 * (wave >> 2);
                        ux4 rgp[8]; float g_a = 0.f, g_A = 0.f, g_b = 0.f, g_A63 = 0.f, g_b63 = 0.f;
#define LINATT_LOAD_IMG(cc) do { const unsigned char* im_ = LB + (size_t)((b * 4 + h) * 32 + (cc)) * CHB; \
                            _Pragma("unroll") for (int k = 0; k < 8; ++k) { const int p = tidv + NTHR * k; rgp[k] = *(const ux4*)(im_ + (size_t)(p < 3840 ? p : 3839) * 16); } \
                            const float* gp_ = (const float*)(im_ + 61440); if (tidv < 64) { g_a = gp_[tidv]; g_A = gp_[64 + tidv]; g_b = gp_[128 + tidv]; } g_A63 = gp_[64 + 63]; g_b63 = gp_[128 + 63]; } while (0)
                        { int tidv = tid; asm volatile("" : "+v"(tidv)); LINATT_LOAD_IMG(0); }
                        for (int c = 0; c < SEQ / 64; ++c) {
                            const size_t row0 = (size_t)b * SEQ + c * 64;
                            int tidv = tid; asm volatile("" : "+v"(tidv));
                            const int lanev = tidv & 63, tokv = lanev & 15, sgv = lanev >> 4;
#pragma unroll
                            for (int k = 0; k < 8; ++k) { const int p = tidv + NTHR * k; if (p < 3840) *(LAS ux4*)(lds + LINATT_PIECE_LDS(p)) = rgp[k]; }
                            const float M63 = (kind == 1) ? fmaxf(m_prev, g_A63) : -g_b63;
                            const float sa_c = __expf(m_prev - M63);
                            if (tidv < 64) { const float M = (kind == 1) ? fmaxf(m_prev, g_A) : -g_b;
                                aArr[tidv] = g_a; MArr[tidv] = M; interArr[tidv] = __expf(m_prev - M); clampArr[tidv] = __expf(-(g_b + M)); eArr[tidv] = __expf(g_a - M63); }
                            if (kind == 1) m_prev = g_b63 + M63;
                            if (c + 1 < SEQ / 64) LINATT_LOAD_IMG(c + 1);
                            LDS_BARRIER(); __builtin_amdgcn_sched_barrier(0);
                            if (wave < 4) {
                                const int st = wave, j = 16 * jt + tokv; fx4 d = (fx4){0.f, 0.f, 0.f, 0.f};
                                if (st <= jt) {
                                    const float Mj = MArr[j];
#pragma unroll
                                    for (int kk = 0; kk < 3; ++kk) { const bx8 yq = *(const LAS bx8*)(Qs + j * 104 + 32 * kk + 8 * sgv), xk = *(const LAS bx8*)(Ks + (16 * st + tokv) * 104 + 32 * kk + 8 * sgv); d = __builtin_amdgcn_mfma_f32_16x16x32_bf16(xk, yq, d, 0, 0, 0); }
#pragma unroll
                                    for (int r = 0; r < 4; ++r) { const int s = 16 * st + 4 * sgv + r; d[r] = (s <= j) ? d[r] * __expf(aArr[s] - Mj) : 0.f; }
                                }
                                ux2 pw; pw.x = pg8::cvt_pk_bf16(d[0], d[1]); pw.y = pg8::cvt_pk_bf16(d[2], d[3]);
                                *(LAS ux2*)(Ps + j * 72 + 16 * st + 4 * sgv) = pw;
                            }
                            LDS_BARRIER();
                            __builtin_amdgcn_sched_barrier(0);
                            if (kind == 1) {
                                const int j = 16 * jt + (tidv >> 5), part = tidv & 31; float dq = 0.f, dp = 0.f;
#pragma unroll
                                for (int i = 0; i < 3; ++i) dq += bf2f(Qs[j * 104 + part * 3 + i]) * nArr[part * 3 + i];
#pragma unroll
                                for (int s = 0; s < 2; ++s) dp += bf2f(Ps[j * 72 + part * 2 + s]);
                                float dn = interArr[j] * dq + dp; dn += sh_xor(dn, 1, lane); dn += sh_xor(dn, 2, lane); dn += sh_xor(dn, 4, lane); dn += sh_xor(dn, 8, lane); dn += sh_xor(dn, 16, lane);
                                if (part == 0) denArr[j] = dn;
                            }
                            __builtin_amdgcn_sched_barrier(0);
                            constexpr int NXT = 2;
                            const int nx = (wave < 4) ? 2 : 1;
                            fx4 acc[NXT];
                            const size_t orow = row0 + 16 * jt + tokv;
                            ux2 ogate[NXT];
#pragma unroll
                            for (int x = 0; x < NXT; ++x) { ogate[x] = (ux2){0u, 0u}; if (x < nx) ogate[x] = *(const ux2*)(proj + orow * LDP + 1536 + h * 192 + 16 * (wave + 8 * x) + 4 * sgv); }
                            {
                                bx8 yq[3];
#pragma unroll
                                for (int kk = 0; kk < 3; ++kk) yq[kk] = *(const LAS bx8*)(Qs + (16 * jt + tokv) * 104 + 32 * kk + 8 * sgv);
#pragma unroll
                                for (int x = 0; x < NXT; ++x) { acc[x] = (fx4){0.f, 0.f, 0.f, 0.f}; const int ct = wave + 8 * x;
                                    if (x < nx) {
#pragma unroll
                                    for (int kk = 0; kk < 3; ++kk) { const bx8 xc = *(const LAS bx8*)(CT + (16 * ct + tokv) * 104 + 32 * kk + 8 * sgv); acc[x] = __builtin_amdgcn_mfma_f32_16x16x32_bf16(xc, yq[kk], acc[x], 0, 0, 0); } } }
                                __builtin_amdgcn_sched_barrier(0);
                                const float in_j = interArr[16 * jt + tokv];
#pragma unroll
                                for (int x = 0; x < NXT; ++x) acc[x] = acc[x] * in_j;
                                bx8 yp[2];
#pragma unroll
                                for (int kk = 0; kk < 2; ++kk) yp[kk] = *(const LAS bx8*)(Ps + (16 * jt + tokv) * 72 + 32 * kk + 8 * sgv);
#pragma unroll
                                for (int x = 0; x < NXT; ++x) { const int ct = wave + 8 * x;
                                    if (x < nx) {
#pragma unroll
                                    for (int kk = 0; kk < 2; ++kk) { const bx8 xv = *(const LAS bx8*)(VT + (16 * ct + tokv) * 72 + 32 * kk + 8 * sgv); acc[x] = __builtin_amdgcn_mfma_f32_16x16x32_bf16(xv, yp[kk], acc[x], 0, 0, 0); } } }
                            }
                            __builtin_amdgcn_sched_barrier(0);
                            {
                                const float sa = sa_c;
                                bx8 yv[3][2];
#pragma unroll
                                for (int x = 0; x < 3; ++x)
#pragma unroll
                                    for (int kk = 0; kk < 2; ++kk) yv[x][kk] = *(const LAS bx8*)(VT + (16 * (ctU + x) + tokv) * 72 + 32 * kk + 8 * sgv);
                                float ev[2][8];
#pragma unroll
                                for (int kk = 0; kk < 2; ++kk) { const fx4 e0 = *(const LAS fx4*)(eArr + 32 * kk + 8 * sgv), e1 = *(const LAS fx4*)(eArr + 32 * kk + 8 * sgv + 4);
                                    ev[kk][0] = e0[0]; ev[kk][1] = e0[1]; ev[kk][2] = e0[2]; ev[kk][3] = e0[3]; ev[kk][4] = e1[0]; ev[kk][5] = e1[1]; ev[kk][6] = e1[2]; ev[kk][7] = e1[3]; }
#pragma unroll
                                for (int x = 0; x < 3; ++x) { bx8 xk[2];
#pragma unroll
                                    for (int kk = 0; kk < 2; ++kk) { const ux4 rawk = *(const LAS ux4*)(KTe + (16 * (itU + x) + tokv) * 72 + 32 * kk + 8 * sgv); ux4 sk;
                                        sk.x = pg8::cvt_pk_bf16(__uint_as_float(rawk.x << 16) * ev[kk][0], __uint_as_float(rawk.x & 0xffff0000u) * ev[kk][1]); sk.y = pg8::cvt_pk_bf16(__uint_as_float(rawk.y << 16) * ev[kk][2], __uint_as_float(rawk.y & 0xffff0000u) * ev[kk][3]);
                                        sk.z = pg8::cvt_pk_bf16(__uint_as_float(rawk.z << 16) * ev[kk][4], __uint_as_float(rawk.z & 0xffff0000u) * ev[kk][5]); sk.w = pg8::cvt_pk_bf16(__uint_as_float(rawk.w << 16) * ev[kk][6], __uint_as_float(rawk.w & 0xffff0000u) * ev[kk][7]);
                                        xk[kk] = __builtin_bit_cast(bx8, sk); }
#pragma unroll
                                    for (int y = 0; y < 3; ++y) { Cst[x][y] = Cst[x][y] * sa;
#pragma unroll
                                        for (int kk = 0; kk < 2; ++kk) Cst[x][y] = __builtin_amdgcn_mfma_f32_16x16x32_bf16(xk[kk], yv[y][kk], Cst[x][y], 0, 0, 0); } }
                                if (kind == 1 && tidv < 96) { float sn = 0.f;
#pragma unroll 8
                                    for (int s = 0; s < 64; ++s) sn += bf2f(KTe[tidv * 72 + s]) * eArr[s];
                                    nreg = sa * nreg + sn; }
                            }
                            __builtin_amdgcn_sched_barrier(0);
                            LDS_BARRIER();
                            {
                                const int j = 16 * jt + tokv;
                                if (kind == 1) { const float dv = 1.0f / fmaxf(fabsf(denArr[j]), clampArr[j]);
#pragma unroll
                                    for (int x = 0; x < NXT; ++x) acc[x] = acc[x] * dv; }
                                float s1 = 0.f, s2 = 0.f;
#pragma unroll
                                for (int x = 0; x < NXT; ++x)
#pragma unroll
                                    for (int r = 0; r < 4; ++r) { s1 += acc[x][r]; s2 += acc[x][r] * acc[x][r]; }
                                s1 += sh_xor(s1, 16, lane); s1 += sh_xor(s1, 32, lane); s2 += sh_xor(s2, 16, lane); s2 += sh_xor(s2, 32, lane);
                                if (sgv == 0) { stat[(tokv * 8 + wave) * 2 + 0] = s1; stat[(tokv * 8 + wave) * 2 + 1] = s2; }
                            }
                            LDS_BARRIER();
                            {
                                const int j = 16 * jt + tokv;
                                float t1 = 0.f, t2 = 0.f;
#pragma unroll
                                for (int w8 = 0; w8 < 8; ++w8) { t1 += stat[(tokv * 8 + w8) * 2 + 0]; t2 += stat[(tokv * 8 + w8) * 2 + 1]; }
                                const float mean = t1 * (1.0f / 192.0f);
                                const float var = t2 * (1.0f / 192.0f) - mean * mean; (void)j;
                                const float rstd = 1.0f / sqrtf(fmaxf(var, 0.f) + LN_EPS);
#pragma unroll
                                for (int x = 0; x < NXT; ++x) if (x < nx) { const int colh = 16 * (wave + 8 * x) + 4 * sgv; const float4 g4 = *(const float4*)(norm_g + h * 192 + colh);
                                    const float o0 = __uint_as_float(ogate[x].x << 16), o1 = __uint_as_float(ogate[x].x & 0xffff0000u), o2 = __uint_as_float(ogate[x].y << 16), o3 = __uint_as_float(ogate[x].y & 0xffff0000u);
                                    float g0, g1, g2, g3;
                                    if (kind == 1) { g0 = sigmoidf(o0); g1 = sigmoidf(o1); g2 = sigmoidf(o2); g3 = sigmoidf(o3); } else { g0 = o0 * sigmoidf(o0); g1 = o1 * sigmoidf(o1); g2 = o2 * sigmoidf(o2); g3 = o3 * sigmoidf(o3); }
                                    ux2 ov; ov.x = pg8::cvt_pk_bf16((acc[x][0] - mean) * rstd * g4.x * g0, (acc[x][1] - mean) * rstd * g4.y * g1); ov.y = pg8::cvt_pk_bf16((acc[x][2] - mean) * rstd * g4.z * g2, (acc[x][3] - mean) * rstd * g4.w * g3);
                                    *(ux2*)(cat + orow * D + h * 192 + colh) = ov; }
#pragma unroll
                                for (int x = 0; x < 3; ++x)
#pragma unroll
                                    for (int y = 0; y < 3; ++y) { ux2 cw; cw.x = pg8::cvt_pk_bf16(Cst[x][y][0], Cst[x][y][1]); cw.y = pg8::cvt_pk_bf16(Cst[x][y][2], Cst[x][y][3]);
                                        *(LAS ux2*)(CT + (16 * (ctU + y) + tokv) * 104 + 16 * (itU + x) + 4 * sgv) = cw; }
                                if (kind == 1 && tidv < 96) nArr[tidv] = nreg;
                            }
                        }
                    }
                }
#elif FAST_LINATT
                {
                    typedef pg8::bf16x8 bx8; typedef pg8::f32x4 fx4; typedef pg8::u32x4 ux4; typedef pg8::u32x2 ux2;
                    LAS bf16* Qs = (LAS bf16*)lds;
                    LAS bf16* Ks = (LAS bf16*)(lds + 13312);
                    LAS bf16* KTe = (LAS bf16*)(lds + 26624);
                    LAS bf16* VT = (LAS bf16*)(lds + 40448);
                    LAS bf16* Ps = (LAS bf16*)(lds + 68096);
                    LAS bf16* CT = (LAS bf16*)(lds + 77312);
                    LAS float* fa = (LAS float*)(lds + 117248);
                    LAS float* aArr = fa, *MArr = fa + 64, *interArr = fa + 128, *clampArr = fa + 192, *eArr = fa + 256, *denArr = fa + 320, *nArr = fa + 384  , *stat = fa + 480  , *scal = fa + 736;
                    const float* conv_q = (const float*)ARGP(17); const float* conv_k = (const float*)ARGP(18);
                    const float* b_i = (const float*)ARGP(19); const float* b_f = (const float*)ARGP(20);
                    const float* norm_g = (const float*)(kind == 1 ? ARGP(21) : ARGP(23));
                    const int tok = lane & 15, sg = lane >> 4;
                    for (int unit = bid; unit < NB * 4; unit += G) {
                        const int b = unit >> 2, h = unit & 3;
                        const float lgam = __logf(1.0f - exp2f(-5.0f - (float)h));
                        fx4 Cst[3][3];
#pragma unroll
                        for (int x = 0; x < 3; ++x)
#pragma unroll
                            for (int y = 0; y < 3; ++y) Cst[x][y] = (fx4){0.f, 0.f, 0.f, 0.f};
                        float nreg = 0.f, m_prev = 0.f;
                        __syncthreads();
                        for (int i = tid; i < 192 * 104 / 2; i += NTHR) ((LAS unsigned*)CT)[i] = 0u;
                        if (tid < 96) nArr[tid] = 0.f;
                        const int ctU = 3 * (wave & 3), itU = 3 * (wave >> 2);
                        const int jt = wave & 3, half = wave >> 2;
                        typedef _Float16 h2_t __attribute__((ext_vector_type(2)));
                        ux4 rv[3], rg[8]; float rig = 0.f, rfg = 0.f;
#pragma unroll
                        for (int q = 0; q < 8; ++q) rg[q] = (ux4){0u, 0u, 0u, 0u};
#define LINATT_LOAD_RAW(cc) do { const size_t r0_ = (size_t)b * SEQ + (size_t)(cc) * 64; \
                            _Pragma("unroll") for (int kq = 0; kq < 3; ++kq) { const int idx = tidv + NTHR * kq, cg = idx >> 6, s = idx & 63; rv[kq] = *(const ux4*)(proj + (r0_ + s) * LDP + 768 + h * 192 + 8 * cg); } \
                            if (kind == 1) { _Pragma("unroll") for (int kq = 0; kq < 3; ++kq) { const int idx = tidv + NTHR * kq, which = idx / 768, rem = idx % 768, cg = rem >> 6, s = rem & 63; \
                                    rg[kq] = *(const ux4*)(proj + (r0_ + s) * LDP + which * 384 + h * 96 + 8 * cg); } \
                                if (wave == 0) { const bf16* pr = proj + (r0_ + lanev) * LDP; rig = bf2f(pr[2304 + h]); rfg = bf2f(pr[2308 + h]); } } \
                            else { _Pragma("unroll") for (int kq = 0; kq < 2; ++kq) { const int idx = tidv + NTHR * kq; if (idx < 768) { const int which = idx / 384, rem = idx % 384, cg = rem >> 6, s = rem & 63; \
                                    const bf16* xp = proj + (r0_ + s) * LDP + which * 384 + h * 96 + 8 * cg; rg[kq] = *(const ux4*)xp; rg[2 + kq] = *(const ux4*)(xp + 48); \
                                    const ux4* rp = (const ux4*)((const unsigned*)rope + (r0_ + s) * 48 + 8 * cg); rg[4 + 2 * kq] = rp[0]; rg[5 + 2 * kq] = rp[1]; } } } } while (0)
                        { int tidv = tid; asm volatile("" : "+v"(tidv)); const int lanev = tidv & 63; LINATT_LOAD_RAW(0); }
                        for (int c = 0; c < SEQ / 64; ++c) {
                            const size_t row0 = (size_t)b * SEQ + c * 64;
                            int tidv = tid; asm volatile("" : "+v"(tidv));
                            const int lanev = tidv & 63, tokv = lanev & 15, sgv = lanev >> 4;
                            if (wave == 0) {
                                float lf, ig;
                                if (kind == 1) { ig = rig + b_i[h]; const float fg = rfg + b_f[h]; lf = fminf(fg, 0.f) - __logf(1.0f + __expf(-fabsf(fg))); }
                                else { ig = 0.f; lf = lgam; }
                                float bc = lf;
#pragma unroll
                                for (int o = 1; o < 64; o <<= 1) { const float t = sh_up(bc, o, lanev); if (lanev >= o) bc += t; }
                                const float a = ig - bc; float M;
                                if (kind == 1) { float A = a;
#pragma unroll
                                    for (int o = 1; o < 64; o <<= 1) { const float t = sh_up(A, o, lanev); if (lanev >= o) A = fmaxf(A, t); }
                                    M = fmaxf(m_prev, A); }
                                else M = -bc;
                                const float M63 = sh_idx(M, 63, lane), btot = sh_idx(bc, 63, lane);
                                aArr[lanev] = a; MArr[lanev] = M; interArr[lanev] = __expf(m_prev - M); clampArr[lanev] = __expf(-(bc + M)); eArr[lanev] = __expf(a - M63);
                                if (lanev == 0) scal[0] = __expf(m_prev - M63);
                                if (kind == 1) m_prev = btot + M63;
                            }
                            LDS_BARRIER();
#pragma unroll
                            for (int kq = 0; kq < 3; ++kq) {
                                const int idx = tidv + NTHR * kq, cg = idx >> 6, s = idx & 63; const ux4 v = rv[kq];
                                LAS bf16* d = VT + (8 * cg) * 72 + s;
                                d[0] = (bf16)(v.x & 0xffffu); d[72] = (bf16)(v.x >> 16); d[144] = (bf16)(v.y & 0xffffu); d[216] = (bf16)(v.y >> 16);
                                d[288] = (bf16)(v.z & 0xffffu); d[360] = (bf16)(v.z >> 16); d[432] = (bf16)(v.w & 0xffffu); d[504] = (bf16)(v.w >> 16);
                            }
                            if (kind == 1) {
#pragma unroll
                                for (int kq = 0; kq < 3; ++kq) {
                                    const int idx = tidv + NTHR * kq, which = idx / 768, rem = idx % 768, cg = rem >> 6, s = rem & 63;
                                    const int ch = h * 96 + 8 * cg;
                                    const float* cw = (which ? conv_k : conv_q) + ch;
                                    float r[8];
                                    { float x[8]; uint4 xu; xu.x = rg[kq].x; xu.y = rg[kq].y; xu.z = rg[kq].z; xu.w = rg[kq].w; unpack8(xu, x);
                                      const float4 w0 = *(const float4*)(cw + 3 * 384), w1 = *(const float4*)(cw + 3 * 384 + 4);
                                      r[0] = w0.x * x[0]; r[1] = w0.y * x[1]; r[2] = w0.z * x[2]; r[3] = w0.w * x[3]; r[4] = w1.x * x[4]; r[5] = w1.y * x[5]; r[6] = w1.z * x[6]; r[7] = w1.w * x[7]; }
#pragma unroll
                                    for (int dl = 1; dl <= 3; ++dl) {
                                        const int sl = (lanev - dl) & 63; uint4 xu;
                                        { const unsigned c0 = sh_idx(rg[kq].x, sl, lanev), p0 = sh_idx(rg[3 + kq].x, sl, lanev); xu.x = (lanev >= dl) ? c0 : p0; }
                                        { const unsigned c0 = sh_idx(rg[kq].y, sl, lanev), p0 = sh_idx(rg[3 + kq].y, sl, lanev); xu.y = (lanev >= dl) ? c0 : p0; }
                                        { const unsigned c0 = sh_idx(rg[kq].z, sl, lanev), p0 = sh_idx(rg[3 + kq].z, sl, lanev); xu.z = (lanev >= dl) ? c0 : p0; }
                                        { const unsigned c0 = sh_idx(rg[kq].w, sl, lanev), p0 = sh_idx(rg[3 + kq].w, sl, lanev); xu.w = (lanev >= dl) ? c0 : p0; }
                                        float x[8]; unpack8(xu, x);
                                        const float4 w0 = *(const float4*)(cw + (3 - dl) * 384), w1 = *(const float4*)(cw + (3 - dl) * 384 + 4);
                                        r[0] += w0.x * x[0]; r[1] += w0.y * x[1]; r[2] += w0.z * x[2]; r[3] += w0.w * x[3]; r[4] += w1.x * x[4]; r[5] += w1.y * x[5]; r[6] += w1.z * x[6]; r[7] += w1.w * x[7];
                                    }
                                    rg[3 + kq] = rg[kq];
                                    const float sc = which ? 1.0f : 0.10206207261596575f;
#pragma unroll
                                    for (int i = 0; i < 8; ++i) r[i] = r[i] * sigmoidf(r[i]) * sc;
                                    ux4 pk; pk.x = pg8::cvt_pk_bf16(r[0], r[1]); pk.y = pg8::cvt_pk_bf16(r[2], r[3]); pk.z = pg8::cvt_pk_bf16(r[4], r[5]); pk.w = pg8::cvt_pk_bf16(r[6], r[7]);
                                    if (which == 0) *(LAS ux4*)(Qs + s * 104 + 8 * cg) = pk;
                                    else { *(LAS ux4*)(Ks + s * 104 + 8 * cg) = pk; const float es = eArr[s]; LAS bf16* d = KTe + (8 * cg) * 72 + s;
#pragma unroll
                                        for (int i = 0; i < 8; ++i) d[72 * i] = f2bf(r[i] * es); }
                                }
                            } else {
#pragma unroll
                                for (int kq = 0; kq < 2; ++kq) {
                                    const int idx = tidv + NTHR * kq;
                                    if (idx < 768) {
                                        const int which = idx / 384, rem = idx % 384, cg = rem >> 6, s = rem & 63;
                                        float x1[8], x2[8]; { uint4 xu; xu.x = rg[kq].x; xu.y = rg[kq].y; xu.z = rg[kq].z; xu.w = rg[kq].w; unpack8(xu, x1); xu.x = rg[2 + kq].x; xu.y = rg[2 + kq].y; xu.z = rg[2 + kq].z; xu.w = rg[2 + kq].w; unpack8(xu, x2); }
                                        const unsigned rpw[8] = {rg[4 + 2 * kq].x, rg[4 + 2 * kq].y, rg[4 + 2 * kq].z, rg[4 + 2 * kq].w, rg[5 + 2 * kq].x, rg[5 + 2 * kq].y, rg[5 + 2 * kq].z, rg[5 + 2 * kq].w};
                                        float o1[8], o2[8]; const float sc = which ? 0.10206207261596575f : 1.0f;
#pragma unroll
                                        for (int q8 = 0; q8 < 8; ++q8) { const h2_t cs_ = __builtin_bit_cast(h2_t, rpw[q8]); const float c0 = (float)cs_.x, s0 = (float)cs_.y;
                                            o1[q8] = (x1[q8] * c0 - x2[q8] * s0) * sc; o2[q8] = (x2[q8] * c0 + x1[q8] * s0) * sc; }
                                        ux4 p1; p1.x = pg8::cvt_pk_bf16(o1[0], o1[1]); p1.y = pg8::cvt_pk_bf16(o1[2], o1[3]); p1.z = pg8::cvt_pk_bf16(o1[4], o1[5]); p1.w = pg8::cvt_pk_bf16(o1[6], o1[7]);
                                        ux4 p2; p2.x = pg8::cvt_pk_bf16(o2[0], o2[1]); p2.y = pg8::cvt_pk_bf16(o2[2], o2[3]); p2.z = pg8::cvt_pk_bf16(o2[4], o2[5]); p2.w = pg8::cvt_pk_bf16(o2[6], o2[7]);
                                        LAS bf16* dst = which ? Ks : Qs;
                                        *(LAS ux4*)(dst + s * 104 + 8 * cg) = p1; *(LAS ux4*)(dst + s * 104 + 48 + 8 * cg) = p2;
                                        if (which) { const float es = eArr[s]; LAS bf16* d = KTe + (8 * cg) * 72 + s;
#pragma unroll
                                            for (int i = 0; i < 8; ++i) { d[72 * i] = f2bf(o1[i] * es); d[72 * (48 + i)] = f2bf(o2[i] * es); } }
                                    }
                                }
                            }
                            if (c + 1 < SEQ / 64) LINATT_LOAD_RAW(c + 1);
                            LDS_BARRIER(); __builtin_amdgcn_sched_barrier(0);
                            {
                                bx8 yq[3];
#pragma unroll
                                for (int kk = 0; kk < 3; ++kk) yq[kk] = *(const LAS bx8*)(Qs + (16 * jt + tokv) * 104 + 32 * kk + 8 * sgv);
                                const int j = 16 * jt + tokv; const float Mj = MArr[j];
#pragma unroll
                                for (int q2 = 0; q2 < 2; ++q2) {
                                    const int st = 2 * half + q2; fx4 d = (fx4){0.f, 0.f, 0.f, 0.f};
                                    if (st <= jt) {
#pragma unroll
                                        for (int kk = 0; kk < 3; ++kk) { const bx8 xk = *(const LAS bx8*)(Ks + (16 * st + tokv) * 104 + 32 * kk + 8 * sgv); d = __builtin_amdgcn_mfma_f32_16x16x32_bf16(xk, yq[kk], d, 0, 0, 0); }
#pragma unroll
                                        for (int r = 0; r < 4; ++r) { const int s = 16 * st + 4 * sgv + r; d[r] = (s <= j) ? d[r] * __expf(aArr[s] - Mj) : 0.f; }
                                    }
                                    ux2 pw; pw.x = pg8::cvt_pk_bf16(d[0], d[1]); pw.y = pg8::cvt_pk_bf16(d[2], d[3]);
                                    *(LAS ux2*)(Ps + j * 72 + 16 * st + 4 * sgv) = pw;
                                }
                            }
                            LDS_BARRIER();
                            __builtin_amdgcn_sched_barrier(0);
                            if (kind == 1) {
                                const int j = tidv >> 3, part = tidv & 7; float dq = 0.f, dp = 0.f;
#pragma unroll
                                for (int i = 0; i < 12; ++i) dq += bf2f(Qs[j * 104 + part * 12 + i]) * nArr[part * 12 + i];
#pragma unroll
                                for (int s = 0; s < 8; ++s) dp += bf2f(Ps[j * 72 + part * 8 + s]);
                                float dn = interArr[j] * dq + dp; dn += sh_xor(dn, 1, lane); dn += sh_xor(dn, 2, lane); dn += sh_xor(dn, 4, lane);
                                if (part == 0) denArr[j] = dn;
                            }
                            __builtin_amdgcn_sched_barrier(0);
                            fx4 acc[6];
                            const size_t orow = row0 + 16 * jt + tokv;
                            ux2 ogate[6];
#pragma unroll
                            for (int x = 0; x < 6; ++x) ogate[x] = *(const ux2*)(proj + orow * LDP + 1536 + h * 192 + 16 * (6 * half + x) + 4 * sgv);
                            {
                                bx8 yq[3];
#pragma unroll
                                for (int kk = 0; kk < 3; ++kk) yq[kk] = *(const LAS bx8*)(Qs + (16 * jt + tokv) * 104 + 32 * kk + 8 * sgv);
#pragma unroll
                                for (int x = 0; x < 6; ++x) { acc[x] = (fx4){0.f, 0.f, 0.f, 0.f}; const int ct = 6 * half + x;
#pragma unroll
                                    for (int kk = 0; kk < 3; ++kk) { const bx8 xc = *(const LAS bx8*)(CT + (16 * ct + tokv) * 104 + 32 * kk + 8 * sgv); acc[x] = __builtin_amdgcn_mfma_f32_16x16x32_bf16(xc, yq[kk], acc[x], 0, 0, 0); } }
                                __builtin_amdgcn_sched_barrier(0);
                                const float in_j = interArr[16 * jt + tokv];
#pragma unroll
                                for (int x = 0; x < 6; ++x) acc[x] = acc[x] * in_j;
                                bx8 yp[2];
#pragma unroll
                                for (int kk = 0; kk < 2; ++kk) yp[kk] = *(const LAS bx8*)(Ps + (16 * jt + tokv) * 72 + 32 * kk + 8 * sgv);
#pragma unroll
                                for (int x = 0; x < 6; ++x) { const int ct = 6 * half + x;
#pragma unroll
                                    for (int kk = 0; kk < 2; ++kk) { const bx8 xv = *(const LAS bx8*)(VT + (16 * ct + tokv) * 72 + 32 * kk + 8 * sgv); acc[x] = __builtin_amdgcn_mfma_f32_16x16x32_bf16(xv, yp[kk], acc[x], 0, 0, 0); } }
                            }
                            __builtin_amdgcn_sched_barrier(0);
                            {
                                const float sa = scal[0];
                                bx8 yv[3][2];
#pragma unroll
                                for (int x = 0; x < 3; ++x)
#pragma unroll
                                    for (int kk = 0; kk < 2; ++kk) yv[x][kk] = *(const LAS bx8*)(VT + (16 * (ctU + x) + tokv) * 72 + 32 * kk + 8 * sgv);
#pragma unroll
                                for (int x = 0; x < 3; ++x) { bx8 xk[2];
#pragma unroll
                                    for (int kk = 0; kk < 2; ++kk) xk[kk] = *(const LAS bx8*)(KTe + (16 * (itU + x) + tokv) * 72 + 32 * kk + 8 * sgv);
#pragma unroll
                                    for (int y = 0; y < 3; ++y) { Cst[x][y] = Cst[x][y] * sa;
#pragma unroll
                                        for (int kk = 0; kk < 2; ++kk) Cst[x][y] = __builtin_amdgcn_mfma_f32_16x16x32_bf16(xk[kk], yv[y][kk], Cst[x][y], 0, 0, 0); } }
                                if (kind == 1 && tidv < 96) { float sn = 0.f;
#pragma unroll 8
                                    for (int s = 0; s < 64; ++s) sn += bf2f(KTe[tidv * 72 + s]);
                                    nreg = sa * nreg + sn; }
                            }
                            __builtin_amdgcn_sched_barrier(0);
                            LDS_BARRIER();
                            {
                                const int j = 16 * jt + tokv;
                                if (kind == 1) { const float dv = 1.0f / fmaxf(fabsf(denArr[j]), clampArr[j]);
#pragma unroll
                                    for (int x = 0; x < 6; ++x) acc[x] = acc[x] * dv; }
                                float s1 = 0.f, s2 = 0.f;
#pragma unroll
                                for (int x = 0; x < 6; ++x)
#pragma unroll
                                    for (int r = 0; r < 4; ++r) { s1 += acc[x][r]; s2 += acc[x][r] * acc[x][r]; }
                                s1 += sh_xor(s1, 16, lane); s1 += sh_xor(s1, 32, lane); s2 += sh_xor(s2, 16, lane); s2 += sh_xor(s2, 32, lane);
                                if (sgv == 0) { stat[(j * 2 + half) * 2 + 0] = s1; stat[(j * 2 + half) * 2 + 1] = s2; }
                            }
                            LDS_BARRIER();
                            {
                                const int j = 16 * jt + tokv;
                                const float mean = (stat[j * 4 + 0] + stat[j * 4 + 2]) * (1.0f / 192.0f);
                                const float var = (stat[j * 4 + 1] + stat[j * 4 + 3]) * (1.0f / 192.0f) - mean * mean;
                                const float rstd = 1.0f / sqrtf(fmaxf(var, 0.f) + LN_EPS);
#pragma unroll
                                for (int x = 0; x < 6; ++x) { const int colh = 16 * (6 * half + x) + 4 * sgv; const float4 g4 = *(const float4*)(norm_g + h * 192 + colh);
                                    const float o0 = __uint_as_float(ogate[x].x << 16), o1 = __uint_as_float(ogate[x].x & 0xffff0000u), o2 = __uint_as_float(ogate[x].y << 16), o3 = __uint_as_float(ogate[x].y & 0xffff0000u);
                                    float g0, g1, g2, g3;
                                    if (kind == 1) { g0 = sigmoidf(o0); g1 = sigmoidf(o1); g2 = sigmoidf(o2); g3 = sigmoidf(o3); } else { g0 = o0 * sigmoidf(o0); g1 = o1 * sigmoidf(o1); g2 = o2 * sigmoidf(o2); g3 = o3 * sigmoidf(o3); }
                                    ux2 ov; ov.x = pg8::cvt_pk_bf16((acc[x][0] - mean) * rstd * g4.x * g0, (acc[x][1] - mean) * rstd * g4.y * g1); ov.y = pg8::cvt_pk_bf16((acc[x][2] - mean) * rstd * g4.z * g2, (acc[x][3] - mean) * rstd * g4.w * g3);
                                    *(ux2*)(cat + orow * D + h * 192 + colh) = ov; }
#pragma unroll
                                for (int x = 0; x < 3; ++x)
#pragma unroll
                                    for (int y = 0; y < 3; ++y) { ux2 cw; cw.x = pg8::cvt_pk_bf16(Cst[x][y][0], Cst[x][y][1]); cw.y = pg8::cvt_pk_bf16(Cst[x][y][2], Cst[x][y][3]);
                                        *(LAS ux2*)(CT + (16 * (ctU + y) + tokv) * 104 + 16 * (itU + x) + 4 * sgv) = cw; }
                                if (kind == 1 && tidv < 96) nArr[tidv] = nreg;
                            }
                        }
                    }
                }
#else
                LAS float* sq = ldsf; LAS float* sk = ldsf + 96; LAS float* sg = ldsf + 192; LAS float* sred = ldsf + 256;
                const float* conv_q = (const float*)ARGP(17); const float* conv_k = (const float*)ARGP(18);
                const float* b_i = (const float*)ARGP(19); const float* b_f = (const float*)ARGP(20);
                const float* norm_g = (const float*)(kind == 1 ? ARGP(21) : ARGP(23));
                for (int unit = bid; unit < NB * 4; unit += G) {
                    const int b = unit >> 2, h = unit & 3;
                    const float gamma = 1.0f - exp2f(-5.0f - (float)h);
                    float C[96];
#pragma unroll
                    for (int i = 0; i < 96; ++i) C[i] = 0.f;
                    for (int t = 0; t < SEQ; ++t) {
                        const size_t row = (size_t)b * SEQ + t; const bf16* pr = proj + row * LDP;
                        if (tid < 192) {
                            const int c = tid % 96; const bool isk = tid >= 96; const int ch = h * 96 + c; const int col = (isk ? 384 : 0) + ch;
                            float s;
                            if (kind == 1) {
                                const float* cw = isk ? conv_k : conv_q; s = 0.f;
#pragma unroll
                                for (int w = 0; w < 4; ++w) { const int tt = t - 3 + w; if (tt >= 0) s += cw[w * 384 + ch] * bf2f(proj[((size_t)b * SEQ + tt) * LDP + col]); }
                                s = s * sigmoidf(s); if (!isk) s *= 0.10206207261596575f;
                            } else {
                                const int i = c % 48; const bool first = c < 48; const int cb = (isk ? 384 : 0) + h * 96;
                                const float t1 = bf2f(pr[cb + i]), t2 = bf2f(pr[cb + 48 + i]);
                                typedef _Float16 h2_t __attribute__((ext_vector_type(2))); const h2_t cs_ = __builtin_bit_cast(h2_t, ((const unsigned*)rope)[row * 48 + i]); const float cs = (float)cs_.x, sn = (float)cs_.y;
                                s = first ? (t1 * cs - t2 * sn) : (t2 * cs + t1 * sn); if (isk) s *= 0.10206207261596575f;
                            }
                            (isk ? sk : sq)[c] = s;
                        }
                        if (tid == 192) {
                            if (kind == 1) { const float ig = bf2f(pr[2304 + h]) + b_i[h], fg = bf2f(pr[2308 + h]) + b_f[h]; sg[0] = sigmoidf(fg); sg[1] = __expf(ig); }
                            else { sg[0] = gamma; sg[1] = 1.0f; }
                        }
                        __syncthreads();
                        const float f = sg[0], ei = sg[1];
                        float num = 0.f;
                        if (tid < 193) {
                            const float v = tid < 192 ? bf2f(pr[768 + h * 192 + tid]) : 1.0f;
#pragma unroll
                            for (int i = 0; i < 96; ++i) { C[i] = f * C[i] + (ei * sk[i]) * v; num += sq[i] * C[i]; if ((i & 15) == 15) asm volatile("" ::: "memory"); }
                            if (tid == 192) sg[2] = num;
                        }
                        __syncthreads();
                        float hv = num;
                        if (kind == 1) hv = num / fmaxf(fabsf(sg[2]), 1.0f);
                        float s1 = (tid < 192) ? hv : 0.f; s1 = wave_sum(s1, lane); if (lane == 0) sred[wave] = s1;
                        __syncthreads();
                        const float mean = (sred[0] + sred[1] + sred[2]) * (1.0f / 192.0f);
                        float dv = (tid < 192) ? (hv - mean) : 0.f; float s2 = wave_sum(dv * dv, lane); if (lane == 0) sred[8 + wave] = s2;
                        __syncthreads();
                        const float var = (sred[8] + sred[9] + sred[10]) * (1.0f / 192.0f);
                        if (tid < 192) {
                            const float yn = dv * (1.0f / sqrtf(var + LN_EPS)) * norm_g[h * 192 + tid];
                            const float ov = bf2f(pr[1536 + h * 192 + tid]);
                            const float outv = (kind == 1) ? sigmoidf(ov) * yn : (ov * sigmoidf(ov)) * yn;
                            cat[row * D + h * 192 + tid] = f2bf(outv);
                        }
                    }
                }
#endif
            }
            }
#if BG_CONV && FAST_MOE
            {
                const bool bg_here = (BG_ALL && LINATT_V2) ? true : (kind != 0);
                if (bg_here) {
                const bool s5_overlap = (kind == 0) && (G >= 192);
                if (!s5_overlap) __syncthreads();
                LAS float* scr = !s5_overlap ? ldsf + wave * (64 * 65) : (wave < 2 ? ldsf + wave * 8192 : ldsf + 16384 + (wave - 2) * (64 * 65));
                unsigned* qh = ctl + CW_CQ + 64 * L;
                constexpr int PERL = NEXP * (512 + 256), HALF2 = LINATT_V2 ? PERL / 2 : PERL;
                const int g0 = (BG_ALL && LINATT_V2) ? L * PERL : ((L == 1) ? PERL : 2 * PERL + HALF2), g1 = (BG_ALL && LINATT_V2) ? (L + 1) * PERL : ((L == 1) ? 2 * PERL + HALF2 : 4 * PERL);
                if (!s5_overlap || wave < 6)
                for (;;) {
                    int it = 0; if (lane == 0) it = (int)__hip_atomic_fetch_add(qh, 1u, __ATOMIC_RELAXED, __HIP_MEMORY_SCOPE_AGENT);
                    it = __builtin_amdgcn_readfirstlane(it) + g0;
                    if (it >= g1) break;
                    const int Lc = it / PERL; it = it % PERL;
                    if (it < NEXP * 512) { const int le = Lc * NEXP + (it >> 9);
#if MOE_FP8
                        tr_item8<LINATT_V2>((const float*)ARGP(42) + (size_t)le * D * 2 * DEXP, 2 * DEXP, D, wgu8 + (size_t)le * 2 * DEXP * D, 32, it & 511, scr, lane, GU_WS, [](int d) { const int tile = d >> 8, q = d & 255; return q < 128 ? tile * 128 + q : DEXP + tile * 128 + (q - 128); });
#else
                        tr_item((const float*)ARGP(42) + (size_t)le * D * 2 * DEXP, 2 * DEXP, D, wgu_t + (size_t)le * 2 * DEXP * D, 32, it & 511, scr, lane, [](int d) { const int tile = d >> 8, q = d & 255; return q < 128 ? tile * 128 + q : DEXP + tile * 128 + (q - 128); });
#endif
                    }
                    else { const int r = it - NEXP * 512; const int le = Lc * NEXP + (r >> 8);
#if MOE_FP8
                        tr_item8<LINATT_V2>((const float*)ARGP(44) + (size_t)le * DEXP * D, D, DEXP, wdn8 + (size_t)le * D * DEXP, 16, r & 255, scr, lane, DN_WS, [](int d) { return d; });
#else
                        tr_item((const float*)ARGP(44) + (size_t)le * DEXP * D, D, DEXP, wdn_t + (size_t)le * D * DEXP, 16, r & 255, scr, lane, [](int d) { return d; });
#endif
                    }
                }
                }
            }
#endif
            REPS(13) { if (rep_) __syncthreads();
#if FAST_XATTN
            {
                typedef pg8::bf16x8 bx8; typedef pg8::f32x4 fx4;
                LAS bf16* Kt = (LAS bf16*)lds;
                LAS bf16* Vt = (LAS bf16*)(lds + 36864);
                const int tok = lane & 15, sg = lane >> 4;
                const int xa_skip = (LINATT_V2 && kind != 0 && G > 192) ? 128 : 0;
                for (int unit = bid - xa_skip; unit >= 0 && unit < NB * 4 * 8; unit += G - xa_skip) {
                    const int b = unit >> 5, head = (unit >> 3) & 3, qt = unit & 7;
                    __syncthreads();
                    const bf16* kg = memK + (size_t)(b * 4 + head) * 256 * 64; const bf16* vg = memVT + (size_t)(b * 4 + head) * 64 * 256;
                    for (int c = tid; c < 2048; c += NTHR) { const int key = c >> 3, d8 = (c & 7) * 8; *(LAS pg8::u32x4*)(Kt + key * 72 + d8) = *(const pg8::u32x4*)(kg + key * 64 + d8); }
                    for (int c = tid; c < 2048; c += NTHR) { const int d = c >> 5, m = (c & 31) * 8; const pg8::u32x4 v = *(const pg8::u32x4*)(vg + d * 256 + m);
                        const int a = m >> 5, w = m & 31, tp = w >> 4, sk = (w & 15) >> 2;
                        pg8::u32x2 lo; lo.x = v.x; lo.y = v.y; pg8::u32x2 hi2; hi2.x = v.z; hi2.y = v.w;
                        *(LAS pg8::u32x2*)(Vt + d * 264 + 32 * a + 8 * sk + 4 * tp) = lo; *(LAS pg8::u32x2*)(Vt + d * 264 + 32 * a + 8 * (sk + 1) + 4 * tp) = hi2; }
                    __syncthreads();
#pragma unroll 1
                    for (int qi = 0; qi < 2; ++qi) {
                        const size_t row = (size_t)b * SEQ + qt * 256 + wave * 32 + qi * 16 + tok;
                        const bf16* qp = proj + row * LDP + xq_off + head * 64 + 8 * sg;
                        const bx8 q0 = __builtin_bit_cast(bx8, *(const uint4*)qp), q1 = __builtin_bit_cast(bx8, *(const uint4*)(qp + 32));
                        fx4 s[16];
#pragma unroll
                        for (int kt = 0; kt < 16; ++kt) { const bx8 k0 = *(const LAS bx8*)(Kt + (16 * kt + tok) * 72 + 8 * sg), k1 = *(const LAS bx8*)(Kt + (16 * kt + tok) * 72 + 32 + 8 * sg);
                            s[kt] = __builtin_amdgcn_mfma_f32_16x16x32_bf16(k0, q0, (fx4){0.f, 0.f, 0.f, 0.f}, 0, 0, 0); s[kt] = __builtin_amdgcn_mfma_f32_16x16x32_bf16(k1, q1, s[kt], 0, 0, 0); }
                        float mx = -3.0e38f;
#pragma unroll
                        for (int kt = 0; kt < 16; ++kt) mx = fmaxf(fmaxf(fmaxf(s[kt][0], s[kt][1]), fmaxf(s[kt][2], s[kt][3])), mx);
                        mx = fmaxf(mx, sh_xor(mx, 16, lane)); mx = fmaxf(mx, sh_xor(mx, 32, lane));
                        float sum = 0.f;
#pragma unroll
                        for (int kt = 0; kt < 16; ++kt)
#pragma unroll
                            for (int r = 0; r < 4; ++r) { const float pe = __expf((s[kt][r] - mx) * 0.125f); s[kt][r] = pe; sum += pe; }
                        sum += sh_xor(sum, 16, lane); sum += sh_xor(sum, 32, lane);
                        fx4 o[4];
#pragma unroll
                        for (int dt = 0; dt < 4; ++dt) o[dt] = (fx4){0.f, 0.f, 0.f, 0.f};
#pragma unroll
                        for (int a = 0; a < 8; ++a) {
                            uint4 pw; pw.x = pg8::cvt_pk_bf16(s[2 * a][0], s[2 * a][1]); pw.y = pg8::cvt_pk_bf16(s[2 * a][2], s[2 * a][3]); pw.z = pg8::cvt_pk_bf16(s[2 * a + 1][0], s[2 * a + 1][1]); pw.w = pg8::cvt_pk_bf16(s[2 * a + 1][2], s[2 * a + 1][3]);
                            const bx8 pf = __builtin_bit_cast(bx8, pw);
#pragma unroll
                            for (int dt = 0; dt < 4; ++dt) { const bx8 vf = *(const LAS bx8*)(Vt + (16 * dt + tok) * 264 + 32 * a + 8 * sg); o[dt] = __builtin_amdgcn_mfma_f32_16x16x32_bf16(vf, pf, o[dt], 0, 0, 0); }
                        }
                        const float inv = 1.0f / sum; bf16* op = cat + row * D + MIXW + head * 64 + 4 * sg;
#pragma unroll
                        for (int dt = 0; dt < 4; ++dt) { uint2 ov; ov.x = pg8::cvt_pk_bf16(o[dt][0] * inv, o[dt][1] * inv); ov.y = pg8::cvt_pk_bf16(o[dt][2] * inv, o[dt][3] * inv); *(uint2*)(op + 16 * dt) = ov; }
                    }
                }
            }
#else
            for (int wu = bid * NWAVES + wave; wu < (T / 16) * 4; wu += G * NWAVES) {
                const int head = wu & 3, row = (wu >> 2) * 16 + (lane >> 2), part = lane & 3, b = row / SEQ;
                float q[16], acc[16];
                { const bf16* qp = proj + (size_t)row * LDP + xq_off + head * 64 + part * 16;
                  unpack8(*(const uint4*)qp, q); unpack8(*(const uint4*)(qp + 8), q + 8);
#pragma unroll
                  for (int d = 0; d < 16; ++d) { q[d] *= 0.125f; acc[d] = 0.f; } }
                float mx = -3.0e38f, l = 0.f;
                const bf16* kb = memK + (size_t)(b * 4 + head) * 256 * 64 + part * 16; const bf16* vb = memV + (size_t)(b * 4 + head) * 256 * 64 + part * 16;
                for (int m = 0; m < NMEM; ++m) {
                    float kk[16]; unpack8(*(const uint4*)(kb + m * 64), kk); unpack8(*(const uint4*)(kb + m * 64 + 8), kk + 8);
                    float s = 0.f;
#pragma unroll
                    for (int j = 0; j < 16; ++j) s += q[j] * kk[j];
                    s += sh_xor(s, 1, lane); s += sh_xor(s, 2, lane);
                    const float mn = fmaxf(mx, s); const float corr = __expf(mx - mn), pv = __expf(s - mn); mx = mn; l = l * corr + pv;
                    float vv[16]; unpack8(*(const uint4*)(vb + m * 64), vv); unpack8(*(const uint4*)(vb + m * 64 + 8), vv + 8);
#pragma unroll
                    for (int j = 0; j < 16; ++j) acc[j] = acc[j] * corr + pv * vv[j];
                }
                const float il = 1.0f / l; bf16* op = cat + (size_t)row * D + MIXW + head * 64 + part * 16;
#pragma unroll
                for (int c = 0; c < 2; ++c) { uint4 o; o.x = pk2(acc[8 * c + 0] * il, acc[8 * c + 1] * il); o.y = pk2(acc[8 * c + 2] * il, acc[8 * c + 3] * il);
                    o.z = pk2(acc[8 * c + 4] * il, acc[8 * c + 5] * il); o.w = pk2(acc[8 * c + 6] * il, acc[8 * c + 7] * il); *(uint4*)(op + 8 * c) = o; }
            }
#endif
        } }
        SEAM(P + LP_MIXA);

        if (IN(P + LP_MIXB)) {
            PHASE_IDS();
            REPS(4) { if (rep_) __syncthreads();
            if (kind == 0) {
                const float* w_glu = (const float*)(L == 0 ? ARGP(14) : ARGP(33)); const float* b_glu = (const float*)(L == 0 ? ARGP(15) : ARGP(34));
#if FAST_DENSE
                { (void)w_glu; pg8::Gemm g{yg, wglu_t + (size_t)(L == 0 ? 0 : 1) * MiB, MIXW, nullptr}; pg8::StaticOrder S; S.init(T, MIXW, G, bid); pg8::EpiGlu E{cat, D, yg, MIXW, b_glu}; pg8::gemm_phase(lds, g, S, E, wave); }
#else
                oracle_gemm(ldsf, T, MIXW, MIXW,
                    [&](int) { return 0; },
                    [&](int m, int k) { return bf2f(yg[(size_t)m * MIXW + k]); },
                    [&](int k, int n, int) { return w_glu[(size_t)k * MIXW + n]; },
                    [&](int m0, int n0, float (&acc)[4][8], int) {
#pragma unroll
                        for (int i = 0; i < 4; ++i)
#pragma unroll
                            for (int j = 0; j < 8; ++j) { const int m = m0 + i, n = n0 + j; const float z = acc[i][j] + b_glu[n]; const float yv = bf2f(yg[(size_t)m * MIXW + n]);
                                cat[(size_t)m * D + n] = f2bf(yv * sigmoidf(z)); }
                    });
#endif
            }
        } }
        if (kind == 0) SEAM(P + LP_MIXB);

        if (IN(P + LP_OUTPROJ)) {
            PHASE_IDS();
            REPS(5) { if (rep_) __syncthreads();
            const float* w_out = (const float*)ARGP(35) + (size_t)L * D * D;
#if FAST_DENSE
            { (void)w_out; pg8::Gemm g{cat, wout_t + (size_t)L * D * D, D, nullptr}; pg8::StaticOrder S; S.init(T, D, G, bid);
#if RES_BF16
              pg8::EpiResBf16 E{(bf16*)y2, hb, D, DN_ALPHA}; pg8::gemm_phase(lds, g, S, E, wave); }
#else
              pg8::EpiResF32 E{y2, hf, D, DN_ALPHA}; pg8::gemm_phase(lds, g, S, E, wave); }
#endif
#else
            oracle_gemm(ldsf, T, D, D,
                [&](int) { return 0; },
                [&](int m, int k) { return bf2f(cat[(size_t)m * D + k]); },
                [&](int k, int n, int) { return w_out[(size_t)k * D + n]; },
                [&](int m0, int n0, float (&acc)[4][8], int) {
#pragma unroll
                    for (int i = 0; i < 4; ++i)
#pragma unroll
                        for (int j = 0; j < 8; ++j) { const size_t o = (size_t)(m0 + i) * D + n0 + j; y2[o] = DN_ALPHA * hf[o] + acc[i][j]; }
                });
#endif
        } }
        SEAM(P + LP_OUTPROJ);

        if (IN(P + LP_LN1)) {
            PHASE_IDS();
            REPS(8) { if (rep_) __syncthreads();
            const float* g1 = (const float*)ARGP(36) + L * D; const float* b1 = (const float*)ARGP(37) + L * D;
            const float* rw = (const float*)ARGP(40) + (size_t)L * D * NEXP; const float* rb = (const float*)ARGP(41) + L * NEXP;
#if FAST_LN1
            {
            typedef pg8::bf16x8 bx8; typedef pg8::f32x4 fx4; typedef pg8::u32x4 ux4;
            LAS bf16* SL = (LAS bf16*)lds;
            LAS float* stg = (LAS float*)(lds + 67584 + wave * 8320);
            LAS int* hist = (LAS int*)(lds + 67584 + 8 * 8320); LAS int* lbase = hist + 32; (void)lbase;
            const bf16* rw_g = rwt + (size_t)(L * 2) * NEXP * D;
#define LN1_SLICE_LOAD(dst, q) do { _Pragma("unroll") for (int i_ = 0; i_ < 4; ++i_) { const int c_ = tid + NTHR * i_; dst[i_] = *(const ux4*)(rw_g + (size_t)((c_ >> 10) * NEXP + ((c_ >> 5) & 31)) * D + 256 * (q) + 8 * (c_ & 31)); } } while (0)
#define LN1_SLICE_STORE(src_, buf) do { _Pragma("unroll") for (int i_ = 0; i_ < 4; ++i_) { const int c_ = tid + NTHR * i_; *(LAS ux4*)(SL + (((buf) * 2 + (c_ >> 10)) * 32 + ((c_ >> 5) & 31)) * 264 + 8 * (c_ & 31)) = src_[i_]; } } while (0)
            { ux4 s0[4]; LN1_SLICE_LOAD(s0, 0); LN1_SLICE_STORE(s0, 0); }
            LAS float* g1s = (LAS float*)(lds + LDS_RMAP); LAS float* b1s = g1s + D;
            for (int i = tid; i < D; i += NTHR) { g1s[i] = g1[i]; b1s[i] = b1[i]; }
            if (tid < 32) hist[tid] = 0;
            __syncthreads();
            const int tok = lane & 15, sg = lane >> 4;
            for (int wt = bid * NWAVES + wave; wt < T / 8; wt += G * NWAVES) {
                float4 v[8][4];
#pragma unroll
                for (int rr = 0; rr < 8; ++rr)
#pragma unroll
                    for (int j = 0; j < 4; ++j) {
#if RES_BF16
                        const uint2 yv_ = *(const uint2*)((const bf16*)y2 + ((size_t)wt * 8 + rr) * D + (lane + 64 * j) * 4);
                        v[rr][j] = make_float4(__uint_as_float(yv_.x << 16), __uint_as_float(yv_.x & 0xffff0000u), __uint_as_float(yv_.y << 16), __uint_as_float(yv_.y & 0xffff0000u));
#else
                        v[rr][j] = *(const float4*)(y2 + ((size_t)wt * 8 + rr) * D + (lane + 64 * j) * 4);
#endif
                    }
#pragma unroll
                for (int rr = 0; rr < 8; ++rr) {
                    float s = 0.f;
#pragma unroll
                    for (int j = 0; j < 4; ++j) s += (v[rr][j].x + v[rr][j].y) + (v[rr][j].z + v[rr][j].w);
                    const float mean = wave_sum(s, lane) * (1.0f / D); float s2 = 0.f;
#pragma unroll
                    for (int j = 0; j < 4; ++j) { v[rr][j].x -= mean; v[rr][j].y -= mean; v[rr][j].z -= mean; v[rr][j].w -= mean; s2 += (v[rr][j].x * v[rr][j].x + v[rr][j].y * v[rr][j].y) + (v[rr][j].z * v[rr][j].z + v[rr][j].w * v[rr][j].w); }
                    const float rstd = 1.0f / sqrtf(wave_sum(s2, lane) * (1.0f / D) + LN_EPS);
                    const size_t row = (size_t)wt * 8 + rr;
#pragma unroll
                    for (int j = 0; j < 4; ++j) { const int cc = (lane + 64 * j) * 4; const fx4 gq_ = *(const LAS fx4*)(g1s + cc), bq_ = *(const LAS fx4*)(b1s + cc); const float4 gg = make_float4(gq_[0], gq_[1], gq_[2], gq_[3]), bb = make_float4(bq_[0], bq_[1], bq_[2], bq_[3]);
                        float4 o; o.x = v[rr][j].x * rstd * gg.x + bb.x; o.y = v[rr][j].y * rstd * gg.y + bb.y; o.z = v[rr][j].z * rstd * gg.z + bb.z; o.w = v[rr][j].w * rstd * gg.w + bb.w;
                        v[rr][j] = o;
#if RES_BF16
                        { uint2 ob; ob.x = pg8::cvt_pk_bf16(o.x, o.y); ob.y = pg8::cvt_pk_bf16(o.z, o.w); *(uint2*)(hb + row * D + cc) = ob; }
#else
                        *(float4*)(hf + row * D + cc) = o;
#endif
#if MOE_FP8 && MOE_GATHER
                        { int w8 = __builtin_amdgcn_cvt_pk_fp8_f32(o.x, o.y, 0, false); w8 = __builtin_amdgcn_cvt_pk_fp8_f32(o.z, o.w, w8, true); *(int*)(hb8 + row * D + cc) = w8; }
#elif !RES_BF16
                        { uint2 ob; ob.x = pg8::cvt_pk_bf16(o.x, o.y); ob.y = pg8::cvt_pk_bf16(o.z, o.w); *(uint2*)(hb + row * D + cc) = ob; }
#endif
                    }
                }
                fx4 lacc[2]; lacc[0] = (fx4){0.f, 0.f, 0.f, 0.f}; lacc[1] = (fx4){0.f, 0.f, 0.f, 0.f};
#pragma unroll
                for (int j = 0; j < 4; ++j) {
                    ux4 snx[4]; if (j < 3) LN1_SLICE_LOAD(snx, j + 1);
#pragma unroll
                    for (int rr = 0; rr < 8; ++rr) *(LAS fx4*)(stg + rr * 260 + lane * 4) = (fx4){v[rr][j].x, v[rr][j].y, v[rr][j].z, v[rr][j].w};
                    asm volatile("s_waitcnt lgkmcnt(0)" ::: "memory");
#pragma unroll 2
                    for (int kk = 0; kk < 8; ++kk) {
                        fx4 f0 = (fx4){0.f, 0.f, 0.f, 0.f}, f1 = f0;
                        if (tok < 8) { f0 = *(const LAS fx4*)(stg + tok * 260 + 32 * kk + 8 * sg); f1 = *(const LAS fx4*)(stg + tok * 260 + 32 * kk + 8 * sg + 4); }
                        ux4 hw, lw;
                        hw.x = pg8::cvt_pk_bf16(f0[0], f0[1]); hw.y = pg8::cvt_pk_bf16(f0[2], f0[3]); hw.z = pg8::cvt_pk_bf16(f1[0], f1[1]); hw.w = pg8::cvt_pk_bf16(f1[2], f1[3]);
                        lw.x = pg8::cvt_pk_bf16(f0[0] - __uint_as_float(hw.x << 16), f0[1] - __uint_as_float(hw.x & 0xffff0000u)); lw.y = pg8::cvt_pk_bf16(f0[2] - __uint_as_float(hw.y << 16), f0[3] - __uint_as_float(hw.y & 0xffff0000u));
                        lw.z = pg8::cvt_pk_bf16(f1[0] - __uint_as_float(hw.z << 16), f1[1] - __uint_as_float(hw.z & 0xffff0000u)); lw.w = pg8::cvt_pk_bf16(f1[2] - __uint_as_float(hw.w << 16), f1[3] - __uint_as_float(hw.w & 0xffff0000u));
                        const bx8 yh = __builtin_bit_cast(bx8, hw), yl = __builtin_bit_cast(bx8, lw);
#pragma unroll
                        for (int t = 0; t < 2; ++t) { const int kcol = 32 * kk + 8 * sg;
                            const bx8 xh = *(const LAS bx8*)(SL + (((j & 1) * 2 + 0) * 32 + 16 * t + tok) * 264 + kcol); const bx8 xl = *(const LAS bx8*)(SL + (((j & 1) * 2 + 1) * 32 + 16 * t + tok) * 264 + kcol);
                            lacc[t] = __builtin_amdgcn_mfma_f32_16x16x32_bf16(xh, yh, lacc[t], 0, 0, 0); lacc[t] = __builtin_amdgcn_mfma_f32_16x16x32_bf16(xl, yh, lacc[t], 0, 0, 0); lacc[t] = __builtin_amdgcn_mfma_f32_16x16x32_bf16(xh, yl, lacc[t], 0, 0, 0); }
                    }
                    if (j < 3) LN1_SLICE_STORE(snx, (j + 1) & 1);
                    LDS_BARRIER();
                }
                if (wt + G * NWAVES < T / 8) { ux4 s0[4]; LN1_SLICE_LOAD(s0, 0); LN1_SLICE_STORE(s0, 0); LDS_BARRIER(); }
                float lv[8];
#pragma unroll
                for (int t = 0; t < 2; ++t) { const float4 rb4 = *(const float4*)(rb + 16 * t + 4 * sg); lv[4 * t + 0] = lacc[t][0] + rb4.x; lv[4 * t + 1] = lacc[t][1] + rb4.y; lv[4 * t + 2] = lacc[t][2] + rb4.z; lv[4 * t + 3] = lacc[t][3] + rb4.w; }
                float tv[4]; int ti[4];
#pragma unroll
                for (int k = 0; k < 4; ++k) {
                    float bv = -3.0e38f; int bi = 0;
#pragma unroll
                    for (int q = 0; q < 8; ++q) { const int e = 16 * (q >> 2) + 4 * sg + (q & 3); if (lv[q] > bv) { bv = lv[q]; bi = e; } }
#pragma unroll
                    for (int o = 16; o <= 32; o <<= 1) { const float ov = sh_xor(bv, o, lane); const int oi = sh_xor(bi, o, lane); if (ov > bv || (ov == bv && oi < bi)) { bv = ov; bi = oi; } }
                    tv[k] = bv; ti[k] = bi;
#pragma unroll
                    for (int q = 0; q < 8; ++q) { const int e = 16 * (q >> 2) + 4 * sg + (q & 3); if (e == bi) lv[q] = -3.0e38f; }
                }
                if (sg == 0 && tok < 8) {
                    const size_t row = (size_t)wt * 8 + tok; float ex[4], sum = 0.f;
#pragma unroll
                    for (int k = 0; k < 4; ++k) { ex[k] = __expf(tv[k] - tv[0]); sum += ex[k]; }
                    const float inv = 1.0f / sum;
                    *(int4*)(top_e + row * 4) = make_int4(ti[0], ti[1], ti[2], ti[3]); *(float4*)(top_g + row * 4) = make_float4(ex[0] * inv, ex[1] * inv, ex[2] * inv, ex[3] * inv);
#pragma unroll
                    for (int k = 0; k < 4; ++k) ti[k] |= atomicAdd((int*)&hist[ti[k]], 1) << 8;
                }
#if MOE_SPARSE
                __syncthreads();
                if (tid < 32) { const int hc = hist[tid]; lbase[tid] = hc ? (int)atomicAdd(ctl + CW_CNT + 64 * L + tid, (unsigned)hc) : 0; hist[tid] = 0; }
                __syncthreads();
                if (sg == 0 && tok < 8) { const size_t row = (size_t)wt * 8 + tok; int dd[4];
#pragma unroll
                    for (int k = 0; k < 4; ++k) { const int e = ti[k] & 255; dd[k] = e * T + lbase[e] + (ti[k] >> 8); row_tok[dd[k]] = (int)row; }
                    *(int4*)(dest + row * 4) = make_int4(dd[0], dd[1], dd[2], dd[3]); }
#endif
            }
#if !MOE_SPARSE
            __syncthreads();
            if (rep_ == 0 && tid < 32 && hist[tid] != 0) atomicAdd(ctl + CW_CNT + 64 * L + tid, (unsigned)hist[tid]);
#endif
            __syncthreads();
            }
#else
            LAS float* rows = ldsf; LAS float* lg = ldsf + 16 * 1024; LAS int* hist = (LAS int*)(ldsf + 16 * 1024 + 512);
            if (tid < 32) hist[tid] = 0;
            __syncthreads();
            for (int tile = bid; tile < T / 16; tile += G) {
#pragma unroll
                for (int rr = 0; rr < 2; ++rr) {
                    const int r = 2 * wave + rr; const size_t row = (size_t)tile * 16 + r;
                    float4 v[4]; float s = 0.f;
#pragma unroll
                    for (int j = 0; j < 4; ++j) { v[j] = *(const float4*)(y2 + row * D + (lane + 64 * j) * 4); s += (v[j].x + v[j].y) + (v[j].z + v[j].w); }
                    const float mean = wave_sum(s, lane) * (1.0f / D); float s2 = 0.f;
#pragma unroll
                    for (int j = 0; j < 4; ++j) { v[j].x -= mean; v[j].y -= mean; v[j].z -= mean; v[j].w -= mean; s2 += (v[j].x * v[j].x + v[j].y * v[j].y) + (v[j].z * v[j].z + v[j].w * v[j].w); }
                    const float rstd = 1.0f / sqrtf(wave_sum(s2, lane) * (1.0f / D) + LN_EPS);
#pragma unroll
                    for (int j = 0; j < 4; ++j) { const int c = (lane + 64 * j) * 4; const float4 gg = *(const float4*)(g1 + c), bb = *(const float4*)(b1 + c);
                        float4 o; o.x = v[j].x * rstd * gg.x + bb.x; o.y = v[j].y * rstd * gg.y + bb.y; o.z = v[j].z * rstd * gg.z + bb.z; o.w = v[j].w * rstd * gg.w + bb.w;
                        *(float4*)(hf + row * D + c) = o; uint2 ob; ob.x = pk2(o.x, o.y); ob.y = pk2(o.z, o.w); *(uint2*)(hb + row * D + c) = ob;
                        rows[r * 1024 + c + 0] = o.x; rows[r * 1024 + c + 1] = o.y; rows[r * 1024 + c + 2] = o.z; rows[r * 1024 + c + 3] = o.w; }
                }
                __syncthreads();
                { const int r = tid >> 5, e = tid & 31; float a = rb[e];
                  for (int k = 0; k < D; ++k) a += rows[r * 1024 + k] * rw[(size_t)k * NEXP + e];
                  lg[r * 32 + e] = a; }
                __syncthreads();
                if (tid < 16) {
                    const size_t row = (size_t)tile * 16 + tid; float tv[4]; int ti[4];
#pragma unroll
                    for (int k = 0; k < 4; ++k) { float best = -3.0e38f; int bi = 0;
                        for (int e = 0; e < NEXP; ++e) { const float v = lg[tid * 32 + e]; if (v > best) { best = v; bi = e; } }
                        tv[k] = best; ti[k] = bi; lg[tid * 32 + bi] = -3.0e38f; }
                    float ex[4], sum = 0.f;
#pragma unroll
                    for (int k = 0; k < 4; ++k) { ex[k] = __expf(tv[k] - tv[0]); sum += ex[k]; }
#pragma unroll
                    for (int k = 0; k < 4; ++k) { top_e[row * 4 + k] = ti[k]; top_g[row * 4 + k] = ex[k] / sum; atomicAdd((int*)&hist[ti[k]], 1); }
                }
                __syncthreads();
            }
            if (rep_ == 0 && tid < 32 && hist[tid] != 0) atomicAdd(ctl + CW_CNT + 64 * L + tid, (unsigned)hist[tid]);
            __syncthreads();
#endif
        } }
        SEAM(P + LP_LN1);

        if (!MOE_SPARSE && IN(P + LP_DISP)) {
            PHASE_IDS();
            REPS(9) { if (rep_) __syncthreads();
            LAS int* pstart = (LAS int*)ldsf; LAS int* lh = pstart + 32; LAS int* lbase = pstart + 64; LAS int* ldest = pstart + 128;
            if (tid == 0) { int a = 0; for (int e = 0; e < NEXP; ++e) { const int c = (int)__hip_atomic_load(ctl + CW_CNT + 64 * L + e, __ATOMIC_RELAXED, __HIP_MEMORY_SCOPE_AGENT); pstart[e] = a; a += ((c + MOEBLK - 1) / MOEBLK) * MOEBLK; } }
            __syncthreads();
#if MOE_GATHER
            for (int idx = bid * NTHR + tid; idx < NEXP * MOEBLK; idx += G * NTHR) { const int e = idx >> 8, r = idx & 255; const int cnt = (int)__hip_atomic_load(ctl + CW_CNT + 64 * L + e, __ATOMIC_RELAXED, __HIP_MEMORY_SCOPE_AGENT);
                const int padded = ((cnt + MOEBLK - 1) / MOEBLK) * MOEBLK; if (cnt + r < padded) row_tok[pstart[e] + cnt + r] = 0; }
#endif
            for (int tile = bid; tile < T * TOPK / NTHR; tile += G) {
                if (tid < 32) lh[tid] = 0;
                __syncthreads();
                const int pair = tile * NTHR + tid; const int e = top_e[pair];
                int dd;
                if (rep_ == 0) {
                const int rank = atomicAdd((int*)&lh[e], 1);
                __syncthreads();
                if (tid < 32) lbase[tid] = lh[tid] ? (int)atomicAdd(ctl + CW_CUR + 64 * L + tid, (unsigned)lh[tid]) : 0;
                __syncthreads();
                dd = pstart[e] + lbase[e] + rank; dest[pair] = dd; } else dd = dest[pair];
                ldest[tid] = dd;
#if MOE_GATHER
                if (rep_ == 0) row_tok[dd] = pair >> 2;
#endif
                __syncthreads();
#if !MOE_GATHER
                for (int i = 0; i < 64; ++i) { const int pp = wave * 64 + i; const int d2 = ldest[pp]; const int tt = (tile * NTHR + pp) >> 2;
                    const uint4* src = (const uint4*)(hb + (size_t)tt * D); uint4* dst = (uint4*)(xr + (size_t)d2 * D);
                    dst[lane] = src[lane]; dst[lane + 64] = src[lane + 64]; }
#endif
                __syncthreads();
            }
        } }
        if (!MOE_SPARSE) SEAM(P + LP_DISP);

        if (IN(P + LP_GU) || IN(P + LP_DOWN)) {
            PHASE_IDS();
            LAS int* pend = (LAS int*)(lds + LDS_MISC + 512);
            if (tid == 0) { int a = 0; for (int e = 0; e < NEXP; ++e) { const int c = (int)__hip_atomic_load(ctl + CW_CNT + 64 * L + e, __ATOMIC_RELAXED, __HIP_MEMORY_SCOPE_AGENT); a += ((c + MOEBLK - 1) / MOEBLK) * MOEBLK; pend[e] = a; } }
            __syncthreads();
        }
        if (IN(P + LP_GU)) {
            PHASE_IDS();
            REPS(6) { if (rep_) __syncthreads();
            const LAS int* pend = (const LAS int*)(lds + LDS_MISC + 512);
            const int nrows = pend[NEXP - 1];
            const float* wgu = (const float*)ARGP(42) + (size_t)L * NEXP * D * 2 * DEXP; const float* bgu = (const float*)ARGP(43) + (size_t)L * NEXP * 2 * DEXP;
#if FAST_MOE
            { (void)wgu; pg8::MoeOrder S{pend, nrows / 256, 8, G, vcu};
#if MOE_GATHER && MOE_FP8
              pg8::EpiSwiglu<true> E{act8, bgu, 1.0f / GU_WS};
              LAS int* rmapL = (LAS int*)(lds + LDS_RMAP);
              { pg8::Unit uu; for (int i = 0; i < 15 && S.next(i, uu); ++i) { if (tid < 256) { const int rt_ = row_tok[uu.pm * 256 + tid]; rmapL[i * 256 + tid] = rt_ < 0 ? 0 : (rt_ < T ? rt_ : T - 1); } } }
              __syncthreads();
              pg8::Gemm g{(const pg8::bf16_t*)hb8, (const pg8::bf16_t*)(wgu8 + (size_t)L * NEXP * 2 * DEXP * D), D, rmapL}; pg8::gemm_phase<pg8::EpiSwiglu<true>, pg8::MoeOrder, true, true, true, true>(lds, g, S, E, wave);
#elif MOE_GATHER
              pg8::EpiSwiglu<false> E{act, bgu, 1.0f};
              LAS int* rmapL = (LAS int*)(lds + LDS_RMAP);
              { pg8::Unit uu; for (int i = 0; i < 15 && S.next(i, uu); ++i) { if (tid < 256) { const int rt_ = row_tok[uu.pm * 256 + tid]; rmapL[i * 256 + tid] = rt_ < 0 ? 0 : (rt_ < T ? rt_ : T - 1); } } }
              __syncthreads();
              pg8::Gemm g{hb, wgu_t + (size_t)L * NEXP * 2 * DEXP * D, D, rmapL}; pg8::gemm_phase<pg8::EpiSwiglu<false>, pg8::MoeOrder, true, true, true>(lds, g, S, E, wave);
#else
              pg8::EpiSwiglu<false> E{act, bgu, 1.0f};
              pg8::Gemm g{xr, wgu_t + (size_t)L * NEXP * 2 * DEXP * D, D, nullptr}; pg8::gemm_phase(lds, g, S, E, wave);
#endif
            }
#else
            oracle_gemm(ldsf, nrows, 2 * DEXP, D,
                [&](int tm) { return expert_of_block(pend, tm >> 1); },
                [&](int m, int k) { return bf2f(xr[(size_t)m * D + k]); },
                [&](int k, int n, int e) { const int tn = n >> 7, v = n & 127; const int c = tn * 64 + (v >> 1) + ((v & 1) ? DEXP : 0); return wgu[((size_t)e * D + k) * (2 * DEXP) + c]; },
                [&](int m0, int n0, float (&acc)[4][8], int e) {
                    const int tn = n0 >> 7, v0 = n0 & 127;
#pragma unroll
                    for (int i = 0; i < 4; ++i)
#pragma unroll
                        for (int jj = 0; jj < 4; ++jj) { const int c = tn * 64 + (v0 >> 1) + jj;
                            const float xg = fminf(acc[i][2 * jj] + bgu[(size_t)e * 2 * DEXP + c], 7.0f);
                            const float xl = fminf(fmaxf(acc[i][2 * jj + 1] + bgu[(size_t)e * 2 * DEXP + DEXP + c], -7.0f), 7.0f);
                            act[(size_t)(m0 + i) * DEXP + c] = f2bf(xg * sigmoidf(1.702f * xg) * (xl + 1.0f)); }
                });
#endif
        } }
        SEAM(P + LP_GU);

        if (IN(P + LP_DOWN)) {
            PHASE_IDS();
            REPS(7) { if (rep_) __syncthreads();
            const LAS int* pend = (const LAS int*)(lds + LDS_MISC + 512);
            const int nrows = pend[NEXP - 1];
            const float* wd = (const float*)ARGP(44) + (size_t)L * NEXP * DEXP * D; const float* bd = (const float*)ARGP(45) + (size_t)L * NEXP * D;
#if FAST_MOE
            { (void)wd; pg8::MoeOrder S{pend, nrows / 256, 4, G, vcu};
#if MOE_FP8 && MOE_GATHER
              pg8::Gemm g{(const pg8::bf16_t*)act8, (const pg8::bf16_t*)(wdn8 + (size_t)L * NEXP * D * DEXP), DEXP, nullptr};
#if YR_FP8
              pg8::EpiBf16T<true> E{(unsigned char*)yr, D, bd, D, 1.0f / DN_WS};
              pg8::gemm_phase<pg8::EpiBf16T<true>, pg8::MoeOrder, true, true, false, true>(lds, g, S, E, wave);
#else
              pg8::EpiBf16 E{yr, D, bd, D, 1.0f / DN_WS};
              pg8::gemm_phase<pg8::EpiBf16, pg8::MoeOrder, true, true, false, true>(lds, g, S, E, wave);
#endif
#else
              pg8::Gemm g{act, wdn_t + (size_t)L * NEXP * D * DEXP, DEXP, nullptr}; pg8::EpiBf16 E{yr, D, bd, D, 1.0f}; pg8::gemm_phase(lds, g, S, E, wave);
#endif
            }
#else
            oracle_gemm(ldsf, nrows, D, DEXP,
                [&](int tm) { return expert_of_block(pend, tm >> 1); },
                [&](int m, int k) { return bf2f(act[(size_t)m * DEXP + k]); },
                [&](int k, int n, int e) { return wd[((size_t)e * DEXP + k) * D + n]; },
                [&](int m0, int n0, float (&acc)[4][8], int e) {
#pragma unroll
                    for (int i = 0; i < 4; ++i)
#pragma unroll
                        for (int j = 0; j < 8; ++j) yr[(size_t)(m0 + i) * D + n0 + j] = f2bf(acc[i][j] + bd[(size_t)e * D + n0 + j]);
                });
#endif
        } }
        SEAM(P + LP_DOWN);

        if (IN(P + LP_COMB)) {
            PHASE_IDS();
            REPS(10) { const bool dummy_ = (rep_ == 0) && ((REP_MASK >> 10) & 1);
            const float* g2 = (const float*)ARGP(38) + L * D; const float* b2 = (const float*)ARGP(39) + L * D;
            LAS float* g2s = ldsf; LAS float* b2s = ldsf + D;
            for (int i = tid; i < D; i += NTHR) { g2s[i] = g2[i]; b2s[i] = b2[i]; }
            __syncthreads();
            const int l32 = lane & 31, hw = lane >> 5;
            for (int row = 2 * (bid * NWAVES + wave) + hw; row < T; row += 2 * G * NWAVES) {
                int dd[4]; float gg[4];
                { const int4 d4 = *(const int4*)(dest + (size_t)row * 4); const float4 g4 = *(const float4*)(top_g + (size_t)row * 4); dd[0] = d4.x; dd[1] = d4.y; dd[2] = d4.z; dd[3] = d4.w; gg[0] = g4.x; gg[1] = g4.y; gg[2] = g4.z; gg[3] = g4.w; }
                float4 v[8]; float s = 0.f;
#pragma unroll
                for (int j = 0; j < 8; ++j) { const int c = (l32 + 32 * j) * 4;
#if RES_BF16
                    const uint2 hv_ = *(const uint2*)(hb + (size_t)row * D + c); const float4 hv = make_float4(__uint_as_float(hv_.x << 16), __uint_as_float(hv_.x & 0xffff0000u), __uint_as_float(hv_.y << 16), __uint_as_float(hv_.y & 0xffff0000u));
#else
                    const float4 hv = *(const float4*)(hf + (size_t)row * D + c);
#endif
                    float4 a; a.x = DN_ALPHA * hv.x; a.y = DN_ALPHA * hv.y; a.z = DN_ALPHA * hv.z; a.w = DN_ALPHA * hv.w;
                    float mo[4] = {0.f, 0.f, 0.f, 0.f};
#pragma unroll
                    for (int k = 0; k < 4; ++k) {
#if YR_FP8 && MOE_FP8 && MOE_GATHER
                        typedef float f32x2_ __attribute__((ext_vector_type(2)));
                        const int yw = *(const int*)((const unsigned char*)yr + (size_t)dd[k] * D + c); const f32x2_ y01 = __builtin_amdgcn_cvt_pk_f32_fp8(yw, false), y23 = __builtin_amdgcn_cvt_pk_f32_fp8(yw, true);
                        mo[0] += gg[k] * y01.x; mo[1] += gg[k] * y01.y; mo[2] += gg[k] * y23.x; mo[3] += gg[k] * y23.y;
#else
                        const uint2 yv = *(const uint2*)(yr + (size_t)dd[k] * D + c);
                        mo[0] += gg[k] * __uint_as_float(yv.x << 16); mo[1] += gg[k] * __uint_as_float(yv.x & 0xffff0000u);
                        mo[2] += gg[k] * __uint_as_float(yv.y << 16); mo[3] += gg[k] * __uint_as_float(yv.y & 0xffff0000u);
#endif
                    }
                    a.x += mo[0]; a.y += mo[1]; a.z += mo[2]; a.w += mo[3];
                    v[j] = a; s += (a.x + a.y) + (a.z + a.w); }
#pragma unroll
                for (int o = 1; o < 32; o <<= 1) s += sh_xor(s, o, lane);
                const float mean = s * (1.0f / D); float s2 = 0.f;
#pragma unroll
                for (int j = 0; j < 8; ++j) { v[j].x -= mean; v[j].y -= mean; v[j].z -= mean; v[j].w -= mean; s2 += (v[j].x * v[j].x + v[j].y * v[j].y) + (v[j].z * v[j].z + v[j].w * v[j].w); }
#pragma unroll
                for (int o = 1; o < 32; o <<= 1) s2 += sh_xor(s2, o, lane);
                const float rstd = 1.0f / sqrtf(s2 * (1.0f / D) + LN_EPS);
#pragma unroll
                for (int j = 0; j < 8; ++j) { const int c = (l32 + 32 * j) * 4; const pg8::f32x4 gq = *(const LAS pg8::f32x4*)(g2s + c), bq = *(const LAS pg8::f32x4*)(b2s + c); const float4 gv = make_float4(gq[0], gq[1], gq[2], gq[3]), bv = make_float4(bq[0], bq[1], bq[2], bq[3]);
                    float4 o; o.x = v[j].x * rstd * gv.x + bv.x; o.y = v[j].y * rstd * gv.y + bv.y; o.z = v[j].z * rstd * gv.z + bv.z; o.w = v[j].w * rstd * gv.w + bv.w;
                    if (dummy_) *(float4*)(y2 + (size_t)row * D + c) = o;
                    else if (L == DEPTH - 1) *(float4*)(((float*)ARGP(46)) + (size_t)row * D + c) = o;
                    else {
#if !RES_BF16
                        *(float4*)(hf + (size_t)row * D + c) = o;
#endif
                        uint2 ob; ob.x = pg8::cvt_pk_bf16(o.x, o.y); ob.y = pg8::cvt_pk_bf16(o.z, o.w); *(uint2*)(hb + (size_t)row * D + c) = ob; } }
            }
        } }
        SEAM(P + LP_COMB);
    }
#undef IN
#undef SEAM
}

extern "C" void kernel_launch(void* const* d_in, const int* in_sizes, int n_in, void* d_out, int out_size, void* d_ws, size_t ws_size, hipStream_t stream) {
    static int grid = 0;
    if (grid == 0) {
        if (n_in != 46 || out_size != T * D || ws_size < WS_END) { fprintf(stderr, "kernel_launch: unexpected problem (n_in %d, out %d, ws %zu < %zu)\n", n_in, out_size, ws_size, (size_t)WS_END); grid = -1; return; }
        int dev = 0, cus = 0, per_cu = 0;
        if (hipGetDevice(&dev) != hipSuccess || hipDeviceGetAttribute(&cus, hipDeviceAttributeMultiprocessorCount, dev) != hipSuccess) { grid = -1; return; }
        if (hipFuncSetAttribute((const void*)mk_fwd, hipFuncAttributeMaxDynamicSharedMemorySize, LDS_BYTES) != hipSuccess) { fprintf(stderr, "kernel_launch: hipFuncSetAttribute failed\n"); grid = -1; return; }
        if (hipOccupancyMaxActiveBlocksPerMultiprocessor(&per_cu, (const void*)mk_fwd, NTHR, LDS_BYTES) != hipSuccess || per_cu < 1) fprintf(stderr, "kernel_launch: occupancy query says %d\n", per_cu);
        (void)hipGetLastError();
        grid = cus;
    }
    if (grid < 0) return;
    (void)hipMemsetAsync((char*)d_ws + WS_CTL, 0, CTL_BYTES, stream);
    Args a{};
    for (int i = 0; i < 46; ++i) a.in[i] = d_in[i];
    a.out = (float*)d_out; a.ws = (unsigned char*)d_ws;
#if MK_ONE_LAUNCH
    a.ph_lo = 0; a.ph_hi = PH_TOTAL;
    hipLaunchKernelGGL(mk_fwd, dim3(grid), dim3(NTHR), LDS_BYTES, stream, a);
#else
    for (int p = 0; p < PH_TOTAL; ++p) {
        const int j = (p - PH_L0) % PH_PER_LAYER, L = (p - PH_L0) / PH_PER_LAYER;
        if (p >= PH_L0 && j == LP_MIXB && (L % 3) != 0) continue;
        a.ph_lo = p; a.ph_hi = p + 1;
        hipLaunchKernelGGL(mk_fwd, dim3(grid), dim3(NTHR), LDS_BYTES, stream, a);
    }
#endif
}
```

```cpp
#include <hip/hip_runtime.h>
#include <cstdio>
#include <cstdint>

#ifndef MK_ONE_LAUNCH
#define MK_ONE_LAUNCH 1
#endif

#ifndef FAST_DENSE
#define FAST_DENSE 1
#endif
#ifndef FAST_MOE
#define FAST_MOE 1
#endif
#ifndef REP_MASK
#define REP_MASK 0
#endif
#define REPS(k) for (int rep_ = 0; rep_ < 1 + ((REP_MASK >> (k)) & 1); ++rep_)
#ifndef FAST_S5
#define FAST_S5 1
#endif
#ifndef MOE_SPARSE
#define MOE_SPARSE 0
#endif
#ifndef YR_FP8
#define YR_FP8 0
#endif
#ifndef NT_STORES
#define NT_STORES 0
#endif
#ifndef WT_STORES
#define WT_STORES 0
#endif
#ifndef RES_BF16
#define RES_BF16 1
#endif
#ifndef BG_ALL
#define BG_ALL 1
#endif
#ifndef LINATT_V2
#define LINATT_V2 1
#endif
#ifndef MOE_FP8
#define MOE_FP8 1
#endif
#ifndef MOE_GATHER
#define MOE_GATHER 1
#endif
#ifndef BG_CONV
#define BG_CONV 1
#endif
#ifndef FAST_LN1
#define FAST_LN1 1
#endif
#ifndef FAST_XATTN
#define FAST_XATTN 1
#endif
#ifndef FAST_LINATT
#define FAST_LINATT 1
#endif
#define LAS __attribute__((address_space(3)))
typedef unsigned short bf16;

#ifndef MOE_SPARSE
#define MOE_SPARSE 0
#endif
#if MOE_SPARSE
#define MOE_SPARSE_ROWS (32 * 16384)
#else
#define MOE_SPARSE_ROWS (16384 * 4 + 32 * 256)
#endif
constexpr int NB = 8, SEQ = 2048, T = NB * SEQ, D = 1024, MIXW = 768, XW = 256, NMEM = 256, DEPTH = 4;
constexpr int NEXP = 32, TOPK = 4, DEXP = 1024, MOEBLK = 256;
constexpr int NROWS_MAX = MOE_SPARSE_ROWS;
constexpr int LDP = 2816;
constexpr float LN_EPS = 1e-5f;
constexpr float DN_ALPHA = 1.6817928305074290f;
constexpr int NWAVES = 8, NTHR = 512;

constexpr size_t MiB = (size_t)1 << 20;
constexpr size_t WS_CTL = 0, CTL_BYTES = 1 * MiB;
constexpr size_t WS_HF = 1 * MiB;
constexpr size_t WS_Y2 = WS_HF + (size_t)T * D * 4;
constexpr size_t WS_HB = WS_Y2 + (size_t)T * D * 4;
constexpr size_t WS_PROJ = WS_HB + (size_t)T * D * 2;
constexpr size_t WS_YG = WS_PROJ + (size_t)T * LDP * 2;
constexpr size_t WS_CAT = WS_YG + (size_t)T * MIXW * 2;
constexpr size_t WS_TOPE = WS_CAT + (size_t)T * D * 2;
constexpr size_t WS_TOPG = WS_TOPE + (size_t)T * 4 * 4;
constexpr size_t WS_DEST = WS_TOPG + (size_t)T * 4 * 4;
constexpr size_t WS_XR = WS_DEST + (size_t)T * 4 * 4;
constexpr size_t WS_ACT = WS_XR + (size_t)(T * TOPK + NEXP * MOEBLK) * D * 2;
constexpr size_t WS_YR = WS_ACT + (size_t)NROWS_MAX * DEXP * 2;
constexpr size_t WS_MEMK = WS_YR + (size_t)NROWS_MAX * D * 2;
constexpr size_t WS_MEMV = WS_MEMK + 1 * MiB;
constexpr size_t WS_MEMVT = WS_MEMV + 1 * MiB;
constexpr size_t WS_ROPE = WS_MEMVT + 1 * MiB;
constexpr size_t WS_WIN = WS_ROPE + (size_t)T * 48 * 2 * 4;
constexpr size_t WS_WGLU = WS_WIN + 4 * 6 * MiB;
constexpr size_t WS_WOUT = WS_WGLU + 2 * 2 * MiB;
constexpr size_t WS_WMEM = WS_WOUT + 4 * 2 * MiB;
constexpr size_t WS_MEMB = WS_WMEM + 1 * MiB;
constexpr size_t WS_WGU = WS_MEMB + 4 * MiB;
constexpr size_t WS_WDN = WS_WGU + (size_t)DEPTH * NEXP * 2 * DEXP * D * 2;
constexpr size_t WS_RWT = WS_WDN + (size_t)DEPTH * NEXP * D * DEXP * 2;
constexpr size_t WS_RTOK = WS_RWT + (size_t)DEPTH * 2 * NEXP * D * 2;
constexpr size_t WS_END = WS_RTOK + (size_t)NROWS_MAX * 4;
constexpr int CW_BAR = 4096;
constexpr int CW_CNT = 16384;
constexpr int CW_CUR = 16384 + 1024;
constexpr int CW_CQ = 16384 + 2048;

constexpr int LDS_BYTES = 163840;
constexpr int LDS_RMAP = 147456;
constexpr int LDS_MISC = 131072 + 8192;

__device__ __forceinline__ float bf2f(bf16 v) { return __uint_as_float(((unsigned)v) << 16); }
__device__ __forceinline__ bf16 f2bf(float f) { unsigned u = __float_as_uint(f); return (bf16)((u + 0x7fffu + ((u >> 16) & 1u)) >> 16); }
__device__ __forceinline__ unsigned pk2(float lo, float hi) { return (unsigned)f2bf(lo) | ((unsigned)f2bf(hi) << 16); }
__device__ __forceinline__ int sh_idx_i(int v, int src, int) { return __builtin_amdgcn_ds_bpermute(src << 2, v); }
__device__ __forceinline__ float sh_idx(float v, int src, int lane) { return __int_as_float(sh_idx_i(__float_as_int(v), src, lane)); }
__device__ __forceinline__ unsigned sh_idx(unsigned v, int src, int lane) { return (unsigned)sh_idx_i((int)v, src, lane); }
__device__ __forceinline__ float sh_xor(float v, int m, int lane) { return __int_as_float(__builtin_amdgcn_ds_bpermute((lane ^ m) << 2, __float_as_int(v))); }
__device__ __forceinline__ int sh_xor(int v, int m, int lane) { return __builtin_amdgcn_ds_bpermute((lane ^ m) << 2, v); }
__device__ __forceinline__ float sh_up(float v, int d, int lane) { const int s = lane - d; return __int_as_float(__builtin_amdgcn_ds_bpermute((s < 0 ? lane : s) << 2, __float_as_int(v))); }
__device__ __forceinline__ float wave_sum(float v, int lane) {
#pragma unroll
    for (int o = 1; o < 64; o <<= 1) v += sh_xor(v, o, lane);
    return v;
}
__device__ __forceinline__ float sigmoidf(float x) { return __builtin_amdgcn_rcpf(1.0f + __expf(-x)); }
__device__ __forceinline__ void unpack8(uint4 v, float* f) {
    f[0] = __uint_as_float(v.x << 16); f[1] = __uint_as_float(v.x & 0xffff0000u);
    f[2] = __uint_as_float(v.y << 16); f[3] = __uint_as_float(v.y & 0xffff0000u);
    f[4] = __uint_as_float(v.z << 16); f[5] = __uint_as_float(v.z & 0xffff0000u);
    f[6] = __uint_as_float(v.w << 16); f[7] = __uint_as_float(v.w & 0xffff0000u);
}
__device__ __forceinline__ void sincos_rad(float ang, float& s, float& c) {
    float r = ang * 0.15915494309189535f; r -= rintf(r);
    s = __builtin_amdgcn_sinf(r); c = __builtin_amdgcn_cosf(r);
}
__device__ __forceinline__ float gelu_tanh(float x) {
    const float u = 0.7978845608028654f * (x + 0.044715f * x * x * x);
    const float e = __expf(2.0f * u);
    const float th = 1.0f - 2.0f / (e + 1.0f);
    return 0.5f * x * (1.0f + th);
}

__device__ __forceinline__ int lane_id_opaque() { int l; asm volatile("v_mbcnt_lo_u32_b32 %0, -1, 0\n\tv_mbcnt_hi_u32_b32 %0, -1, %0" : "=v"(l)); return l; }
__device__ __forceinline__ bool wg_leader(int wave) { return wave == 0 && lane_id_opaque() == 0; }

#define XB_TMO      128
#define XB_XCNT(j)  (256  + 64 * (j))
#define XB_XSUB(j)  (1280 + 64 * (j))
#define XB_XGEN(j)  (2304 + 64 * (j))
#define XB_TOP      3328
#define XB_TOPGEN   3392
#define XCD_BAR_WORDS 3456
#define XB_SPIN_CAP (1u << 24)
__device__ __forceinline__ unsigned xb_ld(unsigned* p)              { return __hip_atomic_load(p, __ATOMIC_RELAXED, __HIP_MEMORY_SCOPE_AGENT); }
__device__ __forceinline__ unsigned xb_add(unsigned* p, unsigned v) { return __hip_atomic_fetch_add(p, v, __ATOMIC_RELAXED, __HIP_MEMORY_SCOPE_AGENT); }
__device__ __forceinline__ unsigned xb_xcc_id() { return (unsigned)__builtin_amdgcn_s_getreg((3 << 11) | 20) & 0xFu; }
#define XB_SPIN(cond, bar) do { unsigned _sp = 0; while (cond) { __builtin_amdgcn_s_sleep(1); \
    if ((++_sp & 255u) == 0u) { if (xb_ld(&(bar)[XB_TMO])) break; if (_sp > XB_SPIN_CAP) { atomicAdd(&(bar)[XB_TMO], 1u); break; } } } } while (0)
struct XcdBarrier { unsigned* bar; unsigned x; volatile LAS unsigned* st; };
__device__ __forceinline__ XcdBarrier xcd_barrier_post(unsigned* bar, volatile LAS unsigned* st, int wave) {
    XcdBarrier b; b.bar = bar; b.x = xb_xcc_id(); b.st = st;
    if (wg_leader(wave)) (void)xb_add(&bar[XB_XCNT(b.x)], 1u);
    return b;
}
__device__ __forceinline__ void xcd_barrier_complete(unsigned* bar, unsigned x, unsigned& nloc, unsigned& nx) {
    const unsigned G = gridDim.x * gridDim.y * gridDim.z;
    unsigned sum, cnt, mine, sp = 0u;
    for (;;) {
        sum = 0u; cnt = 0u; mine = 0u;
#pragma unroll
        for (unsigned j = 0; j < 16; ++j) { const unsigned c = xb_ld(&bar[XB_XCNT(j)]); sum += c; cnt += (c > 0u) ? 1u : 0u; mine = (j == x) ? c : mine; }
        if (sum == G) break;
        __builtin_amdgcn_s_sleep(1);
        if ((++sp & 255u) == 0u) { if (xb_ld(&bar[XB_TMO])) break; if (sp > XB_SPIN_CAP) { atomicAdd(&bar[XB_TMO], 1u); break; } }
    }
    nloc = mine > 0u ? mine : 1u; nx = cnt > 0u ? cnt : 1u;
}
__device__ __forceinline__ void xcd_barrier(const XcdBarrier& b, int wave) {
    asm volatile("s_waitcnt vmcnt(0)" ::: "memory");
    __syncthreads();
    if (wg_leader(wave)) {
        unsigned* bar = b.bar; asm volatile("" : "+s"(bar));
        __builtin_amdgcn_s_waitcnt(0);
        unsigned nloc = b.st[0], nx = b.st[1];
        if (nloc == 0u) { xcd_barrier_complete(bar, b.x, nloc, nx); b.st[0] = nloc; b.st[1] = nx; }
        const unsigned old = xb_add(&bar[XB_XSUB(b.x)], 1u);
        const unsigned gen = old / nloc;
        if (old + 1u == (gen + 1u) * nloc) {
            __builtin_amdgcn_fence(__ATOMIC_RELEASE, "agent");
            asm volatile("s_waitcnt vmcnt(0)" ::: "memory");
            const unsigned og = xb_add(&bar[XB_TOP], 1u);
            const unsigned tg = og / nx;
            if (og + 1u == (tg + 1u) * nx) xb_add(&bar[XB_TOPGEN], 1u);
            else XB_SPIN(xb_ld(&bar[XB_TOPGEN]) == tg, bar);
            __builtin_amdgcn_fence(__ATOMIC_ACQUIRE, "agent");
            xb_add(&bar[XB_XGEN(b.x)], 1u);
            asm volatile("s_waitcnt vmcnt(0)" ::: "memory");
        } else {
            XB_SPIN(xb_ld(&bar[XB_XGEN(b.x)]) == gen, bar);
            __builtin_amdgcn_fence(__ATOMIC_ACQUIRE, "agent");
            asm volatile("s_waitcnt vmcnt(0)" ::: "memory");
        }
    }
    __syncthreads();
}


namespace pg8 {
#define PG8_LAS __attribute__((address_space(3)))
typedef unsigned short bf16_t;
typedef short bf16x8 __attribute__((ext_vector_type(8)));
typedef float f32x4 __attribute__((ext_vector_type(4)));
typedef unsigned u32x4 __attribute__((ext_vector_type(4)));
typedef unsigned u32x2 __attribute__((ext_vector_type(2)));
typedef int i32x4 __attribute__((ext_vector_type(4)));
typedef int i32x8 __attribute__((ext_vector_type(8)));
constexpr int BM = 256, BK = 64, HALF = 128, HTB = HALF * BK * 2, STAGE_BYTES = 8 * HTB, NXCD = 8, WGM = 8;
__host__ __device__ __forceinline__ int lds_byte(int r, int c) { const int st = (r >> 4) * 2 + (c >> 5), rr = r & 15, cc = c & 31, ob = rr * 64 + cc * 2; return st * 1024 + (ob ^ (((ob >> 9) & 1) << 5)); }
__host__ __device__ __forceinline__ void stage_rc(int b, int& R, int& C) { const int st = b / 1024, sb = b % 1024, swz = sb ^ (((sb >> 9) & 1) << 5); R = (st >> 1) * 16 + swz / 64; C = (st & 1) * 32 + (swz % 64) / 2; }
__host__ __device__ __forceinline__ int perm32(int rho) { const int n = rho >> 4, i = rho & 15; return 8 * (i >> 2) + 4 * n + (i & 3); }
struct Unit { int pm, pn, pb, e; };
struct Gemm { const bf16_t* A; const bf16_t* Bt; int K; const PG8_LAS int* rowmap; };
struct StaticOrder {
    int nM, nN, nwg, G, c;
    __device__ __forceinline__ void init(int M, int N, int G_, int c_) { nM = M / BM; nN = N / BM; nwg = nM * nN; G = G_; c = c_; }
    __device__ __forceinline__ bool next(int i, Unit& u) const {
        const long L = (long)i * G + c; if (L >= nwg) return false;
        int wgid = (int)L; { const int q = nwg / NXCD, r = nwg % NXCD, xcd = wgid % NXCD, off = wgid / NXCD; wgid = (xcd < r ? xcd * (q + 1) : r * (q + 1) + (xcd - r) * q) + off; }
        const int nig = WGM * nN, gid = wgid / nig, fm = gid * WGM, gsz = (nM - fm) < WGM ? (nM - fm) : WGM;
        u.pm = fm + ((wgid % nig) % gsz); u.pn = (wgid % nig) / gsz; u.pb = u.pn; u.e = 0; return true;
    }
    __device__ __forceinline__ void a_ready(const Unit&) const {}
    __device__ __forceinline__ void done(const Unit&) const {}
};
struct MoeOrder {
    const PG8_LAS int* pend; int nb, ntn, G, vc;
    __device__ __forceinline__ bool next(int i, Unit& u) const {
        const int U = nb * ntn, per = G >> 3, chunk = (U + 7) >> 3, x = vc / per, r = vc - x * per;
        const int off = i * per + r; if (off >= chunk) return false;
        const long L = (long)x * chunk + off; if (L >= (long)U) return false;
        const int rb = (int)(L / ntn), pn = (int)(L % ntn); const int start = rb * 256; int e = 0, prev = 0;
#pragma unroll
        for (int j = 0; j < 32; ++j) { const int pj = pend[j]; if (start >= pj) { e += 1; prev = pj; } }
        e = e < 31 ? e : 31; e = __builtin_amdgcn_readfirstlane(e); prev = __builtin_amdgcn_readfirstlane(prev);
#if MOE_SPARSE
        u.pm = e * (16384 / 256) + (rb - prev / 256);
#else
        u.pm = rb;
#endif
        u.pn = pn; u.pb = e * ntn + pn; u.e = e; return true;
    }
    __device__ __forceinline__ void a_ready(const Unit&) const {}
    __device__ __forceinline__ void done(const Unit&) const {}
};
__device__ __forceinline__ unsigned cvt_pk_bf16(float lo, float hi) { unsigned r; asm volatile("v_cvt_pk_bf16_f32 %0, %1, %2" : "=v"(r) : "v"(lo), "v"(hi)); return r; }
__device__ __forceinline__ float fsig(float x) { return __builtin_amdgcn_rcpf(1.0f + __expf(-x)); }
#if WT_STORES
__device__ __forceinline__ void st16(void* p, u32x4 v) { asm volatile("global_store_dwordx4 %0, %1, off sc1\n\ts_nop 0" :: "v"(p), "v"(v) : "memory"); }
__device__ __forceinline__ void st8(void* p, u32x2 v) { asm volatile("global_store_dwordx2 %0, %1, off sc1\n\ts_nop 0" :: "v"(p), "v"(v) : "memory"); }
#elif NT_STORES
__device__ __forceinline__ void st16(void* p, u32x4 v) { __builtin_nontemporal_store(v, (u32x4*)p); }
__device__ __forceinline__ void st8(void* p, u32x2 v) { __builtin_nontemporal_store(v, (u32x2*)p); }
#else
__device__ __forceinline__ void st16(void* p, u32x4 v) { *(u32x4*)p = v; }
__device__ __forceinline__ void st8(void* p, u32x2 v) { *(u32x2*)p = v; }
#endif
template <bool OUT8> struct EpiBf16T {
    static constexpr bool PERM = true, AFTER_DRAIN = false;
    void* O; int ldc; const float* bias; int bias_estride; float scale;
    __device__ __forceinline__ void operator()(const f32x4 (&acc)[2][2][4][2], const Unit& u, int wr, int wc, int fr, int fq) const {
        const int row0 = u.pm * BM + wr * 64 + fr, col0 = u.pn * BM + wc * 32 + 8 * fq;
        f32x4 bv[2][2];
#pragma unroll
        for (int bj = 0; bj < 2; ++bj)
#pragma unroll
            for (int n = 0; n < 2; ++n) bv[bj][n] = bias ? *(const f32x4*)(bias + (size_t)u.e * bias_estride + col0 + bj * HALF + 4 * n) : (f32x4){0.f, 0.f, 0.f, 0.f};
#pragma unroll
        for (int ai = 0; ai < 2; ++ai)
#pragma unroll
            for (int m = 0; m < 4; ++m) { const size_t ro = (size_t)(row0 + ai * HALF + m * 16) * ldc + col0;
#pragma unroll
                for (int bj = 0; bj < 2; ++bj) { const f32x4 v0 = acc[ai][bj][m][0] * scale + bv[bj][0], v1 = acc[ai][bj][m][1] * scale + bv[bj][1];
                    if constexpr (OUT8) { int w0 = __builtin_amdgcn_cvt_pk_fp8_f32(v0[0], v0[1], 0, false); w0 = __builtin_amdgcn_cvt_pk_fp8_f32(v0[2], v0[3], w0, true); int w1 = __builtin_amdgcn_cvt_pk_fp8_f32(v1[0], v1[1], 0, false); w1 = __builtin_amdgcn_cvt_pk_fp8_f32(v1[2], v1[3], w1, true);
                        u32x2 w; w.x = (unsigned)w0; w.y = (unsigned)w1; st8((unsigned char*)O + ro + bj * HALF, w); }
                    else { u32x4 w; w.x = cvt_pk_bf16(v0[0], v0[1]); w.y = cvt_pk_bf16(v0[2], v0[3]); w.z = cvt_pk_bf16(v1[0], v1[1]); w.w = cvt_pk_bf16(v1[2], v1[3]);
                        st16((bf16_t*)O + ro + bj * HALF, w); } } }
    }
};
typedef EpiBf16T<false> EpiBf16;
struct EpiGlu {
    static constexpr bool PERM = true, AFTER_DRAIN = false;
    bf16_t* O; int ldc; const bf16_t* Y; int ldy; const float* bias;
    __device__ __forceinline__ void operator()(const f32x4 (&acc)[2][2][4][2], const Unit& u, int wr, int wc, int fr, int fq) const {
        const int row0 = u.pm * BM + wr * 64 + fr, col0 = u.pn * BM + wc * 32 + 8 * fq;
        f32x4 bv[2][2];
#pragma unroll
        for (int bj = 0; bj < 2; ++bj)
#pragma unroll
            for (int n = 0; n < 2; ++n) bv[bj][n] = *(const f32x4*)(bias + col0 + bj * HALF + 4 * n);
#pragma unroll
        for (int ai = 0; ai < 2; ++ai)
#pragma unroll
            for (int m = 0; m < 4; ++m) { const size_t r = (size_t)(row0 + ai * HALF + m * 16);
#pragma unroll
                for (int bj = 0; bj < 2; ++bj) { const int c = col0 + bj * HALF; const u32x4 yv = *(const u32x4*)(Y + r * ldy + c);
                    const f32x4 z0 = acc[ai][bj][m][0] + bv[bj][0], z1 = acc[ai][bj][m][1] + bv[bj][1];
                    float y[8]; y[0] = __uint_as_float(yv.x << 16); y[1] = __uint_as_float(yv.x & 0xffff0000u); y[2] = __uint_as_float(yv.y << 16); y[3] = __uint_as_float(yv.y & 0xffff0000u);
                    y[4] = __uint_as_float(yv.z << 16); y[5] = __uint_as_float(yv.z & 0xffff0000u); y[6] = __uint_as_float(yv.w << 16); y[7] = __uint_as_float(yv.w & 0xffff0000u);
                    u32x4 w; w.x = cvt_pk_bf16(y[0] * fsig(z0[0]), y[1] * fsig(z0[1])); w.y = cvt_pk_bf16(y[2] * fsig(z0[2]), y[3] * fsig(z0[3]));
                    w.z = cvt_pk_bf16(y[4] * fsig(z1[0]), y[5] * fsig(z1[1])); w.w = cvt_pk_bf16(y[6] * fsig(z1[2]), y[7] * fsig(z1[3]));
                    st16(O + r * ldc + c, w); } }
    }
};
struct EpiResF32 {
    static constexpr bool PERM = false, AFTER_DRAIN = false;
    float* C; const float* R; int ldc; float alpha;
    __device__ __forceinline__ void operator()(const f32x4 (&acc)[2][2][4][2], const Unit& u, int wr, int wc, int fr, int fq) const {
        const int row0 = u.pm * BM + wr * 64 + fr, col0 = u.pn * BM + wc * 32 + 4 * fq;
#pragma unroll
        for (int ai = 0; ai < 2; ++ai)
#pragma unroll
            for (int m = 0; m < 4; ++m) { const size_t off = (size_t)(row0 + ai * HALF + m * 16) * ldc + col0;
#pragma unroll
                for (int bj = 0; bj < 2; ++bj)
#pragma unroll
                    for (int n = 0; n < 2; ++n) { const f32x4 rv = *(const f32x4*)(R + off + bj * HALF + n * 16); *(f32x4*)(C + off + bj * HALF + n * 16) = rv * alpha + acc[ai][bj][m][n]; } }
    }
};
struct EpiResBf16 {
    static constexpr bool PERM = true, AFTER_DRAIN = false;
    bf16_t* O; const bf16_t* R; int ldc; float alpha;
    __device__ __forceinline__ void operator()(const f32x4 (&acc)[2][2][4][2], const Unit& u, int wr, int wc, int fr, int fq) const {
        const int row0 = u.pm * BM + wr * 64 + fr, col0 = u.pn * BM + wc * 32 + 8 * fq;
#pragma unroll
        for (int ai = 0; ai < 2; ++ai)
#pragma unroll
            for (int m = 0; m < 4; ++m) { const size_t off = (size_t)(row0 + ai * HALF + m * 16) * ldc + col0;
#pragma unroll
                for (int bj = 0; bj < 2; ++bj) { const u32x4 rv = *(const u32x4*)(R + off + bj * HALF); const f32x4 a0 = acc[ai][bj][m][0], a1 = acc[ai][bj][m][1];
                    u32x4 w; w.x = cvt_pk_bf16(__uint_as_float(rv.x << 16) * alpha + a0[0], __uint_as_float(rv.x & 0xffff0000u) * alpha + a0[1]); w.y = cvt_pk_bf16(__uint_as_float(rv.y << 16) * alpha + a0[2], __uint_as_float(rv.y & 0xffff0000u) * alpha + a0[3]);
                    w.z = cvt_pk_bf16(__uint_as_float(rv.z << 16) * alpha + a1[0], __uint_as_float(rv.z & 0xffff0000u) * alpha + a1[1]); w.w = cvt_pk_bf16(__uint_as_float(rv.w << 16) * alpha + a1[2], __uint_as_float(rv.w & 0xffff0000u) * alpha + a1[3]);
                    st16(O + off + bj * HALF, w); } }
    }
};
template <bool OUT8> struct EpiSwiglu {
    static constexpr bool PERM = true, AFTER_DRAIN = false;
    void* O; const float* bgu; float scale;
    __device__ __forceinline__ void operator()(const f32x4 (&acc)[2][2][4][2], const Unit& u, int wr, int wc, int fr, int fq) const {
        const int row0 = u.pm * BM + wr * 64 + fr, cidx = u.pn * HALF + wc * 32 + 8 * fq;
        const float* bg = bgu + (size_t)u.e * 2048 + cidx;
        f32x4 bG[2], bL[2];
#pragma unroll
        for (int n = 0; n < 2; ++n) { bG[n] = *(const f32x4*)(bg + 4 * n); bL[n] = *(const f32x4*)(bg + 1024 + 4 * n); }
#pragma unroll
        for (int ai = 0; ai < 2; ++ai)
#pragma unroll
            for (int m = 0; m < 4; ++m) { const size_t ro = (size_t)(row0 + ai * HALF + m * 16) * 1024 + cidx; float o[8];
#pragma unroll
                for (int n = 0; n < 2; ++n) { const f32x4 g = acc[ai][0][m][n] * scale + bG[n], l = acc[ai][1][m][n] * scale + bL[n];
#pragma unroll
                    for (int j = 0; j < 4; ++j) { const float xg = fminf(g[j], 7.0f), xl = fminf(fmaxf(l[j], -7.0f), 7.0f); o[4 * n + j] = xg * fsig(1.702f * xg) * (xl + 1.0f); } }
                if constexpr (OUT8) { int w0 = __builtin_amdgcn_cvt_pk_fp8_f32(o[0], o[1], 0, false); w0 = __builtin_amdgcn_cvt_pk_fp8_f32(o[2], o[3], w0, true); int w1 = __builtin_amdgcn_cvt_pk_fp8_f32(o[4], o[5], 0, false); w1 = __builtin_amdgcn_cvt_pk_fp8_f32(o[6], o[7], w1, true);
                    u32x2 w; w.x = (unsigned)w0; w.y = (unsigned)w1; st8((unsigned char*)O + ro, w); }
                else { u32x4 w; w.x = cvt_pk_bf16(o[0], o[1]); w.y = cvt_pk_bf16(o[2], o[3]); w.z = cvt_pk_bf16(o[4], o[5]); w.w = cvt_pk_bf16(o[6], o[7]);
                    st16((bf16_t*)O + ro, w); } }
    }
};
struct EpiMem {
    static constexpr bool PERM = false, AFTER_DRAIN = false;
    bf16_t* mk; bf16_t* mv; bf16_t* mvt;
    __device__ __forceinline__ void operator()(const f32x4 (&acc)[2][2][4][2], const Unit& u, int wr, int wc, int fr, int fq) const {
        const int row0 = u.pm * BM + wr * 64 + fr, col0 = u.pn * BM + wc * 32 + 4 * fq;
#pragma unroll
        for (int ai = 0; ai < 2; ++ai)
#pragma unroll
            for (int m = 0; m < 4; ++m) { const int r = row0 + ai * HALF + m * 16, b = r >> 8, key = r & 255;
#pragma unroll
                for (int bj = 0; bj < 2; ++bj)
#pragma unroll
                    for (int n = 0; n < 2; ++n) { const int c = col0 + bj * HALF + n * 16, cc = c & 255, head = cc >> 6, d = cc & 63; const f32x4 v = acc[ai][bj][m][n];
                        u32x2 w; w.x = cvt_pk_bf16(v[0], v[1]); w.y = cvt_pk_bf16(v[2], v[3]);
                        const size_t o = ((size_t)(b * 4 + head) * 256 + key) * 64 + d;
                        if (c < 256) *(u32x2*)(mk + o) = w;
                        else { *(u32x2*)(mv + o) = w; bf16_t* t = mvt + ((size_t)(b * 4 + head) * 64 + d) * 256 + key;
                            t[0] = (bf16_t)(w.x & 0xffffu); t[256] = (bf16_t)(w.x >> 16); t[512] = (bf16_t)(w.y & 0xffffu); t[768] = (bf16_t)(w.y >> 16); } } }
    }
};
template <class Epi, class Sched, bool ALIGN_EPI = true, bool SP2 = true, bool GATHER = false, bool FP8 = false>
__device__ __forceinline__ void gemm_phase(PG8_LAS unsigned char* lds, const Gemm g, const Sched& S, const Epi& E, const int wave_) {
    const int tid_ = wave_ * 64 + lane_id_opaque();
    const int tid = tid_, wid = wave_, lane = tid & 63, wr = wid >> 2, wc = wid & 3, fr = lane & 15, fq = lane >> 4;
    const int K = g.K, rowb = FP8 ? K : 2 * K  , nt = rowb / (BK * 2);
    unsigned voffA[2], voffB[2];
#pragma unroll
    for (int i = 0; i < 2; ++i) { int R, C; stage_rc(tid * 16 + i * 8192, R, C); const int Rb = Epi::PERM ? ((R & ~31) + perm32(R & 31)) : R;
        voffA[i] = (unsigned)(R * rowb + C * 2); voffB[i] = (unsigned)(Rb * rowb + C * 2); }
    const size_t kstep = (size_t)(BK * 2);
    const size_t hstep = (size_t)HALF * rowb;
    const size_t tstep = 2 * hstep;
    const unsigned ldsw = (unsigned)wid * 1024u;
    int aoffv[2], boffv[2];
#pragma unroll
    for (int k = 0; k < 2; ++k) { const int p = FP8 ? 2 * fq + k : 4 * k + fq; aoffv[k] = lds_byte(wr * 64 + fr, (p & 3) * 8) + (p >> 2) * 1024; boffv[k] = lds_byte(wc * 32 + fr, (p & 3) * 8) + (p >> 2) * 1024; }
#define PG8_SA(b, h) (((b) * 2 + (h)) * HTB)
#define PG8_SB(b, h) ((4 + (b) * 2 + (h)) * HTB)
#define PG8_STAGE(bufoff, gbase, voff) do { _Pragma("unroll") for (int _i = 0; _i < 2; ++_i) \
        __builtin_amdgcn_global_load_lds((const unsigned*)((const char*)(gbase) + (voff)[_i]), (PG8_LAS unsigned*)(lds + (bufoff) + ldsw + _i * 8192), 16, 0, 0); } while (0)
#define PG8_VSEL_0(h, i) vgC[h][i]
#define PG8_VSEL_1(h, i) (last ? vgX[h][i] : vgC[h][i])
#define PG8_STAGE_A(bufoff, gbase, h, set) do { if constexpr (GATHER) { _Pragma("unroll") for (int _i = 0; _i < 2; ++_i) \
        __builtin_amdgcn_global_load_lds((const unsigned*)((const char*)(gbase) + PG8_VSEL_##set(h, _i)), (PG8_LAS unsigned*)(lds + (bufoff) + ldsw + _i * 8192), 16, 0, 0); } \
    else { PG8_STAGE(bufoff, (gbase) + (h) * hstep, voffA); } } while (0)
#define PG8_LDA(dst, b, h) do { if constexpr (FP8) { _Pragma("unroll") for (int m = 0; m < 4; ++m) { const i32x4 lo_ = *(const PG8_LAS i32x4*)(lds + PG8_SA(b, h) + aoffv[0] + m * 2048), hi_ = *(const PG8_LAS i32x4*)(lds + PG8_SA(b, h) + aoffv[1] + m * 2048); dst##8[m] = __builtin_shufflevector(lo_, hi_, 0, 1, 2, 3, 4, 5, 6, 7); } } \
    else { _Pragma("unroll") for (int m = 0; m < 4; ++m) _Pragma("unroll") for (int k = 0; k < 2; ++k) dst[m][k] = *(const PG8_LAS bf16x8*)(lds + PG8_SA(b, h) + aoffv[k] + m * 2048); } } while (0)
#define PG8_LDB(dst, b, h) do { if constexpr (FP8) { _Pragma("unroll") for (int n = 0; n < 2; ++n) { const i32x4 lo_ = *(const PG8_LAS i32x4*)(lds + PG8_SB(b, h) + boffv[0] + n * 2048), hi_ = *(const PG8_LAS i32x4*)(lds + PG8_SB(b, h) + boffv[1] + n * 2048); dst##8[n] = __builtin_shufflevector(lo_, hi_, 0, 1, 2, 3, 4, 5, 6, 7); } } \
    else { _Pragma("unroll") for (int n = 0; n < 2; ++n) _Pragma("unroll") for (int k = 0; k < 2; ++k) dst[n][k] = *(const PG8_LAS bf16x8*)(lds + PG8_SB(b, h) + boffv[k] + n * 2048); } } while (0)
#define PG8_MMA(ai, bj, At, Bt) do { __builtin_amdgcn_s_setprio(1); _Pragma("unroll") for (int m = 0; m < 4; ++m) _Pragma("unroll") for (int n = 0; n < 2; ++n) { \
        if constexpr (FP8) { acc[ai][bj][m][n] = __builtin_amdgcn_mfma_scale_f32_16x16x128_f8f6f4(Bt##8[n], At##8[m], acc[ai][bj][m][n], 0, 0, 0, 0x7f7f7f7f, 0, 0x7f7f7f7f); } \
        else { _Pragma("unroll") for (int k = 0; k < 2; ++k) acc[ai][bj][m][n] = __builtin_amdgcn_mfma_f32_16x16x32_bf16(Bt[n][k], At[m][k], acc[ai][bj][m][n], 0, 0, 0); } } \
        if constexpr (FP8) { _Pragma("unroll") for (int m = 0; m < 4; ++m) asm volatile("" : "+v"(acc[ai][bj][m][0]), "+v"(acc[ai][bj][m][1])); }     \
        __builtin_amdgcn_s_setprio(0); } while (0)
#define PG8_WAIT_V(n) asm volatile("s_waitcnt vmcnt(" #n ")" ::: "memory")
#define PG8_WAIT_L(n) asm volatile("s_waitcnt lgkmcnt(" #n ")" ::: "memory")
#define PG8_BAR __builtin_amdgcn_s_barrier()
#define PG8_SCHED __builtin_amdgcn_sched_barrier(0)
    Unit cur, nxt; int ui = 0;
    if (!S.next(0, cur)) return;
    f32x4 acc[2][2][4][2];
#pragma unroll
    for (int a = 0; a < 2; ++a)
#pragma unroll
        for (int b = 0; b < 2; ++b)
#pragma unroll
            for (int m = 0; m < 4; ++m)
#pragma unroll
                for (int n = 0; n < 2; ++n) acc[a][b][m][n] = (f32x4){0.f, 0.f, 0.f, 0.f};
    bf16x8 At[4][2], B0[2][2], B1[2][2];
    i32x8 At8[4], B08[2], B18[2];
    unsigned vgC[2][2], vgX[2][2];
#define PG8_GOFF(dst, pm_) do { const int t_ = wave_ * 64 + lane_id_opaque();   _Pragma("unroll") for (int _i = 0; _i < 2; ++_i) { int gR_, gC_; stage_rc(t_ * 16 + _i * 8192, gR_, gC_); _Pragma("unroll") for (int _h = 0; _h < 2; ++_h) \
        dst[_h][_i] = (unsigned)(g.rowmap[(pm_) * BM + _h * HALF + gR_] * rowb + gC_ * 2); } } while (0)
    if constexpr (GATHER) { PG8_GOFF(vgC, 0); }
    const char* cA = GATHER ? (const char*)g.A : (const char*)g.A + (size_t)cur.pm * tstep; const char* cB = (const char*)g.Bt + (size_t)cur.pb * tstep;
    S.a_ready(cur);
    if constexpr (SP2) {
        PG8_STAGE(PG8_SB(0, 0), cB, voffB); PG8_STAGE(PG8_SB(0, 1), cB + hstep, voffB); PG8_STAGE_A(PG8_SA(0, 0), cA, 0, 0); PG8_STAGE_A(PG8_SA(0, 1), cA, 1, 0);
        if (wr == 1) PG8_BAR;
        PG8_WAIT_V(2); PG8_BAR;
        PG8_STAGE(PG8_SB(1, 0), cB + kstep, voffB); PG8_STAGE_A(PG8_SA(1, 0), cA + kstep, 0, 0); PG8_STAGE(PG8_SB(1, 1), cB + hstep + kstep, voffB);
        PG8_WAIT_V(6); PG8_BAR;
    } else {
        PG8_STAGE(PG8_SB(0, 0), cB, voffB); PG8_STAGE_A(PG8_SA(0, 0), cA, 0, 0); PG8_STAGE(PG8_SB(0, 1), cB + hstep, voffB); PG8_STAGE_A(PG8_SA(0, 1), cA, 1, 0);
        if (wr == 1) PG8_BAR;
        PG8_WAIT_V(4); PG8_BAR;
        PG8_STAGE(PG8_SB(1, 0), cB + kstep, voffB); PG8_STAGE_A(PG8_SA(1, 0), cA + kstep, 0, 0); PG8_STAGE(PG8_SB(1, 1), cB + hstep + kstep, voffB);
        PG8_WAIT_V(6); PG8_BAR;
    }
    for (;;) {
        const bool has_next = S.next(ui + 1, nxt);
        if constexpr (GATHER) { if (has_next) PG8_GOFF(vgX, ui + 1); else { _Pragma("unroll") for (int _h = 0; _h < 2; ++_h) _Pragma("unroll") for (int _i = 0; _i < 2; ++_i) vgX[_h][_i] = vgC[_h][_i]; } }
        const char* nA = GATHER ? (const char*)g.A : (has_next ? (const char*)g.A + (size_t)nxt.pm * tstep : cA); const char* nB = has_next ? (const char*)g.Bt + (size_t)nxt.pb * tstep : cB;
        for (int t = 0; t < nt; t += 2) {
            const bool last = (t == nt - 2);
            const char* a1 = cA + (size_t)(t + 1) * kstep;
            const char* a2 = last ? nA : cA + (size_t)(t + 2) * kstep; const char* b2 = last ? nB : cB + (size_t)(t + 2) * kstep;
            const char* a3 = a2 + kstep; const char* b3 = b2 + kstep;
            if (last && has_next) S.a_ready(nxt);
            if constexpr (SP2) {
            PG8_LDB(B0, 0, 0); PG8_LDB(B1, 0, 1); PG8_SCHED; PG8_LDA(At, 0, 0); PG8_STAGE_A(PG8_SA(1, 1), a1, 1, 0);
            PG8_WAIT_V(8); PG8_WAIT_L(0); PG8_BAR; PG8_MMA(0, 0, At, B0); PG8_MMA(0, 1, At, B1); PG8_BAR; PG8_SCHED;
            PG8_LDA(At, 0, 1); PG8_STAGE(PG8_SB(0, 0), b2, voffB); PG8_STAGE(PG8_SB(0, 1), b2 + hstep, voffB); PG8_STAGE_A(PG8_SA(0, 0), a2, 0, 1);
            PG8_WAIT_V(8); PG8_WAIT_L(0); PG8_BAR; PG8_MMA(1, 0, At, B0); PG8_MMA(1, 1, At, B1); PG8_BAR; PG8_SCHED;
            PG8_LDB(B0, 1, 0); PG8_LDB(B1, 1, 1); PG8_SCHED; PG8_LDA(At, 1, 0); PG8_STAGE_A(PG8_SA(0, 1), a2, 1, 1);
            PG8_WAIT_V(8); PG8_WAIT_L(0); PG8_BAR; PG8_MMA(0, 0, At, B0); PG8_MMA(0, 1, At, B1); PG8_BAR; PG8_SCHED;
            PG8_LDA(At, 1, 1); PG8_STAGE(PG8_SB(1, 0), b3, voffB); PG8_STAGE(PG8_SB(1, 1), b3 + hstep, voffB); PG8_STAGE_A(PG8_SA(1, 0), a3, 0, 1);
            PG8_WAIT_V(8); PG8_WAIT_L(0); PG8_BAR; PG8_MMA(1, 0, At, B0); PG8_MMA(1, 1, At, B1); PG8_BAR; PG8_SCHED;
            } else {
            PG8_LDB(B0, 0, 0); PG8_SCHED; PG8_LDA(At, 0, 0); PG8_STAGE_A(PG8_SA(1, 1), a1, 1, 0);
            PG8_WAIT_L(8); PG8_BAR; PG8_WAIT_L(0); PG8_MMA(0, 0, At, B0); PG8_BAR; PG8_SCHED;
            PG8_LDB(B1, 0, 1); PG8_STAGE(PG8_SB(0, 0), b2, voffB);
            PG8_BAR; PG8_WAIT_L(0); PG8_MMA(0, 1, At, B1); PG8_BAR;
            PG8_LDA(At, 0, 1); PG8_STAGE_A(PG8_SA(0, 0), a2, 0, 1);
            PG8_BAR; PG8_WAIT_L(0); PG8_MMA(1, 0, At, B0); PG8_BAR; PG8_SCHED;
            PG8_STAGE(PG8_SB(0, 1), b2 + hstep, voffB);
            PG8_WAIT_V(6); PG8_BAR; PG8_MMA(1, 1, At, B1); PG8_BAR;
            PG8_LDB(B0, 1, 0); PG8_SCHED; PG8_LDA(At, 1, 0); PG8_STAGE_A(PG8_SA(0, 1), a2, 1, 1);
            PG8_WAIT_L(8); PG8_BAR; PG8_WAIT_L(0); PG8_MMA(0, 0, At, B0); PG8_BAR; PG8_SCHED;
            PG8_LDB(B1, 1, 1); PG8_STAGE(PG8_SB(1, 0), b3, voffB);
            PG8_BAR; PG8_WAIT_L(0); PG8_MMA(0, 1, At, B1); PG8_BAR;
            PG8_LDA(At, 1, 1); PG8_STAGE_A(PG8_SA(1, 0), a3, 0, 1);
            PG8_BAR; PG8_WAIT_L(0); PG8_MMA(1, 0, At, B0); PG8_BAR; PG8_SCHED;
            PG8_STAGE(PG8_SB(1, 1), b3 + hstep, voffB);
            PG8_WAIT_V(6); PG8_BAR; PG8_MMA(1, 1, At, B1); PG8_BAR;
            }
        }
        if constexpr (ALIGN_EPI) { if (wr == 0) PG8_BAR; }
        if constexpr (!Epi::AFTER_DRAIN) { const int l2_ = lane_id_opaque(); E(acc, cur, wr, wc, l2_ & 15, l2_ >> 4); S.done(cur); }
        if (!has_next) break;
#pragma unroll
        for (int a = 0; a < 2; ++a)
#pragma unroll
            for (int b = 0; b < 2; ++b)
#pragma unroll
                for (int m = 0; m < 4; ++m)
#pragma unroll
                    for (int n = 0; n < 2; ++n) acc[a][b][m][n] = (f32x4){0.f, 0.f, 0.f, 0.f};
        cur = nxt; cA = nA; cB = nB; ++ui;
        if constexpr (GATHER) { _Pragma("unroll") for (int _h = 0; _h < 2; ++_h) _Pragma("unroll") for (int _i = 0; _i < 2; ++_i) vgC[_h][_i] = vgX[_h][_i]; }
        if constexpr (ALIGN_EPI) { if (wr == 1) PG8_BAR; }
    }
    PG8_WAIT_V(0);
    if constexpr (!ALIGN_EPI) { if (wr == 0) PG8_BAR; }
    PG8_BAR;
    if constexpr (Epi::AFTER_DRAIN) { E.fused(acc, cur, wr, wc, fr, fq, lds, wid, lane); S.done(cur); }
#undef PG8_GOFF
#undef PG8_SA
#undef PG8_SB
#undef PG8_STAGE
#undef PG8_STAGE_A
#undef PG8_VSEL_0
#undef PG8_VSEL_1
#undef PG8_LDA
#undef PG8_LDB
#undef PG8_MMA
#undef PG8_WAIT_V
#undef PG8_WAIT_L
#undef PG8_BAR
#undef PG8_SCHED
}
}

template <class TC, class LA, class LB, class EP>
__device__ __forceinline__ void oracle_gemm(LAS float* lds, int M, int N, int K, TC tilectx, LA loadA, LB loadB, EP epi) {
    LAS float* As = lds; LAS float* Bs = lds + 16 * 132;
    int tid = threadIdx.x; asm volatile("" : "+v"(tid)); const int ty = tid >> 4, tx = tid & 15;
    const int ntm = M / 128, ntn = (N + 127) / 128;
    for (int tile = blockIdx.x; tile < ntm * ntn; tile += gridDim.x) {
        const int tm = tile / ntn, tn = tile % ntn;
        const int ctx = tilectx(tm);
        float acc[4][8];
#pragma unroll
        for (int i = 0; i < 4; ++i)
#pragma unroll
            for (int j = 0; j < 8; ++j) acc[i][j] = 0.f;
        for (int k0 = 0; k0 < K; k0 += 16) {
#pragma unroll
            for (int i = 0; i < 4; ++i) { const int idx = tid + 512 * i; const int r = idx >> 4, kk = idx & 15; As[kk * 132 + r] = loadA(tm * 128 + r, k0 + kk); }
#pragma unroll
            for (int i = 0; i < 4; ++i) { const int idx = tid + 512 * i; const int kk = idx >> 7, n = idx & 127; Bs[kk * 132 + n] = loadB(k0 + kk, tn * 128 + n, ctx); }
            __syncthreads();
#pragma unroll 2
            for (int kk = 0; kk < 16; ++kk) {
                float a[4], b[8];
#pragma unroll
                for (int i = 0; i < 4; ++i) a[i] = As[kk * 132 + ty * 4 + i];
#pragma unroll
                for (int j = 0; j < 8; ++j) b[j] = Bs[kk * 132 + tx * 8 + j];
#pragma unroll
                for (int i = 0; i < 4; ++i)
#pragma unroll
                    for (int j = 0; j < 8; ++j) acc[i][j] += a[i] * b[j];
            }
            __syncthreads();
        }
        epi(tm * 128 + ty * 4, tn * 128 + tx * 8, acc, ctx);
    }
}


template <class MAP>
__device__ __forceinline__ void tr_item(const float* W, int ldw, int K, bf16* WT, int nblk, int item, LAS float* scr, int lane, MAP map) {
    const int kb = item / nblk, nb = item % nblk, k0 = kb * 64, n0 = nb * 64;
    const int s = map(n0 + lane);
    const float* wp = W + (size_t)k0 * ldw + (s >= 0 ? s : 0);
#pragma unroll 8
    for (int i = 0; i < 64; ++i) scr[i * 65 + lane] = (s >= 0) ? wp[(size_t)i * ldw] : 0.f;
    asm volatile("s_waitcnt lgkmcnt(0)" ::: "memory");
    const int c = lane & 7;
#pragma unroll
    for (int j = 0; j < 8; ++j) { const int n = (lane >> 3) + 8 * j; const LAS float* sp = scr + (8 * c) * 65 + n;
        uint4 o; o.x = pg8::cvt_pk_bf16(sp[0], sp[65]); o.y = pg8::cvt_pk_bf16(sp[130], sp[195]); o.z = pg8::cvt_pk_bf16(sp[260], sp[325]); o.w = pg8::cvt_pk_bf16(sp[390], sp[455]);
        *(uint4*)(WT + (size_t)(n0 + n) * K + k0 + 8 * c) = o; }
    asm volatile("s_waitcnt lgkmcnt(0)" ::: "memory");
}

template <int DEEP, class MAP>
__device__ __forceinline__ void tr_item8(const float* W, int ldw, int K, unsigned char* WT8, int nblk, int item, LAS float* scr, int lane, float scale, MAP map) {
    const int kb = item / nblk, nb = item % nblk, k0 = kb * 64, n0 = nb * 64;
    const int s = map(n0 + lane);
    const float* wp = W + (size_t)k0 * ldw + (s >= 0 ? s : 0);
    if constexpr (DEEP) {
#pragma unroll
        for (int h2 = 0; h2 < 2; ++h2) { float v[32];
#pragma unroll
            for (int i = 0; i < 32; ++i) v[i] = (s >= 0) ? wp[(size_t)(32 * h2 + i) * ldw] : 0.f;
#pragma unroll
            for (int i = 0; i < 32; ++i) scr[(32 * h2 + i) * 65 + lane] = v[i] * scale; }
    } else {
#pragma unroll 8
        for (int i = 0; i < 64; ++i) scr[i * 65 + lane] = (s >= 0) ? wp[(size_t)i * ldw] * scale : 0.f;
    }
    asm volatile("s_waitcnt lgkmcnt(0)" ::: "memory");
    const int c = lane & 7;
#pragma unroll
    for (int j = 0; j < 8; ++j) { const int n = (lane >> 3) + 8 * j; const LAS float* sp = scr + (8 * c) * 65 + n;
        int w0 = __builtin_amdgcn_cvt_pk_fp8_f32(sp[0], sp[65], 0, false); w0 = __builtin_amdgcn_cvt_pk_fp8_f32(sp[130], sp[195], w0, true);
        int w1 = __builtin_amdgcn_cvt_pk_fp8_f32(sp[260], sp[325], 0, false); w1 = __builtin_amdgcn_cvt_pk_fp8_f32(sp[390], sp[455], w1, true);
        uint2 o; o.x = (unsigned)w0; o.y = (unsigned)w1; *(uint2*)(WT8 + (size_t)(n0 + n) * K + k0 + 8 * c) = o; }
    asm volatile("s_waitcnt lgkmcnt(0)" ::: "memory");
}

struct Args { const void* in[46]; float* out; unsigned char* ws; int ph_lo, ph_hi; };

enum { PH_PRO = 0, PH_MEM = 1, PH_L0 = 2, PH_PER_LAYER = 9, PH_TOTAL = 2 + 9 * DEPTH };
enum { LP_INPROJ = 0, LP_MIXA = 1, LP_MIXB = 2, LP_OUTPROJ = 3, LP_LN1 = 4, LP_DISP = 5, LP_GU = 6, LP_DOWN = 7, LP_COMB = 8 };

__device__ __forceinline__ int expert_of_block(const LAS int* pend, int rb) {
    const int start = rb * MOEBLK; int e = 0;
#pragma unroll
    for (int i = 0; i < NEXP; ++i) e += (start >= pend[i]) ? 1 : 0;
    return e < NEXP - 1 ? e : NEXP - 1;
}

typedef const void* const __attribute__((address_space(4)))* KARG;
__global__ void __launch_bounds__(NTHR, 2) mk_fwd(Args args) {
    extern __shared__ __attribute__((aligned(16))) unsigned char lds_raw[];
    LAS unsigned char* lds = (LAS unsigned char*)lds_raw;
    LAS float* ldsf = (LAS float*)lds;
    volatile LAS unsigned* MISC = (volatile LAS unsigned*)(lds + LDS_MISC);
    const int tid0 = threadIdx.x, wave0 = __builtin_amdgcn_readfirstlane(tid0 >> 6);
    const int G = gridDim.x, bid = blockIdx.x;
#define LDS_BARRIER() do { asm volatile("s_waitcnt lgkmcnt(0)" ::: "memory"); __builtin_amdgcn_s_barrier(); asm volatile("" ::: "memory"); } while (0)
#define ARGP(i) ((const void*)kp_[i])
#define PHASE_IDS() int wave = wave0; asm volatile("" : "+s"(wave)); KARG kp_ = (KARG)__builtin_amdgcn_kernarg_segment_ptr(); asm volatile("" : "+s"(kp_)); unsigned char* ws = ws0; asm volatile("" : "+s"(ws)); unsigned* const ctl = (unsigned*)(ws + WS_CTL); (void)ctl; const int tid = wave * 64 + lane_id_opaque(); const int lane = tid & 63; (void)lane
    unsigned char* const ws0 = args.ws;
    unsigned* const ctl0 = (unsigned*)(ws0 + WS_CTL);
#define hf ((float*)(ws + WS_HF))
#define y2 ((float*)(ws + WS_Y2))
#define hb ((bf16*)(ws + WS_HB))
#define proj ((bf16*)(ws + WS_PROJ))
#define yg ((bf16*)(ws + WS_YG))
#define cat ((bf16*)(ws + WS_CAT))
#define top_e ((int*)(ws + WS_TOPE))
#define top_g ((float*)(ws + WS_TOPG))
#define dest ((int*)(ws + WS_DEST))
#define xr ((bf16*)(ws + WS_XR))
#define act ((bf16*)(ws + WS_ACT))
#define yr ((bf16*)(ws + WS_YR))
#define memK ((bf16*)(ws + WS_MEMK))
#define memV ((bf16*)(ws + WS_MEMV))
#define memVT ((bf16*)(ws + WS_MEMVT))
#define rope ((float*)(ws + WS_ROPE))
#define win_t ((bf16*)(ws + WS_WIN))
#define wglu_t ((bf16*)(ws + WS_WGLU))
#define wout_t ((bf16*)(ws + WS_WOUT))
#define wmem_t ((bf16*)(ws + WS_WMEM))
#define memb ((bf16*)(ws + WS_MEMB))
#define wgu_t ((bf16*)(ws + WS_WGU))
#define wdn_t ((bf16*)(ws + WS_WDN))
#define rwt ((bf16*)(ws + WS_RWT))
#define row_tok ((int*)(ws + WS_RTOK))
#define wgu8 (ws + WS_WGU)
#define wdn8 (ws + WS_WDN)
#define act8 (ws + WS_ACT)
#define hb8 (ws + WS_XR)
    constexpr float GU_WS = 32.0f, DN_WS = 64.0f;
    const int vcu = (G % 8 == 0) ? (bid % 8) * (G / 8) + bid / 8 : bid;

    if (tid0 < 64) MISC[tid0] = 0u;
    __syncthreads();
    const int lo = args.ph_lo, hi = args.ph_hi;
    XcdBarrier bar; bar.bar = ctl0 + CW_BAR; bar.x = 0; bar.st = MISC;
    if (hi - lo > 1) bar = xcd_barrier_post(ctl0 + CW_BAR, MISC, wave0);
#define IN(k) (lo <= (k) && (k) < hi)
#define SEAM(k) do { if (IN(k) && IN((k) + 1)) xcd_barrier(bar, wave0); } while (0)

    if (IN(PH_PRO)) {
            PHASE_IDS();
            REPS(0) { if (rep_) __syncthreads();
        {
            LAS float* scr = ldsf + wave * (64 * 65);
            const int gw = vcu * NWAVES + wave, NGW = G * NWAVES;
            constexpr int PRO_LAYERS = BG_CONV ? ((BG_ALL && LINATT_V2) ? 0 : 1) : DEPTH;
            constexpr int N_GU = FAST_MOE ? PRO_LAYERS * NEXP * 512 : 0, N_DN = FAST_MOE ? PRO_LAYERS * NEXP * 256 : 0;
            constexpr int N_IN0 = FAST_DENSE ? 256 : 0, N_IN1 = FAST_DENSE ? 704 : 0, N_IN2 = FAST_DENSE ? 640 : 0, N_IN3 = N_IN0, N_GLU = FAST_DENSE ? 144 : 0, N_OUT = FAST_DENSE ? 256 : 0, N_MEM = FAST_DENSE ? 64 : 0;
            constexpr int NITEMS = N_GU + N_DN + N_IN0 + N_IN1 + N_IN2 + N_IN3 + 2 * N_GLU + 4 * N_OUT + 2 * N_MEM;
            for (int it = gw; it < NITEMS; it += NGW) {
                int r = it;
                if (r < N_GU) { const int le = r >> 9;
#if MOE_FP8
                    tr_item8<0>((const float*)ARGP(42) + (size_t)le * D * 2 * DEXP, 2 * DEXP, D, wgu8 + (size_t)le * 2 * DEXP * D, 32, r & 511, scr, lane, GU_WS, [](int d) { const int tile = d >> 8, q = d & 255; return q < 128 ? tile * 128 + q : DEXP + tile * 128 + (q - 128); });
#else
                    tr_item((const float*)ARGP(42) + (size_t)le * D * 2 * DEXP, 2 * DEXP, D, wgu_t + (size_t)le * 2 * DEXP * D, 32, r & 511, scr, lane, [](int d) { const int tile = d >> 8, q = d & 255; return q < 128 ? tile * 128 + q : DEXP + tile * 128 + (q - 128); });
#endif
                    continue; } r -= N_GU;
                if (r < N_DN) { const int le = r >> 8;
#if MOE_FP8
                    tr_item8<0>((const float*)ARGP(44) + (size_t)le * DEXP * D, D, DEXP, wdn8 + (size_t)le * D * DEXP, 16, r & 255, scr, lane, DN_WS, [](int d) { return d; });
#else
                    tr_item((const float*)ARGP(44) + (size_t)le * DEXP * D, D, DEXP, wdn_t + (size_t)le * D * DEXP, 16, r & 255, scr, lane, [](int d) { return d; });
#endif
                    continue; } r -= N_DN;
                if (r < N_IN0) { tr_item((const float*)ARGP(5), 1024, D, win_t, 16, r, scr, lane, [](int d) { return d; }); continue; } r -= N_IN0;
                if (r < N_IN1) { tr_item((const float*)ARGP(16), 2568, D, win_t + (size_t)1 * 3 * MiB, 44, r, scr, lane, [](int d) { return d < 2568 ? d : -1; }); continue; } r -= N_IN1;
                if (r < N_IN2) { tr_item((const float*)ARGP(22), 2560, D, win_t + (size_t)2 * 3 * MiB, 40, r, scr, lane, [](int d) { return d; }); continue; } r -= N_IN2;
                if (r < N_IN3) { tr_item((const float*)ARGP(24), 1024, D, win_t + (size_t)3 * 3 * MiB, 16, r, scr, lane, [](int d) { return d; }); continue; } r -= N_IN3;
                if (r < N_GLU) { tr_item((const float*)ARGP(14), MIXW, MIXW, wglu_t, 12, r, scr, lane, [](int d) { return d; }); continue; } r -= N_GLU;
                if (r < N_GLU) { tr_item((const float*)ARGP(33), MIXW, MIXW, wglu_t + (size_t)1 * MiB, 12, r, scr, lane, [](int d) { return d; }); continue; } r -= N_GLU;
                if (r < 4 * N_OUT) { const int l = r >> 8; tr_item((const float*)ARGP(35) + (size_t)l * D * D, D, D, wout_t + (size_t)l * D * D, 16, r & 255, scr, lane, [](int d) { return d; }); continue; } r -= 4 * N_OUT;
                if (r < N_MEM) { tr_item((const float*)ARGP(3), 256, D, wmem_t, 4, r, scr, lane, [](int d) { return d; }); continue; } r -= N_MEM;
                tr_item((const float*)ARGP(4), 256, D, wmem_t + (size_t)256 * D, 4, r, scr, lane, [](int d) { return d; });
            }
            const float* mem = (const float*)ARGP(1);
            for (size_t i = ((size_t)bid * NTHR + tid) * 4; i < (size_t)NB * NMEM * D; i += (size_t)G * NTHR * 4) {
                const float4 v = *(const float4*)(mem + i); uint2 o; o.x = pg8::cvt_pk_bf16(v.x, v.y); o.y = pg8::cvt_pk_bf16(v.z, v.w); *(uint2*)(memb + i) = o; }
        }
        {
            const float* rwf = (const float*)ARGP(40);
            for (int i = bid * NTHR + tid; i < DEPTH * NEXP * D; i += G * NTHR) { const int l = i / (NEXP * D), rem = i % (NEXP * D), e = rem / D, k = rem % D;
                const float v = rwf[((size_t)l * D + k) * NEXP + e]; const bf16 hi_ = f2bf(v); const bf16 lo_ = f2bf(v - bf2f(hi_));
                rwt[((size_t)(l * 2 + 0) * NEXP + e) * D + k] = hi_; rwt[((size_t)(l * 2 + 1) * NEXP + e) * D + k] = lo_; }
        }
        const float* x = (const float*)ARGP(0);
        for (size_t i = ((size_t)bid * NTHR + tid) * 4; i < (size_t)T * D; i += (size_t)G * NTHR * 4) {
            const float4 v = *(const float4*)(x + i);
#if !RES_BF16
            *(float4*)(hf + i) = v;
#endif
            uint2 o; o.x = pk2(v.x, v.y); o.y = pk2(v.z, v.w); *(uint2*)(hb + i) = o;
        }
        const int* pos = (const int*)ARGP(2);
        for (int idx = bid * NTHR + tid; idx < T * 48; idx += G * NTHR) {
            const int t = idx / 48, i = idx % 48;
            const double inv = exp(-((double)(2 * i) / 96.0) * 9.210340371976184);
            double r = (double)pos[t] * inv * 0.15915494309189535; r -= rint(r);
            const float rf = (float)r;
            typedef _Float16 h2_t __attribute__((ext_vector_type(2))); h2_t cs_; cs_.x = (_Float16)__builtin_amdgcn_cosf(rf); cs_.y = (_Float16)__builtin_amdgcn_sinf(rf);
            ((unsigned*)rope)[idx] = __builtin_bit_cast(unsigned, cs_);
        }
    } }
    SEAM(PH_PRO);

    if (IN(PH_MEM)) {
            PHASE_IDS();
            REPS(1) { if (rep_) __syncthreads();
#if FAST_DENSE
        { pg8::Gemm g{memb, wmem_t, D, nullptr}; pg8::StaticOrder S; S.init(NB * NMEM, 512, G, bid); pg8::EpiMem E{memK, memV, memVT}; pg8::gemm_phase(lds, g, S, E, wave); }
#else
        const float* mem = (const float*)ARGP(1); const float* wk = (const float*)ARGP(3); const float* wv = (const float*)ARGP(4);
        oracle_gemm(ldsf, NB * NMEM, 512, D,
            [&](int) { return 0; },
            [&](int m, int k) { return mem[(size_t)m * D + k]; },
            [&](int k, int n, int) { return n < 256 ? wk[(size_t)k * 256 + n] : wv[(size_t)k * 256 + n - 256]; },
            [&](int m0, int n0, float (&acc)[4][8], int) {
#pragma unroll
                for (int i = 0; i < 4; ++i)
#pragma unroll
                    for (int j = 0; j < 8; ++j) { const int m = m0 + i, n = n0 + j; const int b = m >> 8, key = m & 255; const int nn = n & 255, head = nn >> 6, d = nn & 63; const bf16 v = f2bf(acc[i][j]);
                        if (n < 256) memK[((size_t)(b * 4 + head) * 256 + key) * 64 + d] = v;
                        else { memV[((size_t)(b * 4 + head) * 256 + key) * 64 + d] = v; memVT[((size_t)(b * 4 + head) * 64 + d) * 256 + key] = v; } }
            });
#endif
    } }

    for (int L = 0; L < DEPTH; ++L) {
        const int P = PH_L0 + PH_PER_LAYER * L;
        const int kind = L % 3;
        const int Nin = (kind == 0) ? 1024 : (kind == 1 ? 2568 : 2560);
        const int xq_off = (kind == 0) ? 768 : (kind == 1 ? 2312 : 2304);

        if (IN(P + LP_INPROJ)) {
            PHASE_IDS();
            REPS(2) { if (rep_) __syncthreads();
#if FAST_DENSE
            { const int Npad = (kind == 0) ? 1024 : (kind == 1 ? 2816 : 2560);
              pg8::Gemm g{hb, win_t + (size_t)L * 3 * MiB, D, nullptr}; pg8::StaticOrder S; S.init(T, Npad, G, bid); pg8::EpiBf16 E{proj, LDP, nullptr, 0, 1.0f}; pg8::gemm_phase(lds, g, S, E, wave); }
#else
            const float* w_in = (const float*)(L == 0 ? ARGP(5) : L == 1 ? ARGP(16) : L == 2 ? ARGP(22) : ARGP(24));
            oracle_gemm(ldsf, T, Nin, D,
                [&](int) { return 0; },
                [&](int m, int k) { return bf2f(hb[(size_t)m * D + k]); },
                [&](int k, int n, int) { return n < Nin ? w_in[(size_t)k * Nin + n] : 0.f; },
                [&](int m0, int n0, float (&acc)[4][8], int) {
#pragma unroll
                    for (int i = 0; i < 4; ++i)
#pragma unroll
                        for (int j = 0; j < 8; ++j) if (n0 + j < Nin) proj[(size_t)(m0 + i) * LDP + n0 + j] = f2bf(acc[i][j]);
                });
#endif
        } }
        SEAM(P + LP_INPROJ);

        if (IN(P + LP_MIXA)) {
            PHASE_IDS();
            REPS(kind == 0 ? 11 : 12) { if (rep_) __syncthreads();
            if (kind == 0) {
                const int o = (L == 0) ? 6 : 25;
                const float* a_re = (const float*)args.in[o + 0]; const float* a_im = (const float*)args.in[o + 1]; const float* log_dt = (const float*)args.in[o + 2];
                const float* b_re = (const float*)args.in[o + 3]; const float* b_im = (const float*)args.in[o + 4]; const float* c_re = (const float*)args.in[o + 5];
                const float* c_im = (const float*)args.in[o + 6]; const float* d_skip = (const float*)args.in[o + 7];
#if FAST_S5
                typedef pg8::bf16x8 bx8; typedef pg8::f32x4 fx4;
                LAS float* BU = (LAS float*)(lds + wave * 32768);
                LAS bf16* XS = (LAS bf16*)(lds + wave * 32768 + 16896);
                for (int unit = wave * G + vcu; wave < 4 && unit < NB * 48; unit += G * 4) {
                    const int b = unit / 48, g = unit % 48, p = lane, tok = lane & 15, sg = lane >> 4;
                    const float lre = fminf(a_re[g * 64 + p], -1e-4f), lim = a_im[g * 64 + p];
                    const float dt = __expf(log_dt[g]);
                    const float mag = __expf(dt * lre); float sn, cs; sincos_rad(dt * lim, sn, cs);
                    const float abr = mag * cs, abi = mag * sn;
                    const float den = lre * lre + lim * lim, nr = abr - 1.0f;
                    const float cr = (nr * lre + abi * lim) / den, ci = (abi * lre - nr * lim) / den;
                    bx8 Bf[8], Cf[4];
#pragma unroll
                    for (int tI = 0; tI < 4; ++tI) {
                        const int sp = 16 * tI + tok; const float crs = sh_idx(cr, sp, lane), cis = sh_idx(ci, sp, lane);
                        unsigned wr_[4] = {0u, 0u, 0u, 0u}, wi_[4] = {0u, 0u, 0u, 0u};
                        if (sg < 2) { const float4* pr_ = (const float4*)(b_re + (size_t)(g * 64 + sp) * 16 + 8 * sg); const float4* pi_ = (const float4*)(b_im + (size_t)(g * 64 + sp) * 16 + 8 * sg);
                            const float4 r0 = pr_[0], r1 = pr_[1], i0 = pi_[0], i1 = pi_[1];
                            const float br[8] = {r0.x, r0.y, r0.z, r0.w, r1.x, r1.y, r1.z, r1.w}, bi[8] = {i0.x, i0.y, i0.z, i0.w, i1.x, i1.y, i1.z, i1.w};
#pragma unroll
                            for (int q = 0; q < 4; ++q) { wr_[q] = pk2(crs * br[2 * q] - cis * bi[2 * q], crs * br[2 * q + 1] - cis * bi[2 * q + 1]); wi_[q] = pk2(crs * bi[2 * q] + cis * br[2 * q], crs * bi[2 * q + 1] + cis * br[2 * q + 1]); } }
                        uint4 a4; a4.x = wr_[0]; a4.y = wr_[1]; a4.z = wr_[2]; a4.w = wr_[3]; Bf[tI] = __builtin_bit_cast(bx8, a4);
                        uint4 b4; b4.x = wi_[0]; b4.y = wi_[1]; b4.z = wi_[2]; b4.w = wi_[3]; Bf[4 + tI] = __builtin_bit_cast(bx8, b4);
                    }
#pragma unroll
                    for (int j = 0; j < 4; ++j) {
                        const float4 c4 = *(const float4*)(c_re + (size_t)(g * 16 + tok) * 64 + 16 * j + 4 * sg), d4 = *(const float4*)(c_im + (size_t)(g * 16 + tok) * 64 + 16 * j + 4 * sg);
                        uint4 a4; a4.x = pk2(c4.x, -d4.x); a4.y = pk2(c4.y, -d4.y); a4.z = pk2(c4.z, -d4.z); a4.w = pk2(c4.w, -d4.w); Cf[j] = __builtin_bit_cast(bx8, a4);
                    }
                    const float4 dsk4 = *(const float4*)(d_skip + g * 16 + 4 * sg);
                    float sxr = 0.f, sxi = 0.f;
                    const bf16* ubase = proj + (size_t)b * SEQ * LDP + g * 16;
                    uint4 unx[4]; uint2 uex[4];
#pragma unroll
                    for (int q = 0; q < 4; ++q) { unx[q] = make_uint4(0u, 0u, 0u, 0u); if (sg < 2) unx[q] = *(const uint4*)(ubase + (size_t)(16 * q + tok) * LDP + 8 * sg); uex[q] = *(const uint2*)(ubase + (size_t)(16 * q + tok) * LDP + 4 * sg); }
                    fx4 dnx[8];
                    { const bx8 uf0 = __builtin_bit_cast(bx8, unx[0]);
#pragma unroll
                      for (int tI = 0; tI < 8; ++tI) { const fx4 d = __builtin_amdgcn_mfma_f32_16x16x32_bf16(Bf[tI], uf0, (fx4){0.f, 0.f, 0.f, 0.f}, 0, 0, 0); *(LAS fx4*)(BU + tok * 132 + 16 * tI + 4 * sg) = d; } }
                    uint2 ue_prev = make_uint2(0u, 0u);
                    for (int t64 = 0; t64 < SEQ; t64 += 64) {
                        uint4 ucu[4]; uint2 uec[4];
#pragma unroll
                        for (int q = 0; q < 4; ++q) { ucu[q] = unx[q]; uec[q] = uex[q]; }
                        if (t64 + 64 < SEQ) {
#pragma unroll
                            for (int q = 0; q < 4; ++q) { if (sg < 2) unx[q] = *(const uint4*)(ubase + (size_t)(t64 + 64 + 16 * q + tok) * LDP + 8 * sg); uex[q] = *(const uint2*)(ubase + (size_t)(t64 + 64 + 16 * q + tok) * LDP + 4 * sg); } }
#pragma unroll
                        for (int q = 0; q < 4; ++q) {
                            const int t0 = t64 + 16 * q, cb = q & 1, nb = cb ^ 1;
                            LAS float* BUc = BU + cb * (16 * 132); LAS float* BUn = BU + nb * (16 * 132);
                            LAS bf16* XSc = XS + cb * (16 * 136); LAS bf16* XSp = XS + nb * (16 * 136);
                            float bre[16], bim[16];
#pragma unroll
                            for (int t = 0; t < 16; ++t) { bre[t] = BUc[t * 132 + p]; bim[t] = BUc[t * 132 + 64 + p]; }
                            const bool has_next = (t0 + 16 < SEQ);
                            { const bx8 ufn = __builtin_bit_cast(bx8, (q < 3) ? ucu[(q + 1) & 3] : unx[0]);
#pragma unroll
                              for (int tI = 0; tI < 8; ++tI) dnx[tI] = __builtin_amdgcn_mfma_f32_16x16x32_bf16(Bf[tI], ufn, (fx4){0.f, 0.f, 0.f, 0.f}, 0, 0, 0); }
                            fx4 y = (fx4){0.f, 0.f, 0.f, 0.f};
                            if (t0 > 0) {
#pragma unroll
                                for (int j = 0; j < 4; ++j) { const bx8 xf = *(const LAS bx8*)(XSp + tok * 136 + 32 * j + 8 * sg); y = __builtin_amdgcn_mfma_f32_16x16x32_bf16(Cf[j], xf, y, 0, 0, 0); } }
#pragma unroll
                            for (int t = 0; t < 16; ++t) { const float nxr = abr * sxr - abi * sxi + bre[t], nxi = abr * sxi + abi * sxr + bim[t]; sxr = nxr; sxi = nxi;
                                *(LAS unsigned*)(XSc + t * 136 + 2 * p) = pg8::cvt_pk_bf16(sxr, sxi); }
                            if (has_next) {
#pragma unroll
                                for (int tI = 0; tI < 8; ++tI) *(LAS fx4*)(BUn + tok * 132 + 16 * tI + 4 * sg) = dnx[tI]; }
                            if (t0 > 0) {
                                const float u0 = __uint_as_float(ue_prev.x << 16), u1 = __uint_as_float(ue_prev.x & 0xffff0000u), u2 = __uint_as_float(ue_prev.y << 16), u3 = __uint_as_float(ue_prev.y & 0xffff0000u);
                                uint2 o; o.x = pg8::cvt_pk_bf16(gelu_tanh(y[0] + dsk4.x * u0), gelu_tanh(y[1] + dsk4.y * u1)); o.y = pg8::cvt_pk_bf16(gelu_tanh(y[2] + dsk4.z * u2), gelu_tanh(y[3] + dsk4.w * u3));
                                *(uint2*)(yg + (size_t)(b * SEQ + t0 - 16 + tok) * MIXW + g * 16 + 4 * sg) = o; }
                            ue_prev = uec[q];
                        }
                    }
                    {
                        LAS bf16* XSp = XS + 1 * (16 * 136);
                        fx4 y = (fx4){0.f, 0.f, 0.f, 0.f};
#pragma unroll
                        for (int j = 0; j < 4; ++j) { const bx8 xf = *(const LAS bx8*)(XSp + tok * 136 + 32 * j + 8 * sg); y = __builtin_amdgcn_mfma_f32_16x16x32_bf16(Cf[j], xf, y, 0, 0, 0); }
                        const float u0 = __uint_as_float(ue_prev.x << 16), u1 = __uint_as_float(ue_prev.x & 0xffff0000u), u2 = __uint_as_float(ue_prev.y << 16), u3 = __uint_as_float(ue_prev.y & 0xffff0000u);
                        uint2 o; o.x = pg8::cvt_pk_bf16(gelu_tanh(y[0] + dsk4.x * u0), gelu_tanh(y[1] + dsk4.y * u1)); o.y = pg8::cvt_pk_bf16(gelu_tanh(y[2] + dsk4.z * u2), gelu_tanh(y[3] + dsk4.w * u3));
                        *(uint2*)(yg + (size_t)(b * SEQ + SEQ - 16 + tok) * MIXW + g * 16 + 4 * sg) = o;
                    }
                }
#else
                for (int unit = bid * NWAVES + wave; unit < NB * 48; unit += G * NWAVES) {
                    const int b = unit / 48, g = unit % 48, p = lane;
                    const float lre = fminf(a_re[g * 64 + p], -1e-4f), lim = a_im[g * 64 + p];
                    const float dt = __expf(log_dt[g]);
                    const float mag = __expf(dt * lre); float sn, cs; sincos_rad(dt * lim, sn, cs);
                    const float abr = mag * cs, abi = mag * sn;
                    const float den = lre * lre + lim * lim, nr = abr - 1.0f;
                    const float cr = (nr * lre + abi * lim) / den, ci = (abi * lre - nr * lim) / den;
                    float Br[16], Bi[16], Cr[16], Ci[16];
#pragma unroll
                    for (int h = 0; h < 16; ++h) { const float br = b_re[(size_t)(g * 64 + p) * 16 + h], bi = b_im[(size_t)(g * 64 + p) * 16 + h];
                        Br[h] = cr * br - ci * bi; Bi[h] = cr * bi + ci * br; Cr[h] = c_re[(size_t)(g * 16 + h) * 64 + p]; Ci[h] = c_im[(size_t)(g * 16 + h) * 64 + p]; }
                    const float dsk = d_skip[g * 16 + (lane & 15)];
                    float sxr = 0.f, sxi = 0.f;
                    for (int t = 0; t < SEQ; ++t) {
                        const bf16* up = proj + (size_t)(b * SEQ + t) * LDP + g * 16;
                        float u[16]; unpack8(*(const uint4*)up, u); unpack8(*(const uint4*)(up + 8), u + 8);
                        float bur = 0.f, bui = 0.f;
#pragma unroll
                        for (int h = 0; h < 16; ++h) { bur += Br[h] * u[h]; bui += Bi[h] * u[h]; }
                        const float nxr = abr * sxr - abi * sxi + bur, nxi = abr * sxi + abi * sxr + bui; sxr = nxr; sxi = nxi;
                        float myy = 0.f;
#pragma unroll
                        for (int h = 0; h < 16; ++h) { float v = Cr[h] * sxr - Ci[h] * sxi; v = wave_sum(v, lane); myy = (lane == h) ? v : myy; }
                        if (lane < 16) { const float uu = bf2f(up[lane]); const float y = gelu_tanh(myy + dsk * uu); yg[(size_t)(b * SEQ + t) * MIXW + g * 16 + lane] = f2bf(y); }
                    }
                }
#endif
            } else {
#if FAST_LINATT && LINATT_V2
                {
                    typedef pg8::bf16x8 bx8; typedef pg8::f32x4 fx4; typedef pg8::u32x4 ux4; typedef pg8::u32x2 ux2;
                    typedef _Float16 h2_t __attribute__((ext_vector_type(2)));
                    LAS bf16* Qs = (LAS bf16*)lds;
                    LAS bf16* Ks = (LAS bf16*)(lds + 13312);
                    LAS bf16* KTe = (LAS bf16*)(lds + 26624);
                    LAS bf16* VT = (LAS bf16*)(lds + 40448);
                    LAS bf16* Ps = (LAS bf16*)(lds + 68096);
                    LAS bf16* CT = (LAS bf16*)(lds + 77312);
                    LAS float* fa = (LAS float*)(lds + 117248);
                    LAS float* aArr = fa, *MArr = fa + 64, *interArr = fa + 128, *clampArr = fa + 192, *eArr = fa + 256, *denArr = fa + 320, *nArr = fa + 384  , *stat = fa + 480  ;
                    const float* conv_q = (const float*)ARGP(17); const float* conv_k = (const float*)ARGP(18);
                    const float* b_i = (const float*)ARGP(19); const float* b_f = (const float*)ARGP(20);
                    const float* norm_g = (const float*)(kind == 1 ? ARGP(21) : ARGP(23));
                    constexpr int CHB = 62208;
                    unsigned char* const LB = (unsigned char*)(ws + WS_ACT);
#define LINATT_PIECE_LDS(p) ((p) < 768 ? (((p) / 12) * 104 + ((p) % 12) * 8) * 2 : (p) < 1536 ? 13312 + ((((p) - 768) / 12) * 104 + (((p) - 768) % 12) * 8) * 2 : \
                             (p) < 2304 ? 26624 + ((((p) - 1536) >> 3) * 72 + (((p) - 1536) & 7) * 8) * 2 : 40448 + ((((p) - 2304) >> 3) * 72 + (((p) - 2304) & 7) * 8) * 2)
                    for (int unit = bid; unit < NB * 4 * 8; unit += G) {
                        const int b = unit >> 5, h = (unit >> 3) & 3, c0 = (unit & 7) * 4;
                        const float lgam = __logf(1.0f - exp2f(-5.0f - (float)h));
                        ux4 rv[3], rg[8]; float rig = 0.f, rfg = 0.f;
#pragma unroll
                        for (int q = 0; q < 8; ++q) rg[q] = (ux4){0u, 0u, 0u, 0u};
#define LINATT_LOAD_RAW(cc) do { const size_t r0_ = (size_t)b * SEQ + (size_t)(cc) * 64; \
                            _Pragma("unroll") for (int kq = 0; kq < 3; ++kq) { const int idx = tidv + NTHR * kq, cg = idx >> 6, s = idx & 63; rv[kq] = *(const ux4*)(proj + (r0_ + s) * LDP + 768 + h * 192 + 8 * cg); } \
                            if (kind == 1) { _Pragma("unroll") for (int kq = 0; kq < 3; ++kq) { const int idx = tidv + NTHR * kq, which = idx / 768, rem = idx % 768, cg = rem >> 6, s = rem & 63; \
                                    rg[kq] = *(const ux4*)(proj + (r0_ + s) * LDP + which * 384 + h * 96 + 8 * cg); } \
                                if (wave == 0) { const bf16* pr = proj + (r0_ + lanev) * LDP; rig = bf2f(pr[2304 + h]); rfg = bf2f(pr[2308 + h]); } } \
                            else { _Pragma("unroll") for (int kq = 0; kq < 2; ++kq) { const int idx = tidv + NTHR * kq; if (idx < 768) { const int which = idx / 384, rem = idx % 384, cg = rem >> 6, s = rem & 63; \
                                    const bf16* xp = proj + (r0_ + s) * LDP + which * 384 + h * 96 + 8 * cg; rg[kq] = *(const ux4*)xp; rg[2 + kq] = *(const ux4*)(xp + 48); \
                                    const ux4* rp = (const ux4*)((const unsigned*)rope + (r0_ + s) * 48 + 8 * cg); rg[4 + 2 * kq] = rp[0]; rg[5 + 2 * kq] = rp[1]; } } } } while (0)
                        { int tidv = tid; asm volatile("" : "+v"(tidv)); const int lanev = tidv & 63; (void)lanev;
                          if (kind == 1 && c0 > 0) {
                              const size_t rp_ = (size_t)b * SEQ + (size_t)(c0 - 1) * 64;
#pragma unroll
                              for (int kq = 0; kq < 3; ++kq) { const int idx = tidv + NTHR * kq, which = idx / 768, rem = idx % 768, cg = rem >> 6, s = rem & 63; rg[3 + kq] = *(const ux4*)(proj + (rp_ + s) * LDP + which * 384 + h * 96 + 8 * cg); } }
                          LINATT_LOAD_RAW(c0); }
                        for (int cc = 0; cc < 4; ++cc) {
                            const int c = c0 + cc;
                            int tidv = tid; asm volatile("" : "+v"(tidv));
                            const int lanev = tidv & 63;
                            unsigned char* const img = LB + (size_t)((b * 4 + h) * 32 + c) * CHB;
                            if (wave == 0) {
                                float lf, ig;
                                if (kind == 1) { ig = rig + b_i[h]; const float fg = rfg + b_f[h]; lf = fminf(fg, 0.f) - __logf(1.0f + __expf(-fabsf(fg))); }
                                else { ig = 0.f; lf = lgam; }
                                float bc = lf;
#pragma unroll
                                for (int o = 1; o < 64; o <<= 1) { const float t = sh_up(bc, o, lanev); if (lanev >= o) bc += t; }
                                const float a = ig - bc; float A = a;
#pragma unroll
                                for (int o = 1; o < 64; o <<= 1) { const float t = sh_up(A, o, lanev); if (lanev >= o) A = fmaxf(A, t); }
                                float* gp = (float*)(img + 61440); gp[lanev] = a; gp[64 + lanev] = A; gp[128 + lanev] = bc;
                            }
#pragma unroll
                            for (int kq = 0; kq < 3; ++kq) {
                                const int idx = tidv + NTHR * kq, cg = idx >> 6, s = idx & 63; const ux4 v = rv[kq];
                                LAS bf16* d = VT + (8 * cg) * 72 + s;
                                d[0] = (bf16)(v.x & 0xffffu); d[72] = (bf16)(v.x >> 16); d[144] = (bf16)(v.y & 0xffffu); d[216] = (bf16)(v.y >> 16);
                                d[288] = (bf16)(v.z & 0xffffu); d[360] = (bf16)(v.z >> 16); d[432] = (bf16)(v.w & 0xffffu); d[504] = (bf16)(v.w >> 16);
                            }
                            if (kind == 1) {
#pragma unroll
                                for (int kq = 0; kq < 3; ++kq) {
                                    const int idx = tidv + NTHR * kq, which = idx / 768, rem = idx % 768, cg = rem >> 6, s = rem & 63;
                                    const int ch = h * 96 + 8 * cg;
                                    const float* cw = (which ? conv_k : conv_q) + ch;
                                    float r[8];
                                    { float x[8]; uint4 xu; xu.x = rg[kq].x; xu.y = rg[kq].y; xu.z = rg[kq].z; xu.w = rg[kq].w; unpack8(xu, x);
                                      const float4 w0 = *(const float4*)(cw + 3 * 384), w1 = *(const float4*)(cw + 3 * 384 + 4);
                                      r[0] = w0.x * x[0]; r[1] = w0.y * x[1]; r[2] = w0.z * x[2]; r[3] = w0.w * x[3]; r[4] = w1.x * x[4]; r[5] = w1.y * x[5]; r[6] = w1.z * x[6]; r[7] = w1.w * x[7]; }
#pragma unroll
                                    for (int dl = 1; dl <= 3; ++dl) {
                                        const int sl = (lanev - dl) & 63; uint4 xu;
                                        { const unsigned c0 = sh_idx(rg[kq].x, sl, lanev), p0 = sh_idx(rg[3 + kq].x, sl, lanev); xu.x = (lanev >= dl) ? c0 : p0; }
                                        { const unsigned c0 = sh_idx(rg[kq].y, sl, lanev), p0 = sh_idx(rg[3 + kq].y, sl, lanev); xu.y = (lanev >= dl) ? c0 : p0; }
                                        { const unsigned c0 = sh_idx(rg[kq].z, sl, lanev), p0 = sh_idx(rg[3 + kq].z, sl, lanev); xu.z = (lanev >= dl) ? c0 : p0; }
                                        { const unsigned c0 = sh_idx(rg[kq].w, sl, lanev), p0 = sh_idx(rg[3 + kq].w, sl, lanev); xu.w = (lanev >= dl) ? c0 : p0; }
                                        float x[8]; unpack8(xu, x);
                                        const float4 w0 = *(const float4*)(cw + (3 - dl) * 384), w1 = *(const float4*)(cw + (3 - dl) * 384 + 4);
                                        r[0] += w0.x * x[0]; r[1] += w0.y * x[1]; r[2] += w0.z * x[2]; r[3] += w0.w * x[3]; r[4] += w1.x * x[4]; r[5] += w1.y * x[5]; r[6] += w1.z * x[6]; r[7] += w1.w * x[7];
                                    }
                                    rg[3 + kq] = rg[kq];
                                    const float sc = which ? 1.0f : 0.10206207261596575f;
#pragma unroll
                                    for (int i = 0; i < 8; ++i) r[i] = r[i] * sigmoidf(r[i]) * sc;
                                    ux4 pk; pk.x = pg8::cvt_pk_bf16(r[0], r[1]); pk.y = pg8::cvt_pk_bf16(r[2], r[3]); pk.z = pg8::cvt_pk_bf16(r[4], r[5]); pk.w = pg8::cvt_pk_bf16(r[6], r[7]);
                                    if (which == 0) *(LAS ux4*)(Qs + s * 104 + 8 * cg) = pk;
                                    else { *(LAS ux4*)(Ks + s * 104 + 8 * cg) = pk; const float es = 1.0f; LAS bf16* d = KTe + (8 * cg) * 72 + s;
#pragma unroll
                                        for (int i = 0; i < 8; ++i) d[72 * i] = f2bf(r[i] * es); }
                                }
                            } else {
#pragma unroll
                                for (int kq = 0; kq < 2; ++kq) {
                                    const int idx = tidv + NTHR * kq;
                                    if (idx < 768) {
                                        const int which = idx / 384, rem = idx % 384, cg = rem >> 6, s = rem & 63;
                                        float x1[8], x2[8]; { uint4 xu; xu.x = rg[kq].x; xu.y = rg[kq].y; xu.z = rg[kq].z; xu.w = rg[kq].w; unpack8(xu, x1); xu.x = rg[2 + kq].x; xu.y = rg[2 + kq].y; xu.z = rg[2 + kq].z; xu.w = rg[2 + kq].w; unpack8(xu, x2); }
                                        const unsigned rpw[8] = {rg[4 + 2 * kq].x, rg[4 + 2 * kq].y, rg[4 + 2 * kq].z, rg[4 + 2 * kq].w, rg[5 + 2 * kq].x, rg[5 + 2 * kq].y, rg[5 + 2 * kq].z, rg[5 + 2 * kq].w};
                                        float o1[8], o2[8]; const float sc = which ? 0.10206207261596575f : 1.0f;
#pragma unroll
                                        for (int q8 = 0; q8 < 8; ++q8) { const h2_t cs_ = __builtin_bit_cast(h2_t, rpw[q8]); const float c0 = (float)cs_.x, s0 = (float)cs_.y;
                                            o1[q8] = (x1[q8] * c0 - x2[q8] * s0) * sc; o2[q8] = (x2[q8] * c0 + x1[q8] * s0) * sc; }
                                        ux4 p1; p1.x = pg8::cvt_pk_bf16(o1[0], o1[1]); p1.y = pg8::cvt_pk_bf16(o1[2], o1[3]); p1.z = pg8::cvt_pk_bf16(o1[4], o1[5]); p1.w = pg8::cvt_pk_bf16(o1[6], o1[7]);
                                        ux4 p2; p2.x = pg8::cvt_pk_bf16(o2[0], o2[1]); p2.y = pg8::cvt_pk_bf16(o2[2], o2[3]); p2.z = pg8::cvt_pk_bf16(o2[4], o2[5]); p2.w = pg8::cvt_pk_bf16(o2[6], o2[7]);
                                        LAS bf16* dst = which ? Ks : Qs;
                                        *(LAS ux4*)(dst + s * 104 + 8 * cg) = p1; *(LAS ux4*)(dst + s * 104 + 48 + 8 * cg) = p2;
                                        if (which) { const float es = 1.0f; LAS bf16* d = KTe + (8 * cg) * 72 + s;
#pragma unroll
                                            for (int i = 0; i < 8; ++i) { d[72 * i] = f2bf(o1[i] * es); d[72 * (48 + i)] = f2bf(o2[i] * es); } }
                                    }
                                }
                            }
                            if (cc + 1 < 4) LINATT_LOAD_RAW(c + 1);
                            LDS_BARRIER();
#pragma unroll
                            for (int k = 0; k < 8; ++k) { const int p = tidv + NTHR * k; if (p < 3840) *(ux4*)(img + (size_t)p * 16) = *(const LAS ux4*)(lds + LINATT_PIECE_LDS(p)); }
                            LDS_BARRIER();
                        }
                    }
#undef LINATT_LOAD_RAW
                    xcd_barrier(bar, wave0);
                    const int tok = lane & 15, sg = lane >> 4; (void)tok; (void)sg;
                    for (int unit = bid; unit < NB * 4 * 4; unit += G) {
                        const int b = unit >> 4, h = (unit >> 2) & 3, jt = unit & 3;
                        fx4 Cst[3][3];
#pragma unroll
                        for (int x = 0; x < 3; ++x)
#pragma unroll
                            for (int y = 0; y < 3; ++y) Cst[x][y] = (fx4){0.f, 0.f, 0.f, 0.f};
                        float nreg = 0.f, m_prev = 0.f;
                        __syncthreads();
                        for (int i = tid; i < 192 * 104 / 2; i += NTHR) ((LAS unsigned*)CT)[i] = 0u;
                        if (tid < 96) nArr[tid] = 0.f;
                        const int ctU = 3 * (wave & 3), itU = 3 * (wave >> 2);
                        float4 ng4[2];
#pragma unroll
                        for (int x = 0; x < 2; ++x) ng4[x] = *(const float4*)(norm_g + h * 192 + 16 * (wave + ((x && wave < 4) ? 8 : 0)) + 4 * sg);
                        ux4 rgp[8]; float g_a = 0.f, g_A = 0.f, g_b = 0.f, g_A63 = 0.f, g_b63 = 0.f;
#define LINATT_LOAD_IMG(cc) do { const unsigned char* im_ = LB + (size_t)((b * 4 + h) * 32 + (cc)) * CHB; \
                            _Pragma("unroll") for (int k = 0; k < 8; ++k) { const int p = tidv + NTHR * k; rgp[k] = *(const ux4*)(im_ + (size_t)(p < 3840 ? p : 3839) * 16); } \
                            const float* gp_ = (const float*)(im_ + 61440); if (tidv < 64) { g_a = gp_[tidv]; g_A = gp_[64 + tidv]; g_b = gp_[128 + tidv]; } g_A63 = gp_[64 + 63]; g_b63 = gp_[128 + 63]; } while (0)
                        { int tidv = tid; asm volatile("" : "+v"(tidv)); LINATT_LOAD_IMG(0); }
                        for (int c = 0; c < SEQ / 64; ++c) {
                            const size_t row0 = (size_t)b * SEQ + c * 64;
                            int tidv = tid; asm volatile("" : "+v"(tidv));
                            const int lanev = tidv & 63, tokv = lanev & 15, sgv = lanev >> 4;
#pragma unroll
                            for (int k = 0; k < 8; ++k) { const int p = tidv + NTHR * k; if (p < 3840) *(LAS ux4*)(lds + LINATT_PIECE_LDS(p)) = rgp[k]; }
                            const float M63 = (kind == 1) ? fmaxf(m_prev, g_A63) : -g_b63;
                            const float sa_c = __expf(m_prev - M63);
                            if (tidv < 64) { const float M = (kind == 1) ? fmaxf(m_prev, g_A) : -g_b;
                                aArr[tidv] = g_a; MArr[tidv] = M; interArr[tidv] = __expf(m_prev - M); clampArr[tidv] = __expf(-(g_b + M)); eArr[tidv] = __expf(g_a - M63); }
                            if (kind == 1) m_prev = g_b63 + M63;
                            if (c + 1 < SEQ / 64) LINATT_LOAD_IMG(c + 1);
                            LDS_BARRIER(); __builtin_amdgcn_sched_barrier(0);
                            if (wave < 4) {
                                const int st = wave, j = 16 * jt + tokv; fx4 d = (fx4){0.f, 0.f, 0.f, 0.f};
                                if (st <= jt) {
                                    const float Mj = MArr[j];
#pragma unroll
                                    for (int kk = 0; kk < 3; ++kk) { const bx8 yq = *(const LAS bx8*)(Qs + j * 104 + 32 * kk + 8 * sgv), xk = *(const LAS bx8*)(Ks + (16 * st + tokv) * 104 + 32 * kk + 8 * sgv); d = __builtin_amdgcn_mfma_f32_16x16x32_bf16(xk, yq, d, 0, 0, 0); }
#pragma unroll
                                    for (int r = 0; r < 4; ++r) { const int s = 16 * st + 4 * sgv + r; d[r] = (s <= j) ? d[r] * __expf(aArr[s] - Mj) : 0.f; }
                                }
                                ux2 pw; pw.x = pg8::cvt_pk_bf16(d[0], d[1]); pw.y = pg8::cvt_pk_bf16(d[2], d[3]);
                                *(LAS ux2*)(Ps + j * 72 + 16 * st + 4 * sgv) = pw;
                            }
                            LDS_BARRIER();
                            __builtin_amdgcn_sched_barrier(0);
                            if (kind == 1) {
                                const int j = 16 * jt + (tidv >> 5), part = tidv & 31; float dq = 0.f, dp = 0.f;
#pragma unroll
                                for (int i = 0; i < 3; ++i) dq += bf2f(Qs[j * 104 + part * 3 + i]) * nArr[part * 3 + i];
#pragma unroll
                                for (int s = 0; s < 2; ++s) dp += bf2f(Ps[j * 72 + part * 2 + s]);
                                float dn = interArr[j] * dq + dp; dn += sh_xor(dn, 1, lane); dn += sh_xor(dn, 2, lane); dn += sh_xor(dn, 4, lane); dn += sh_xor(dn, 8, lane); dn += sh_xor(dn, 16, lane);
                                if (part == 0) denArr[j] = dn;
                            }
                            __builtin_amdgcn_sched_barrier(0);
                            constexpr int NXT = 2;
                            const int nx = (wave < 4) ? 2 : 1;
                            fx4 acc[NXT];
                            const size_t orow = row0 + 16 * jt + tokv;
                            ux2 ogate[NXT];
#pragma unroll
                            for (int x = 0; x < NXT; ++x) { ogate[x] = (ux2){0u, 0u}; if (x < nx) ogate[x] = *(const ux2*)(proj + orow * LDP + 1536 + h * 192 + 16 * (wave + 8 * x) + 4 * sgv); }
                            {
                                bx8 yq[3];
#pragma unroll
                                for (int kk = 0; kk < 3; ++kk) yq[kk] = *(const LAS bx8*)(Qs + (16 * jt + tokv) * 104 + 32 * kk + 8 * sgv);
#pragma unroll
                                for (int x = 0; x < NXT; ++x) { acc[x] = (fx4){0.f, 0.f, 0.f, 0.f}; const int ct = wave + 8 * x;
                                    if (x < nx) {
#pragma unroll
                                    for (int kk = 0; kk < 3; ++kk) { const bx8 xc = *(const LAS bx8*)(CT + (16 * ct + tokv) * 104 + 32 * kk + 8 * sgv); acc[x] = __builtin_amdgcn_mfma_f32_16x16x32_bf16(xc, yq[kk], acc[x], 0, 0, 0); } } }
                                __builtin_amdgcn_sched_barrier(0);
                                const float in_j = interArr[16 * jt + tokv];
#pragma unroll
                                for (int x = 0; x < NXT; ++x) acc[x] = acc[x] * in_j;
                                bx8 yp[2];
#pragma unroll
                                for (int kk = 0; kk < 2; ++kk) yp[kk] = *(const LAS bx8*)(Ps + (16 * jt + tokv) * 72 + 32 * kk + 8 * sgv);
#pragma unroll
                                for (int x = 0; x < NXT; ++x) { const int ct = wave + 8 * x;
                                    if (x < nx) {
#pragma unroll
                                    for (int kk = 0; kk < 2; ++kk) { const bx8 xv = *(const LAS bx8*)(VT + (16 * ct + tokv) * 72 + 32 * kk + 8 * sgv); acc[x] = __builtin_amdgcn_mfma_f32_16x16x32_bf16(xv, yp[kk], acc[x], 0, 0, 0); } } }
                            }
                            __builtin_amdgcn_sched_barrier(0);
                            {
                                const float sa = sa_c;
                                bx8 yv[3][2];
#pragma unroll
                                for (int x = 0; x < 3; ++x)
#pragma unroll
                                    for (int kk = 0; kk < 2; ++kk) yv[x][kk] = *(const LAS bx8*)(VT + (16 * (ctU + x) + tokv) * 72 + 32 * kk + 8 * sgv);
                                float ev[2][8];
#pragma unroll
                                for (int kk = 0; kk < 2; ++kk) { const fx4 e0 = *(const LAS fx4*)(eArr + 32 * kk + 8 * sgv), e1 = *(const LAS fx4*)(eArr + 32 * kk + 8 * sgv + 4);
                                    ev[kk][0] = e0[0]; ev[kk][1] = e0[1]; ev[kk][2] = e0[2]; ev[kk][3] = e0[3]; ev[kk][4] = e1[0]; ev[kk][5] = e1[1]; ev[kk][6] = e1[2]; ev[kk][7] = e1[3]; }
#pragma unroll
                                for (int x = 0; x < 3; ++x) { bx8 xk[2];
#pragma unroll
                                    for (int kk = 0; kk < 2; ++kk) { const ux4 rawk = *(const LAS ux4*)(KTe + (16 * (itU + x) + tokv) * 72 + 32 * kk + 8 * sgv); ux4 sk;
                                        sk.x = pg8::cvt_pk_bf16(__uint_as_float(rawk.x << 16) * ev[kk][0], __uint_as_float(rawk.x & 0xffff0000u) * ev[kk][1]); sk.y = pg8::cvt_pk_bf16(__uint_as_float(rawk.y << 16) * ev[kk][2], __uint_as_float(rawk.y & 0xffff0000u) * ev[kk][3]);
                                        sk.z = pg8::cvt_pk_bf16(__uint_as_float(rawk.z << 16) * ev[kk][4], __uint_as_float(rawk.z & 0xffff0000u) * ev[kk][5]); sk.w = pg8::cvt_pk_bf16(__uint_as_float(rawk.w << 16) * ev[kk][6], __uint_as_float(rawk.w & 0xffff0000u) * ev[kk][7]);
                                        xk[kk] = __builtin_bit_cast(bx8, sk); }
#pragma unroll
                                    for (int y = 0; y < 3; ++y) { Cst[x][y] = Cst[x][y] * sa;
#pragma unroll
                                        for (int kk = 0; kk < 2; ++kk) Cst[x][y] = __builtin_amdgcn_mfma_f32_16x16x32_bf16(xk[kk], yv[y][kk], Cst[x][y], 0, 0, 0); } }
                                if (kind == 1 && tidv < 96) { float sn = 0.f;
#pragma unroll 8
                                    for (int s = 0; s < 64; ++s) sn += bf2f(KTe[tidv * 72 + s]) * eArr[s];
                                    nreg = sa * nreg + sn; }
                            }
                            __builtin_amdgcn_sched_barrier(0);
                            LDS_BARRIER();
                            {
                                const int j = 16 * jt + tokv;
                                if (kind == 1) { const float dv = 1.0f / fmaxf(fabsf(denArr[j]), clampArr[j]);
#pragma unroll
                                    for (int x = 0; x < NXT; ++x) acc[x] = acc[x] * dv; }
                                float s1 = 0.f, s2 = 0.f;
#pragma unroll
                                for (int x = 0; x < NXT; ++x)
#pragma unroll
                                    for (int r = 0; r < 4; ++r) { s1 += acc[x][r]; s2 += acc[x][r] * acc[x][r]; }
                                s1 += sh_xor(s1, 16, lane); s1 += sh_xor(s1, 32, lane); s2 += sh_xor(s2, 16, lane); s2 += sh_xor(s2, 32, lane);
                                if (sgv == 0) { stat[(tokv * 8 + wave) * 2 + 0] = s1; stat[(tokv * 8 + wave) * 2 + 1] = s2; }
                            }
                            LDS_BARRIER();
                            {
                                const int j = 16 * jt + tokv;
                                float t1 = 0.f, t2 = 0.f;
#pragma unroll
                                for (int w8 = 0; w8 < 8; ++w8) { t1 += stat[(tokv * 8 + w8) * 2 + 0]; t2 += stat[(tokv * 8 + w8) * 2 + 1]; }
                                const float mean = t1 * (1.0f / 192.0f);
                                const float var = t2 * (1.0f / 192.0f) - mean * mean; (void)j;
                                const float rstd = 1.0f / sqrtf(fmaxf(var, 0.f) + LN_EPS);
#pragma unroll
                                for (int x = 0; x < NXT; ++x) if (x < nx) { const int colh = 16 * (wave + 8 * x) + 4 * sgv; const float4 g4 = ng4[x];
                                    const float o0 = __uint_as_float(ogate[x].x << 16), o1 = __uint_as_float(ogate[x].x & 0xffff0000u), o2 = __uint_as_float(ogate[x].y << 16), o3 = __uint_as_float(ogate[x].y & 0xffff0000u);
                                    float g0, g1, g2, g3;
                                    if (kind == 1) { g0 = sigmoidf(o0); g1 = sigmoidf(o1); g2 = sigmoidf(o2); g3 = sigmoidf(o3); } else { g0 = o0 * sigmoidf(o0); g1 = o1 * sigmoidf(o1); g2 = o2 * sigmoidf(o2); g3 = o3 * sigmoidf(o3); }
                                    ux2 ov; ov.x = pg8::cvt_pk_bf16((acc[x][0] - mean) * rstd * g4.x * g0, (acc[x][1] - mean) * rstd * g4.y * g1); ov.y = pg8::cvt_pk_bf16((acc[x][2] - mean) * rstd * g4.z * g2, (acc[x][3] - mean) * rstd * g4.w * g3);
                                    *(ux2*)(cat + orow * D + h * 192 + colh) = ov; }
#pragma unroll
                                for (int x = 0; x < 3; ++x)
#pragma unroll
                                    for (int y = 0; y < 3; ++y) { ux2 cw; cw.x = pg8::cvt_pk_bf16(Cst[x][y][0], Cst[x][y][1]); cw.y = pg8::cvt_pk_bf16(Cst[x][y][2], Cst[x][y][3]);
                                        *(LAS ux2*)(CT + (16 * (ctU + y) + tokv) * 104 + 16 * (itU + x) + 4 * sgv) = cw; }
                                if (kind == 1 && tidv < 96) nArr[tidv] = nreg;
                            }
                        }
                    }
                }
#elif FAST_LINATT
                {
                    typedef pg8::bf16x8 bx8; typedef pg8::f32x4 fx4; typedef pg8::u32x4 ux4; typedef pg8::u32x2 ux2;
                    LAS bf16* Qs = (LAS bf16*)lds;
                    LAS bf16* Ks = (LAS bf16*)(lds + 13312);
                    LAS bf16* KTe = (LAS bf16*)(lds + 26624);
                    LAS bf16* VT = (LAS bf16*)(lds + 40448);
                    LAS bf16* Ps = (LAS bf16*)(lds + 68096);
                    LAS bf16* CT = (LAS bf16*)(lds + 77312);
                    LAS float* fa = (LAS float*)(lds + 117248);
                    LAS float* aArr = fa, *MArr = fa + 64, *interArr = fa + 128, *clampArr = fa + 192, *eArr = fa + 256, *denArr = fa + 320, *nArr = fa + 384  , *stat = fa + 480  , *scal = fa + 736;
                    const float* conv_q = (const float*)ARGP(17); const float* conv_k = (const float*)ARGP(18);
                    const float* b_i = (const float*)ARGP(19); const float* b_f = (const float*)ARGP(20);
                    const float* norm_g = (const float*)(kind == 1 ? ARGP(21) : ARGP(23));
                    const int tok = lane & 15, sg = lane >> 4;
                    for (int unit = bid; unit < NB * 4; unit += G) {
                        const int b = unit >> 2, h = unit & 3;
                        const float lgam = __logf(1.0f - exp2f(-5.0f - (float)h));
                        fx4 Cst[3][3];
#pragma unroll
                        for (int x = 0; x < 3; ++x)
#pragma unroll
                            for (int y = 0; y < 3; ++y) Cst[x][y] = (fx4){0.f, 0.f, 0.f, 0.f};
                        float nreg = 0.f, m_prev = 0.f;
                        __syncthreads();
                        for (int i = tid; i < 192 * 104 / 2; i += NTHR) ((LAS unsigned*)CT)[i] = 0u;
                        if (tid < 96) nArr[tid] = 0.f;
                        const int ctU = 3 * (wave & 3), itU = 3 * (wave >> 2);
                        const int jt = wave & 3, half = wave >> 2;
                        typedef _Float16 h2_t __attribute__((ext_vector_type(2)));
                        ux4 rv[3], rg[8]; float rig = 0.f, rfg = 0.f;
#pragma unroll
                        for (int q = 0; q < 8; ++q) rg[q] = (ux4){0u, 0u, 0u, 0u};
#define LINATT_LOAD_RAW(cc) do { const size_t r0_ = (size_t)b * SEQ + (size_t)(cc) * 64; \
                            _Pragma("unroll") for (int kq = 0; kq < 3; ++kq) { const int idx = tidv + NTHR * kq, cg = idx >> 6, s = idx & 63; rv[kq] = *(const ux4*)(proj + (r0_ + s) * LDP + 768 + h * 192 + 8 * cg); } \
                            if (kind == 1) { _Pragma("unroll") for (int kq = 0; kq < 3; ++kq) { const int idx = tidv + NTHR * kq, which = idx / 768, rem = idx % 768, cg = rem >> 6, s = rem & 63; \
                                    rg[kq] = *(const ux4*)(proj + (r0_ + s) * LDP + which * 384 + h * 96 + 8 * cg); } \
                                if (wave == 0) { const bf16* pr = proj + (r0_ + lanev) * LDP; rig = bf2f(pr[2304 + h]); rfg = bf2f(pr[2308 + h]); } } \
                            else { _Pragma("unroll") for (int kq = 0; kq < 2; ++kq) { const int idx = tidv + NTHR * kq; if (idx < 768) { const int which = idx / 384, rem = idx % 384, cg = rem >> 6, s = rem & 63; \
                                    const bf16* xp = proj + (r0_ + s) * LDP + which * 384 + h * 96 + 8 * cg; rg[kq] = *(const ux4*)xp; rg[2 + kq] = *(const ux4*)(xp + 48); \
                                    const ux4* rp = (const ux4*)((const unsigned*)rope + (r0_ + s) * 48 + 8 * cg); rg[4 + 2 * kq] = rp[0]; rg[5 + 2 * kq] = rp[1]; } } } } while (0)
                        { int tidv = tid; asm volatile("" : "+v"(tidv)); const int lanev = tidv & 63; LINATT_LOAD_RAW(0); }
                        for (int c = 0; c < SEQ / 64; ++c) {
                            const size_t row0 = (size_t)b * SEQ + c * 64;
                            int tidv = tid; asm volatile("" : "+v"(tidv));
                            const int lanev = tidv & 63, tokv = lanev & 15, sgv = lanev >> 4;
                            if (wave == 0) {
                                float lf, ig;
                                if (kind == 1) { ig = rig + b_i[h]; const float fg = rfg + b_f[h]; lf = fminf(fg, 0.f) - __logf(1.0f + __expf(-fabsf(fg))); }
                                else { ig = 0.f; lf = lgam; }
                                float bc = lf;
#pragma unroll
                                for (int o = 1; o < 64; o <<= 1) { const float t = sh_up(bc, o, lanev); if (lanev >= o) bc += t; }
                                const float a = ig - bc; float M;
                                if (kind == 1) { float A = a;
#pragma unroll
                                    for (int o = 1; o < 64; o <<= 1) { const float t = sh_up(A, o, lanev); if (lanev >= o) A = fmaxf(A, t); }
                                    M = fmaxf(m_prev, A); }
                                else M = -bc;
                                const float M63 = sh_idx(M, 63, lane), btot = sh_idx(bc, 63, lane);
                                aArr[lanev] = a; MArr[lanev] = M; interArr[lanev] = __expf(m_prev - M); clampArr[lanev] = __expf(-(bc + M)); eArr[lanev] = __expf(a - M63);
                                if (lanev == 0) scal[0] = __expf(m_prev - M63);
                                if (kind == 1) m_prev = btot + M63;
                            }
                            LDS_BARRIER();
#pragma unroll
                            for (int kq = 0; kq < 3; ++kq) {
                                const int idx = tidv + NTHR * kq, cg = idx >> 6, s = idx & 63; const ux4 v = rv[kq];
                                LAS bf16* d = VT + (8 * cg) * 72 + s;
                                d[0] = (bf16)(v.x & 0xffffu); d[72] = (bf16)(v.x >> 16); d[144] = (bf16)(v.y & 0xffffu); d[216] = (bf16)(v.y >> 16);
                                d[288] = (bf16)(v.z & 0xffffu); d[360] = (bf16)(v.z >> 16); d[432] = (bf16)(v.w & 0xffffu); d[504] = (bf16)(v.w >> 16);
                            }
                            if (kind == 1) {
#pragma unroll
                                for (int kq = 0; kq < 3; ++kq) {
                                    const int idx = tidv + NTHR * kq, which = idx / 768, rem = idx % 768, cg = rem >> 6, s = rem & 63;
                                    const int ch = h * 96 + 8 * cg;
                                    const float* cw = (which ? conv_k : conv_q) + ch;
                                    float r[8];
                                    { float x[8]; uint4 xu; xu.x = rg[kq].x; xu.y = rg[kq].y; xu.z = rg[kq].z; xu.w = rg[kq].w; unpack8(xu, x);
                                      const float4 w0 = *(const float4*)(cw + 3 * 384), w1 = *(const float4*)(cw + 3 * 384 + 4);
                                      r[0] = w0.x * x[0]; r[1] = w0.y * x[1]; r[2] = w0.z * x[2]; r[3] = w0.w * x[3]; r[4] = w1.x * x[4]; r[5] = w1.y * x[5]; r[6] = w1.z * x[6]; r[7] = w1.w * x[7]; }
#pragma unroll
                                    for (int dl = 1; dl <= 3; ++dl) {
                                        const int sl = (lanev - dl) & 63; uint4 xu;
                                        { const unsigned c0 = sh_idx(rg[kq].x, sl, lanev), p0 = sh_idx(rg[3 + kq].x, sl, lanev); xu.x = (lanev >= dl) ? c0 : p0; }
                                        { const unsigned c0 = sh_idx(rg[kq].y, sl, lanev), p0 = sh_idx(rg[3 + kq].y, sl, lanev); xu.y = (lanev >= dl) ? c0 : p0; }
                                        { const unsigned c0 = sh_idx(rg[kq].z, sl, lanev), p0 = sh_idx(rg[3 + kq].z, sl, lanev); xu.z = (lanev >= dl) ? c0 : p0; }
                                        { const unsigned c0 = sh_idx(rg[kq].w, sl, lanev), p0 = sh_idx(rg[3 + kq].w, sl, lanev); xu.w = (lanev >= dl) ? c0 : p0; }
                                        float x[8]; unpack8(xu, x);
                                        const float4 w0 = *(const float4*)(cw + (3 - dl) * 384), w1 = *(const float4*)(cw + (3 - dl) * 384 + 4);
                                        r[0] += w0.x * x[0]; r[1] += w0.y * x[1]; r[2] += w0.z * x[2]; r[3] += w0.w * x[3]; r[4] += w1.x * x[4]; r[5] += w1.y * x[5]; r[6] += w1.z * x[6]; r[7] += w1.w * x[7];
                                    }
                                    rg[3 + kq] = rg[kq];
                                    const float sc = which ? 1.0f : 0.10206207261596575f;
#pragma unroll
                                    for (int i = 0; i < 8; ++i) r[i] = r[i] * sigmoidf(r[i]) * sc;
                                    ux4 pk; pk.x = pg8::cvt_pk_bf16(r[0], r[1]); pk.y = pg8::cvt_pk_bf16(r[2], r[3]); pk.z = pg8::cvt_pk_bf16(r[4], r[5]); pk.w = pg8::cvt_pk_bf16(r[6], r[7]);
                                    if (which == 0) *(LAS ux4*)(Qs + s * 104 + 8 * cg) = pk;
                                    else { *(LAS ux4*)(Ks + s * 104 + 8 * cg) = pk; const float es = eArr[s]; LAS bf16* d = KTe + (8 * cg) * 72 + s;
#pragma unroll
                                        for (int i = 0; i < 8; ++i) d[72 * i] = f2bf(r[i] * es); }
                                }
                            } else {
#pragma unroll
                                for (int kq = 0; kq < 2; ++kq) {
                                    const int idx = tidv + NTHR * kq;
                                    if (idx < 768) {
                                        const int which = idx / 384, rem = idx % 384, cg = rem >> 6, s = rem & 63;
                                        float x1[8], x2[8]; { uint4 xu; xu.x = rg[kq].x; xu.y = rg[kq].y; xu.z = rg[kq].z; xu.w = rg[kq].w; unpack8(xu, x1); xu.x = rg[2 + kq].x; xu.y = rg[2 + kq].y; xu.z = rg[2 + kq].z; xu.w = rg[2 + kq].w; unpack8(xu, x2); }
                                        const unsigned rpw[8] = {rg[4 + 2 * kq].x, rg[4 + 2 * kq].y, rg[4 + 2 * kq].z, rg[4 + 2 * kq].w, rg[5 + 2 * kq].x, rg[5 + 2 * kq].y, rg[5 + 2 * kq].z, rg[5 + 2 * kq].w};
                                        float o1[8], o2[8]; const float sc = which ? 0.10206207261596575f : 1.0f;
#pragma unroll
                                        for (int q8 = 0; q8 < 8; ++q8) { const h2_t cs_ = __builtin_bit_cast(h2_t, rpw[q8]); const float c0 = (float)cs_.x, s0 = (float)cs_.y;
                                            o1[q8] = (x1[q8] * c0 - x2[q8] * s0) * sc; o2[q8] = (x2[q8] * c0 + x1[q8] * s0) * sc; }
                                        ux4 p1; p1.x = pg8::cvt_pk_bf16(o1[0], o1[1]); p1.y = pg8::cvt_pk_bf16(o1[2], o1[3]); p1.z = pg8::cvt_pk_bf16(o1[4], o1[5]); p1.w = pg8::cvt_pk_bf16(o1[6], o1[7]);
                                        ux4 p2; p2.x = pg8::cvt_pk_bf16(o2[0], o2[1]); p2.y = pg8::cvt_pk_bf16(o2[2], o2[3]); p2.z = pg8::cvt_pk_bf16(o2[4], o2[5]); p2.w = pg8::cvt_pk_bf16(o2[6], o2[7]);
                                        LAS bf16* dst = which ? Ks : Qs;
                                        *(LAS ux4*)(dst + s * 104 + 8 * cg) = p1; *(LAS ux4*)(dst + s * 104 + 48 + 8 * cg) = p2;
                                        if (which) { const float es = eArr[s]; LAS bf16* d = KTe + (8 * cg) * 72 + s;
#pragma unroll
                                            for (int i = 0; i < 8; ++i) { d[72 * i] = f2bf(o1[i] * es); d[72 * (48 + i)] = f2bf(o2[i] * es); } }
                                    }
                                }
                            }
                            if (c + 1 < SEQ / 64) LINATT_LOAD_RAW(c + 1);
                            LDS_BARRIER(); __builtin_amdgcn_sched_barrier(0);
                            {
                                bx8 yq[3];
#pragma unroll
                                for (int kk = 0; kk < 3; ++kk) yq[kk] = *(const LAS bx8*)(Qs + (16 * jt + tokv) * 104 + 32 * kk + 8 * sgv);
                                const int j = 16 * jt + tokv; const float Mj = MArr[j];
#pragma unroll
                                for (int q2 = 0; q2 < 2; ++q2) {
                                    const int st = 2 * half + q2; fx4 d = (fx4){0.f, 0.f, 0.f, 0.f};
                                    if (st <= jt) {
#pragma unroll
                                        for (int kk = 0; kk < 3; ++kk) { const bx8 xk = *(const LAS bx8*)(Ks + (16 * st + tokv) * 104 + 32 * kk + 8 * sgv); d = __builtin_amdgcn_mfma_f32_16x16x32_bf16(xk, yq[kk], d, 0, 0, 0); }
#pragma unroll
                                        for (int r = 0; r < 4; ++r) { const int s = 16 * st + 4 * sgv + r; d[r] = (s <= j) ? d[r] * __expf(aArr[s] - Mj) : 0.f; }
                                    }
                                    ux2 pw; pw.x = pg8::cvt_pk_bf16(d[0], d[1]); pw.y = pg8::cvt_pk_bf16(d[2], d[3]);
                                    *(LAS ux2*)(Ps + j * 72 + 16 * st + 4 * sgv) = pw;
                                }
                            }
                            LDS_BARRIER();
                            __builtin_amdgcn_sched_barrier(0);
                            if (kind == 1) {
                                const int j = tidv >> 3, part = tidv & 7; float dq = 0.f, dp = 0.f;
#pragma unroll
                                for (int i = 0; i < 12; ++i) dq += bf2f(Qs[j * 104 + part * 12 + i]) * nArr[part * 12 + i];
#pragma unroll
                                for (int s = 0; s < 8; ++s) dp += bf2f(Ps[j * 72 + part * 8 + s]);
                                float dn = interArr[j] * dq + dp; dn += sh_xor(dn, 1, lane); dn += sh_xor(dn, 2, lane); dn += sh_xor(dn, 4, lane);
                                if (part == 0) denArr[j] = dn;
                            }
                            __builtin_amdgcn_sched_barrier(0);
                            fx4 acc[6];
                            const size_t orow = row0 + 16 * jt + tokv;
                            ux2 ogate[6];
#pragma unroll
                            for (int x = 0; x < 6; ++x) ogate[x] = *(const ux2*)(proj + orow * LDP + 1536 + h * 192 + 16 * (6 * half + x) + 4 * sgv);
                            {
                                bx8 yq[3];
#pragma unroll
                                for (int kk = 0; kk < 3; ++kk) yq[kk] = *(const LAS bx8*)(Qs + (16 * jt + tokv) * 104 + 32 * kk + 8 * sgv);
#pragma unroll
                                for (int x = 0; x < 6; ++x) { acc[x] = (fx4){0.f, 0.f, 0.f, 0.f}; const int ct = 6 * half + x;
#pragma unroll
                                    for (int kk = 0; kk < 3; ++kk) { const bx8 xc = *(const LAS bx8*)(CT + (16 * ct + tokv) * 104 + 32 * kk + 8 * sgv); acc[x] = __builtin_amdgcn_mfma_f32_16x16x32_bf16(xc, yq[kk], acc[x], 0, 0, 0); } }
                                __builtin_amdgcn_sched_barrier(0);
                                const float in_j = interArr[16 * jt + tokv];
#pragma unroll
                                for (int x = 0; x < 6; ++x) acc[x] = acc[x] * in_j;
                                bx8 yp[2];
#pragma unroll
                                for (int kk = 0; kk < 2; ++kk) yp[kk] = *(const LAS bx8*)(Ps + (16 * jt + tokv) * 72 + 32 * kk + 8 * sgv);
#pragma unroll
                                for (int x = 0; x < 6; ++x) { const int ct = 6 * half + x;
#pragma unroll
                                    for (int kk = 0; kk < 2; ++kk) { const bx8 xv = *(const LAS bx8*)(VT + (16 * ct + tokv) * 72 + 32 * kk + 8 * sgv); acc[x] = __builtin_amdgcn_mfma_f32_16x16x32_bf16(xv, yp[kk], acc[x], 0, 0, 0); } }
                            }
                            __builtin_amdgcn_sched_barrier(0);
                            {
                                const float sa = scal[0];
                                bx8 yv[3][2];
#pragma unroll
                                for (int x = 0; x < 3; ++x)
#pragma unroll
                                    for (int kk = 0; kk < 2; ++kk) yv[x][kk] = *(const LAS bx8*)(VT + (16 * (ctU + x) + tokv) * 72 + 32 * kk + 8 * sgv);
#pragma unroll
                                for (int x = 0; x < 3; ++x) { bx8 xk[2];
#pragma unroll
                                    for (int kk = 0; kk < 2; ++kk) xk[kk] = *(const LAS bx8*)(KTe + (16 * (itU + x) + tokv) * 72 + 32 * kk + 8 * sgv);
#pragma unroll
                                    for (int y = 0; y < 3; ++y) { Cst[x][y] = Cst[x][y] * sa;
#pragma unroll
                                        for (int kk = 0; kk < 2; ++kk) Cst[x][y] = __builtin_amdgcn_mfma_f32_16x16x32_bf16(xk[kk], yv[y][kk], Cst[x][y], 0, 0, 0); } }
                                if (kind == 1 && tidv < 96) { float sn = 0.f;
#pragma unroll 8
                                    for (int s = 0; s < 64; ++s) sn += bf2f(KTe[tidv * 72 + s]);
                                    nreg = sa * nreg + sn; }
                            }
                            __builtin_amdgcn_sched_barrier(0);
                            LDS_BARRIER();
                            {
                                const int j = 16 * jt + tokv;
                                if (kind == 1) { const float dv = 1.0f / fmaxf(fabsf(denArr[j]), clampArr[j]);
#pragma unroll
                                    for (int x = 0; x < 6; ++x) acc[x] = acc[x] * dv; }
                                float s1 = 0.f, s2 = 0.f;
#pragma unroll
                                for (int x = 0; x < 6; ++x)
#pragma unroll
                                    for (int r = 0; r < 4; ++r) { s1 += acc[x][r]; s2 += acc[x][r] * acc[x][r]; }
                                s1 += sh_xor(s1, 16, lane); s1 += sh_xor(s1, 32, lane); s2 += sh_xor(s2, 16, lane); s2 += sh_xor(s2, 32, lane);
                                if (sgv == 0) { stat[(j * 2 + half) * 2 + 0] = s1; stat[(j * 2 + half) * 2 + 1] = s2; }
                            }
                            LDS_BARRIER();
                            {
                                const int j = 16 * jt + tokv;
                                const float mean = (stat[j * 4 + 0] + stat[j * 4 + 2]) * (1.0f / 192.0f);
                                const float var = (stat[j * 4 + 1] + stat[j * 4 + 3]) * (1.0f / 192.0f) - mean * mean;
                                const float rstd = 1.0f / sqrtf(fmaxf(var, 0.f) + LN_EPS);
#pragma unroll
                                for (int x = 0; x < 6; ++x) { const int colh = 16 * (6 * half + x) + 4 * sgv; const float4 g4 = *(const float4*)(norm_g + h * 192 + colh);
                                    const float o0 = __uint_as_float(ogate[x].x << 16), o1 = __uint_as_float(ogate[x].x & 0xffff0000u), o2 = __uint_as_float(ogate[x].y << 16), o3 = __uint_as_float(ogate[x].y & 0xffff0000u);
                                    float g0, g1, g2, g3;
                                    if (kind == 1) { g0 = sigmoidf(o0); g1 = sigmoidf(o1); g2 = sigmoidf(o2); g3 = sigmoidf(o3); } else { g0 = o0 * sigmoidf(o0); g1 = o1 * sigmoidf(o1); g2 = o2 * sigmoidf(o2); g3 = o3 * sigmoidf(o3); }
                                    ux2 ov; ov.x = pg8::cvt_pk_bf16((acc[x][0] - mean) * rstd * g4.x * g0, (acc[x][1] - mean) * rstd * g4.y * g1); ov.y = pg8::cvt_pk_bf16((acc[x][2] - mean) * rstd * g4.z * g2, (acc[x][3] - mean) * rstd * g4.w * g3);
                                    *(ux2*)(cat + orow * D + h * 192 + colh) = ov; }
#pragma unroll
                                for (int x = 0; x < 3; ++x)
#pragma unroll
                                    for (int y = 0; y < 3; ++y) { ux2 cw; cw.x = pg8::cvt_pk_bf16(Cst[x][y][0], Cst[x][y][1]); cw.y = pg8::cvt_pk_bf16(Cst[x][y][2], Cst[x][y][3]);
                                        *(LAS ux2*)(CT + (16 * (ctU + y) + tokv) * 104 + 16 * (itU + x) + 4 * sgv) = cw; }
                                if (kind == 1 && tidv < 96) nArr[tidv] = nreg;
                            }
                        }
                    }
                }
#else
                LAS float* sq = ldsf; LAS float* sk = ldsf + 96; LAS float* sg = ldsf + 192; LAS float* sred = ldsf + 256;
                const float* conv_q = (const float*)ARGP(17); const float* conv_k = (const float*)ARGP(18);
                const float* b_i = (const float*)ARGP(19); const float* b_f = (const float*)ARGP(20);
                const float* norm_g = (const float*)(kind == 1 ? ARGP(21) : ARGP(23));
                for (int unit = bid; unit < NB * 4; unit += G) {
                    const int b = unit >> 2, h = unit & 3;
                    const float gamma = 1.0f - exp2f(-5.0f - (float)h);
                    float C[96];
#pragma unroll
                    for (int i = 0; i < 96; ++i) C[i] = 0.f;
                    for (int t = 0; t < SEQ; ++t) {
                        const size_t row = (size_t)b * SEQ + t; const bf16* pr = proj + row * LDP;
                        if (tid < 192) {
                            const int c = tid % 96; const bool isk = tid >= 96; const int ch = h * 96 + c; const int col = (isk ? 384 : 0) + ch;
                            float s;
                            if (kind == 1) {
                                const float* cw = isk ? conv_k : conv_q; s = 0.f;
#pragma unroll
                                for (int w = 0; w < 4; ++w) { const int tt = t - 3 + w; if (tt >= 0) s += cw[w * 384 + ch] * bf2f(proj[((size_t)b * SEQ + tt) * LDP + col]); }
                                s = s * sigmoidf(s); if (!isk) s *= 0.10206207261596575f;
                            } else {
                                const int i = c % 48; const bool first = c < 48; const int cb = (isk ? 384 : 0) + h * 96;
                                const float t1 = bf2f(pr[cb + i]), t2 = bf2f(pr[cb + 48 + i]);
                                typedef _Float16 h2_t __attribute__((ext_vector_type(2))); const h2_t cs_ = __builtin_bit_cast(h2_t, ((const unsigned*)rope)[row * 48 + i]); const float cs = (float)cs_.x, sn = (float)cs_.y;
                                s = first ? (t1 * cs - t2 * sn) : (t2 * cs + t1 * sn); if (isk) s *= 0.10206207261596575f;
                            }
                            (isk ? sk : sq)[c] = s;
                        }
                        if (tid == 192) {
                            if (kind == 1) { const float ig = bf2f(pr[2304 + h]) + b_i[h], fg = bf2f(pr[2308 + h]) + b_f[h]; sg[0] = sigmoidf(fg); sg[1] = __expf(ig); }
                            else { sg[0] = gamma; sg[1] = 1.0f; }
                        }
                        __syncthreads();
                        const float f = sg[0], ei = sg[1];
                        float num = 0.f;
                        if (tid < 193) {
                            const float v = tid < 192 ? bf2f(pr[768 + h * 192 + tid]) : 1.0f;
#pragma unroll
                            for (int i = 0; i < 96; ++i) { C[i] = f * C[i] + (ei * sk[i]) * v; num += sq[i] * C[i]; if ((i & 15) == 15) asm volatile("" ::: "memory"); }
                            if (tid == 192) sg[2] = num;
                        }
                        __syncthreads();
                        float hv = num;
                        if (kind == 1) hv = num / fmaxf(fabsf(sg[2]), 1.0f);
                        float s1 = (tid < 192) ? hv : 0.f; s1 = wave_sum(s1, lane); if (lane == 0) sred[wave] = s1;
                        __syncthreads();
                        const float mean = (sred[0] + sred[1] + sred[2]) * (1.0f / 192.0f);
                        float dv = (tid < 192) ? (hv - mean) : 0.f; float s2 = wave_sum(dv * dv, lane); if (lane == 0) sred[8 + wave] = s2;
                        __syncthreads();
                        const float var = (sred[8] + sred[9] + sred[10]) * (1.0f / 192.0f);
                        if (tid < 192) {
                            const float yn = dv * (1.0f / sqrtf(var + LN_EPS)) * norm_g[h * 192 + tid];
                            const float ov = bf2f(pr[1536 + h * 192 + tid]);
                            const float outv = (kind == 1) ? sigmoidf(ov) * yn : (ov * sigmoidf(ov)) * yn;
                            cat[row * D + h * 192 + tid] = f2bf(outv);
                        }
                    }
                }
#endif
            }
            }
#if BG_CONV && FAST_MOE
            {
                const bool bg_here = (BG_ALL && LINATT_V2) ? true : (kind != 0);
                if (bg_here) {
                const bool s5_overlap = (kind == 0) && (G >= 192);
                if (!s5_overlap) __syncthreads();
                LAS float* scr = !s5_overlap ? ldsf + wave * (64 * 65) : (wave < 2 ? ldsf + wave * 8192 : ldsf + 16384 + (wave - 2) * (64 * 65));
                unsigned* qh = ctl + CW_CQ + 64 * L;
                constexpr int PERL = NEXP * (512 + 256), HALF2 = LINATT_V2 ? PERL / 2 : PERL;
                const int g0 = (BG_ALL && LINATT_V2) ? L * PERL : ((L == 1) ? PERL : 2 * PERL + HALF2), g1 = (BG_ALL && LINATT_V2) ? (L + 1) * PERL : ((L == 1) ? 2 * PERL + HALF2 : 4 * PERL);
                if (!s5_overlap || wave < 6)
                for (;;) {
                    int it = 0; if (lane == 0) it = (int)__hip_atomic_fetch_add(qh, 1u, __ATOMIC_RELAXED, __HIP_MEMORY_SCOPE_AGENT);
                    it = __builtin_amdgcn_readfirstlane(it) + g0;
                    if (it >= g1) break;
                    const int Lc = it / PERL; it = it % PERL;
                    if (it < NEXP * 512) { const int le = Lc * NEXP + (it >> 9);
#if MOE_FP8
                        tr_item8<LINATT_V2>((const float*)ARGP(42) + (size_t)le * D * 2 * DEXP, 2 * DEXP, D, wgu8 + (size_t)le * 2 * DEXP * D, 32, it & 511, scr, lane, GU_WS, [](int d) { const int tile = d >> 8, q = d & 255; return q < 128 ? tile * 128 + q : DEXP + tile * 128 + (q - 128); });
#else
                        tr_item((const float*)ARGP(42) + (size_t)le * D * 2 * DEXP, 2 * DEXP, D, wgu_t + (size_t)le * 2 * DEXP * D, 32, it & 511, scr, lane, [](int d) { const int tile = d >> 8, q = d & 255; return q < 128 ? tile * 128 + q : DEXP + tile * 128 + (q - 128); });
#endif
                    }
                    else { const int r = it - NEXP * 512; const int le = Lc * NEXP + (r >> 8);
#if MOE_FP8
                        tr_item8<LINATT_V2>((const float*)ARGP(44) + (size_t)le * DEXP * D, D, DEXP, wdn8 + (size_t)le * D * DEXP, 16, r & 255, scr, lane, DN_WS, [](int d) { return d; });
#else
                        tr_item((const float*)ARGP(44) + (size_t)le * DEXP * D, D, DEXP, wdn_t + (size_t)le * D * DEXP, 16, r & 255, scr, lane, [](int d) { return d; });
#endif
                    }
                }
                }
            }
#endif
            REPS(13) { if (rep_) __syncthreads();
#if FAST_XATTN
            {
                typedef pg8::bf16x8 bx8; typedef pg8::f32x4 fx4;
                LAS bf16* Kt = (LAS bf16*)lds;
                LAS bf16* Vt = (LAS bf16*)(lds + 36864);
                const int tok = lane & 15, sg = lane >> 4;
                const int xa_skip = (LINATT_V2 && kind != 0 && G > 192) ? 128 : 0;
                for (int unit = bid - xa_skip; unit >= 0 && unit < NB * 4 * 8; unit += G - xa_skip) {
                    const int b = unit >> 5, head = (unit >> 3) & 3, qt = unit & 7;
                    __syncthreads();
                    const bf16* kg = memK + (size_t)(b * 4 + head) * 256 * 64; const bf16* vg = memVT + (size_t)(b * 4 + head) * 64 * 256;
                    for (int c = tid; c < 2048; c += NTHR) { const int key = c >> 3, d8 = (c & 7) * 8; *(LAS pg8::u32x4*)(Kt + key * 72 + d8) = *(const pg8::u32x4*)(kg + key * 64 + d8); }
                    for (int c = tid; c < 2048; c += NTHR) { const int d = c >> 5, m = (c & 31) * 8; const pg8::u32x4 v = *(const pg8::u32x4*)(vg + d * 256 + m);
                        const int a = m >> 5, w = m & 31, tp = w >> 4, sk = (w & 15) >> 2;
                        pg8::u32x2 lo; lo.x = v.x; lo.y = v.y; pg8::u32x2 hi2; hi2.x = v.z; hi2.y = v.w;
                        *(LAS pg8::u32x2*)(Vt + d * 264 + 32 * a + 8 * sk + 4 * tp) = lo; *(LAS pg8::u32x2*)(Vt + d * 264 + 32 * a + 8 * (sk + 1) + 4 * tp) = hi2; }
                    __syncthreads();
#pragma unroll 1
                    for (int qi = 0; qi < 2; ++qi) {
                        const size_t row = (size_t)b * SEQ + qt * 256 + wave * 32 + qi * 16 + tok;
                        const bf16* qp = proj + row * LDP + xq_off + head * 64 + 8 * sg;
                        const bx8 q0 = __builtin_bit_cast(bx8, *(const uint4*)qp), q1 = __builtin_bit_cast(bx8, *(const uint4*)(qp + 32));
                        fx4 s[16];
#pragma unroll
                        for (int kt = 0; kt < 16; ++kt) { const bx8 k0 = *(const LAS bx8*)(Kt + (16 * kt + tok) * 72 + 8 * sg), k1 = *(const LAS bx8*)(Kt + (16 * kt + tok) * 72 + 32 + 8 * sg);
                            s[kt] = __builtin_amdgcn_mfma_f32_16x16x32_bf16(k0, q0, (fx4){0.f, 0.f, 0.f, 0.f}, 0, 0, 0); s[kt] = __builtin_amdgcn_mfma_f32_16x16x32_bf16(k1, q1, s[kt], 0, 0, 0); }
                        float mx = -3.0e38f;
#pragma unroll
                        for (int kt = 0; kt < 16; ++kt) mx = fmaxf(fmaxf(fmaxf(s[kt][0], s[kt][1]), fmaxf(s[kt][2], s[kt][3])), mx);
                        mx = fmaxf(mx, sh_xor(mx, 16, lane)); mx = fmaxf(mx, sh_xor(mx, 32, lane));
                        float sum = 0.f;
#pragma unroll
                        for (int kt = 0; kt < 16; ++kt)
#pragma unroll
                            for (int r = 0; r < 4; ++r) { const float pe = __expf((s[kt][r] - mx) * 0.125f); s[kt][r] = pe; sum += pe; }
                        sum += sh_xor(sum, 16, lane); sum += sh_xor(sum, 32, lane);
                        fx4 o[4];
#pragma unroll
                        for (int dt = 0; dt < 4; ++dt) o[dt] = (fx4){0.f, 0.f, 0.f, 0.f};
#pragma unroll
                        for (int a = 0; a < 8; ++a) {
                            uint4 pw; pw.x = pg8::cvt_pk_bf16(s[2 * a][0], s[2 * a][1]); pw.y = pg8::cvt_pk_bf16(s[2 * a][2], s[2 * a][3]); pw.z = pg8::cvt_pk_bf16(s[2 * a + 1][0], s[2 * a + 1][1]); pw.w = pg8::cvt_pk_bf16(s[2 * a + 1][2], s[2 * a + 1][3]);
                            const bx8 pf = __builtin_bit_cast(bx8, pw);
#pragma unroll
                            for (int dt = 0; dt < 4; ++dt) { const bx8 vf = *(const LAS bx8*)(Vt + (16 * dt + tok) * 264 + 32 * a + 8 * sg); o[dt] = __builtin_amdgcn_mfma_f32_16x16x32_bf16(vf, pf, o[dt], 0, 0, 0); }
                        }
                        const float inv = 1.0f / sum; bf16* op = cat + row * D + MIXW + head * 64 + 4 * sg;
#pragma unroll
                        for (int dt = 0; dt < 4; ++dt) { uint2 ov; ov.x = pg8::cvt_pk_bf16(o[dt][0] * inv, o[dt][1] * inv); ov.y = pg8::cvt_pk_bf16(o[dt][2] * inv, o[dt][3] * inv); *(uint2*)(op + 16 * dt) = ov; }
                    }
                }
            }
#else
            for (int wu = bid * NWAVES + wave; wu < (T / 16) * 4; wu += G * NWAVES) {
                const int head = wu & 3, row = (wu >> 2) * 16 + (lane >> 2), part = lane & 3, b = row / SEQ;
                float q[16], acc[16];
                { const bf16* qp = proj + (size_t)row * LDP + xq_off + head * 64 + part * 16;
                  unpack8(*(const uint4*)qp, q); unpack8(*(const uint4*)(qp + 8), q + 8);
#pragma unroll
                  for (int d = 0; d < 16; ++d) { q[d] *= 0.125f; acc[d] = 0.f; } }
                float mx = -3.0e38f, l = 0.f;
                const bf16* kb = memK + (size_t)(b * 4 + head) * 256 * 64 + part * 16; const bf16* vb = memV + (size_t)(b * 4 + head) * 256 * 64 + part * 16;
                for (int m = 0; m < NMEM; ++m) {
                    float kk[16]; unpack8(*(const uint4*)(kb + m * 64), kk); unpack8(*(const uint4*)(kb + m * 64 + 8), kk + 8);
                    float s = 0.f;
#pragma unroll
                    for (int j = 0; j < 16; ++j) s += q[j] * kk[j];
                    s += sh_xor(s, 1, lane); s += sh_xor(s, 2, lane);
                    const float mn = fmaxf(mx, s); const float corr = __expf(mx - mn), pv = __expf(s - mn); mx = mn; l = l * corr + pv;
                    float vv[16]; unpack8(*(const uint4*)(vb + m * 64), vv); unpack8(*(const uint4*)(vb + m * 64 + 8), vv + 8);
#pragma unroll
                    for (int j = 0; j < 16; ++j) acc[j] = acc[j] * corr + pv * vv[j];
                }
                const float il = 1.0f / l; bf16* op = cat + (size_t)row * D + MIXW + head * 64 + part * 16;
#pragma unroll
                for (int c = 0; c < 2; ++c) { uint4 o; o.x = pk2(acc[8 * c + 0] * il, acc[8 * c + 1] * il); o.y = pk2(acc[8 * c + 2] * il, acc[8 * c + 3] * il);
                    o.z = pk2(acc[8 * c + 4] * il, acc[8 * c + 5] * il); o.w = pk2(acc[8 * c + 6] * il, acc[8 * c + 7] * il); *(uint4*)(op + 8 * c) = o; }
            }
#endif
        } }
        SEAM(P + LP_MIXA);

        if (IN(P + LP_MIXB)) {
            PHASE_IDS();
            REPS(4) { if (rep_) __syncthreads();
            if (kind == 0) {
                const float* w_glu = (const float*)(L == 0 ? ARGP(14) : ARGP(33)); const float* b_glu = (const float*)(L == 0 ? ARGP(15) : ARGP(34));
#if FAST_DENSE
                { (void)w_glu; pg8::Gemm g{yg, wglu_t + (size_t)(L == 0 ? 0 : 1) * MiB, MIXW, nullptr}; pg8::StaticOrder S; S.init(T, MIXW, G, bid); pg8::EpiGlu E{cat, D, yg, MIXW, b_glu}; pg8::gemm_phase(lds, g, S, E, wave); }
#else
                oracle_gemm(ldsf, T, MIXW, MIXW,
                    [&](int) { return 0; },
                    [&](int m, int k) { return bf2f(yg[(size_t)m * MIXW + k]); },
                    [&](int k, int n, int) { return w_glu[(size_t)k * MIXW + n]; },
                    [&](int m0, int n0, float (&acc)[4][8], int) {
#pragma unroll
                        for (int i = 0; i < 4; ++i)
#pragma unroll
                            for (int j = 0; j < 8; ++j) { const int m = m0 + i, n = n0 + j; const float z = acc[i][j] + b_glu[n]; const float yv = bf2f(yg[(size_t)m * MIXW + n]);
                                cat[(size_t)m * D + n] = f2bf(yv * sigmoidf(z)); }
                    });
#endif
            }
        } }
        if (kind == 0) SEAM(P + LP_MIXB);

        if (IN(P + LP_OUTPROJ)) {
            PHASE_IDS();
            REPS(5) { if (rep_) __syncthreads();
            const float* w_out = (const float*)ARGP(35) + (size_t)L * D * D;
#if FAST_DENSE
            { (void)w_out; pg8::Gemm g{cat, wout_t + (size_t)L * D * D, D, nullptr}; pg8::StaticOrder S; S.init(T, D, G, bid);
#if RES_BF16
              pg8::EpiResBf16 E{(bf16*)y2, hb, D, DN_ALPHA}; pg8::gemm_phase(lds, g, S, E, wave); }
#else
              pg8::EpiResF32 E{y2, hf, D, DN_ALPHA}; pg8::gemm_phase(lds, g, S, E, wave); }
#endif
#else
            oracle_gemm(ldsf, T, D, D,
                [&](int) { return 0; },
                [&](int m, int k) { return bf2f(cat[(size_t)m * D + k]); },
                [&](int k, int n, int) { return w_out[(size_t)k * D + n]; },
                [&](int m0, int n0, float (&acc)[4][8], int) {
#pragma unroll
                    for (int i = 0; i < 4; ++i)
#pragma unroll
                        for (int j = 0; j < 8; ++j) { const size_t o = (size_t)(m0 + i) * D + n0 + j; y2[o] = DN_ALPHA * hf[o] + acc[i][j]; }
                });
#endif
        } }
        SEAM(P + LP_OUTPROJ);

        if (IN(P + LP_LN1)) {
            PHASE_IDS();
            REPS(8) { if (rep_) __syncthreads();
            const float* g1 = (const float*)ARGP(36) + L * D; const float* b1 = (const float*)ARGP(37) + L * D;
            const float* rw = (const float*)ARGP(40) + (size_t)L * D * NEXP; const float* rb = (const float*)ARGP(41) + L * NEXP;
#if FAST_LN1
            {
            typedef pg8::bf16x8 bx8; typedef pg8::f32x4 fx4; typedef pg8::u32x4 ux4;
            LAS bf16* SL = (LAS bf16*)lds;
            LAS float* stg = (LAS float*)(lds + 67584 + wave * 8320);
            LAS int* hist = (LAS int*)(lds + 67584 + 8 * 8320); LAS int* lbase = hist + 32; (void)lbase;
            const bf16* rw_g = rwt + (size_t)(L * 2) * NEXP * D;
#define LN1_SLICE_LOAD(dst, q) do { _Pragma("unroll") for (int i_ = 0; i_ < 4; ++i_) { const int c_ = tid + NTHR * i_; dst[i_] = *(const ux4*)(rw_g + (size_t)((c_ >> 10) * NEXP + ((c_ >> 5) & 31)) * D + 256 * (q) + 8 * (c_ & 31)); } } while (0)
#define LN1_SLICE_STORE(src_, buf) do { _Pragma("unroll") for (int i_ = 0; i_ < 4; ++i_) { const int c_ = tid + NTHR * i_; *(LAS ux4*)(SL + (((buf) * 2 + (c_ >> 10)) * 32 + ((c_ >> 5) & 31)) * 264 + 8 * (c_ & 31)) = src_[i_]; } } while (0)
            { ux4 s0[4]; LN1_SLICE_LOAD(s0, 0); LN1_SLICE_STORE(s0, 0); }
            LAS float* g1s = (LAS float*)(lds + LDS_RMAP); LAS float* b1s = g1s + D;
            for (int i = tid; i < D; i += NTHR) { g1s[i] = g1[i]; b1s[i] = b1[i]; }
            if (tid < 32) hist[tid] = 0;
            __syncthreads();
            const int tok = lane & 15, sg = lane >> 4;
            for (int wt = bid * NWAVES + wave; wt < T / 8; wt += G * NWAVES) {
                float4 v[8][4];
#pragma unroll
                for (int rr = 0; rr < 8; ++rr)
#pragma unroll
                    for (int j = 0; j < 4; ++j) {
#if RES_BF16
                        const uint2 yv_ = *(const uint2*)((const bf16*)y2 + ((size_t)wt * 8 + rr) * D + (lane + 64 * j) * 4);
                        v[rr][j] = make_float4(__uint_as_float(yv_.x << 16), __uint_as_float(yv_.x & 0xffff0000u), __uint_as_float(yv_.y << 16), __uint_as_float(yv_.y & 0xffff0000u));
#else
                        v[rr][j] = *(const float4*)(y2 + ((size_t)wt * 8 + rr) * D + (lane + 64 * j) * 4);
#endif
                    }
#pragma unroll
                for (int rr = 0; rr < 8; ++rr) {
                    float s = 0.f;
#pragma unroll
                    for (int j = 0; j < 4; ++j) s += (v[rr][j].x + v[rr][j].y) + (v[rr][j].z + v[rr][j].w);
                    const float mean = wave_sum(s, lane) * (1.0f / D); float s2 = 0.f;
#pragma unroll
                    for (int j = 0; j < 4; ++j) { v[rr][j].x -= mean; v[rr][j].y -= mean; v[rr][j].z -= mean; v[rr][j].w -= mean; s2 += (v[rr][j].x * v[rr][j].x + v[rr][j].y * v[rr][j].y) + (v[rr][j].z * v[rr][j].z + v[rr][j].w * v[rr][j].w); }
                    const float rstd = 1.0f / sqrtf(wave_sum(s2, lane) * (1.0f / D) + LN_EPS);
                    const size_t row = (size_t)wt * 8 + rr;
#pragma unroll
                    for (int j = 0; j < 4; ++j) { const int cc = (lane + 64 * j) * 4; const fx4 gq_ = *(const LAS fx4*)(g1s + cc), bq_ = *(const LAS fx4*)(b1s + cc); const float4 gg = make_float4(gq_[0], gq_[1], gq_[2], gq_[3]), bb = make_float4(bq_[0], bq_[1], bq_[2], bq_[3]);
                        float4 o; o.x = v[rr][j].x * rstd * gg.x + bb.x; o.y = v[rr][j].y * rstd * gg.y + bb.y; o.z = v[rr][j].z * rstd * gg.z + bb.z; o.w = v[rr][j].w * rstd * gg.w + bb.w;
                        v[rr][j] = o;
#if RES_BF16
                        { uint2 ob; ob.x = pg8::cvt_pk_bf16(o.x, o.y); ob.y = pg8::cvt_pk_bf16(o.z, o.w); *(uint2*)(hb + row * D + cc) = ob; }
#else
                        *(float4*)(hf + row * D + cc) = o;
#endif
#if MOE_FP8 && MOE_GATHER
                        { int w8 = __builtin_amdgcn_cvt_pk_fp8_f32(o.x, o.y, 0, false); w8 = __builtin_amdgcn_cvt_pk_fp8_f32(o.z, o.w, w8, true); *(int*)(hb8 + row * D + cc) = w8; }
#elif !RES_BF16
                        { uint2 ob; ob.x = pg8::cvt_pk_bf16(o.x, o.y); ob.y = pg8::cvt_pk_bf16(o.z, o.w); *(uint2*)(hb + row * D + cc) = ob; }
#endif
                    }
                }
                fx4 lacc[2]; lacc[0] = (fx4){0.f, 0.f, 0.f, 0.f}; lacc[1] = (fx4){0.f, 0.f, 0.f, 0.f};
#pragma unroll
                for (int j = 0; j < 4; ++j) {
                    ux4 snx[4]; if (j < 3) LN1_SLICE_LOAD(snx, j + 1);
#pragma unroll
                    for (int rr = 0; rr < 8; ++rr) *(LAS fx4*)(stg + rr * 260 + lane * 4) = (fx4){v[rr][j].x, v[rr][j].y, v[rr][j].z, v[rr][j].w};
                    asm volatile("s_waitcnt lgkmcnt(0)" ::: "memory");
#pragma unroll 2
                    for (int kk = 0; kk < 8; ++kk) {
                        fx4 f0 = (fx4){0.f, 0.f, 0.f, 0.f}, f1 = f0;
                        if (tok < 8) { f0 = *(const LAS fx4*)(stg + tok * 260 + 32 * kk + 8 * sg); f1 = *(const LAS fx4*)(stg + tok * 260 + 32 * kk + 8 * sg + 4); }
                        ux4 hw, lw;
                        hw.x = pg8::cvt_pk_bf16(f0[0], f0[1]); hw.y = pg8::cvt_pk_bf16(f0[2], f0[3]); hw.z = pg8::cvt_pk_bf16(f1[0], f1[1]); hw.w = pg8::cvt_pk_bf16(f1[2], f1[3]);
                        lw.x = pg8::cvt_pk_bf16(f0[0] - __uint_as_float(hw.x << 16), f0[1] - __uint_as_float(hw.x & 0xffff0000u)); lw.y = pg8::cvt_pk_bf16(f0[2] - __uint_as_float(hw.y << 16), f0[3] - __uint_as_float(hw.y & 0xffff0000u));
                        lw.z = pg8::cvt_pk_bf16(f1[0] - __uint_as_float(hw.z << 16), f1[1] - __uint_as_float(hw.z & 0xffff0000u)); lw.w = pg8::cvt_pk_bf16(f1[2] - __uint_as_float(hw.w << 16), f1[3] - __uint_as_float(hw.w & 0xffff0000u));
                        const bx8 yh = __builtin_bit_cast(bx8, hw), yl = __builtin_bit_cast(bx8, lw);
#pragma unroll
                        for (int t = 0; t < 2; ++t) { const int kcol = 32 * kk + 8 * sg;
                            const bx8 xh = *(const LAS bx8*)(SL + (((j & 1) * 2 + 0) * 32 + 16 * t + tok) * 264 + kcol); const bx8 xl = *(const LAS bx8*)(SL + (((j & 1) * 2 + 1) * 32 + 16 * t + tok) * 264 + kcol);
                            lacc[t] = __builtin_amdgcn_mfma_f32_16x16x32_bf16(xh, yh, lacc[t], 0, 0, 0); lacc[t] = __builtin_amdgcn_mfma_f32_16x16x32_bf16(xl, yh, lacc[t], 0, 0, 0); lacc[t] = __builtin_amdgcn_mfma_f32_16x16x32_bf16(xh, yl, lacc[t], 0, 0, 0); }
                    }
                    if (j < 3) LN1_SLICE_STORE(snx, (j + 1) & 1);
                    LDS_BARRIER();
                }
                if (wt + G * NWAVES < T / 8) { ux4 s0[4]; LN1_SLICE_LOAD(s0, 0); LN1_SLICE_STORE(s0, 0); LDS_BARRIER(); }
                float lv[8];
#pragma unroll
                for (int t = 0; t < 2; ++t) { const float4 rb4 = *(const float4*)(rb + 16 * t + 4 * sg); lv[4 * t + 0] = lacc[t][0] + rb4.x; lv[4 * t + 1] = lacc[t][1] + rb4.y; lv[4 * t + 2] = lacc[t][2] + rb4.z; lv[4 * t + 3] = lacc[t][3] + rb4.w; }
                float tv[4]; int ti[4];
#pragma unroll
                for (int k = 0; k < 4; ++k) {
                    float bv = -3.0e38f; int bi = 0;
#pragma unroll
                    for (int q = 0; q < 8; ++q) { const int e = 16 * (q >> 2) + 4 * sg + (q & 3); if (lv[q] > bv) { bv = lv[q]; bi = e; } }
#pragma unroll
                    for (int o = 16; o <= 32; o <<= 1) { const float ov = sh_xor(bv, o, lane); const int oi = sh_xor(bi, o, lane); if (ov > bv || (ov == bv && oi < bi)) { bv = ov; bi = oi; } }
                    tv[k] = bv; ti[k] = bi;
#pragma unroll
                    for (int q = 0; q < 8; ++q) { const int e = 16 * (q >> 2) + 4 * sg + (q & 3); if (e == bi) lv[q] = -3.0e38f; }
                }
                if (sg == 0 && tok < 8) {
                    const size_t row = (size_t)wt * 8 + tok; float ex[4], sum = 0.f;
#pragma unroll
                    for (int k = 0; k < 4; ++k) { ex[k] = __expf(tv[k] - tv[0]); sum += ex[k]; }
                    const float inv = 1.0f / sum;
                    *(int4*)(top_e + row * 4) = make_int4(ti[0], ti[1], ti[2], ti[3]); *(float4*)(top_g + row * 4) = make_float4(ex[0] * inv, ex[1] * inv, ex[2] * inv, ex[3] * inv);
#pragma unroll
                    for (int k = 0; k < 4; ++k) ti[k] |= atomicAdd((int*)&hist[ti[k]], 1) << 8;
                }
#if MOE_SPARSE
                __syncthreads();
                if (tid < 32) { const int hc = hist[tid]; lbase[tid] = hc ? (int)atomicAdd(ctl + CW_CNT + 64 * L + tid, (unsigned)hc) : 0; hist[tid] = 0; }
                __syncthreads();
                if (sg == 0 && tok < 8) { const size_t row = (size_t)wt * 8 + tok; int dd[4];
#pragma unroll
                    for (int k = 0; k < 4; ++k) { const int e = ti[k] & 255; dd[k] = e * T + lbase[e] + (ti[k] >> 8); row_tok[dd[k]] = (int)row; }
                    *(int4*)(dest + row * 4) = make_int4(dd[0], dd[1], dd[2], dd[3]); }
#endif
            }
#if !MOE_SPARSE
            __syncthreads();
            if (rep_ == 0 && tid < 32 && hist[tid] != 0) atomicAdd(ctl + CW_CNT + 64 * L + tid, (unsigned)hist[tid]);
#endif
            __syncthreads();
            }
#else
            LAS float* rows = ldsf; LAS float* lg = ldsf + 16 * 1024; LAS int* hist = (LAS int*)(ldsf + 16 * 1024 + 512);
            if (tid < 32) hist[tid] = 0;
            __syncthreads();
            for (int tile = bid; tile < T / 16; tile += G) {
#pragma unroll
                for (int rr = 0; rr < 2; ++rr) {
                    const int r = 2 * wave + rr; const size_t row = (size_t)tile * 16 + r;
                    float4 v[4]; float s = 0.f;
#pragma unroll
                    for (int j = 0; j < 4; ++j) { v[j] = *(const float4*)(y2 + row * D + (lane + 64 * j) * 4); s += (v[j].x + v[j].y) + (v[j].z + v[j].w); }
                    const float mean = wave_sum(s, lane) * (1.0f / D); float s2 = 0.f;
#pragma unroll
                    for (int j = 0; j < 4; ++j) { v[j].x -= mean; v[j].y -= mean; v[j].z -= mean; v[j].w -= mean; s2 += (v[j].x * v[j].x + v[j].y * v[j].y) + (v[j].z * v[j].z + v[j].w * v[j].w); }
                    const float rstd = 1.0f / sqrtf(wave_sum(s2, lane) * (1.0f / D) + LN_EPS);
#pragma unroll
                    for (int j = 0; j < 4; ++j) { const int c = (lane + 64 * j) * 4; const float4 gg = *(const float4*)(g1 + c), bb = *(const float4*)(b1 + c);
                        float4 o; o.x = v[j].x * rstd * gg.x + bb.x; o.y = v[j].y * rstd * gg.y + bb.y; o.z = v[j].z * rstd * gg.z + bb.z; o.w = v[j].w * rstd * gg.w + bb.w;
                        *(float4*)(hf + row * D + c) = o; uint2 ob; ob.x = pk2(o.x, o.y); ob.y = pk2(o.z, o.w); *(uint2*)(hb + row * D + c) = ob;
                        rows[r * 1024 + c + 0] = o.x; rows[r * 1024 + c + 1] = o.y; rows[r * 1024 + c + 2] = o.z; rows[r * 1024 + c + 3] = o.w; }
                }
                __syncthreads();
                { const int r = tid >> 5, e = tid & 31; float a = rb[e];
                  for (int k = 0; k < D; ++k) a += rows[r * 1024 + k] * rw[(size_t)k * NEXP + e];
                  lg[r * 32 + e] = a; }
                __syncthreads();
                if (tid < 16) {
                    const size_t row = (size_t)tile * 16 + tid; float tv[4]; int ti[4];
#pragma unroll
                    for (int k = 0; k < 4; ++k) { float best = -3.0e38f; int bi = 0;
                        for (int e = 0; e < NEXP; ++e) { const float v = lg[tid * 32 + e]; if (v > best) { best = v; bi = e; } }
                        tv[k] = best; ti[k] = bi; lg[tid * 32 + bi] = -3.0e38f; }
                    float ex[4], sum = 0.f;
#pragma unroll
                    for (int k = 0; k < 4; ++k) { ex[k] = __expf(tv[k] - tv[0]); sum += ex[k]; }
#pragma unroll
                    for (int k = 0; k < 4; ++k) { top_e[row * 4 + k] = ti[k]; top_g[row * 4 + k] = ex[k] / sum; atomicAdd((int*)&hist[ti[k]], 1); }
                }
                __syncthreads();
            }
            if (rep_ == 0 && tid < 32 && hist[tid] != 0) atomicAdd(ctl + CW_CNT + 64 * L + tid, (unsigned)hist[tid]);
            __syncthreads();
#endif
        } }
        SEAM(P + LP_LN1);

        if (!MOE_SPARSE && IN(P + LP_DISP)) {
            PHASE_IDS();
            REPS(9) { if (rep_) __syncthreads();
            LAS int* pstart = (LAS int*)ldsf; LAS int* lh = pstart + 32; LAS int* lbase = pstart + 64; LAS int* ldest = pstart + 128;
            if (tid == 0) { int a = 0; for (int e = 0; e < NEXP; ++e) { const int c = (int)__hip_atomic_load(ctl + CW_CNT + 64 * L + e, __ATOMIC_RELAXED, __HIP_MEMORY_SCOPE_AGENT); pstart[e] = a; a += ((c + MOEBLK - 1) / MOEBLK) * MOEBLK; } }
            __syncthreads();
#if MOE_GATHER
            for (int idx = bid * NTHR + tid; idx < NEXP * MOEBLK; idx += G * NTHR) { const int e = idx >> 8, r = idx & 255; const int cnt = (int)__hip_atomic_load(ctl + CW_CNT + 64 * L + e, __ATOMIC_RELAXED, __HIP_MEMORY_SCOPE_AGENT);
                const int padded = ((cnt + MOEBLK - 1) / MOEBLK) * MOEBLK; if (cnt + r < padded) row_tok[pstart[e] + cnt + r] = 0; }
#endif
            for (int tile = bid; tile < T * TOPK / NTHR; tile += G) {
                if (tid < 32) lh[tid] = 0;
                __syncthreads();
                const int pair = tile * NTHR + tid; const int e = top_e[pair];
                int dd;
                if (rep_ == 0) {
                const int rank = atomicAdd((int*)&lh[e], 1);
                __syncthreads();
                if (tid < 32) lbase[tid] = lh[tid] ? (int)atomicAdd(ctl + CW_CUR + 64 * L + tid, (unsigned)lh[tid]) : 0;
                __syncthreads();
                dd = pstart[e] + lbase[e] + rank; dest[pair] = dd; } else dd = dest[pair];
                ldest[tid] = dd;
#if MOE_GATHER
                if (rep_ == 0) row_tok[dd] = pair >> 2;
#endif
                __syncthreads();
#if !MOE_GATHER
                for (int i = 0; i < 64; ++i) { const int pp = wave * 64 + i; const int d2 = ldest[pp]; const int tt = (tile * NTHR + pp) >> 2;
                    const uint4* src = (const uint4*)(hb + (size_t)tt * D); uint4* dst = (uint4*)(xr + (size_t)d2 * D);
                    dst[lane] = src[lane]; dst[lane + 64] = src[lane + 64]; }
#endif
                __syncthreads();
            }
        } }
        if (!MOE_SPARSE) SEAM(P + LP_DISP);

        if (IN(P + LP_GU) || IN(P + LP_DOWN)) {
            PHASE_IDS();
            LAS int* pend = (LAS int*)(lds + LDS_MISC + 512);
            if (tid == 0) { int a = 0; for (int e = 0; e < NEXP; ++e) { const int c = (int)__hip_atomic_load(ctl + CW_CNT + 64 * L + e, __ATOMIC_RELAXED, __HIP_MEMORY_SCOPE_AGENT); a += ((c + MOEBLK - 1) / MOEBLK) * MOEBLK; pend[e] = a; } }
            __syncthreads();
        }
        if (IN(P + LP_GU)) {
            PHASE_IDS();
            REPS(6) { if (rep_) __syncthreads();
            const LAS int* pend = (const LAS int*)(lds + LDS_MISC + 512);
            const int nrows = pend[NEXP - 1];
            const float* wgu = (const float*)ARGP(42) + (size_t)L * NEXP * D * 2 * DEXP; const float* bgu = (const float*)ARGP(43) + (size_t)L * NEXP * 2 * DEXP;
#if FAST_MOE
            { (void)wgu; pg8::MoeOrder S{pend, nrows / 256, 8, G, vcu};
#if MOE_GATHER && MOE_FP8
              pg8::EpiSwiglu<true> E{act8, bgu, 1.0f / GU_WS};
              LAS int* rmapL = (LAS int*)(lds + LDS_RMAP);
              { pg8::Unit uu; for (int i = 0; i < 15 && S.next(i, uu); ++i) { if (tid < 256) { const int rt_ = row_tok[uu.pm * 256 + tid]; rmapL[i * 256 + tid] = rt_ < 0 ? 0 : (rt_ < T ? rt_ : T - 1); } } }
              __syncthreads();
              pg8::Gemm g{(const pg8::bf16_t*)hb8, (const pg8::bf16_t*)(wgu8 + (size_t)L * NEXP * 2 * DEXP * D), D, rmapL}; pg8::gemm_phase<pg8::EpiSwiglu<true>, pg8::MoeOrder, true, true, true, true>(lds, g, S, E, wave);
#elif MOE_GATHER
              pg8::EpiSwiglu<false> E{act, bgu, 1.0f};
              LAS int* rmapL = (LAS int*)(lds + LDS_RMAP);
              { pg8::Unit uu; for (int i = 0; i < 15 && S.next(i, uu); ++i) { if (tid < 256) { const int rt_ = row_tok[uu.pm * 256 + tid]; rmapL[i * 256 + tid] = rt_ < 0 ? 0 : (rt_ < T ? rt_ : T - 1); } } }
              __syncthreads();
              pg8::Gemm g{hb, wgu_t + (size_t)L * NEXP * 2 * DEXP * D, D, rmapL}; pg8::gemm_phase<pg8::EpiSwiglu<false>, pg8::MoeOrder, true, true, true>(lds, g, S, E, wave);
#else
              pg8::EpiSwiglu<false> E{act, bgu, 1.0f};
              pg8::Gemm g{xr, wgu_t + (size_t)L * NEXP * 2 * DEXP * D, D, nullptr}; pg8::gemm_phase(lds, g, S, E, wave);
#endif
            }
#else
            oracle_gemm(ldsf, nrows, 2 * DEXP, D,
                [&](int tm) { return expert_of_block(pend, tm >> 1); },
                [&](int m, int k) { return bf2f(xr[(size_t)m * D + k]); },
                [&](int k, int n, int e) { const int tn = n >> 7, v = n & 127; const int c = tn * 64 + (v >> 1) + ((v & 1) ? DEXP : 0); return wgu[((size_t)e * D + k) * (2 * DEXP) + c]; },
                [&](int m0, int n0, float (&acc)[4][8], int e) {
                    const int tn = n0 >> 7, v0 = n0 & 127;
#pragma unroll
                    for (int i = 0; i < 4; ++i)
#pragma unroll
                        for (int jj = 0; jj < 4; ++jj) { const int c = tn * 64 + (v0 >> 1) + jj;
                            const float xg = fminf(acc[i][2 * jj] + bgu[(size_t)e * 2 * DEXP + c], 7.0f);
                            const float xl = fminf(fmaxf(acc[i][2 * jj + 1] + bgu[(size_t)e * 2 * DEXP + DEXP + c], -7.0f), 7.0f);
                            act[(size_t)(m0 + i) * DEXP + c] = f2bf(xg * sigmoidf(1.702f * xg) * (xl + 1.0f)); }
                });
#endif
        } }
        SEAM(P + LP_GU);

        if (IN(P + LP_DOWN)) {
            PHASE_IDS();
            REPS(7) { if (rep_) __syncthreads();
            const LAS int* pend = (const LAS int*)(lds + LDS_MISC + 512);
            const int nrows = pend[NEXP - 1];
            const float* wd = (const float*)ARGP(44) + (size_t)L * NEXP * DEXP * D; const float* bd = (const float*)ARGP(45) + (size_t)L * NEXP * D;
#if FAST_MOE
            { (void)wd; pg8::MoeOrder S{pend, nrows / 256, 4, G, vcu};
#if MOE_FP8 && MOE_GATHER
              pg8::Gemm g{(const pg8::bf16_t*)act8, (const pg8::bf16_t*)(wdn8 + (size_t)L * NEXP * D * DEXP), DEXP, nullptr};
#if YR_FP8
              pg8::EpiBf16T<true> E{(unsigned char*)yr, D, bd, D, 1.0f / DN_WS};
              pg8::gemm_phase<pg8::EpiBf16T<true>, pg8::MoeOrder, true, true, false, true>(lds, g, S, E, wave);
#else
              pg8::EpiBf16 E{yr, D, bd, D, 1.0f / DN_WS};
              pg8::gemm_phase<pg8::EpiBf16, pg8::MoeOrder, true, true, false, true>(lds, g, S, E, wave);
#endif
#else
              pg8::Gemm g{act, wdn_t + (size_t)L * NEXP * D * DEXP, DEXP, nullptr}; pg8::EpiBf16 E{yr, D, bd, D, 1.0f}; pg8::gemm_phase(lds, g, S, E, wave);
#endif
            }
#else
            oracle_gemm(ldsf, nrows, D, DEXP,
                [&](int tm) { return expert_of_block(pend, tm >> 1); },
                [&](int m, int k) { return bf2f(act[(size_t)m * DEXP + k]); },
                [&](int k, int n, int e) { return wd[((size_t)e * DEXP + k) * D + n]; },
                [&](int m0, int n0, float (&acc)[4][8], int e) {
#pragma unroll
                    for (int i = 0; i < 4; ++i)
#pragma unroll
                        for (int j = 0; j < 8; ++j) yr[(size_t)(m0 + i) * D + n0 + j] = f2bf(acc[i][j] + bd[(size_t)e * D + n0 + j]);
                });
#endif
        } }
        SEAM(P + LP_DOWN);

        if (IN(P + LP_COMB)) {
            PHASE_IDS();
            REPS(10) { const bool dummy_ = (rep_ == 0) && ((REP_MASK >> 10) & 1);
            const float* g2 = (const float*)ARGP(38) + L * D; const float* b2 = (const float*)ARGP(39) + L * D;
            LAS float* g2s = ldsf; LAS float* b2s = ldsf + D;
            for (int i = tid; i < D; i += NTHR) { g2s[i] = g2[i]; b2s[i] = b2[i]; }
            __syncthreads();
            const int l32 = lane & 31, hw = lane >> 5;
            const int row_first = 2 * (bid * NWAVES + wave) + hw;
            int4 d4n = make_int4(0, 0, 0, 0); float4 g4n = make_float4(0.f, 0.f, 0.f, 0.f);
            if (row_first < T) { d4n = *(const int4*)(dest + (size_t)row_first * 4); g4n = *(const float4*)(top_g + (size_t)row_first * 4); }
            for (int row = row_first; row < T; row += 2 * G * NWAVES) {
                int dd[4]; float gg[4];
                { const int4 d4 = d4n; const float4 g4 = g4n; dd[0] = d4.x; dd[1] = d4.y; dd[2] = d4.z; dd[3] = d4.w; gg[0] = g4.x; gg[1] = g4.y; gg[2] = g4.z; gg[3] = g4.w;
                  const int rown = row + 2 * G * NWAVES; if (rown < T) { d4n = *(const int4*)(dest + (size_t)rown * 4); g4n = *(const float4*)(top_g + (size_t)rown * 4); } }
                float4 v[8]; float s = 0.f;
#pragma unroll
                for (int j = 0; j < 8; ++j) { const int c = (l32 + 32 * j) * 4;
#if RES_BF16
                    const uint2 hv_ = *(const uint2*)(hb + (size_t)row * D + c); const float4 hv = make_float4(__uint_as_float(hv_.x << 16), __uint_as_float(hv_.x & 0xffff0000u), __uint_as_float(hv_.y << 16), __uint_as_float(hv_.y & 0xffff0000u));
#else
                    const float4 hv = *(const float4*)(hf + (size_t)row * D + c);
#endif
                    float4 a; a.x = DN_ALPHA * hv.x; a.y = DN_ALPHA * hv.y; a.z = DN_ALPHA * hv.z; a.w = DN_ALPHA * hv.w;
                    float mo[4] = {0.f, 0.f, 0.f, 0.f};
#pragma unroll
                    for (int k = 0; k < 4; ++k) {
#if YR_FP8 && MOE_FP8 && MOE_GATHER
                        typedef float f32x2_ __attribute__((ext_vector_type(2)));
                        const int yw = *(const int*)((const unsigned char*)yr + (size_t)dd[k] * D + c); const f32x2_ y01 = __builtin_amdgcn_cvt_pk_f32_fp8(yw, false), y23 = __builtin_amdgcn_cvt_pk_f32_fp8(yw, true);
                        mo[0] += gg[k] * y01.x; mo[1] += gg[k] * y01.y; mo[2] += gg[k] * y23.x; mo[3] += gg[k] * y23.y;
#else
                        const uint2 yv = *(const uint2*)(yr + (size_t)dd[k] * D + c);
                        mo[0] += gg[k] * __uint_as_float(yv.x << 16); mo[1] += gg[k] * __uint_as_float(yv.x & 0xffff0000u);
                        mo[2] += gg[k] * __uint_as_float(yv.y << 16); mo[3] += gg[k] * __uint_as_float(yv.y & 0xffff0000u);
#endif
                    }
                    a.x += mo[0]; a.y += mo[1]; a.z += mo[2]; a.w += mo[3];
                    v[j] = a; s += (a.x + a.y) + (a.z + a.w); }
#pragma unroll
                for (int o = 1; o < 32; o <<= 1) s += sh_xor(s, o, lane);
                const float mean = s * (1.0f / D); float s2 = 0.f;
#pragma unroll
                for (int j = 0; j < 8; ++j) { v[j].x -= mean; v[j].y -= mean; v[j].z -= mean; v[j].w -= mean; s2 += (v[j].x * v[j].x + v[j].y * v[j].y) + (v[j].z * v[j].z + v[j].w * v[j].w); }
#pragma unroll
                for (int o = 1; o < 32; o <<= 1) s2 += sh_xor(s2, o, lane);
                const float rstd = 1.0f / sqrtf(s2 * (1.0f / D) + LN_EPS);
#pragma unroll
                for (int j = 0; j < 8; ++j) { const int c = (l32 + 32 * j) * 4; const pg8::f32x4 gq = *(const LAS pg8::f32x4*)(g2s + c), bq = *(const LAS pg8::f32x4*)(b2s + c); const float4 gv = make_float4(gq[0], gq[1], gq[2], gq[3]), bv = make_float4(bq[0], bq[1], bq[2], bq[3]);
                    float4 o; o.x = v[j].x * rstd * gv.x + bv.x; o.y = v[j].y * rstd * gv.y + bv.y; o.z = v[j].z * rstd * gv.z + bv.z; o.w = v[j].w * rstd * gv.w + bv.w;
                    if (dummy_) *(float4*)(y2 + (size_t)row * D + c) = o;
                    else if (L == DEPTH - 1) *(float4*)(((float*)ARGP(46)) + (size_t)row * D + c) = o;
                    else {
#if !RES_BF16
                        *(float4*)(hf + (size_t)row * D + c) = o;
#endif
                        uint2 ob; ob.x = pg8::cvt_pk_bf16(o.x, o.y); ob.y = pg8::cvt_pk_bf16(o.z, o.w); *(uint2*)(hb + (size_t)row * D + c) = ob; } }
            }
        } }
        SEAM(P + LP_COMB);
    }
#undef IN
#undef SEAM
}

extern "C" void kernel_launch(void* const* d_in, const int* in_sizes, int n_in, void* d_out, int out_size, void* d_ws, size_t ws_size, hipStream_t stream) {
    static int grid = 0;
    if (grid == 0) {
        if (n_in != 46 || out_size != T * D || ws_size < WS_END) { fprintf(stderr, "kernel_launch: unexpected problem (n_in %d, out %d, ws %zu < %zu)\n", n_in, out_size, ws_size, (size_t)WS_END); grid = -1; return; }
        int dev = 0, cus = 0, per_cu = 0;
        if (hipGetDevice(&dev) != hipSuccess || hipDeviceGetAttribute(&cus, hipDeviceAttributeMultiprocessorCount, dev) != hipSuccess) { grid = -1; return; }
        if (hipFuncSetAttribute((const void*)mk_fwd, hipFuncAttributeMaxDynamicSharedMemorySize, LDS_BYTES) != hipSuccess) { fprintf(stderr, "kernel_launch: hipFuncSetAttribute failed\n"); grid = -1; return; }
        if (hipOccupancyMaxActiveBlocksPerMultiprocessor(&per_cu, (const void*)mk_fwd, NTHR, LDS_BYTES) != hipSuccess || per_cu < 1) fprintf(stderr, "kernel_launch: occupancy query says %d\n", per_cu);
        (void)hipGetLastError();
        grid = cus;
    }
    if (grid < 0) return;
    (void)hipMemsetAsync((char*)d_ws + WS_CTL, 0, CTL_BYTES, stream);
    Args a{};
    for (int i = 0; i < 46; ++i) a.in[i] = d_in[i];
    a.out = (float*)d_out; a.ws = (unsigned char*)d_ws;
#if MK_ONE_LAUNCH
    a.ph_lo = 0; a.ph_hi = PH_TOTAL;
    hipLaunchKernelGGL(mk_fwd, dim3(grid), dim3(NTHR), LDS_BYTES, stream, a);
#else
    for (int p = 0; p < PH_TOTAL; ++p) {
        const int j = (p - PH_L0) % PH_PER_LAYER, L = (p - PH_L0) / PH_PER_LAYER;
        if (p >= PH_L0 && j == LP_MIXB && (L % 3) != 0) continue;
        a.ph_lo = p; a.ph_hi = p + 1;
        hipLaunchKernelGGL(mk_fwd, dim3(grid), dim3(NTHR), LDS_BYTES, stream, a);
    }
#endif
}
```
